# Optimizing an MI355X kernel written in HIP

```python
import math
import jax, jax.numpy as jnp
from jax import lax
import numpy as np

D_MODEL = 1024
BATCH = 2
SEQ = 8192
DEPTH = 2

CHUNK = 64
N_META = 16
SSM_WIDTH = D_MODEL // 2
SSM_GROUP = 16
SSM_GROUPS = SSM_WIDTH // SSM_GROUP
SSM_STATE = 64
DT_MIN = 0.001
DT_MAX = 0.1
CONV_WIDTH = D_MODEL // 2
CONV_K = 3
ATTN_HEADS = 8
ATTN_HEAD_DIM = 64
ATTN_VALUE_DIM = 2 * ATTN_HEAD_DIM
ATTN_WIDTH = ATTN_HEADS * ATTN_VALUE_DIM
ROPE_THETA = 10000.0
Q_BLOCK = 128
N_BRANCH = 3
IN_WIDTH = SSM_WIDTH + 3 * CONV_WIDTH + 3 * ATTN_WIDTH
N_EXPERTS = 32
TOP_K = 4
D_FF = D_MODEL
SWIGLU_LIMIT = 7.0
SWIGLU_ALPHA = 1.702
DEEPNORM_ALPHA = (2.0 * DEPTH) ** 0.25
DEEPNORM_BETA = (8.0 * DEPTH) ** -0.25
LN_EPS = 1e-5
RMS_EPS = 1e-5
NEG_INF = -1e30

kernel_name = "hybrid_s5_shortconv_diffattn_moe_deepnorm"


def layer_norm(x, g, b):
    xf = x.astype(jnp.float32)
    mu = xf.mean(-1, keepdims=True)
    var = jnp.square(xf - mu).mean(-1, keepdims=True)
    return ((xf - mu) * lax.rsqrt(var + LN_EPS) * g.astype(jnp.float32) + b.astype(jnp.float32)).astype(x.dtype)


def rope_tables(length):
    pos = jnp.arange(length, dtype=jnp.float32)
    inv = ROPE_THETA ** (-jnp.arange(0, ATTN_HEAD_DIM, 2, dtype=jnp.float32) / ATTN_HEAD_DIM)
    ang = pos[:, None] * inv[None, :]
    ang = jnp.concatenate([ang, ang], axis=-1)
    return jnp.cos(ang), jnp.sin(ang)


def apply_rope(x, cos, sin):
    xf = x.astype(jnp.float32)
    half = ATTN_HEAD_DIM // 2
    rot = jnp.concatenate([-xf[..., half:], xf[..., :half]], axis=-1)
    c = cos[None, :, None, None, :]
    s = sin[None, :, None, None, :]
    return (xf * c + rot * s).astype(x.dtype)


def chunk_ids(length, padded_len):
    p = jnp.arange(padded_len)
    cid = jnp.where(p < N_META, 0, 1 + (p - N_META) // CHUNK)
    return jnp.where(p < length, cid, padded_len)


def _complex_affine_combine(e1, e2):
    a1r, a1i, b1r, b1i = e1
    a2r, a2i, b2r, b2i = e2
    ar = a2r * a1r - a2i * a1i
    ai = a2r * a1i + a2i * a1r
    br = a2r * b1r - a2i * b1i + b2r
    bi = a2r * b1i + a2i * b1r + b2i
    return (ar, ai, br, bi)


def s5_branch(u, lam_re, lam_im, log_dt, b_re, b_im, c_re, c_im, d_skip, w_glu):
    bsz, length, _ = u.shape
    f32 = jnp.float32
    uf = u.astype(f32).reshape(bsz, length, SSM_GROUPS, SSM_GROUP)
    lr = lam_re.astype(f32)
    li = lam_im.astype(f32)
    dt = jnp.exp(log_dt.astype(f32))[:, None]
    mag = jnp.exp(lr * dt)
    ar = mag * jnp.cos(li * dt)
    ai = mag * jnp.sin(li * dt)
    denom = lr * lr + li * li
    nr, ni = ar - 1.0, ai
    coef_r = (nr * lr + ni * li) / denom
    coef_i = (ni * lr - nr * li) / denom
    br, bi = b_re.astype(f32), b_im.astype(f32)
    bbar_r = coef_r[..., None] * br - coef_i[..., None] * bi
    bbar_i = coef_r[..., None] * bi + coef_i[..., None] * br
    bu_r = jnp.einsum('blgc,gpc->blgp', uf, bbar_r)
    bu_i = jnp.einsum('blgc,gpc->blgp', uf, bbar_i)
    a_r = jnp.broadcast_to(ar, bu_r.shape)
    a_i = jnp.broadcast_to(ai, bu_i.shape)
    _, _, xr, xi = lax.associative_scan(_complex_affine_combine, (a_r, a_i, bu_r, bu_i), axis=1)
    y = (jnp.einsum('gcp,blgp->blgc', c_re.astype(f32), xr)
         - jnp.einsum('gcp,blgp->blgc', c_im.astype(f32), xi)
         + d_skip.astype(f32).reshape(SSM_GROUPS, SSM_GROUP) * uf)
    y = jax.nn.gelu(y.reshape(bsz, length, SSM_WIDTH))
    y = y * jax.nn.sigmoid(y @ w_glu.astype(f32))
    return y.astype(u.dtype)


def short_conv_branch(gate_b, gate_c, h, conv_w):
    z = gate_c * h
    length = z.shape[1]
    zp = jnp.pad(z, ((0, 0), (CONV_K - 1, 0), (0, 0)))
    y = zp[:, 0:length] * conv_w[0]
    for j in range(1, CONV_K):
        y = y + zp[:, j:j + length] * conv_w[j]
    return gate_b * y


def diff_attention(q, k, v, lam, lam_init, subln_g):
    bsz, length = q.shape[0], q.shape[1]
    padded = -(-length // Q_BLOCK) * Q_BLOCK
    n_blocks = padded // Q_BLOCK
    pad = padded - length
    q = jnp.pad(q, ((0, 0), (0, pad), (0, 0), (0, 0), (0, 0)))
    k = jnp.pad(k, ((0, 0), (0, pad), (0, 0), (0, 0), (0, 0)))
    v = jnp.pad(v, ((0, 0), (0, pad), (0, 0), (0, 0)))
    cid = chunk_ids(length, padded)
    q_blocks = q.reshape(bsz, n_blocks, Q_BLOCK, ATTN_HEADS, 2, ATTN_HEAD_DIM).transpose(1, 0, 2, 3, 4, 5)
    cid_blocks = cid.reshape(n_blocks, Q_BLOCK)
    scale = ATTN_HEAD_DIM ** -0.5

    def one_block(args):
        qi, ci = args
        s = jnp.einsum('bqhcd,bkhcd->bchqk', qi, k).astype(jnp.float32) * scale
        mask = ci[:, None] >= cid[None, :]
        s = jnp.where(mask, s, NEG_INF)
        p = jax.nn.softmax(s, axis=-1)
        p = p[:, 0] - lam * p[:, 1]
        return jnp.einsum('bhqk,bkhe->bqhe', p.astype(v.dtype), v)

    o = lax.map(one_block, (q_blocks, cid_blocks))
    o = o.transpose(1, 0, 2, 3, 4).reshape(bsz, padded, ATTN_HEADS, ATTN_VALUE_DIM)[:, :length]
    of = o.astype(jnp.float32)
    of = of * lax.rsqrt(jnp.mean(of * of, axis=-1, keepdims=True) + RMS_EPS)
    of = of * subln_g.astype(jnp.float32) * (1.0 - lam_init)
    return of.reshape(bsz, length, ATTN_WIDTH).astype(q.dtype)


def moe_ffn(h, router_w, router_b, w_gu, b_gu, w_down, b_down):
    bsz, length, d = h.shape
    xt = h.reshape(bsz * length, d)
    logits = (xt @ router_w + router_b).astype(jnp.float32)
    top_v, top_i = lax.top_k(logits, TOP_K)
    top_w = jax.nn.softmax(top_v, axis=-1)
    combine = jnp.einsum('tk,tke->te', top_w, jax.nn.one_hot(top_i, N_EXPERTS, dtype=jnp.float32))

    def expert_step(acc, ex):
        wgu, bgu, wd, bd, cw = ex
        gu = xt @ wgu + bgu
        gate = jnp.minimum(gu[:, :D_FF], SWIGLU_LIMIT)
        up = jnp.clip(gu[:, D_FF:], -SWIGLU_LIMIT, SWIGLU_LIMIT)
        hid = (up + 1.0) * gate * jax.nn.sigmoid(SWIGLU_ALPHA * gate)
        out = hid @ wd + bd
        return acc + cw[:, None] * out.astype(jnp.float32), None

    acc0 = jnp.zeros((bsz * length, d), jnp.float32)
    out, _ = lax.scan(expert_step, acc0, (w_gu, b_gu, w_down, b_down, combine.T))
    return out.reshape(bsz, length, d).astype(h.dtype)


def setup_inputs(seed: int = 0) -> dict:
    key = jax.random.key(seed)
    ks = jax.random.split(key, 40)
    f32 = jnp.float32

    def nrm(k, shape, scale):
        return jax.random.normal(k, shape, f32) * scale

    D = D_MODEL
    col_scale = jnp.concatenate([jnp.ones((IN_WIDTH - ATTN_WIDTH,), f32),
                                 jnp.full((ATTN_WIDTH,), DEEPNORM_BETA, f32)])
    n = jnp.arange(SSM_STATE, dtype=f32)
    return {
        "x": nrm(ks[0], (BATCH, SEQ, D), 1.0),
        "meta_tokens": nrm(ks[1], (N_META, D), 1.0),
        "ln_in_g": 1.0 + nrm(ks[2], (D,), 0.01),
        "ln_in_b": nrm(ks[3], (D,), 0.01),
        "w_in": nrm(ks[4], (DEPTH, D, IN_WIDTH), D ** -0.5) * col_scale,
        "ssm_lambda_re": -0.5 + nrm(ks[5], (DEPTH, SSM_GROUPS, SSM_STATE), 0.01),
        "ssm_lambda_im": math.pi * n + nrm(ks[6], (DEPTH, SSM_GROUPS, SSM_STATE), 0.01),
        "ssm_log_dt": jax.random.uniform(ks[7], (DEPTH, SSM_GROUPS), f32, math.log(DT_MIN), math.log(DT_MAX)),
        "ssm_b_re": nrm(ks[8], (DEPTH, SSM_GROUPS, SSM_STATE, SSM_GROUP), (2 * SSM_GROUP) ** -0.5),
        "ssm_b_im": nrm(ks[9], (DEPTH, SSM_GROUPS, SSM_STATE, SSM_GROUP), (2 * SSM_GROUP) ** -0.5),
        "ssm_c_re": nrm(ks[10], (DEPTH, SSM_GROUPS, SSM_GROUP, SSM_STATE), (2 * SSM_STATE) ** -0.5),
        "ssm_c_im": nrm(ks[11], (DEPTH, SSM_GROUPS, SSM_GROUP, SSM_STATE), (2 * SSM_STATE) ** -0.5),
        "ssm_d": nrm(ks[12], (DEPTH, SSM_WIDTH), 1.0),
        "ssm_w_glu": nrm(ks[13], (DEPTH, SSM_WIDTH, SSM_WIDTH), SSM_WIDTH ** -0.5),
        "ssm_w_out": nrm(ks[14], (DEPTH, SSM_WIDTH, D), SSM_WIDTH ** -0.5),
        "conv_w": nrm(ks[15], (DEPTH, CONV_K, CONV_WIDTH), CONV_K ** -0.5),
        "conv_w_out": nrm(ks[16], (DEPTH, CONV_WIDTH, D), CONV_WIDTH ** -0.5),
        "attn_lambda_q1": nrm(ks[17], (DEPTH, ATTN_HEAD_DIM), 0.1),
        "attn_lambda_k1": nrm(ks[18], (DEPTH, ATTN_HEAD_DIM), 0.1),
        "attn_lambda_q2": nrm(ks[19], (DEPTH, ATTN_HEAD_DIM), 0.1),
        "attn_lambda_k2": nrm(ks[20], (DEPTH, ATTN_HEAD_DIM), 0.1),
        "attn_subln_g": 1.0 + nrm(ks[21], (DEPTH, ATTN_VALUE_DIM), 0.01),
        "attn_w_out": nrm(ks[22], (DEPTH, ATTN_WIDTH, D), ATTN_WIDTH ** -0.5),
        "gate_w": nrm(ks[23], (DEPTH, D, N_BRANCH * D), D ** -0.5),
        "gate_b": nrm(ks[24], (DEPTH, N_BRANCH * D), 0.01),
        "w_o": nrm(ks[25], (DEPTH, D, D), D ** -0.5 * DEEPNORM_BETA),
        "ln1_g": 1.0 + nrm(ks[26], (DEPTH, D), 0.01),
        "ln1_b": nrm(ks[27], (DEPTH, D), 0.01),
        "router_w": nrm(ks[28], (DEPTH, D, N_EXPERTS), D ** -0.5),
        "router_b": nrm(ks[29], (DEPTH, N_EXPERTS), 0.01),
        "expert_w_gu": nrm(ks[30], (DEPTH, N_EXPERTS, D, 2 * D_FF), D ** -0.5),
        "expert_b_gu": nrm(ks[31], (DEPTH, N_EXPERTS, 2 * D_FF), 0.01),
        "expert_w_down": nrm(ks[32], (DEPTH, N_EXPERTS, D_FF, D), D_FF ** -0.5 * DEEPNORM_BETA),
        "expert_b_down": nrm(ks[33], (DEPTH, N_EXPERTS, D), 0.01),
        "ln2_g": 1.0 + nrm(ks[34], (DEPTH, D), 0.01),
        "ln2_b": nrm(ks[35], (DEPTH, D), 0.01),
    }


def reference(x, meta_tokens, ln_in_g, ln_in_b, w_in, ssm_lambda_re, ssm_lambda_im, ssm_log_dt,
              ssm_b_re, ssm_b_im, ssm_c_re, ssm_c_im, ssm_d, ssm_w_glu, ssm_w_out, conv_w, conv_w_out,
              attn_lambda_q1, attn_lambda_k1, attn_lambda_q2, attn_lambda_k2, attn_subln_g, attn_w_out,
              gate_w, gate_b, w_o, ln1_g, ln1_b, router_w, router_b, expert_w_gu, expert_b_gu,
              expert_w_down, expert_b_down, ln2_g, ln2_b):
    bsz, seq, d = x.shape
    meta = jnp.broadcast_to(meta_tokens.astype(x.dtype)[None], (bsz, N_META, d))
    h = jnp.concatenate([meta, x], axis=1)
    length = h.shape[1]
    h = layer_norm(h, ln_in_g, ln_in_b)
    cos, sin = rope_tables(length)
    s0 = SSM_WIDTH
    s1 = s0 + CONV_WIDTH
    s2 = s1 + CONV_WIDTH
    s3 = s2 + CONV_WIDTH
    s4 = s3 + ATTN_WIDTH
    s5 = s4 + ATTN_WIDTH
    for l in range(DEPTH):
        proj = h @ w_in[l]
        u_ssm = proj[..., :s0]
        cb, cc, ch = proj[..., s0:s1], proj[..., s1:s2], proj[..., s2:s3]
        q = proj[..., s3:s4].reshape(bsz, length, ATTN_HEADS, 2, ATTN_HEAD_DIM)
        k = proj[..., s4:s5].reshape(bsz, length, ATTN_HEADS, 2, ATTN_HEAD_DIM)
        v = proj[..., s5:].reshape(bsz, length, ATTN_HEADS, ATTN_VALUE_DIM)
        y_ssm = s5_branch(u_ssm, ssm_lambda_re[l], ssm_lambda_im[l], ssm_log_dt[l], ssm_b_re[l], ssm_b_im[l],
                          ssm_c_re[l], ssm_c_im[l], ssm_d[l], ssm_w_glu[l]) @ ssm_w_out[l]
        y_conv = short_conv_branch(cb, cc, ch, conv_w[l]) @ conv_w_out[l]
        lam_init = 0.8 - 0.6 * math.exp(-0.3 * l)
        lam = (jnp.exp(jnp.sum(attn_lambda_q1[l].astype(jnp.float32) * attn_lambda_k1[l].astype(jnp.float32)))
               - jnp.exp(jnp.sum(attn_lambda_q2[l].astype(jnp.float32) * attn_lambda_k2[l].astype(jnp.float32)))
               + lam_init)
        y_attn = diff_attention(apply_rope(q, cos, sin), apply_rope(k, cos, sin), v, lam, lam_init,
                                attn_subln_g[l]) @ attn_w_out[l]
        g = jax.nn.sigmoid(h @ gate_w[l] + gate_b[l]).reshape(bsz, length, N_BRANCH, d)
        merged = g[:, :, 0] * y_ssm + g[:, :, 1] * y_conv + g[:, :, 2] * y_attn
        h = layer_norm(DEEPNORM_ALPHA * h + merged @ w_o[l], ln1_g[l], ln1_b[l])
        ffn = moe_ffn(h, router_w[l], router_b[l], expert_w_gu[l], expert_b_gu[l], expert_w_down[l], expert_b_down[l])
        h = layer_norm(DEEPNORM_ALPHA * h + ffn, ln2_g[l], ln2_b[l])
    return h[:, N_META:]
```

```cpp
#define SELFCHK 1
#include <hip/hip_runtime.h>
#include <cstdio>
#include <cstdint>
namespace pg8 {
#define PG8_LAS __attribute__((address_space(3)))
typedef unsigned short bf16_t;
typedef short bf16x8 __attribute__((ext_vector_type(8)));
typedef float f32x4 __attribute__((ext_vector_type(4)));
typedef unsigned u32x4 __attribute__((ext_vector_type(4)));
constexpr int BM = 256, BK = 64, HALF = 128, HTB = HALF * BK * 2  , STAGE_BYTES = 8 * HTB, NXCD = 8, WGM = 8;

__host__ __device__ __forceinline__ int lds_byte(int r, int c) { const int st = (r >> 4) * 2 + (c >> 5), rr = r & 15, cc = c & 31, ob = rr * 64 + cc * 2; return st * 1024 + (ob ^ (((ob >> 9) & 1) << 5)); }
__host__ __device__ __forceinline__ void stage_rc(int b, int& R, int& C) { const int st = b / 1024, sb = b % 1024, swz = sb ^ (((sb >> 9) & 1) << 5); R = (st >> 1) * 16 + swz / 64; C = (st & 1) * 32 + (swz % 64) / 2; }
__host__ __device__ __forceinline__ int perm32(int rho) { const int n = rho >> 4, i = rho & 15; return 8 * (i >> 2) + 4 * n + (i & 3); }

struct Unit { int pm, pn; };
struct Gemm { const bf16_t* A; const bf16_t* Bt; int lda, ldb, K; };

struct StaticOrder {
    int nM, nN, nwg, G, c;
    __host__ __device__ void init(int M, int N, int G_, int c_) { nM = M / BM; nN = N / BM; nwg = nM * nN; G = G_; c = c_; }
    __host__ __device__ bool next(int i, Unit& u) const {
        const long L = (long)i * G + c; if (L >= nwg) return false;
        int wgid = (int)L; { const int q = nwg / NXCD, r = nwg % NXCD, xcd = wgid % NXCD, off = wgid / NXCD; wgid = (xcd < r ? xcd * (q + 1) : r * (q + 1) + (xcd - r) * q) + off; }
        const int nig = WGM * nN, gid = wgid / nig, fm = gid * WGM, gsz = (nM - fm) < WGM ? (nM - fm) : WGM;
        u.pm = fm + ((wgid % nig) % gsz); u.pn = (wgid % nig) / gsz; return true;
    }
    __device__ __forceinline__ void a_ready(const Unit&) const {}
    __device__ __forceinline__ void done(const Unit&) const {}
};

__device__ __forceinline__ unsigned cvt_pk_bf16(float lo, float hi) { unsigned r; asm volatile("v_cvt_pk_bf16_f32 %0, %1, %2" : "=v"(r) : "v"(lo), "v"(hi)); return r; }
typedef float f32x2 __attribute__((ext_vector_type(2)));
typedef unsigned u32x2 __attribute__((ext_vector_type(2)));
__device__ __forceinline__ u32x4 pack8(f32x4 a, f32x4 b) { u32x4 w; w.x = cvt_pk_bf16(a[0], a[1]); w.y = cvt_pk_bf16(a[2], a[3]); w.z = cvt_pk_bf16(b[0], b[1]); w.w = cvt_pk_bf16(b[2], b[3]); return w; }
__device__ __forceinline__ u32x2 pack4(f32x4 a) { u32x2 w; w.x = cvt_pk_bf16(a[0], a[1]); w.y = cvt_pk_bf16(a[2], a[3]); return w; }
__device__ __forceinline__ float bf_lo(unsigned w) { return __uint_as_float(w << 16); }
__device__ __forceinline__ float bf_hi(unsigned w) { return __uint_as_float(w & 0xffff0000u); }
__device__ __forceinline__ void unpack8(u32x4 w, f32x4& a, f32x4& b) { a = (f32x4){bf_lo(w.x), bf_hi(w.x), bf_lo(w.y), bf_hi(w.y)}; b = (f32x4){bf_lo(w.z), bf_hi(w.z), bf_lo(w.w), bf_hi(w.w)}; }
__device__ __forceinline__ float sigm(float x) { return __builtin_amdgcn_rcpf(1.0f + __builtin_amdgcn_exp2f(-1.4426950408889634f * x)); }
__device__ __forceinline__ f32x4 sigm4(f32x4 v) { return (f32x4){sigm(v[0]), sigm(v[1]), sigm(v[2]), sigm(v[3])}; }
__device__ __forceinline__ float gelu_t(float x) { const float u = 0.7978845608028654f * (x + 0.044715f * x * x * x); return x * sigm(2.0f * u); }
__device__ __forceinline__ f32x4 gelu4(f32x4 v) { return (f32x4){gelu_t(v[0]), gelu_t(v[1]), gelu_t(v[2]), gelu_t(v[3])}; }

constexpr int MREAL = 16384, MVALID = 16416;
constexpr float QSCALE = 0.125f * 1.4426950408889634f;
__device__ __forceinline__ int kv_row(int R) { return R < MREAL ? (R >> 13) * 8320 + (R & 8191) : ((R - MREAL) >> 4) * 8320 + 8256 + ((R - MREAL) & 15); }

#define EPI_ROWS(R) _Pragma("unroll") for (int ai = 0; ai < 2; ++ai) _Pragma("unroll") for (int m = 0; m < 4; ++m) { const int R = rbase + ai * HALF + m * 16;
#define EPI_COLS _Pragma("unroll") for (int bj = 0; bj < 2; ++bj) {
#define EPI_END }

struct EpiP1 {
    static constexpr bool PERM = true, AFTER_DRAIN = false;
    bf16_t *UC, *UMETA, *CONVB, *Q, *K, *V, *GB; const float* rope; const float* gate_b;
    __device__ __forceinline__ void operator()(const f32x4 (&acc)[2][2][4][2], const Unit& u, int wr, int wc, int fr, int fq) const {
        const int pn = u.pn, rbase = u.pm * BM + wr * 64 + fr, cw = wc * 32 + 8 * fq;
        if (pn < 2) {
            EPI_ROWS(R)
                if (R < MREAL) { const int chunkrow = (R >> 13) * 128 + ((R & 8191) >> 6), s = R & 63;
                    EPI_COLS const int c = pn * 256 + bj * HALF + cw; *(u32x4*)(UC + ((size_t)((c >> 4) * 256 + chunkrow) * 1152 + s * 16 + (c & 15))) = pack8(acc[ai][bj][m][0], acc[ai][bj][m][1]); EPI_END }
                else if (R < MVALID) {
                    EPI_COLS const int c = pn * 256 + bj * HALF + cw; *(u32x4*)(UMETA + (size_t)(R - MREAL) * 512 + c) = pack8(acc[ai][bj][m][0], acc[ai][bj][m][1]); EPI_END }
            EPI_END
        } else if (pn < 8) {
            EPI_ROWS(R)
                if (R < MVALID) { EPI_COLS const int c = (pn - 2) * 256 + bj * HALF + cw; *(u32x4*)(CONVB + (size_t)R * 1536 + c) = pack8(acc[ai][bj][m][0], acc[ai][bj][m][1]); EPI_END }
            EPI_END
        } else if (pn < 16) {
            const bool isq = pn < 12; const int ct = (pn - (isq ? 8 : 12)) * 256; bf16_t* dstb = isq ? Q : K; const float sc = isq ? QSCALE : 1.0f;
            EPI_ROWS(R)
                if (R < MVALID) { const int pos = R < MREAL ? 16 + (R & 8191) : ((R - MREAL) & 15); const size_t drow = isq ? (size_t)R : (size_t)kv_row(R);
                    EPI_COLS const int c = ct + bj * HALF + cw, hh = c >> 6, gq = (c & 63) >> 3;
                        const f32x4 cs = *(const f32x4*)(rope + (size_t)pos * 64 + 4 * gq), sn = *(const f32x4*)(rope + (size_t)pos * 64 + 32 + 4 * gq);
                        const f32x4 x0 = acc[ai][bj][m][0], x1 = acc[ai][bj][m][1];
                        const f32x4 lo = (x0 * cs - x1 * sn) * sc, hi = (x1 * cs + x0 * sn) * sc;
                        bf16_t* d = dstb + drow * 1024 + hh * 64 + 4 * gq; *(u32x2*)d = pack4(lo); *(u32x2*)(d + 32) = pack4(hi); EPI_END }
            EPI_END
        } else if (pn < 20) {
            EPI_ROWS(R)
                if (R < MVALID) { const size_t drow = (size_t)kv_row(R);
                    EPI_COLS const int c = (pn - 16) * 256 + bj * HALF + cw; *(u32x4*)(V + drow * 1024 + c) = pack8(acc[ai][bj][m][0], acc[ai][bj][m][1]); EPI_END }
            EPI_END
        } else {
            f32x4 b0[2], b1[2];
#pragma unroll
            for (int bj = 0; bj < 2; ++bj) { const int c = (pn - 20) * 256 + bj * HALF + cw; b0[bj] = *(const f32x4*)(gate_b + c); b1[bj] = *(const f32x4*)(gate_b + c + 4); }
            EPI_ROWS(R)
                if (R < MVALID) { EPI_COLS const int c = (pn - 20) * 256 + bj * HALF + cw;
                    *(u32x4*)(GB + (size_t)R * 3072 + c) = pack8(sigm4(acc[ai][bj][m][0] + b0[bj]), sigm4(acc[ai][bj][m][1] + b1[bj])); EPI_END }
            EPI_END
        }
    }
};
struct EpiSloc {
    static constexpr bool PERM = false, AFTER_DRAIN = false;
    float* SL;
    __device__ __forceinline__ void operator()(const f32x4 (&acc)[2][2][4][2], const Unit& u, int wr, int wc, int fr, int fq) const {
        const int rbase = u.pm * BM + wr * 64 + fr, col0 = wc * 32 + 4 * fq;
        EPI_ROWS(R)
            float* rowp = SL + (size_t)R * 128 + col0;
#pragma unroll
            for (int n = 0; n < 2; ++n) *(f32x4*)(rowp + n * 16) = acc[ai][0][m][n];
        EPI_END
    }
};
struct EpiY {
    static constexpr bool PERM = true, AFTER_DRAIN = false;
    bf16_t* YG;
    __device__ __forceinline__ void operator()(const f32x4 (&acc)[2][2][4][2], const Unit& u, int wr, int wc, int fr, int fq) const {
        const int g = u.pm, nt = u.pn & 3, rbase = wr * 64 + fr, cw = wc * 32 + 8 * fq;
        EPI_ROWS(R)
            const int b = R >> 7, k = R & 127;
            EPI_COLS const int n = nt * 256 + bj * HALF + cw, t = n >> 4, co0 = n & 15; const size_t row = (size_t)b * 8192 + k * 64 + t;
                *(u32x4*)(YG + row * 512 + g * 16 + co0) = pack8(gelu4(acc[ai][bj][m][0]), gelu4(acc[ai][bj][m][1])); EPI_END
        EPI_END
    }
};
struct EpiGLU {
    static constexpr bool PERM = true, AFTER_DRAIN = false;
    const bf16_t* YG; bf16_t* YS;
    __device__ __forceinline__ void operator()(const f32x4 (&acc)[2][2][4][2], const Unit& u, int wr, int wc, int fr, int fq) const {
        const int rbase = u.pm * BM + wr * 64 + fr, cw = wc * 32 + 8 * fq;
        EPI_ROWS(R)
            EPI_COLS const int c = u.pn * 256 + bj * HALF + cw; f32x4 ya, yb; unpack8(*(const u32x4*)(YG + (size_t)R * 512 + c), ya, yb);
                *(u32x4*)(YS + (size_t)R * 512 + c) = pack8(ya * sigm4(acc[ai][bj][m][0]), yb * sigm4(acc[ai][bj][m][1])); EPI_END
        EPI_END
    }
};
template <int I> struct EpiMerge {
    static constexpr bool PERM = true, AFTER_DRAIN = false;
    const bf16_t* GB; bf16_t* MG;
    __device__ __forceinline__ void operator()(const f32x4 (&acc)[2][2][4][2], const Unit& u, int wr, int wc, int fr, int fq) const {
        const int rbase = u.pm * BM + wr * 64 + fr, cw = wc * 32 + 8 * fq;
        EPI_ROWS(R)
            EPI_COLS const int c = u.pn * 256 + bj * HALF + cw; f32x4 ga, gb; unpack8(*(const u32x4*)(GB + (size_t)R * 3072 + I * 1024 + c), ga, gb);
                f32x4 oa = ga * acc[ai][bj][m][0], ob = gb * acc[ai][bj][m][1];
                if (I > 0) { f32x4 pa, pb; unpack8(*(const u32x4*)(MG + (size_t)R * 1024 + c), pa, pb); oa += pa; ob += pb; }
                *(u32x4*)(MG + (size_t)R * 1024 + c) = pack8(oa, ob); EPI_END
        EPI_END
    }
};
struct EpiPre {
    static constexpr bool PERM = false, AFTER_DRAIN = false;
    const float* HF; float* PRE; float alpha;
    __device__ __forceinline__ void operator()(const f32x4 (&acc)[2][2][4][2], const Unit& u, int wr, int wc, int fr, int fq) const {
        const int rbase = u.pm * BM + wr * 64 + fr, col0 = u.pn * BM + wc * 32 + 4 * fq;
        EPI_ROWS(R)
            EPI_COLS
#pragma unroll
                for (int n = 0; n < 2; ++n) { const size_t off = (size_t)R * 1024 + col0 + bj * HALF + n * 16; *(f32x4*)(PRE + off) = *(const f32x4*)(HF + off) * alpha + acc[ai][bj][m][n]; }
            EPI_END
        EPI_END
    }
};
struct EpiSwiGLU {
    static constexpr bool PERM = true, AFTER_DRAIN = false;
    bf16_t* HID; const float* bgu;
    __device__ __forceinline__ void operator()(const f32x4 (&acc)[2][2][4][2], const Unit& u, int wr, int wc, int fr, int fq) const {
        const int e = u.pn >> 3, nt = u.pn & 7, rbase = u.pm * BM + wr * 64 + fr, hw = wc * 16 + 4 * fq;
        f32x4 bg[2], bu[2];
#pragma unroll
        for (int bj = 0; bj < 2; ++bj) { const int hcol = nt * 128 + bj * 64 + hw; bg[bj] = *(const f32x4*)(bgu + (size_t)e * 2048 + hcol); bu[bj] = *(const f32x4*)(bgu + (size_t)e * 2048 + 1024 + hcol); }
        EPI_ROWS(R)
            EPI_COLS const int hcol = nt * 128 + bj * 64 + hw; const f32x4 gt = acc[ai][bj][m][0] + bg[bj], up = acc[ai][bj][m][1] + bu[bj]; f32x4 h;
#pragma unroll
                for (int i = 0; i < 4; ++i) { const float gg = fminf(gt[i], 7.0f), uu = fminf(fmaxf(up[i], -7.0f), 7.0f); h[i] = (uu + 1.0f) * gg * sigm(1.702f * gg); }
                *(u32x2*)(HID + (size_t)R * 1024 + hcol) = pack4(h); EPI_END
        EPI_END
    }
};
struct EpiDown {
    static constexpr bool PERM = true, AFTER_DRAIN = false;
    bf16_t* OUTS; const float* bdn;
    __device__ __forceinline__ void operator()(const f32x4 (&acc)[2][2][4][2], const Unit& u, int wr, int wc, int fr, int fq) const {
        const int e = u.pn >> 2, nt = u.pn & 3, rbase = u.pm * BM + wr * 64 + fr, cw = wc * 32 + 8 * fq;
        f32x4 b0[2], b1[2];
#pragma unroll
        for (int bj = 0; bj < 2; ++bj) { const int c = nt * 256 + bj * HALF + cw; b0[bj] = *(const f32x4*)(bdn + (size_t)e * 1024 + c); b1[bj] = *(const f32x4*)(bdn + (size_t)e * 1024 + c + 4); }
        EPI_ROWS(R)
            EPI_COLS const int c = nt * 256 + bj * HALF + cw; *(u32x4*)(OUTS + (size_t)R * 1024 + c) = pack8(acc[ai][bj][m][0] + b0[bj], acc[ai][bj][m][1] + b1[bj]); EPI_END
        EPI_END
    }
};
struct FirstN {
    int n, div, G, c;
    __device__ __forceinline__ bool next(int i, Unit& u) const { const int L = i * G + c; if (L >= n) return false; u.pm = L / div; u.pn = L; return true; }
    __device__ __forceinline__ void a_ready(const Unit&) const {}
    __device__ __forceinline__ void done(const Unit&) const {}
};
struct MoeOrder {
    const PG8_LAS int* tb; int nN, G, c;
    __device__ __forceinline__ bool next(int i, Unit& u) const {
        const int L = i * G + c, mtg = L / nN; if (mtg >= tb[32]) return false;
        int e = 0; while (tb[e + 1] <= mtg) ++e;
        u.pm = mtg; u.pn = e * nN + (L - mtg * nN); return true; }
    __device__ __forceinline__ void a_ready(const Unit&) const {}
    __device__ __forceinline__ void done(const Unit&) const {}
};
template <class Epi, class Sched, bool ALIGN_EPI = false, bool SP2 = false>
__device__ __forceinline__ void gemm_phase(PG8_LAS unsigned char* lds, const Gemm g, const Sched& S, const Epi& E) {
    int tid_ = threadIdx.x; asm volatile("" : "+v"(tid_));
    const int tid = tid_, wid = __builtin_amdgcn_readfirstlane(tid >> 6), lane = tid & 63, wr = wid >> 2, wc = wid & 3, fr = lane & 15, fq = lane >> 4;
    const int K = g.K, nt = K / BK;
    unsigned voffA[2], voffB[2];
#pragma unroll
    for (int i = 0; i < 2; ++i) { int R, C; stage_rc(tid * 16 + i * 8192, R, C); const int Rb = Epi::PERM ? ((R & ~31) + perm32(R & 31)) : R;
        voffA[i] = (unsigned)(R * g.lda + C) * 2u; voffB[i] = (unsigned)(Rb * g.ldb + C) * 2u; }
    const size_t kstep = (size_t)(BK * 2);
    const size_t hstepA = (size_t)HALF * g.lda * 2, hstepB = (size_t)HALF * g.ldb * 2;
    const size_t tstepA = 2 * hstepA, tstepB = 2 * hstepB;
    const unsigned ldsw = (unsigned)wid * 1024u;
    const int aoff = lds_byte(wr * 64 + fr, fq * 8), boff = lds_byte(wc * 32 + fr, fq * 8);
#define PG8_SA(b, h) (((b) * 2 + (h)) * HTB)
#define PG8_SB(b, h) ((4 + (b) * 2 + (h)) * HTB)
#define PG8_STAGE(bufoff, gbase, voff) do { _Pragma("unroll") for (int _i = 0; _i < 2; ++_i) \
        __builtin_amdgcn_global_load_lds((const unsigned*)((const char*)(gbase) + (voff)[_i]), (PG8_LAS unsigned*)(lds + (bufoff) + ldsw + _i * 8192), 16, 0, 0); } while (0)
#define PG8_LDA(dst, b, h) do { _Pragma("unroll") for (int m = 0; m < 4; ++m) _Pragma("unroll") for (int k = 0; k < 2; ++k) dst[m][k] = *(const PG8_LAS bf16x8*)(lds + PG8_SA(b, h) + aoff + m * 2048 + k * 1024); } while (0)
#define PG8_LDB(dst, b, h) do { _Pragma("unroll") for (int n = 0; n < 2; ++n) _Pragma("unroll") for (int k = 0; k < 2; ++k) dst[n][k] = *(const PG8_LAS bf16x8*)(lds + PG8_SB(b, h) + boff + n * 2048 + k * 1024); } while (0)
#define PG8_MMA(ai, bj, At, Bt) do { __builtin_amdgcn_s_setprio(1); _Pragma("unroll") for (int m = 0; m < 4; ++m) _Pragma("unroll") for (int n = 0; n < 2; ++n) _Pragma("unroll") for (int k = 0; k < 2; ++k) \
        acc[ai][bj][m][n] = __builtin_amdgcn_mfma_f32_16x16x32_bf16(Bt[n][k], At[m][k], acc[ai][bj][m][n], 0, 0, 0); __builtin_amdgcn_s_setprio(0); } while (0)
#define PG8_WAIT_V(n) asm volatile("s_waitcnt vmcnt(" #n ")" ::: "memory")
#define PG8_WAIT_L(n) asm volatile("s_waitcnt lgkmcnt(" #n ")" ::: "memory")
#define PG8_BAR __builtin_amdgcn_s_barrier()
#define PG8_SCHED __builtin_amdgcn_sched_barrier(0)
    Unit cur, nxt; int ui = 0;
    if (!S.next(0, cur)) return;
    f32x4 acc[2][2][4][2];
#pragma unroll
    for (int a = 0; a < 2; ++a)
#pragma unroll
        for (int b = 0; b < 2; ++b)
#pragma unroll
            for (int m = 0; m < 4; ++m)
#pragma unroll
                for (int n = 0; n < 2; ++n) acc[a][b][m][n] = (f32x4){0.f, 0.f, 0.f, 0.f};
    bf16x8 At[4][2], B0[2][2], B1[2][2];
    const char* cA = (const char*)g.A + (size_t)cur.pm * tstepA; const char* cB = (const char*)g.Bt + (size_t)cur.pn * tstepB;
    S.a_ready(cur);
    if constexpr (SP2) {
        PG8_STAGE(PG8_SB(0, 0), cB, voffB); PG8_STAGE(PG8_SB(0, 1), cB + hstepB, voffB); PG8_STAGE(PG8_SA(0, 0), cA, voffA); PG8_STAGE(PG8_SA(0, 1), cA + hstepA, voffA);
        if (wr == 1) PG8_BAR;
        PG8_WAIT_V(2); PG8_BAR;
        PG8_STAGE(PG8_SB(1, 0), cB + kstep, voffB); PG8_STAGE(PG8_SA(1, 0), cA + kstep, voffA); PG8_STAGE(PG8_SB(1, 1), cB + hstepB + kstep, voffB);
        PG8_WAIT_V(6); PG8_BAR;
    } else {
        PG8_STAGE(PG8_SB(0, 0), cB, voffB); PG8_STAGE(PG8_SA(0, 0), cA, voffA); PG8_STAGE(PG8_SB(0, 1), cB + hstepB, voffB); PG8_STAGE(PG8_SA(0, 1), cA + hstepA, voffA);
        if (wr == 1) PG8_BAR;
        PG8_WAIT_V(4); PG8_BAR;
        PG8_STAGE(PG8_SB(1, 0), cB + kstep, voffB); PG8_STAGE(PG8_SA(1, 0), cA + kstep, voffA); PG8_STAGE(PG8_SB(1, 1), cB + hstepB + kstep, voffB);
        PG8_WAIT_V(6); PG8_BAR;
    }
    for (;;) {
        const bool has_next = S.next(ui + 1, nxt);
        const char* nA = has_next ? (const char*)g.A + (size_t)nxt.pm * tstepA : cA; const char* nB = has_next ? (const char*)g.Bt + (size_t)nxt.pn * tstepB : cB;
        for (int t = 0; t < nt; t += 2) {
            const bool last = (t == nt - 2);
            const char* a1 = cA + (size_t)(t + 1) * kstep;
            const char* a2 = last ? nA : cA + (size_t)(t + 2) * kstep; const char* b2 = last ? nB : cB + (size_t)(t + 2) * kstep;
            const char* a3 = a2 + kstep; const char* b3 = b2 + kstep;
            if (last && has_next) S.a_ready(nxt);
            if constexpr (SP2) {
            PG8_LDB(B0, 0, 0); PG8_LDB(B1, 0, 1); PG8_SCHED; PG8_LDA(At, 0, 0); PG8_STAGE(PG8_SA(1, 1), a1 + hstepA, voffA);
            PG8_WAIT_V(8); PG8_WAIT_L(0); PG8_BAR; PG8_MMA(0, 0, At, B0); PG8_MMA(0, 1, At, B1); PG8_BAR; PG8_SCHED;
            PG8_LDA(At, 0, 1); PG8_STAGE(PG8_SB(0, 0), b2, voffB); PG8_STAGE(PG8_SB(0, 1), b2 + hstepB, voffB); PG8_STAGE(PG8_SA(0, 0), a2, voffA);
            PG8_WAIT_V(8); PG8_WAIT_L(0); PG8_BAR; PG8_MMA(1, 0, At, B0); PG8_MMA(1, 1, At, B1); PG8_BAR; PG8_SCHED;
            PG8_LDB(B0, 1, 0); PG8_LDB(B1, 1, 1); PG8_SCHED; PG8_LDA(At, 1, 0); PG8_STAGE(PG8_SA(0, 1), a2 + hstepA, voffA);
            PG8_WAIT_V(8); PG8_WAIT_L(0); PG8_BAR; PG8_MMA(0, 0, At, B0); PG8_MMA(0, 1, At, B1); PG8_BAR; PG8_SCHED;
            PG8_LDA(At, 1, 1); PG8_STAGE(PG8_SB(1, 0), b3, voffB); PG8_STAGE(PG8_SB(1, 1), b3 + hstepB, voffB); PG8_STAGE(PG8_SA(1, 0), a3, voffA);
            PG8_WAIT_V(8); PG8_WAIT_L(0); PG8_BAR; PG8_MMA(1, 0, At, B0); PG8_MMA(1, 1, At, B1); PG8_BAR; PG8_SCHED;
            } else {
            PG8_LDB(B0, 0, 0); PG8_SCHED; PG8_LDA(At, 0, 0); PG8_STAGE(PG8_SA(1, 1), a1 + hstepA, voffA);
            PG8_WAIT_L(8); PG8_BAR; PG8_WAIT_L(0); PG8_MMA(0, 0, At, B0); PG8_BAR; PG8_SCHED;
            PG8_LDB(B1, 0, 1); PG8_STAGE(PG8_SB(0, 0), b2, voffB);
            PG8_BAR; PG8_WAIT_L(0); PG8_MMA(0, 1, At, B1); PG8_BAR;
            PG8_LDA(At, 0, 1); PG8_STAGE(PG8_SA(0, 0), a2, voffA);
            PG8_BAR; PG8_WAIT_L(0); PG8_MMA(1, 0, At, B0); PG8_BAR; PG8_SCHED;
            PG8_STAGE(PG8_SB(0, 1), b2 + hstepB, voffB);
            PG8_WAIT_V(6); PG8_BAR; PG8_MMA(1, 1, At, B1); PG8_BAR;
            PG8_LDB(B0, 1, 0); PG8_SCHED; PG8_LDA(At, 1, 0); PG8_STAGE(PG8_SA(0, 1), a2 + hstepA, voffA);
            PG8_WAIT_L(8); PG8_BAR; PG8_WAIT_L(0); PG8_MMA(0, 0, At, B0); PG8_BAR; PG8_SCHED;
            PG8_LDB(B1, 1, 1); PG8_STAGE(PG8_SB(1, 0), b3, voffB);
            PG8_BAR; PG8_WAIT_L(0); PG8_MMA(0, 1, At, B1); PG8_BAR;
            PG8_LDA(At, 1, 1); PG8_STAGE(PG8_SA(1, 0), a3, voffA);
            PG8_BAR; PG8_WAIT_L(0); PG8_MMA(1, 0, At, B0); PG8_BAR; PG8_SCHED;
            PG8_STAGE(PG8_SB(1, 1), b3 + hstepB, voffB);
            PG8_WAIT_V(6); PG8_BAR; PG8_MMA(1, 1, At, B1); PG8_BAR;
            }
        }
        if constexpr (ALIGN_EPI) { if (wr == 0) PG8_BAR; }
        if constexpr (!Epi::AFTER_DRAIN) { E(acc, cur, wr, wc, fr, fq); S.done(cur); }
        if (!has_next) break;
#pragma unroll
        for (int a = 0; a < 2; ++a)
#pragma unroll
            for (int b = 0; b < 2; ++b)
#pragma unroll
                for (int m = 0; m < 4; ++m)
#pragma unroll
                    for (int n = 0; n < 2; ++n) acc[a][b][m][n] = (f32x4){0.f, 0.f, 0.f, 0.f};
        cur = nxt; cA = nA; cB = nB; ++ui;
        if constexpr (ALIGN_EPI) { if (wr == 1) PG8_BAR; }
    }
    PG8_WAIT_V(0);
    if constexpr (!ALIGN_EPI) { if (wr == 0) PG8_BAR; }
    PG8_BAR;
    if constexpr (Epi::AFTER_DRAIN) { E.fused(acc, cur, wr, wc, fr, fq, lds, wid, lane); S.done(cur); }
#undef PG8_SA
#undef PG8_SB
#undef PG8_STAGE
#undef PG8_LDA
#undef PG8_LDB
#undef PG8_MMA
#undef PG8_WAIT_V
#undef PG8_WAIT_L
#undef PG8_BAR
#undef PG8_SCHED
}
}

#ifndef PG8_SP2
#define PG8_SP2 true
#endif
#ifndef PG8_ALIGN
#define PG8_ALIGN true
#endif
#include <hip/hip_bf16.h>
#include <cmath>
namespace attn_body {
using bf16=__hip_bfloat16;
using bf16x8=__attribute__((ext_vector_type(8)))short;
using s16x4=__attribute__((ext_vector_type(4)))short;
using f32x16=__attribute__((ext_vector_type(16)))float;
using u32x4=__attribute__((ext_vector_type(4)))unsigned;
constexpr int BATCH=2,NHEAD=16,SEQ=8192,D=64,DM=NHEAD*D;
constexpr int NW=8,QBLK=32,QB=QBLK*NW,KVBLK=64,NQB=SEQ/QB;
constexpr int ATTN_PITCH=DM, ATTN_UNIT_ROWS=QB, OPITCH=2048, KVROWS=8320, NVH=32;
__device__ __forceinline__ int crow(int r,int hi){return (r&3)+8*(r>>2)+4*hi;}
#define SBAR() __builtin_amdgcn_sched_barrier(0)
__device__ __forceinline__ void cmask(f32x16&p0,f32x16&p1,int jb,int qrel,int hi){
  const float NEG=-INFINITY;
  if(jb<4){ if(jb>(qrel>>6)){
    #pragma unroll
    for(int r=0;r<16;++r){p0[r]=NEG;p1[r]=NEG;} } }
  else if(jb==4){
    #pragma unroll
    for(int r=0;r<16;++r){p0[r]=NEG;p1[r]=NEG;} }
  else{
    #pragma unroll
    for(int r=0;r<16;++r){ if(r>=8)p0[r]=NEG; p1[r]=NEG; } }
}

constexpr int NSLOT=3, SLOTB=8192;
constexpr int LDS_K=0, LDS_V=NSLOT*SLOTB, LDS_WS=2*NSLOT*SLOTB, LDS_OST=LDS_WS+NW*64*4, LDS_BYTES=LDS_OST+NW*4096;
constexpr float C2=0.125f*1.4426950408889634f;
__device__ __forceinline__ void glds16(const void*gsrc,unsigned lds_dst){unsigned keep;
  asm volatile("s_mov_b32 %0, m0\n\ts_mov_b32 m0, %2\n\ts_nop 0\n\tglobal_load_lds_dwordx4 %1, off\n\ts_mov_b32 m0, %0":"=&s"(keep):"v"(gsrc),"s"(lds_dst):"memory");}
__device__ __forceinline__ float max3f(float a,float b,float c){float r;asm("v_max3_f32 %0, %1, %2, %3":"=v"(r):"v"(a),"v"(b),"v"(c));return r;}
__device__ __forceinline__ float max2f(float a,float b){float r;asm("v_max_f32_e32 %0, %1, %2":"=v"(r):"v"(a),"v"(b));return r;}
__device__ __forceinline__ float fadd_s(float a,float b){float r;asm("v_add_f32_e32 %0, %1, %2":"=v"(r):"v"(a),"v"(b));return r;}
__device__ __forceinline__ float fsub_s(float a,float b){float r;asm("v_sub_f32_e32 %0, %1, %2":"=v"(r):"v"(a),"v"(b));return r;}
typedef float f32x2_t __attribute__((ext_vector_type(2))); typedef __bf16 bf16x2_t __attribute__((ext_vector_type(2)));
__device__ __forceinline__ unsigned cvtpk_s(float lo,float hi){f32x2_t v={lo,hi};bf16x2_t b=__builtin_convertvector(v,bf16x2_t);return __builtin_bit_cast(unsigned,b);}
#define WAIT_BAR(N) asm volatile("s_waitcnt vmcnt(" #N ") lgkmcnt(0)\n\ts_barrier":::"memory")

__device__ __forceinline__ void qkt(f32x16&p0,f32x16&p1,const char*Kslot,const bf16x8*qr,const f32x16&negm,int r32,int hi){
  const char*kb=Kslot+hi*1024+r32*16;
  #pragma unroll
  for(int d0=0;d0<4;++d0){
    const bf16x8 b0=*reinterpret_cast<const bf16x8*>(kb+d0*2048);
    const bf16x8 b1=*reinterpret_cast<const bf16x8*>(kb+d0*2048+512);
    if(d0==0){p0=__builtin_amdgcn_mfma_f32_32x32x16_bf16(b0,qr[0],negm,0,0,0);p1=__builtin_amdgcn_mfma_f32_32x32x16_bf16(b1,qr[0],negm,0,0,0);}
    else{p0=__builtin_amdgcn_mfma_f32_32x32x16_bf16(b0,qr[d0],p0,0,0,0);p1=__builtin_amdgcn_mfma_f32_32x32x16_bf16(b1,qr[d0],p1,0,0,0);}}
}
typedef __attribute__((address_space(3))) const char* lds_cptr;
typedef short v4i16_t __attribute__((ext_vector_type(4)));
__device__ __forceinline__ void kload8(bf16x8*kf,lds_cptr kp){
  kf[0]=*(const __attribute__((address_space(3))) bf16x8*)(kp);      kf[1]=*(const __attribute__((address_space(3))) bf16x8*)(kp+512);
  kf[2]=*(const __attribute__((address_space(3))) bf16x8*)(kp+2048); kf[3]=*(const __attribute__((address_space(3))) bf16x8*)(kp+2560);
  kf[4]=*(const __attribute__((address_space(3))) bf16x8*)(kp+4096); kf[5]=*(const __attribute__((address_space(3))) bf16x8*)(kp+4608);
  kf[6]=*(const __attribute__((address_space(3))) bf16x8*)(kp+6144); kf[7]=*(const __attribute__((address_space(3))) bf16x8*)(kp+6656);
}
__device__ __forceinline__ void kload2(bf16x8*kf,lds_cptr kp,int j){ kf[2*j]=*(const __attribute__((address_space(3))) bf16x8*)(kp+j*2048); kf[2*j+1]=*(const __attribute__((address_space(3))) bf16x8*)(kp+j*2048+512); }
__device__ __forceinline__ s16x4 vtr(lds_cptr p){ return __builtin_bit_cast(s16x4,__builtin_amdgcn_ds_read_tr16_b64_v4i16((__attribute__((address_space(3))) v4i16_t*)p)); }
__device__ __forceinline__ float rowmax(const f32x16&p0,const f32x16&p1){
  float a=max3f(p0[0],p0[1],p1[0]),b=max3f(p0[2],p0[3],p1[1]);a=max3f(a,p1[2],p1[3]);
  #pragma unroll
  for(int r=4;r<16;r+=4){a=max3f(a,p0[r],p0[r+1]);b=max3f(b,p0[r+2],p0[r+3]);a=max3f(a,p1[r],p1[r+1]);b=max3f(b,p1[r+2],p1[r+3]);}
  const float m=max2f(a,b);
  auto rr=__builtin_amdgcn_permlane32_swap(__float_as_uint(m),__float_as_uint(m),false,false);
  return max2f(__uint_as_float(rr[0]),__uint_as_float(rr[1]));
}
__device__ __forceinline__ void pv(f32x16*o,int vb,bf16x8 pa0,bf16x8 pa1,bf16x8 pa2,bf16x8 pa3){
  #pragma unroll
  for(int d0=0;d0<2;++d0){s16x4 lo[4],hi[4];
    #pragma unroll
    for(int ks=0;ks<4;++ks){
      asm volatile("ds_read_b64_tr_b16 %0,%1 offset:%c2":"=&v"(lo[ks]):"v"(vb),"i"(d0*4096+ks*1024):"memory");
      asm volatile("ds_read_b64_tr_b16 %0,%1 offset:%c2":"=&v"(hi[ks]):"v"(vb),"i"(d0*4096+ks*1024+512):"memory");}
    asm volatile("s_waitcnt lgkmcnt(0)":::"memory");SBAR();
    #define PK(k) (bf16x8){lo[k][0],lo[k][1],lo[k][2],lo[k][3],hi[k][0],hi[k][1],hi[k][2],hi[k][3]}
    o[d0]=__builtin_amdgcn_mfma_f32_32x32x16_bf16(pa0,PK(0),o[d0],0,0,0);
    o[d0]=__builtin_amdgcn_mfma_f32_32x32x16_bf16(pa1,PK(1),o[d0],0,0,0);
    o[d0]=__builtin_amdgcn_mfma_f32_32x32x16_bf16(pa2,PK(2),o[d0],0,0,0);
    o[d0]=__builtin_amdgcn_mfma_f32_32x32x16_bf16(pa3,PK(3),o[d0],0,0,0);
    #undef PK
  }
}

#ifndef ATTN_STORE16
#define ATTN_STORE16(p,v) (*(u32x4*)(p)=(v))
#endif
template<int THRL> __device__ __forceinline__ void attn_unit(int b,int vh,int qb,const bf16*Q,const bf16*__restrict__ K,const bf16*__restrict__ V,bf16*O,char*shm){
  int tid_=threadIdx.x; asm volatile("":"+v"(tid_));
  const int tid=tid_,lane=tid&63,r32=lane&31,hi=lane>>5; const int wid=__builtin_amdgcn_readfirstlane(tid>>6);
  const long rowbase=(long)b*SEQ, kvbase=(long)b*KVROWS; const int q0=qb*QB; const int hc=vh>>1;
  const bf16*Qw=Q+(rowbase+q0+wid*QBLK)*DM+hc*D;
  const bf16*Kh=K+kvbase*DM+hc*D,*Vh=V+kvbase*DM+(vh>>2)*128+(vh&1)*64;
  const unsigned lds0=(unsigned)(uintptr_t)shm;
  float*wsf=(float*)(shm+LDS_WS)+wid*64;
  const bf16*ksrc=Kh+(long)lane*DM+wid*8;
  const bf16*vsrc=Vh+(long)(16*(wid&3)+(lane>>2))*DM+(wid>>2)*32+(lane&3)*8;
  const unsigned kdst=lds0+LDS_K+wid*1024, vdst=lds0+LDS_V+wid*1024;
  #define TROW(t) (((t)<NT-2)?(long)(t)*KVBLK:(long)(8192+((t)-(NT-2))*KVBLK))
  #define DMA_K(t,slot) glds16(ksrc+TROW(t)*DM,(unsigned)__builtin_amdgcn_readfirstlane(kdst+(slot)))
  #define DMA_V(t,slot) glds16(vsrc+TROW(t)*DM,(unsigned)__builtin_amdgcn_readfirstlane(vdst+(slot)))
  const int vb0=(int)(lds0+LDS_V)+((lane>>4)&1)*32+(lane&3)*8+(4*hi+((lane&15)>>2))*64;
  const char*Kbase=shm+LDS_K; bf16x8 kf[8];
  const lds_cptr shm3=(lds_cptr)shm; const lds_cptr kp0=shm3+LDS_K+hi*1024+r32*16; const lds_cptr vp0=shm3+LDS_V+((lane>>4)&1)*32+(lane&3)*8+(4*hi+((lane&15)>>2))*64;
  const int NT=(q0+QB)/KVBLK+2;
  DMA_K(0,0);DMA_V(0,0);DMA_K(1,SLOTB);
  bf16x8 qr[4];
  #pragma unroll
  for(int d0=0;d0<4;++d0)qr[d0]=*reinterpret_cast<const bf16x8*>(&Qw[(long)r32*DM+d0*16+hi*8]);
  float mhat=0.f,l_reg=0.f;f32x16 o[2];o[0]=f32x16{};o[1]=f32x16{};f32x16 negm=f32x16{};asm volatile("":"+v"(negm));
  const int qrel=wid*QBLK+r32;
  #define CMASK(P0,P1,t) do{int jb_=(t)-(NT-6); if(jb_>=0)cmask(P0,P1,jb_,qrel,hi);}while(0)
  bool resc=false;
  #define START(P0,P1) do{ const float rm=rowmax(P0,P1); resc=false; \
    { const float dl=rm; mhat=fadd_s(mhat,dl); \
      _Pragma("unroll") for(int r=0;r<16;++r){P0[r]=fsub_s(P0[r],dl);P1[r]=fsub_s(P1[r],dl);} \
      _Pragma("unroll") for(int r=0;r<16;++r)negm[r]=-mhat; asm volatile("":"+v"(negm)); } \
    _Pragma("unroll") for(int r=0;r<16;++r)P0[r]=__builtin_amdgcn_exp2f(P0[r]); }while(0)
  #define RESC() do{ if(resc){ asm volatile("s_waitcnt lgkmcnt(0)":::"memory"); \
      _Pragma("unroll") for(int d_=0;d_<2;++d_) _Pragma("unroll") for(int r=0;r<16;++r)o[d_][r]*=wsf[crow(r,hi)]; } }while(0)
  f32x16 pA0,pA1,pB0,pB1;
  int sl_prev=0,sl_cur=0,sl_next=SLOTB;
  #define ROT() do{sl_prev=sl_cur;sl_cur=sl_next;sl_next=(sl_next==(NSLOT-1)*SLOTB)?0:sl_next+SLOTB;}while(0)
  DMA_K(2,2*SLOTB);
  WAIT_BAR(3);
  qkt(pA0,pA1,Kbase,qr,negm,r32,hi);asm volatile("s_nop 15\n\ts_nop 7":"+v"(pA0),"+v"(pA1));CMASK(pA0,pA1,0);
  START(pA0,pA1);
  _Pragma("unroll") for(int r=0;r<16;++r)pA1[r]=__builtin_amdgcn_exp2f(pA1[r]);
  WAIT_BAR(0);
  DMA_K(3,0);DMA_V(1,SLOTB);
  ROT();
  kload8(kf,kp0+sl_cur);
  WAIT_BAR(2);
  s16x4 vlo[8],vhi[8]; u32x4 pw0,pw1,pw2,pw3;
  #define PKW(P,B) cvtpk_s(P[B],P[B+1])
  #define PAF(k) __builtin_bit_cast(bf16x8,pw##k)
  #define VFR(i) (bf16x8){vlo[i][0],vlo[i][1],vlo[i][2],vlo[i][3],vhi[i][0],vhi[i][1],vhi[i][2],vhi[i][3]}
  #define PIN(x) asm volatile("":"+v"(x))
  #define MX3(a,b,c) __builtin_fmaxf(__builtin_fmaxf((a),(b)),(c))
  #define GAPA(MF,A0,A1,A2,A3,W0,W1,PW) do{ MF; sacc+=A0; sacc+=A1; sacc+=A2; sacc+=A3; PIN(sacc); W0; W1; PIN(PW); SBAR(); }while(0)
  #define EX(v) __builtin_amdgcn_exp2f(v)
  #define GAPB(MF,X,B) do{ MF; X[B]=EX(X[B]); X[B+1]=EX(X[B+1]); X[B+2]=EX(X[B+2]); X[B+3]=EX(X[B+3]); PIN(X); SBAR(); }while(0)
  #define VRD(i) do{ vlo[i]=vtr(vp_+(((i)>>2)*4096+((i)&3)*1024)); vhi[i]=vtr(vp_+(((i)>>2)*4096+((i)&3)*1024+512)); }while(0)
  #define KRD(G,j) do{ if(G){ kload2(kf,kp0+sl_next,j); SBAR(); } }while(0)
  #define STEP(C0,C1,P0,P1,t,GK,GV,GL) do{ SBAR(); \
    const lds_cptr vp_=vp0+sl_prev; \
    VRD(0); SBAR(); float sacc=(P0[0]+P0[1]); \
    GAPA(C0=__builtin_amdgcn_mfma_f32_32x32x16_bf16(kf[0],qr[0],negm,0,0,0), P0[2],P0[3],P0[4],P0[5],     pw0[0]=PKW(P0,0), pw0[1]=PKW(P0,2), pw0); \
    VRD(4); SBAR(); GAPA(C1=__builtin_amdgcn_mfma_f32_32x32x16_bf16(kf[1],qr[0],negm,0,0,0), P0[6],P0[7],P0[8],P0[9],     pw0[2]=PKW(P0,4), pw0[3]=PKW(P0,6), pw0); \
    VRD(1); SBAR(); GAPA(C0=__builtin_amdgcn_mfma_f32_32x32x16_bf16(kf[2],qr[1],C0,0,0,0),   P0[10],P0[11],P0[12],P0[13], pw1[0]=PKW(P0,8), pw1[1]=PKW(P0,10), pw1); \
    VRD(5); SBAR(); GAPA(C1=__builtin_amdgcn_mfma_f32_32x32x16_bf16(kf[3],qr[1],C1,0,0,0),   P0[14],P0[15],P1[0],P1[1],   pw1[2]=PKW(P0,12),pw1[3]=PKW(P0,14), pw1); \
    VRD(2); SBAR(); GAPA(C0=__builtin_amdgcn_mfma_f32_32x32x16_bf16(kf[4],qr[2],C0,0,0,0),   P1[2],P1[3],P1[4],P1[5],     pw2[0]=PKW(P1,0), pw2[1]=PKW(P1,2), pw2); \
    VRD(6); SBAR(); GAPA(C1=__builtin_amdgcn_mfma_f32_32x32x16_bf16(kf[5],qr[2],C1,0,0,0),   P1[6],P1[7],P1[8],P1[9],     pw2[2]=PKW(P1,4), pw2[3]=PKW(P1,6), pw2); \
    VRD(3); SBAR(); GAPA(C0=__builtin_amdgcn_mfma_f32_32x32x16_bf16(kf[6],qr[3],C0,0,0,0),   P1[10],P1[11],P1[12],P1[13], pw3[0]=PKW(P1,8), pw3[1]=PKW(P1,10), pw3); \
    VRD(7); SBAR(); GAPA(C1=__builtin_amdgcn_mfma_f32_32x32x16_bf16(kf[7],qr[3],C1,0,0,0),   P1[14],P1[15],0.f,0.f,       pw3[2]=PKW(P1,12),pw3[3]=PKW(P1,14), pw3); \
    l_reg+=sacc; \
    if(GK){DMA_K((t)+3,sl_cur);} if(GV){DMA_V((t)+1,sl_next);} \
    CMASK(C0,C1,t); \
    { float a=MX3(C0[0],C0[1],C1[0]),b=MX3(C0[2],C0[3],C1[1]); a=MX3(a,C1[2],C1[3]); \
      _Pragma("unroll") for(int r=4;r<16;r+=4){a=MX3(a,C0[r],C0[r+1]);b=MX3(b,C0[r+2],C0[r+3]);a=MX3(a,C1[r],C1[r+1]);b=MX3(b,C1[r+2],C1[r+3]);} \
      float rm=__builtin_fmaxf(a,b); { auto rr=__builtin_amdgcn_permlane32_swap(__float_as_uint(rm),__float_as_uint(rm),false,false); rm=__builtin_fmaxf(__uint_as_float(rr[0]),__uint_as_float(rr[1])); } \
      resc=false; \
      if(__builtin_expect(__any(rm>(float)THRL),0)){ const float dl=__builtin_fmaxf(rm,0.f); mhat+=dl; \
        _Pragma("unroll") for(int r=0;r<16;++r){C0[r]-=dl;C1[r]-=dl;} \
        _Pragma("unroll") for(int r=0;r<16;++r)negm[r]=-mhat; asm volatile("":"+v"(negm)); \
        const float f=__builtin_amdgcn_exp2f(-dl); l_reg*=f; if(hi==0)wsf[r32]=f; resc=true; } } \
    SBAR(); \
    GAPB(o[0]=__builtin_amdgcn_mfma_f32_32x32x16_bf16(PAF(0),VFR(0),o[0],0,0,0), C0,0); \
    GAPB(o[1]=__builtin_amdgcn_mfma_f32_32x32x16_bf16(PAF(0),VFR(4),o[1],0,0,0), C0,4); \
    KRD(GL,0); GAPB(o[0]=__builtin_amdgcn_mfma_f32_32x32x16_bf16(PAF(1),VFR(1),o[0],0,0,0), C0,8); \
    KRD(GL,1); GAPB(o[1]=__builtin_amdgcn_mfma_f32_32x32x16_bf16(PAF(1),VFR(5),o[1],0,0,0), C0,12); \
    KRD(GL,2); GAPB(o[0]=__builtin_amdgcn_mfma_f32_32x32x16_bf16(PAF(2),VFR(2),o[0],0,0,0), C1,0); \
    KRD(GL,3); GAPB(o[1]=__builtin_amdgcn_mfma_f32_32x32x16_bf16(PAF(2),VFR(6),o[1],0,0,0), C1,4); \
    GAPB(o[0]=__builtin_amdgcn_mfma_f32_32x32x16_bf16(PAF(3),VFR(3),o[0],0,0,0), C1,8); \
    GAPB(o[1]=__builtin_amdgcn_mfma_f32_32x32x16_bf16(PAF(3),VFR(7),o[1],0,0,0), C1,12); \
    }while(0)
  int t=1;
  #undef CMASK
  #define CMASK(P0,P1,t) do{}while(0)
  for(;t+7<NT;t+=2){
    STEP(pB0,pB1,pA0,pA1,t,true,true,true);     WAIT_BAR(2); RESC(); ROT();
    STEP(pA0,pA1,pB0,pB1,t+1,true,true,true);   WAIT_BAR(2); RESC(); ROT();
  }
  #undef CMASK
  #define CMASK(P0,P1,t) do{int jb_=(t)-(NT-6); if(jb_>=0)cmask(P0,P1,jb_,qrel,hi);}while(0)
  #define ENDW(tt) do{ if((tt)+3<NT){WAIT_BAR(2);} else if((tt)+2<NT){WAIT_BAR(1);} else {WAIT_BAR(0);} }while(0)
  for(;t+1<NT;t+=2){
    STEP(pB0,pB1,pA0,pA1,t,(t+3<NT),(t+1<NT),(t+1<NT));       ENDW(t);   RESC(); ROT();
    STEP(pA0,pA1,pB0,pB1,t+1,(t+4<NT),(t+2<NT),(t+2<NT));     ENDW(t+1); RESC(); ROT();
  }
  STEP(pB0,pB1,pA0,pA1,NT-1,false,false,false); RESC();
  { float sacc=pB0[0]+pB0[1]; _Pragma("unroll") for(int r=2;r<16;++r)sacc+=pB0[r]; _Pragma("unroll") for(int r=0;r<16;++r)sacc+=pB1[r]; l_reg+=sacc;
    pw0=(u32x4){PKW(pB0,0),PKW(pB0,2),PKW(pB0,4),PKW(pB0,6)};pw1=(u32x4){PKW(pB0,8),PKW(pB0,10),PKW(pB0,12),PKW(pB0,14)};pw2=(u32x4){PKW(pB1,0),PKW(pB1,2),PKW(pB1,4),PKW(pB1,6)};pw3=(u32x4){PKW(pB1,8),PKW(pB1,10),PKW(pB1,12),PKW(pB1,14)};
    SBAR(); pv(o,vb0+sl_cur,PAF(0),PAF(1),PAF(2),PAF(3)); }
  #undef PKW
  #undef PAF
  #undef VFR
  #undef PIN
  #undef MX3
  #undef GAPA
  #undef GAPB
  #undef EX
  #undef VRD
  #undef KRD
  #undef STEP
  #undef ENDW
  {auto rr=__builtin_amdgcn_permlane32_swap(__float_as_uint(l_reg),__float_as_uint(l_reg),false,false);l_reg=__uint_as_float(rr[0])+__uint_as_float(rr[1]);}
  if(hi==0)wsf[32+r32]=l_reg;asm volatile("s_waitcnt lgkmcnt(0)":::"memory");
  float rli[16];
  #pragma unroll
  for(int r=0;r<16;++r)rli[r]=__builtin_amdgcn_rcpf(wsf[32+crow(r,hi)]);
  bf16*Ow=O+(rowbase+q0+wid*QBLK)*OPITCH+vh*D;
  { bf16*stg=(bf16*)(shm+LDS_OST)+wid*2048;
    #pragma unroll
    for(int r=0;r<16;++r){const int orow=crow(r,hi);
      #pragma unroll
      for(int d0=0;d0<2;++d0)stg[orow*64+d0*32+r32]=__float2bfloat16(o[d0][r]*rli[r]);}
    asm volatile("s_waitcnt lgkmcnt(0)":::"memory");
    #pragma unroll
    for(int i=0;i<4;++i){const int row=i*8+(lane>>3),ch=lane&7; const u32x4 v=*(const u32x4*)(stg+row*64+ch*8); ATTN_STORE16(Ow+(long)row*OPITCH+ch*8,v);} }
  asm volatile("s_waitcnt lgkmcnt(0)\n\ts_barrier":::"memory");
  #undef DMA_K
  #undef TROW
  #undef DMA_V
  #undef CMASK
  #undef START
  #undef RESC
  #undef ROT
}
constexpr int ATTN_LDS_BYTES=LDS_BYTES;
struct AttnTensors { const bf16* Q; const bf16* K; const bf16* V; bf16* O; };
struct AttnUnit { int bh; int qb; };
struct StaticOrder {
  int vcu;
  __device__ __forceinline__ explicit StaticOrder(int grid,int block):vcu((block%8)*(grid/8)+block/8){}
  __device__ __forceinline__ bool next(int i,AttnUnit&u)const{ if(i>=8)return false; const int s=vcu&3; u.bh=vcu>>2; u.qb=(i&1)?(4*i+3-s):(4*i+s); return true; }
  __device__ __forceinline__ void a_ready(const AttnUnit&)const{}
  __device__ __forceinline__ void done(const AttnUnit&)const{}
};
template<class Sched,int THRL=8> __device__ __forceinline__ void attn_phase(char*lds,const AttnTensors&T,const Sched&S){
  AttnUnit u;
  for(int i=0;S.next(i,u);++i){ S.a_ready(u); attn_unit<THRL>(u.bh/NVH,u.bh%NVH,u.qb,T.Q,T.K,T.V,T.O,lds); S.done(u); }
}
#undef SBAR
#undef WAIT_BAR
}
#define GAS __attribute__((address_space(1)))
#define LAS __attribute__((address_space(3)))
typedef unsigned short bf16;
typedef unsigned v4u __attribute__((ext_vector_type(4)));
typedef float f32x4 __attribute__((ext_vector_type(4)));
typedef short bf16x8 __attribute__((ext_vector_type(8)));
typedef GAS unsigned gu32;
typedef GAS unsigned long long gu64;
#define RLX_AGENT __ATOMIC_RELAXED, __HIP_MEMORY_SCOPE_AGENT
#define LDS_WAIT() asm volatile("s_waitcnt lgkmcnt(0)" ::: "memory")
#define VM_WAIT() asm volatile("s_waitcnt vmcnt(0)" ::: "memory")
__device__ __forceinline__ unsigned long long rt() { return __builtin_amdgcn_s_memrealtime(); }
__device__ __forceinline__ unsigned f2bf(float f) { unsigned u = __builtin_bit_cast(unsigned, f); return (u + 0x7fffu + ((u >> 16) & 1u)) >> 16; }
__device__ __forceinline__ unsigned pk2(float lo, float hi) { return f2bf(lo) | (f2bf(hi) << 16); }

#define XB_TMO      128
#define XB_XCNT(j)  (256  + 64 * (j))
#define XB_XSUB(j)  (1280 + 64 * (j))
#define XB_XGEN(j)  (2304 + 64 * (j))
#define XB_TOP      3328
#define XB_TOPGEN   3392
#define XCD_BAR_WORDS 3456
#define XB_SPIN_CAP (1u << 18)

__device__ __forceinline__ unsigned xb_ld(unsigned* p)              { return __hip_atomic_load(p, __ATOMIC_RELAXED, __HIP_MEMORY_SCOPE_AGENT); }
__device__ __forceinline__ unsigned xb_add(unsigned* p, unsigned v) { return __hip_atomic_fetch_add(p, v, __ATOMIC_RELAXED, __HIP_MEMORY_SCOPE_AGENT); }
__device__ __forceinline__ unsigned xb_xcc_id() { return (unsigned)__builtin_amdgcn_s_getreg((3 << 11) | 20) & 0xFu; }
#define XB_SPIN(cond, bar) do { unsigned _sp = 0; while (cond) { __builtin_amdgcn_s_sleep(1); \
    if ((++_sp & 255u) == 0u) { if (xb_ld(&(bar)[XB_TMO])) break; if (_sp > XB_SPIN_CAP) { atomicAdd(&(bar)[XB_TMO], 1u); break; } } } } while (0)

struct XcdBarrier {
    unsigned* bar; unsigned x;
    volatile LAS unsigned* st;
};

__device__ __forceinline__ XcdBarrier xcd_barrier_post(unsigned* bar, volatile LAS unsigned* st) {
    XcdBarrier b; b.bar = bar; b.x = xb_xcc_id(); b.st = st;
    if (threadIdx.x == 0) (void)xb_add(&bar[XB_XCNT(b.x)], 1u);
    return b;
}
__device__ __forceinline__ void xcd_barrier_complete(unsigned* bar, unsigned x, unsigned& nloc, unsigned& nx) {
    const unsigned G = gridDim.x * gridDim.y * gridDim.z;
    unsigned sum, cnt, mine, sp = 0u;
    for (;;) {
        sum = 0u; cnt = 0u; mine = 0u;
#pragma unroll
        for (unsigned j = 0; j < 16; ++j) { const unsigned c = xb_ld(&bar[XB_XCNT(j)]); sum += c; cnt += (c > 0u) ? 1u : 0u; mine = (j == x) ? c : mine; }
        if (sum == G) break;
        __builtin_amdgcn_s_sleep(1);
        if ((++sp & 255u) == 0u) { if (xb_ld(&bar[XB_TMO])) break; if (sp > XB_SPIN_CAP) { atomicAdd(&bar[XB_TMO], 1u); break; } }
    }
    nloc = mine > 0u ? mine : 1u; nx = cnt > 0u ? cnt : 1u;
}

__device__ __forceinline__ void xcd_barrier(const XcdBarrier& b) {
    asm volatile("s_waitcnt vmcnt(0)" ::: "memory");
    __syncthreads();
    if (threadIdx.x == 0) {
        unsigned* bar = b.bar;
        __builtin_amdgcn_s_waitcnt(0);
        unsigned nloc = b.st[0], nx = b.st[1];
        if (nloc == 0u) { xcd_barrier_complete(bar, b.x, nloc, nx); b.st[0] = nloc; b.st[1] = nx; }
        const unsigned old = xb_add(&bar[XB_XSUB(b.x)], 1u);
        const unsigned gen = old / nloc;
        if (old + 1u == (gen + 1u) * nloc) {
            __builtin_amdgcn_fence(__ATOMIC_RELEASE, "agent");
            asm volatile("s_waitcnt vmcnt(0)" ::: "memory");
            const unsigned og = xb_add(&bar[XB_TOP], 1u);
            const unsigned tg = og / nx;
            if (og + 1u == (tg + 1u) * nx) xb_add(&bar[XB_TOPGEN], 1u);
            else XB_SPIN(xb_ld(&bar[XB_TOPGEN]) == tg, bar);
            __builtin_amdgcn_fence(__ATOMIC_ACQUIRE, "agent");
            xb_add(&bar[XB_XGEN(b.x)], 1u);
            asm volatile("s_waitcnt vmcnt(0)" ::: "memory");
        } else {
            XB_SPIN(xb_ld(&bar[XB_XGEN(b.x)]) == gen, bar);
            __builtin_amdgcn_fence(__ATOMIC_ACQUIRE, "agent");
            asm volatile("s_waitcnt vmcnt(0)" ::: "memory");
        }
    }
    __syncthreads();
}

constexpr int NWAVES = 8;
#ifndef MK_N_LAUNCHES
#define MK_N_LAUNCHES 25
#endif
constexpr int NPH = 25;
constexpr int N_LAUNCHES = MK_N_LAUNCHES;
static_assert(N_LAUNCHES == 1 || N_LAUNCHES == NPH, "MK_N_LAUNCHES is 1 or 25");

constexpr int DM_ = 1024, NLAYER = 2, NMETA = 16, SEQ_ = 8192;
constexpr int MREAL = pg8::MREAL, MVALID = pg8::MVALID, MP = 16640;
constexpr int NP1 = 8192;
constexpr int MOE_ROWS = 74240;
constexpr int CAP = 16416;
constexpr float LN_EPS = 1e-5f, ALPHA = 1.4142135623730951f;

constexpr size_t MiB = 1u << 20;
constexpr size_t WS_CTL = 0, CTL_ZERO_BYTES = 1 * MiB;
constexpr size_t WL_IN = 0, WL_GLU = 16 * MiB, WL_SO = 17 * MiB, WL_CO = 18 * MiB, WL_AO = 19 * MiB, WL_WO = 21 * MiB, WL_GU = 23 * MiB, WL_DN = 151 * MiB, WL_ST = 215 * MiB, WL_TOE = 231 * MiB, WL_STRIDE = 304 * MiB;
constexpr size_t WS_W = 2 * MiB;
constexpr size_t WS_SSMC = WS_W + NLAYER * WL_STRIDE;
constexpr size_t WS_ROPE = WS_SSMC + 2 * MiB;
constexpr size_t WS_HF = WS_ROPE + 3 * MiB;
constexpr size_t WS_HB = WS_HF + 65 * MiB;
constexpr size_t WS_UC = WS_HB + 33 * MiB;
constexpr size_t WS_UMETA = WS_UC + 18 * MiB;
constexpr size_t WS_CONV = WS_UMETA + 1 * MiB;
constexpr size_t WS_Q = WS_CONV + 49 * MiB;
constexpr size_t WS_K = WS_Q + 33 * MiB;
constexpr size_t WS_V = WS_K + 33 * MiB;
constexpr size_t WS_GB = WS_V + 33 * MiB;
constexpr size_t WS_SLOC = WS_GB + 98 * MiB;
constexpr size_t WS_SM = WS_SLOC + 4 * MiB;
constexpr size_t WS_OC = WS_SM + 1 * MiB;
constexpr size_t WS_YG = WS_OC + 65 * MiB;
constexpr size_t WS_YS = WS_YG + 17 * MiB;
constexpr size_t WS_YC = WS_YS + 17 * MiB;
constexpr size_t WS_YA = WS_YC + 17 * MiB;
constexpr size_t WS_MG = WS_YA + 33 * MiB;
constexpr size_t WS_PRE = WS_MG + 33 * MiB;
constexpr size_t WS_XG = WS_PRE + 65 * MiB;
constexpr size_t WS_HID = WS_XG + 145 * MiB;
constexpr size_t WS_OUTS = WS_HID + 145 * MiB;
constexpr size_t WS_ROWIDX = WS_OUTS + 145 * MiB;
constexpr size_t WS_TOKE = WS_ROWIDX + 3 * MiB;
constexpr size_t WS_TOKW = WS_TOKE + 1 * MiB;
constexpr size_t WS_END = WS_TOKW + 1 * MiB;
static_assert((size_t)MOE_ROWS * 1024 * 2 <= 145 * MiB && (size_t)MP * 3072 * 2 <= 98 * MiB && (size_t)MP * 1536 * 2 <= 49 * MiB && (size_t)MP * 4096 <= 65 * MiB && (size_t)32 * 1024 * 1152 * 2 <= 73 * MiB, "d_ws map");
constexpr int CW_TMO = 0, CW_CODE = 1;
constexpr int CW_BAR = 4096;
constexpr int CW_CNT = 16384;
static_assert((CW_CNT + NLAYER * 32 * 64) * 4 <= (int)CTL_ZERO_BYTES, "CTL words inside the memset region");

constexpr int RING_OFF = 0, RING_BYTES = 131072;
constexpr int LDSCTL_OFF = RING_BYTES, MISC_OFF = LDSCTL_OFF + 320;
constexpr int REC_OFF = MISC_OFF + 192;
constexpr int LDS_BYTES = 147456;
static_assert(REC_OFF + 8 * 40 * 8 <= LDS_BYTES && (REC_OFF % 16) == 0, "LDS map");

enum InIdx { I_X = 0, I_META, I_LNIN_G, I_LNIN_B, I_WIN, I_LAMRE, I_LAMIM, I_LOGDT, I_BRE, I_BIM, I_CRE, I_CIM, I_SSMD, I_WGLU, I_SSMWO, I_CONVW, I_CONVWO,
             I_LQ1, I_LK1, I_LQ2, I_LK2, I_SUBLN, I_ATTNWO, I_GATEW, I_GATEB, I_WO, I_LN1G, I_LN1B, I_RW, I_RB, I_WGU, I_BGU, I_WDN, I_BDN, I_LN2G, I_LN2B, N_IN };
struct Args { const float* in[N_IN]; float* out; unsigned char* ws; int ph_lo, ph_hi, li, pad; };
struct Frame {
    LAS unsigned char* lds;
    volatile LAS unsigned* MISC;
    gu32* ctl;
    unsigned char* ws;
    int tid, lane, wave;
    int vcu, G;
};
__device__ __forceinline__ float wave_sum(float v) {
#pragma unroll
    for (int o = 1; o < 64; o <<= 1) v += __shfl_xor(v, o);
    return v;
}
__device__ __forceinline__ float wave_max(float v) {
#pragma unroll
    for (int o = 1; o < 64; o <<= 1) v = fmaxf(v, __shfl_xor(v, o));
    return v;
}
__device__ __forceinline__ int wave_min_i(int v) {
#pragma unroll
    for (int o = 1; o < 64; o <<= 1) { const int w = __shfl_xor(v, o); v = w < v ? w : v; }
    return v;
}
__device__ __forceinline__ float bflo(unsigned w) { return __uint_as_float(w << 16); }
__device__ __forceinline__ float bfhi(unsigned w) { return __uint_as_float(w & 0xffff0000u); }
__device__ __forceinline__ void unpk8(v4u w, float (&f)[8]) { f[0] = bflo(w.x); f[1] = bfhi(w.x); f[2] = bflo(w.y); f[3] = bfhi(w.y); f[4] = bflo(w.z); f[5] = bfhi(w.z); f[6] = bflo(w.w); f[7] = bfhi(w.w); }
__device__ __forceinline__ v4u pk8(const float (&f)[8]) { v4u o; o.x = pk2(f[0], f[1]); o.y = pk2(f[2], f[3]); o.z = pk2(f[4], f[5]); o.w = pk2(f[6], f[7]); return o; }
__device__ __forceinline__ float sigm_(float x) { return 1.0f / (1.0f + __expf(-x)); }
__device__ __forceinline__ float gelu_(float x) { const float u = 0.7978845608028654f * (x + 0.044715f * x * x * x); return x * sigm_(2.0f * u); }

__device__ __forceinline__ int rowmap(int n, int mode) {
    if (mode == 1) { if (n >= 2048 && n < 4096) { const int d = n & 63; return (n & ~63) + (d < 32 ? 8 * (d >> 2) + (d & 3) : 8 * ((d - 32) >> 2) + 4 + (d & 3)); } return n; }
    if (mode == 2) { return n < 1024 ? 8 * (n >> 2) + (n & 3) : 8 * ((n - 1024) >> 2) + 4 + (n & 3); }
    return n;
}
__device__ __forceinline__ void transpose_item(const float* W, int K, int N, bf16* WT, int mode, LAS float* scr, int item, int lane) {
    const int nblk = N / 32, kb = item / nblk, nb = item - kb * nblk, k0 = 64 * kb, n0 = 32 * nb;
    typedef float f2 __attribute__((ext_vector_type(2)));
    f2 v[16];
    const int lr = lane >> 4, lc = 2 * (lane & 15);
#pragma unroll
    for (int i = 0; i < 16; ++i) v[i] = *(const GAS f2*)(W + (size_t)(k0 + 4 * i + lr) * N + n0 + lc);
#pragma unroll
    for (int i = 0; i < 16; ++i) { scr[(4 * i + lr) * 33 + lc] = v[i].x; scr[(4 * i + lr) * 33 + lc + 1] = v[i].y; }
    LDS_WAIT(); asm volatile("" ::: "memory");
    const int c = lane & 7;
#pragma unroll
    for (int j = 0; j < 4; ++j) { const int n = (lane >> 3) + 8 * j; const LAS float* s = scr + (8 * c) * 33 + n;
        v4u o; o.x = pk2(s[0 * 33], s[1 * 33]); o.y = pk2(s[2 * 33], s[3 * 33]); o.z = pk2(s[4 * 33], s[5 * 33]); o.w = pk2(s[6 * 33], s[7 * 33]);
        *(GAS v4u*)(WT + (size_t)rowmap(n0 + n, mode) * K + k0 + 8 * c) = o; }
    LDS_WAIT(); asm volatile("" ::: "memory");
}
__device__ __forceinline__ void ln16(f32x4 (&v)[4], const float* g, const float* b, int lane) {
    float s = 0.f;
#pragma unroll
    for (int j = 0; j < 4; ++j) s += (v[j].x + v[j].y) + (v[j].z + v[j].w);
    const float mean = wave_sum(s) * (1.f / 1024.f); float s2 = 0.f;
#pragma unroll
    for (int j = 0; j < 4; ++j) { v[j] = v[j] - mean; s2 += (v[j].x * v[j].x + v[j].y * v[j].y) + (v[j].z * v[j].z + v[j].w * v[j].w); }
    const float rstd = 1.f / sqrtf(wave_sum(s2) * (1.f / 1024.f) + LN_EPS);
#pragma unroll
    for (int j = 0; j < 4; ++j) { const f32x4 gg = *(const GAS f32x4*)(g + 256 * j + 4 * lane), bb = *(const GAS f32x4*)(b + 256 * j + 4 * lane); v[j] = v[j] * rstd * gg + bb; }
}
__device__ __forceinline__ void store_row_f32_bf16(const f32x4 (&v)[4], float* hf, bf16* hb, int lane) {
#pragma unroll
    for (int j = 0; j < 4; ++j) { if (hf) *(GAS f32x4*)(hf + 256 * j + 4 * lane) = v[j];
        *(GAS unsigned long long*)(hb + 256 * j + 4 * lane) = (unsigned long long)pk2(v[j].x, v[j].y) | ((unsigned long long)pk2(v[j].z, v[j].w) << 32); }
}

__device__ __forceinline__ void ssm_build(Frame& F, const Args& A, int l, int g) {
    LAS float* L = (LAS float*)(F.lds + RING_OFF);
    LAS float* AP_re = L; LAS float* AP_im = L + 4160; LAS float* BB_re = L + 8320; LAS float* BB_im = L + 9344; LAS float* CC_re = L + 10368; LAS float* CC_im = L + 11392; LAS float* KM = L + 12416;
    const int lg = l * 32 + g; const int tid = F.tid;
    const float dt = __expf(A.in[I_LOGDT][lg]);
    for (int idx = tid; idx < 65 * 64; idx += 512) { const int j = idx >> 6, p = idx & 63; const float lr = A.in[I_LAMRE][lg * 64 + p], li = A.in[I_LAMIM][lg * 64 + p];
        const float mag = expf(lr * dt * (float)j), ang = li * dt * (float)j; AP_re[idx] = mag * cosf(ang); AP_im[idx] = mag * sinf(ang); }
    __syncthreads();
    for (int idx = tid; idx < 1024; idx += 512) {
        { const int p = idx >> 4, c = idx & 15; const float lr = A.in[I_LAMRE][lg * 64 + p], li = A.in[I_LAMIM][lg * 64 + p];
          const float ar = AP_re[64 + p], ai = AP_im[64 + p], nr = ar - 1.0f, den = lr * lr + li * li;
          const float cr = (nr * lr + ai * li) / den, ci = (ai * lr - nr * li) / den;
          const float br = A.in[I_BRE][(size_t)(lg * 64 + p) * 16 + c], bi = A.in[I_BIM][(size_t)(lg * 64 + p) * 16 + c];
          BB_re[idx] = cr * br - ci * bi; BB_im[idx] = cr * bi + ci * br; }
        { CC_re[idx] = A.in[I_CRE][(size_t)lg * 1024 + idx]; CC_im[idx] = A.in[I_CIM][(size_t)lg * 1024 + idx]; }
    }
    __syncthreads();
    for (int idx = tid; idx < 16384; idx += 512) { const int j = idx >> 8, co = (idx >> 4) & 15, ci = idx & 15; float s = 0.f;
        for (int p = 0; p < 64; ++p) { const float Ar = AP_re[j * 64 + p], Ai = AP_im[j * 64 + p], Br = BB_re[p * 16 + ci], Bi = BB_im[p * 16 + ci];
            const float er = Ar * Br - Ai * Bi, ei = Ar * Bi + Ai * Br; s += CC_re[co * 64 + p] * er - CC_im[co * 64 + p] * ei; }
        if (j == 0 && co == ci) s += A.in[I_SSMD][l * 512 + g * 16 + co];
        KM[idx] = s; }
    __syncthreads();
    bf16* TOE = (bf16*)(F.ws + WS_W + (size_t)l * WL_STRIDE + WL_TOE) + (size_t)g * 1024 * 1152;
    for (int q = tid; q < 1024 * 144; q += 512) { const int n = q / 144, kc = q - n * 144, t = n >> 4, co = n & 15; float f[8];
        if (kc < 128) { const int s = kc >> 1, ci0 = (kc & 1) * 8;
            if (s <= t) {
#pragma unroll
                for (int i = 0; i < 8; ++i) f[i] = KM[(t - s) * 256 + co * 16 + ci0 + i]; }
            else {
#pragma unroll
                for (int i = 0; i < 8; ++i) f[i] = 0.f; } }
        else { const int p0 = (kc - 128) * 8;
#pragma unroll
            for (int i = 0; i < 8; ++i) { const int p = (p0 + i) & 63; const float Cr = CC_re[co * 64 + p], Ci = CC_im[co * 64 + p], Ar = AP_re[(t + 1) * 64 + p], Ai = AP_im[(t + 1) * 64 + p];
                f[i] = p0 < 64 ? (Cr * Ar - Ci * Ai) : -(Cr * Ai + Ci * Ar); } }
        *(GAS v4u*)(TOE + (size_t)n * 1152 + kc * 8) = pk8(f); }
    bf16* WST = (bf16*)(F.ws + WS_W + (size_t)l * WL_STRIDE + WL_ST) + (size_t)g * 256 * 1024;
    for (int q = tid; q < 256 * 128; q += 512) { const int n = q >> 7, kc = q & 127, s = kc >> 1, ci0 = (kc & 1) * 8; float f[8];
        if (n < 128) { const int p = n & 63; const float Ar = AP_re[(63 - s) * 64 + p], Ai = AP_im[(63 - s) * 64 + p];
#pragma unroll
            for (int i = 0; i < 8; ++i) { const float Br = BB_re[p * 16 + ci0 + i], Bi = BB_im[p * 16 + ci0 + i]; f[i] = n < 64 ? (Ar * Br - Ai * Bi) : (Ar * Bi + Ai * Br); } }
        else {
#pragma unroll
            for (int i = 0; i < 8; ++i) f[i] = 0.f; }
        *(GAS v4u*)(WST + (size_t)n * 1024 + kc * 8) = pk8(f); }
    float* SC = (float*)(F.ws + WS_SSMC + (size_t)l * MiB);
    if (tid < 64) { const int p = tid; SC[(lg * 64 + p) * 2] = AP_re[64 + p]; SC[(lg * 64 + p) * 2 + 1] = AP_im[64 + p];
        SC[16384 + (lg * 64 + p) * 2] = AP_re[64 * 64 + p]; SC[16384 + (lg * 64 + p) * 2 + 1] = AP_im[64 * 64 + p]; }
    for (int idx = tid; idx < 1024; idx += 512) { const int p = idx >> 4, c = idx & 15; SC[32768 + (size_t)(lg * 64 + p) * 32 + c] = BB_re[idx]; SC[32768 + (size_t)(lg * 64 + p) * 32 + 16 + c] = BB_im[idx]; }
    __syncthreads();
}

__device__ __forceinline__ void p0_prologue(Frame& F, const Args& A) {
    for (int job = F.vcu; job < NLAYER * 32; job += F.G) ssm_build(F, A, job >> 5, job & 31);
    const int gw = F.vcu * NWAVES + F.wave, NGW = F.G * NWAVES, lane = F.lane;
    float* HF = (float*)(F.ws + WS_HF); bf16* HB = (bf16*)(F.ws + WS_HB);
    for (int R = gw; R < MVALID; R += NGW) { const float* src = R < MREAL ? A.in[I_X] + (size_t)R * 1024 : A.in[I_META] + (size_t)((R - MREAL) & 15) * 1024;
        f32x4 v[4];
#pragma unroll
        for (int j = 0; j < 4; ++j) v[j] = *(const GAS f32x4*)(src + 256 * j + 4 * lane);
        ln16(v, A.in[I_LNIN_G], A.in[I_LNIN_B], lane); store_row_f32_bf16(v, HF + (size_t)R * 1024, HB + (size_t)R * 1024, lane); }
    { float* ROPE = (float*)(F.ws + WS_ROPE); const int gt = F.vcu * 512 + F.tid, NGT = F.G * 512;
      for (int idx = gt; idx < 8208 * 32; idx += NGT) { const int pos = idx >> 5, j = idx & 31; const float inv = exp2f(-(float)j * (13.287712379549449f / 32.0f)); const float ang = (float)pos * inv;
          ROPE[(size_t)pos * 64 + j] = cosf(ang); ROPE[(size_t)pos * 64 + 32 + j] = sinf(ang); } }
    { bf16* KB = (bf16*)(F.ws + WS_K); bf16* VB = (bf16*)(F.ws + WS_V);
      for (int r = gw; r < 512; r += NGW) { bf16* base = (r & 256) ? VB : KB; const int b = (r >> 7) & 1, rr = r & 127; GAS v4u* d = (GAS v4u*)(base + (size_t)(b * 8320 + 8192 + rr) * 1024);
          d[lane] = (v4u){0u, 0u, 0u, 0u}; d[64 + lane] = (v4u){0u, 0u, 0u, 0u}; } }
    LAS float* scr = (LAS float*)(F.lds + RING_OFF + F.wave * 16384);
    constexpr int IT_IN = 16 * 160, IT_GATE = 16 * 96, IT_GLU = 8 * 16, IT_SO = 8 * 32, IT_CO = 8 * 32, IT_AO = 16 * 32, IT_WO = 16 * 32, IT_GU1 = 16 * 64, IT_DN1 = 16 * 32;
    constexpr int IT_L = IT_IN + IT_GATE + IT_GLU + IT_SO + IT_CO + IT_AO + IT_WO + 32 * IT_GU1 + 32 * IT_DN1;
    for (int it = gw; it < NLAYER * IT_L; it += NGW) {
        const int l = it / IT_L; int r = it - l * IT_L; unsigned char* wl = F.ws + WS_W + (size_t)l * WL_STRIDE;
        if (r < IT_IN) { transpose_item(A.in[I_WIN] + (size_t)l * 1024 * 5120, 1024, 5120, (bf16*)(wl + WL_IN), 1, scr, r, lane); continue; } r -= IT_IN;
        if (r < IT_GATE) { transpose_item(A.in[I_GATEW] + (size_t)l * 1024 * 3072, 1024, 3072, (bf16*)(wl + WL_IN) + (size_t)5120 * 1024, 0, scr, r, lane); continue; } r -= IT_GATE;
        if (r < IT_GLU) { transpose_item(A.in[I_WGLU] + (size_t)l * 512 * 512, 512, 512, (bf16*)(wl + WL_GLU), 0, scr, r, lane); continue; } r -= IT_GLU;
        if (r < IT_SO) { transpose_item(A.in[I_SSMWO] + (size_t)l * 512 * 1024, 512, 1024, (bf16*)(wl + WL_SO), 0, scr, r, lane); continue; } r -= IT_SO;
        if (r < IT_CO) { transpose_item(A.in[I_CONVWO] + (size_t)l * 512 * 1024, 512, 1024, (bf16*)(wl + WL_CO), 0, scr, r, lane); continue; } r -= IT_CO;
        if (r < IT_AO) { transpose_item(A.in[I_ATTNWO] + (size_t)l * 1024 * 1024, 1024, 1024, (bf16*)(wl + WL_AO), 0, scr, r, lane); continue; } r -= IT_AO;
        if (r < IT_WO) { transpose_item(A.in[I_WO] + (size_t)l * 1024 * 1024, 1024, 1024, (bf16*)(wl + WL_WO), 0, scr, r, lane); continue; } r -= IT_WO;
        if (r < 32 * IT_GU1) { const int e = r / IT_GU1; transpose_item(A.in[I_WGU] + ((size_t)l * 32 + e) * 1024 * 2048, 1024, 2048, (bf16*)(wl + WL_GU) + (size_t)e * 2048 * 1024, 2, scr, r - e * IT_GU1, lane); continue; } r -= 32 * IT_GU1;
        { const int e = r / IT_DN1; transpose_item(A.in[I_WDN] + ((size_t)l * 32 + e) * 1024 * 1024, 1024, 1024, (bf16*)(wl + WL_DN) + (size_t)e * 1024 * 1024, 0, scr, r - e * IT_DN1, lane); }
    }
}

__device__ __forceinline__ int prev_row(int R, int k) {
    if (R < MREAL) { const int t = R & 8191, b = R >> 13; return t >= k ? R - k : MREAL + b * 16 + 16 - (k - t); }
    const int i = (R - MREAL) & 15; return i >= k ? R - k : -1;
}
__device__ __forceinline__ void conv_rows(Frame& F, const Args& A, int l) {
    const int gw = F.vcu * NWAVES + F.wave, NGW = F.G * NWAVES, lane = F.lane, c0 = 8 * lane;
    const bf16* CB = (const bf16*)(F.ws + WS_CONV); bf16* YC = (bf16*)(F.ws + WS_YC);
    float w0[8], w1[8], w2[8];
#pragma unroll
    for (int i = 0; i < 8; ++i) { w0[i] = A.in[I_CONVW][(size_t)l * 1536 + c0 + i]; w1[i] = A.in[I_CONVW][(size_t)l * 1536 + 512 + c0 + i]; w2[i] = A.in[I_CONVW][(size_t)l * 1536 + 1024 + c0 + i]; }
    for (int R = gw; R < MVALID; R += NGW) {
        const int r1 = prev_row(R, 1), r2 = prev_row(R, 2);
        float gb[8], a[8], h[8], z0[8], z1[8], z2[8];
        unpk8(*(const GAS v4u*)(CB + (size_t)R * 1536 + c0), gb);
        unpk8(*(const GAS v4u*)(CB + (size_t)R * 1536 + 512 + c0), a); unpk8(*(const GAS v4u*)(CB + (size_t)R * 1536 + 1024 + c0), h);
#pragma unroll
        for (int i = 0; i < 8; ++i) z0[i] = a[i] * h[i];
        if (r1 >= 0) { unpk8(*(const GAS v4u*)(CB + (size_t)r1 * 1536 + 512 + c0), a); unpk8(*(const GAS v4u*)(CB + (size_t)r1 * 1536 + 1024 + c0), h);
#pragma unroll
            for (int i = 0; i < 8; ++i) z1[i] = a[i] * h[i]; }
        else {
#pragma unroll
            for (int i = 0; i < 8; ++i) z1[i] = 0.f; }
        if (r2 >= 0) { unpk8(*(const GAS v4u*)(CB + (size_t)r2 * 1536 + 512 + c0), a); unpk8(*(const GAS v4u*)(CB + (size_t)r2 * 1536 + 1024 + c0), h);
#pragma unroll
            for (int i = 0; i < 8; ++i) z2[i] = a[i] * h[i]; }
        else {
#pragma unroll
            for (int i = 0; i < 8; ++i) z2[i] = 0.f; }
        float y[8];
#pragma unroll
        for (int i = 0; i < 8; ++i) y[i] = gb[i] * (w0[i] * z2[i] + w1[i] * z1[i] + w2[i] * z0[i]);
        *(GAS v4u*)(YC + (size_t)R * 512 + c0) = pk8(y);
    }
}
__device__ __forceinline__ void ssm_meta_job(Frame& F, const Args& A, int l, int bm, int g) {
    const int lane = F.lane, lg = l * 32 + g;
    const float* SC = (const float*)(F.ws + WS_SSMC + (size_t)l * MiB);
    const bf16* UM = (const bf16*)(F.ws + WS_UMETA); bf16* YG = (bf16*)(F.ws + WS_YG); float* SM = (float*)(F.ws + WS_SM);
    LAS float* scr = (LAS float*)(F.lds + RING_OFF + F.wave * 16384);
    const float ar = SC[(lg * 64 + lane) * 2], ai = SC[(lg * 64 + lane) * 2 + 1];
    float bbr[16], bbi[16];
#pragma unroll
    for (int c = 0; c < 16; ++c) { bbr[c] = SC[32768 + (size_t)(lg * 64 + lane) * 32 + c]; bbi[c] = SC[32768 + (size_t)(lg * 64 + lane) * 32 + 16 + c]; }
    float xr = 0.f, xi = 0.f;
    for (int s = 0; s < 16; ++s) { float ua[8], ub[8];
        unpk8(*(const GAS v4u*)(UM + (size_t)(bm * 16 + s) * 512 + g * 16), ua); unpk8(*(const GAS v4u*)(UM + (size_t)(bm * 16 + s) * 512 + g * 16 + 8), ub);
        float bur = 0.f, bui = 0.f;
#pragma unroll
        for (int c = 0; c < 8; ++c) { bur += bbr[c] * ua[c] + bbr[8 + c] * ub[c]; bui += bbi[c] * ua[c] + bbi[8 + c] * ub[c]; }
        const float nr = ar * xr - ai * xi + bur, ni = ar * xi + ai * xr + bui; xr = nr; xi = ni;
        scr[s * 128 + lane] = xr; scr[s * 128 + 64 + lane] = xi; }
    SM[(size_t)(bm * 32 + g) * 128 + lane] = xr; SM[(size_t)(bm * 32 + g) * 128 + 64 + lane] = xi;
    LDS_WAIT(); asm volatile("" ::: "memory");
    const int s = lane >> 2, coq = (lane & 3) * 4; float y[4];
#pragma unroll
    for (int i = 0; i < 4; ++i) { const int co = coq + i; const float* cre = A.in[I_CRE] + (size_t)(lg * 16 + co) * 64; const float* cim = A.in[I_CIM] + (size_t)(lg * 16 + co) * 64; float acc = 0.f;
        for (int p = 0; p < 64; ++p) acc += cre[p] * scr[s * 128 + p] - cim[p] * scr[s * 128 + 64 + p];
        y[i] = acc + A.in[I_SSMD][l * 512 + g * 16 + co] * __uint_as_float((unsigned)UM[(size_t)(bm * 16 + s) * 512 + g * 16 + co] << 16); }
    const unsigned long long o = (unsigned long long)pk2(gelu_(y[0]), gelu_(y[1])) | ((unsigned long long)pk2(gelu_(y[2]), gelu_(y[3])) << 32);
    *(GAS unsigned long long*)(YG + (size_t)(MREAL + bm * 16 + s) * 512 + g * 16 + coq) = o;
    LDS_WAIT(); asm volatile("" ::: "memory");
}
__device__ __forceinline__ void ssm_carry(Frame& F, int l) {
    const int T = F.vcu * 512 + F.tid; if (T >= 4096) return;
    const int b = T >> 11, g = (T >> 6) & 31, p = T & 63, lg = l * 32 + g;
    const float* SC = (const float*)(F.ws + WS_SSMC + (size_t)l * MiB); const float* SM = (const float*)(F.ws + WS_SM); const float* SL = (const float*)(F.ws + WS_SLOC); bf16* UC = (bf16*)(F.ws + WS_UC);
    const float a64r = SC[16384 + (lg * 64 + p) * 2], a64i = SC[16384 + (lg * 64 + p) * 2 + 1];
    float Sr = SM[(size_t)(b * 32 + g) * 128 + p], Si = SM[(size_t)(b * 32 + g) * 128 + 64 + p];
#pragma unroll 8
    for (int k = 0; k < 128; ++k) { const size_t row = (size_t)g * 256 + b * 128 + k;
        UC[row * 1152 + 1024 + p] = (bf16)f2bf(Sr); UC[row * 1152 + 1088 + p] = (bf16)f2bf(Si);
        const float lr = SL[row * 128 + p], li = SL[row * 128 + 64 + p];
        const float nr = a64r * Sr - a64i * Si + lr, ni = a64r * Si + a64i * Sr + li; Sr = nr; Si = ni; }
}
__device__ __forceinline__ void attn_meta_job(Frame& F, int Rm, int h) {
    const int lane = F.lane, bm = Rm >> 4, R = MREAL + Rm, j = lane >> 2, dq = lane & 3;
    const bf16* Q = (const bf16*)(F.ws + WS_Q); const bf16* K = (const bf16*)(F.ws + WS_K); const bf16* V = (const bf16*)(F.ws + WS_V); bf16* OC = (bf16*)(F.ws + WS_OC);
    const size_t krow = (size_t)bm * 8320 + 8256;
#pragma unroll
    for (int c = 0; c < 2; ++c) { const int hc = h * 2 + c; float qa[8], qb[8], ka[8], kb[8];
        unpk8(*(const GAS v4u*)(Q + (size_t)R * 1024 + hc * 64 + dq * 16), qa); unpk8(*(const GAS v4u*)(Q + (size_t)R * 1024 + hc * 64 + dq * 16 + 8), qb);
        unpk8(*(const GAS v4u*)(K + (krow + j) * 1024 + hc * 64 + dq * 16), ka); unpk8(*(const GAS v4u*)(K + (krow + j) * 1024 + hc * 64 + dq * 16 + 8), kb);
        float s = 0.f;
#pragma unroll
        for (int i = 0; i < 8; ++i) s += qa[i] * ka[i] + qb[i] * kb[i];
        s += __shfl_xor(s, 1); s += __shfl_xor(s, 2);
        float m = s;
#pragma unroll
        for (int o = 4; o < 64; o <<= 1) m = fmaxf(m, __shfl_xor(m, o));
        const float pj = exp2f(s - m); float lsum = pj;
#pragma unroll
        for (int o = 4; o < 64; o <<= 1) lsum += __shfl_xor(lsum, o);
        float o0 = 0.f, o1 = 0.f;
#pragma unroll
        for (int jj = 0; jj < 16; ++jj) { const float pp = __shfl(pj, 4 * jj); const unsigned vv = *(const GAS unsigned*)(V + (krow + jj) * 1024 + h * 128 + 2 * lane); o0 += pp * bflo(vv); o1 += pp * bfhi(vv); }
        const float rl = 1.0f / lsum;
        *(GAS unsigned*)(OC + (size_t)R * 2048 + hc * 128 + 2 * lane) = pk2(o0 * rl, o1 * rl); }
}
__device__ __forceinline__ void attn_combine_rows(Frame& F, const Args& A, int l) {
    const int gw = F.vcu * NWAVES + F.wave, NGW = F.G * NWAVES, lane = F.lane;
    const bf16* OC = (const bf16*)(F.ws + WS_OC); bf16* YA = (bf16*)(F.ws + WS_YA);
    const float lam_init = 0.8f - 0.6f * expf(-0.3f * (float)l);
    const float d1 = wave_sum(A.in[I_LQ1][l * 64 + lane] * A.in[I_LK1][l * 64 + lane]), d2 = wave_sum(A.in[I_LQ2][l * 64 + lane] * A.in[I_LK2][l * 64 + lane]);
    const float lam = expf(d1) - expf(d2) + lam_init;
    const int e0 = (lane & 15) * 8; float sg[8];
#pragma unroll
    for (int i = 0; i < 8; ++i) sg[i] = A.in[I_SUBLN][l * 128 + e0 + i] * (1.0f - lam_init);
    for (int R = gw; R < MVALID; R += NGW) {
#pragma unroll
        for (int pass = 0; pass < 2; ++pass) { const int h = pass * 4 + (lane >> 4); float a[8], b[8], d[8];
            unpk8(*(const GAS v4u*)(OC + (size_t)R * 2048 + (2 * h) * 128 + e0), a); unpk8(*(const GAS v4u*)(OC + (size_t)R * 2048 + (2 * h + 1) * 128 + e0), b);
            float ss = 0.f;
#pragma unroll
            for (int i = 0; i < 8; ++i) { d[i] = a[i] - lam * b[i]; ss += d[i] * d[i]; }
            ss += __shfl_xor(ss, 1); ss += __shfl_xor(ss, 2); ss += __shfl_xor(ss, 4); ss += __shfl_xor(ss, 8);
            const float rs = 1.0f / sqrtf(ss * (1.0f / 128.0f) + 1e-5f);
#pragma unroll
            for (int i = 0; i < 8; ++i) d[i] = d[i] * rs * sg[i];
            *(GAS v4u*)(YA + (size_t)R * 1024 + h * 128 + e0) = pk8(d); }
    }
}
__device__ __forceinline__ void ln1_router(Frame& F, const Args& A, int l) {
    const int tid = F.tid, lane = F.lane, wave = F.wave, gw = F.vcu * NWAVES + wave, NGW = F.G * NWAVES;
    LAS float* WT = (LAS float*)(F.lds + RING_OFF);
    LAS int* lcnt = (LAS int*)(F.lds + LDSCTL_OFF); LAS int* gbase = lcnt + 32;
    LAS unsigned* rec = (LAS unsigned*)(F.lds + REC_OFF) + wave * 80;
    const float* rw = A.in[I_RW] + (size_t)l * 1024 * 32;
    for (int idx = tid; idx < 32768; idx += 512) WT[(idx & 31) * 1024 + (idx >> 5)] = rw[idx];
    if (tid < 32) lcnt[tid] = 0;
    __syncthreads();
    const float* PRE = (const float*)(F.ws + WS_PRE); float* HF = (float*)(F.ws + WS_HF); bf16* HB = (bf16*)(F.ws + WS_HB);
    float* TOKW = (float*)(F.ws + WS_TOKW); unsigned* TOKE = (unsigned*)(F.ws + WS_TOKE); int* ROWIDX = (int*)(F.ws + WS_ROWIDX);
    const float rb = A.in[I_RB][l * 32 + (lane >> 1)];
    int nrec = 0;
    for (int R = gw; R < MVALID; R += NGW) {
        f32x4 v[4];
#pragma unroll
        for (int j = 0; j < 4; ++j) v[j] = *(const GAS f32x4*)(PRE + (size_t)R * 1024 + 256 * j + 4 * lane);
        ln16(v, A.in[I_LN1G] + l * 1024, A.in[I_LN1B] + l * 1024, lane);
        store_row_f32_bf16(v, HF + (size_t)R * 1024, HB + (size_t)R * 1024, lane);
        float acc[32];
#pragma unroll
        for (int e = 0; e < 32; ++e) { float s = 0.f;
#pragma unroll
            for (int j = 0; j < 4; ++j) { const f32x4 w = *(const LAS f32x4*)(WT + e * 1024 + 256 * j + 4 * lane); s += (v[j].x * w.x + v[j].y * w.y) + (v[j].z * w.z + v[j].w * w.w); }
            acc[e] = s; }
        float a16[16], a8[8], a4[4], a2[2], a1;
        { const bool hi = lane & 32;
#pragma unroll
          for (int i = 0; i < 16; ++i) { const float keep = hi ? acc[i + 16] : acc[i], give = hi ? acc[i] : acc[i + 16]; a16[i] = keep + __shfl_xor(give, 32); } }
        { const bool hi = lane & 16;
#pragma unroll
          for (int i = 0; i < 8; ++i) { const float keep = hi ? a16[i + 8] : a16[i], give = hi ? a16[i] : a16[i + 8]; a8[i] = keep + __shfl_xor(give, 16); } }
        { const bool hi = lane & 8;
#pragma unroll
          for (int i = 0; i < 4; ++i) { const float keep = hi ? a8[i + 4] : a8[i], give = hi ? a8[i] : a8[i + 4]; a4[i] = keep + __shfl_xor(give, 8); } }
        { const bool hi = lane & 4;
#pragma unroll
          for (int i = 0; i < 2; ++i) { const float keep = hi ? a4[i + 2] : a4[i], give = hi ? a4[i] : a4[i + 2]; a2[i] = keep + __shfl_xor(give, 4); } }
        { const bool hi = lane & 2; const float keep = hi ? a2[1] : a2[0], give = hi ? a2[0] : a2[1]; a1 = keep + __shfl_xor(give, 2); }
        float val = a1 + __shfl_xor(a1, 1) + rb;
        const int e_me = lane >> 1;
        float tv[4]; int te[4];
#pragma unroll
        for (int k = 0; k < 4; ++k) { const float m = wave_max(val); const int cand = (val == m) ? e_me : 99; const int idx = wave_min_i(cand); tv[k] = m; te[k] = idx; if (e_me == idx) val = -INFINITY; }
        const float p1 = __expf(tv[1] - tv[0]), p2 = __expf(tv[2] - tv[0]), p3 = __expf(tv[3] - tv[0]), rs = 1.0f / (1.0f + p1 + p2 + p3);
        if (lane < 4) { const int k = lane; const int e = k == 0 ? te[0] : k == 1 ? te[1] : k == 2 ? te[2] : te[3]; const float w = (k == 0 ? 1.0f : k == 1 ? p1 : k == 2 ? p2 : p3) * rs;
            TOKW[(size_t)R * 4 + k] = w; const int lp = __hip_atomic_fetch_add(&lcnt[e], 1, __ATOMIC_RELAXED, __HIP_MEMORY_SCOPE_WORKGROUP);
            rec[(nrec * 4 + k) * 2] = (unsigned)R; rec[(nrec * 4 + k) * 2 + 1] = (unsigned)e | ((unsigned)lp << 8); }
        ++nrec;
    }
    __syncthreads();
    if (tid < 32) gbase[tid] = (int)__hip_atomic_fetch_add(F.ctl + CW_CNT + (l * 32 + tid) * 64, (unsigned)lcnt[tid], RLX_AGENT);
    __syncthreads();
    if (lane < 4) for (int i = 0; i < nrec; ++i) { const unsigned R = rec[(i * 4 + lane) * 2], w = rec[(i * 4 + lane) * 2 + 1]; const int e = w & 255, pos = gbase[e] + (int)(w >> 8);
        ROWIDX[(size_t)e * CAP + pos] = (int)R; TOKE[(size_t)R * 4 + lane] = (unsigned)e | ((unsigned)pos << 8); }
    __syncthreads();
}
__device__ __forceinline__ void moe_tables(Frame& F, int l) {
    LAS int* tb = (LAS int*)(F.lds + LDSCTL_OFF); LAS int* cn = tb + 34;
    __syncthreads();
    if (F.tid < 32) cn[F.tid] = (int)__hip_atomic_load(F.ctl + CW_CNT + (l * 32 + F.tid) * 64, RLX_AGENT);
    __syncthreads();
    if (F.tid == 0) { int s = 0; for (int e = 0; e < 32; ++e) { tb[e] = s; s += (cn[e] + 255) >> 8; } tb[32] = s; }
    __syncthreads();
}
__device__ __forceinline__ void moe_gather(Frame& F) {
    const LAS int* tb = (const LAS int*)(F.lds + LDSCTL_OFF); const LAS int* cn = tb + 34;
    const int gw = F.vcu * NWAVES + F.wave, NGW = F.G * NWAVES, lane = F.lane;
    const bf16* HB = (const bf16*)(F.ws + WS_HB); bf16* XG = (bf16*)(F.ws + WS_XG); const int* ROWIDX = (const int*)(F.ws + WS_ROWIDX);
    const int total = tb[32] * 256;
    for (int r = gw; r < total; r += NGW) { const int mt = r >> 8; int e = 0; while (tb[e + 1] <= mt) ++e; const int pos = r - tb[e] * 256;
        if (pos < cn[e]) { const int src = ROWIDX[(size_t)e * CAP + pos]; const GAS v4u* s = (const GAS v4u*)(HB + (size_t)src * 1024); GAS v4u* d = (GAS v4u*)(XG + (size_t)r * 1024);
            const v4u a = s[lane], b = s[64 + lane]; d[lane] = a; d[64 + lane] = b; } }
}
__device__ __forceinline__ void ln2_rows(Frame& F, const Args& A, int l) {
    const LAS int* tb = (const LAS int*)(F.lds + LDSCTL_OFF);
    const int gw = F.vcu * NWAVES + F.wave, NGW = F.G * NWAVES, lane = F.lane;
    float* HF = (float*)(F.ws + WS_HF); bf16* HB = (bf16*)(F.ws + WS_HB); const bf16* OUTS = (const bf16*)(F.ws + WS_OUTS);
    const float* TOKW = (const float*)(F.ws + WS_TOKW); const unsigned* TOKE = (const unsigned*)(F.ws + WS_TOKE);
    for (int R = gw; R < MVALID; R += NGW) {
        f32x4 v[4];
#pragma unroll
        for (int j = 0; j < 4; ++j) v[j] = *(const GAS f32x4*)(HF + (size_t)R * 1024 + 256 * j + 4 * lane) * ALPHA;
#pragma unroll
        for (int k = 0; k < 4; ++k) { const unsigned te = TOKE[(size_t)R * 4 + k]; const float w = TOKW[(size_t)R * 4 + k]; const size_t crow = (size_t)tb[te & 255] * 256 + (te >> 8);
#pragma unroll
            for (int j = 0; j < 4; ++j) { const unsigned long long o = *(const GAS unsigned long long*)(OUTS + crow * 1024 + 256 * j + 4 * lane); const unsigned lo = (unsigned)o, hi = (unsigned)(o >> 32);
                v[j].x += w * bflo(lo); v[j].y += w * bfhi(lo); v[j].z += w * bflo(hi); v[j].w += w * bfhi(hi); } }
        ln16(v, A.in[I_LN2G] + l * 1024, A.in[I_LN2B] + l * 1024, lane);
#if defined(SELFCHK)
        if (l == NLAYER - 1) { const unsigned mask = __hip_atomic_load(F.ctl + 2048, RLX_AGENT); if (mask) { const float pv = (float)(1u << (__ffs((int)mask) - 1));
#pragma unroll
            for (int j = 0; j < 4; ++j) v[j] = (f32x4){pv, pv, pv, pv}; } }
#endif
        if (l == NLAYER - 1) { if (R < MREAL) {
#pragma unroll
                for (int j = 0; j < 4; ++j) *(GAS f32x4*)(A.out + (size_t)R * 1024 + 256 * j + 4 * lane) = v[j]; } }
        else store_row_f32_bf16(v, HF + (size_t)R * 1024, HB + (size_t)R * 1024, lane);
    }
}

#if defined(SELFCHK)
constexpr int CW_FAIL = 2048;
__device__ __forceinline__ void chk_report(Frame& F, int id, float got, float ref, float scale) {
    const float err = fabsf(got - ref);
    if (!(err <= 0.03f * fabsf(ref) + 0.03f * scale)) __hip_atomic_fetch_or(F.ctl + CW_FAIL, 1u << id, RLX_AGENT);
}
__device__ __forceinline__ float bfr(float x) { return __uint_as_float(f2bf(x) << 16); }
__device__ __forceinline__ float ldbf(const bf16* p) { return __uint_as_float((unsigned)(*(const GAS bf16*)p) << 16); }
__device__ __forceinline__ float dot_bf_w(const bf16* a, const float* W, int K, int ldw, int col, int lane) {
    float s = 0.f; for (int k = lane; k < K; k += 64) s += ldbf(a + k) * bfr(W[(size_t)k * ldw + col]); return wave_sum(s);
}
__device__ __forceinline__ int smp_row(int i) { const int t[16] = {0, 1, 2, 63, 64, 100, 255, 256, 8191, 8192, 8193, 12345, 16383, 16384, 16399, 16415}; int r = 0;
#pragma unroll
    for (int j = 0; j < 16; ++j) if (i == j) r = t[j];
    return r; }
__device__ __forceinline__ void chk_p1(Frame& F, const Args& A, int l) {
    const int gw = F.vcu * NWAVES + F.wave, NGW = F.G * NWAVES, lane = F.lane;
    const bf16* HB = (const bf16*)(F.ws + WS_HB); const float* Win = A.in[I_WIN] + (size_t)l * 1024 * 5120; const float* Wg = A.in[I_GATEW] + (size_t)l * 1024 * 3072;
    const float* ROPE = (const float*)(F.ws + WS_ROPE);
    for (int job = gw; job < 16 * 24; job += NGW) { const int R = smp_row(job / 24), ci = job % 24; const bf16* a = HB + (size_t)R * 1024;
        if (ci < 4) { const int c = (ci * 171 + 5) & 511; const float ref = dot_bf_w(a, Win, 1024, 5120, c, lane); float got;
            if (R < MREAL) { const int g = c >> 4, chunkrow = (R >> 13) * 128 + ((R & 8191) >> 6), s = R & 63; got = ldbf((const bf16*)(F.ws + WS_UC) + ((size_t)(g * 256 + chunkrow) * 1152 + s * 16 + (c & 15))); }
            else got = ldbf((const bf16*)(F.ws + WS_UMETA) + (size_t)(R - MREAL) * 512 + c);
            if (lane == 0) chk_report(F, 1, got, ref, 1.0f); }
        else if (ci < 8) { const int c = ((ci - 4) * 397 + 11) % 1536; const float ref = dot_bf_w(a, Win, 1024, 5120, 512 + c, lane); const float got = ldbf((const bf16*)(F.ws + WS_CONV) + (size_t)R * 1536 + c);
            if (lane == 0) chk_report(F, 1, got, ref, 1.0f); }
        else if (ci < 16) { const bool isq = ci < 12; const int cc = ((ci & 3) * 277 + 33) & 1023, hh = cc >> 6, d = cc & 63, j = d & 31;
            const int base = (isq ? 2048 : 3072) + hh * 64; const float xl = dot_bf_w(a, Win, 1024, 5120, base + j, lane), xh = dot_bf_w(a, Win, 1024, 5120, base + 32 + j, lane);
            const int pos = R < MREAL ? 16 + (R & 8191) : ((R - MREAL) & 15); const float cs = ROPE[(size_t)pos * 64 + j], sn = ROPE[(size_t)pos * 64 + 32 + j];
            float ref = d < 32 ? xl * cs - xh * sn : xh * cs + xl * sn; if (isq) ref *= pg8::QSCALE;
            const float got = isq ? ldbf((const bf16*)(F.ws + WS_Q) + (size_t)R * 1024 + cc) : ldbf((const bf16*)(F.ws + WS_K) + (size_t)pg8::kv_row(R) * 1024 + cc);
            if (lane == 0) chk_report(F, 2, got, ref, isq ? 0.2f : 1.0f); }
        else if (ci < 20) { const int c = ((ci - 16) * 301 + 7) & 1023; const float ref = dot_bf_w(a, Win, 1024, 5120, 4096 + c, lane); const float got = ldbf((const bf16*)(F.ws + WS_V) + (size_t)pg8::kv_row(R) * 1024 + c);
            if (lane == 0) chk_report(F, 3, got, ref, 0.5f); }
        else { const int c = ((ci - 20) * 811 + 3) % 3072; const float ref = sigm_(dot_bf_w(a, Wg, 1024, 3072, c, lane) + A.in[I_GATEB][(size_t)l * 3072 + c]); const float got = ldbf((const bf16*)(F.ws + WS_GB) + (size_t)R * 3072 + c);
            if (lane == 0) chk_report(F, 3, got, ref, 0.3f); }
    }
}
__device__ __forceinline__ float u_at(Frame& F, int b, int sp, int c) {
    if (sp < 16) return ldbf((const bf16*)(F.ws + WS_UMETA) + (size_t)(b * 16 + sp) * 512 + c);
    const int t = sp - 16; return ldbf((const bf16*)(F.ws + WS_UC) + ((size_t)((c >> 4) * 256 + b * 128 + (t >> 6)) * 1152 + (t & 63) * 16 + (c & 15)));
}
__device__ __forceinline__ int seq_row(int b, int sp) { return sp < 16 ? MREAL + b * 16 + sp : b * 8192 + (sp - 16); }
__device__ __forceinline__ void chk_ssm_conv(Frame& F, const Args& A, int l) {
    const int gw = F.vcu * NWAVES + F.wave, NGW = F.G * NWAVES, lane = F.lane;
    LAS float* scr = (LAS float*)(F.lds + RING_OFF + F.wave * 16384);
    for (int job = gw; job < 2 * 12 * 3; job += NGW) { const int b = job / 36, si = (job / 3) % 12, gi = job % 3; const int g = gi == 0 ? 0 : gi == 1 ? 13 : 31;
        const int sps[12] = {0, 15, 16, 17, 79, 80, 81, 143, 144, 1000, 4111, 8207}; int sp = 0;
#pragma unroll
        for (int j = 0; j < 12; ++j) if (si == j) sp = sps[j];
        const int lg = l * 32 + g, p = lane; const float lr = A.in[I_LAMRE][lg * 64 + p], li = A.in[I_LAMIM][lg * 64 + p], dt = expf(A.in[I_LOGDT][lg]);
        const float mag = expf(lr * dt), ar = mag * cosf(li * dt), ai = mag * sinf(li * dt), nr = ar - 1.0f, den = lr * lr + li * li;
        const float cr = (nr * lr + ai * li) / den, ci = (ai * lr - nr * li) / den;
        float bbr[16], bbi[16];
#pragma unroll
        for (int c = 0; c < 16; ++c) { const float br = A.in[I_BRE][(size_t)(lg * 64 + p) * 16 + c], bi = A.in[I_BIM][(size_t)(lg * 64 + p) * 16 + c]; bbr[c] = cr * br - ci * bi; bbi[c] = cr * bi + ci * br; }
        float xr = 0.f, xi = 0.f;
        for (int s = 0; s <= sp; ++s) { float bur = 0.f, bui = 0.f;
#pragma unroll
            for (int c = 0; c < 16; ++c) { const float u = u_at(F, b, s, g * 16 + c); bur += bbr[c] * u; bui += bbi[c] * u; }
            const float n1 = ar * xr - ai * xi + bur, n2 = ar * xi + ai * xr + bui; xr = n1; xi = n2; }
        scr[lane] = xr; scr[64 + lane] = xi; LDS_WAIT(); asm volatile("" ::: "memory");
        if (lane < 16) { const int co = lane; float y = 0.f;
            for (int q = 0; q < 64; ++q) y += A.in[I_CRE][(size_t)(lg * 16 + co) * 64 + q] * scr[q] - A.in[I_CIM][(size_t)(lg * 16 + co) * 64 + q] * scr[64 + q];
            y += A.in[I_SSMD][l * 512 + g * 16 + co] * u_at(F, b, sp, g * 16 + co);
            const float ref = gelu_(y), got = ldbf((const bf16*)(F.ws + WS_YG) + (size_t)seq_row(b, sp) * 512 + g * 16 + co);
            chk_report(F, sp < 16 ? 4 : 5, got, ref, 0.3f); }
        LDS_WAIT(); asm volatile("" ::: "memory");
    }
    for (int job = gw; job < 16; job += NGW) { const int R = smp_row(job), c = (lane * 37 + 5) & 511; const bf16* CB = (const bf16*)(F.ws + WS_CONV);
        float y = 0.f;
        for (int k = 0; k < 3; ++k) { const int r = k == 0 ? R : prev_row(R, k); if (r >= 0) y += A.in[I_CONVW][(size_t)l * 1536 + (2 - k) * 512 + c] * ldbf(CB + (size_t)r * 1536 + 512 + c) * ldbf(CB + (size_t)r * 1536 + 1024 + c); }
        const float ref = y * ldbf(CB + (size_t)R * 1536 + c), got = ldbf((const bf16*)(F.ws + WS_YC) + (size_t)R * 512 + c);
        chk_report(F, 6, got, ref, 0.5f); }
}
__device__ __forceinline__ void chk_attn(Frame& F) {
    const int gw = F.vcu * NWAVES + F.wave, NGW = F.G * NWAVES, lane = F.lane;
    const bf16* Q = (const bf16*)(F.ws + WS_Q); const bf16* K = (const bf16*)(F.ws + WS_K); const bf16* V = (const bf16*)(F.ws + WS_V); const bf16* OC = (const bf16*)(F.ws + WS_OC);
    for (int job = gw; job < 16 * 3; job += NGW) { const int R = smp_row(job / 3), hi_ = job % 3, hc = hi_ == 0 ? 0 : hi_ == 1 ? 5 : 15, h = hc >> 1;
        const int b = R < MREAL ? (R >> 13) : ((R - MREAL) >> 4); const int nreal = R < MREAL ? (((R & 8191) >> 6) + 1) * 64 : 0, nk = 16 + nreal;
        const float q = ldbf(Q + (size_t)R * 1024 + hc * 64 + lane);
        float m = -INFINITY;
        for (int j = 0; j < nk; ++j) { const size_t kr = (size_t)b * 8320 + (j < 16 ? 8256 + j : j - 16); const float s = wave_sum(q * ldbf(K + kr * 1024 + hc * 64 + lane)); m = fmaxf(m, s); }
        float lsum = 0.f, o0 = 0.f, o1 = 0.f;
        for (int j = 0; j < nk; ++j) { const size_t kr = (size_t)b * 8320 + (j < 16 ? 8256 + j : j - 16); const float s = wave_sum(q * ldbf(K + kr * 1024 + hc * 64 + lane)); const float p = exp2f(s - m);
            lsum += p; o0 += p * ldbf(V + kr * 1024 + h * 128 + 2 * lane); o1 += p * ldbf(V + kr * 1024 + h * 128 + 2 * lane + 1); }
        const float g0 = ldbf(OC + (size_t)R * 2048 + hc * 128 + 2 * lane), g1 = ldbf(OC + (size_t)R * 2048 + hc * 128 + 2 * lane + 1);
        chk_report(F, R < MREAL ? 7 : 8, g0, o0 / lsum, 0.05f); chk_report(F, R < MREAL ? 7 : 8, g1, o1 / lsum, 0.05f); }
}
__device__ __forceinline__ void chk_mix(Frame& F, const Args& A, int l) {
    const int gw = F.vcu * NWAVES + F.wave, NGW = F.G * NWAVES, lane = F.lane;
    const bf16* YG = (const bf16*)(F.ws + WS_YG); const bf16* YS = (const bf16*)(F.ws + WS_YS); const bf16* YC = (const bf16*)(F.ws + WS_YC); const bf16* YA = (const bf16*)(F.ws + WS_YA);
    const bf16* GB = (const bf16*)(F.ws + WS_GB); const bf16* MG = (const bf16*)(F.ws + WS_MG); const bf16* OC = (const bf16*)(F.ws + WS_OC);
    for (int job = gw; job < 16 * 4; job += NGW) { const int R = smp_row(job >> 2), ci = job & 3;
        { const int c = (ci * 139 + 21) & 511; const float z = dot_bf_w(YG + (size_t)R * 512, A.in[I_WGLU] + (size_t)l * 512 * 512, 512, 512, c, lane); const float ref = ldbf(YG + (size_t)R * 512 + c) * sigm_(z);
          if (lane == 0) chk_report(F, 9, ldbf(YS + (size_t)R * 512 + c), ref, 0.2f); }
        { const int h = (ci * 3 + 1) & 7; const float lam_init = 0.8f - 0.6f * expf(-0.3f * (float)l);
          const float d1 = wave_sum(A.in[I_LQ1][l * 64 + lane] * A.in[I_LK1][l * 64 + lane]), d2 = wave_sum(A.in[I_LQ2][l * 64 + lane] * A.in[I_LK2][l * 64 + lane]); const float lam = expf(d1) - expf(d2) + lam_init;
          const float a0 = ldbf(OC + (size_t)R * 2048 + (2 * h) * 128 + lane) - lam * ldbf(OC + (size_t)R * 2048 + (2 * h + 1) * 128 + lane), a1 = ldbf(OC + (size_t)R * 2048 + (2 * h) * 128 + 64 + lane) - lam * ldbf(OC + (size_t)R * 2048 + (2 * h + 1) * 128 + 64 + lane);
          const float rs = 1.0f / sqrtf(wave_sum(a0 * a0 + a1 * a1) * (1.0f / 128.0f) + 1e-5f);
          chk_report(F, 10, ldbf(YA + (size_t)R * 1024 + h * 128 + lane), a0 * rs * A.in[I_SUBLN][l * 128 + lane] * (1.0f - lam_init), 0.3f);
          chk_report(F, 10, ldbf(YA + (size_t)R * 1024 + h * 128 + 64 + lane), a1 * rs * A.in[I_SUBLN][l * 128 + 64 + lane] * (1.0f - lam_init), 0.3f); }
        { const int c = (ci * 269 + 77) & 1023;
          const float p0 = dot_bf_w(YS + (size_t)R * 512, A.in[I_SSMWO] + (size_t)l * 512 * 1024, 512, 1024, c, lane), p1 = dot_bf_w(YC + (size_t)R * 512, A.in[I_CONVWO] + (size_t)l * 512 * 1024, 512, 1024, c, lane),
                      p2 = dot_bf_w(YA + (size_t)R * 1024, A.in[I_ATTNWO] + (size_t)l * 1024 * 1024, 1024, 1024, c, lane);
          const float ref = ldbf(GB + (size_t)R * 3072 + c) * p0 + ldbf(GB + (size_t)R * 3072 + 1024 + c) * p1 + ldbf(GB + (size_t)R * 3072 + 2048 + c) * p2;
          if (lane == 0) chk_report(F, 11, ldbf(MG + (size_t)R * 1024 + c), ref, 0.3f);
          const float pr = dot_bf_w(MG + (size_t)R * 1024, A.in[I_WO] + (size_t)l * 1024 * 1024, 1024, 1024, c, lane);
          if (lane == 0) chk_report(F, 12, ((const float*)(F.ws + WS_PRE))[(size_t)R * 1024 + c], ALPHA * ((const float*)(F.ws + WS_HF))[(size_t)R * 1024 + c] + pr, 0.5f); }
    }
}
__device__ __forceinline__ void chk_moe(Frame& F, const Args& A, int l) {
    const LAS int* tb = (const LAS int*)(F.lds + LDSCTL_OFF);
    const int gw = F.vcu * NWAVES + F.wave, NGW = F.G * NWAVES, lane = F.lane;
    const float* HF = (const float*)(F.ws + WS_HF); const bf16* HB = (const bf16*)(F.ws + WS_HB); const unsigned* TOKE = (const unsigned*)(F.ws + WS_TOKE); const float* TOKW = (const float*)(F.ws + WS_TOKW);
    LAS float* scr = (LAS float*)(F.lds + RING_OFF + F.wave * 16384);
    for (int job = gw; job < 16 * 4; job += NGW) { const int R = smp_row(job >> 2), k = job & 3;
        float lg_ = -INFINITY; if (lane < 32) { float s = 0.f; for (int q = 0; q < 1024; ++q) s += HF[(size_t)R * 1024 + q] * A.in[I_RW][(size_t)l * 32768 + q * 32 + lane]; lg_ = s + A.in[I_RB][l * 32 + lane]; }
        float val = lg_, tv[4]; int te[4];
#pragma unroll
        for (int kk = 0; kk < 4; ++kk) { const float m = wave_max(val); const int idx = wave_min_i(val == m ? lane : 99); tv[kk] = m; te[kk] = idx; if (lane == idx) val = -INFINITY; }
        const float den = 1.0f + expf(tv[1] - tv[0]) + expf(tv[2] - tv[0]) + expf(tv[3] - tv[0]);
        const unsigned tk = TOKE[(size_t)R * 4 + k]; const int e = tk & 255, pos = tk >> 8; const float w = TOKW[(size_t)R * 4 + k];
        const int ek = k == 0 ? te[0] : k == 1 ? te[1] : k == 2 ? te[2] : te[3]; const float wk = expf((k == 0 ? tv[0] : k == 1 ? tv[1] : k == 2 ? tv[2] : tv[3]) - tv[0]) / den;
        const float gap = tv[3] - wave_max(val);
        if (lane == 0 && gap > 1e-3f) { chk_report(F, 13, (float)e, (float)ek, 0.0f); chk_report(F, 13, w, wk, 0.01f); }
        if (((const int*)(F.ws + WS_ROWIDX))[(size_t)e * CAP + pos] != R && lane == 0) chk_report(F, 14, 1.0f, 0.0f, 0.0f);
        const float* wgu = A.in[I_WGU] + ((size_t)l * 32 + e) * 1024 * 2048; const float* bgu = A.in[I_BGU] + ((size_t)l * 32 + e) * 2048;
        for (int j = lane; j < 1024; j += 64) { float g = 0.f, u = 0.f; for (int q = 0; q < 1024; ++q) { const float x = ldbf(HB + (size_t)R * 1024 + q); g += x * bfr(wgu[(size_t)q * 2048 + j]); u += x * bfr(wgu[(size_t)q * 2048 + 1024 + j]); }
            g = fminf(g + bgu[j], 7.0f); u = fminf(fmaxf(u + bgu[1024 + j], -7.0f), 7.0f); scr[j] = bfr((u + 1.0f) * g * sigm_(1.702f * g)); }
        LDS_WAIT(); asm volatile("" ::: "memory");
        const float* wd = A.in[I_WDN] + ((size_t)l * 32 + e) * 1024 * 1024; const int c = (lane * 13 + k * 251) & 1023; float o = 0.f;
        for (int q = 0; q < 1024; ++q) o += scr[q] * bfr(wd[(size_t)q * 1024 + c]);
        o += A.in[I_BDN][((size_t)l * 32 + e) * 1024 + c];
        chk_report(F, 15, ldbf((const bf16*)(F.ws + WS_OUTS) + ((size_t)tb[e] * 256 + pos) * 1024 + c), o, 0.1f);
        LDS_WAIT(); asm volatile("" ::: "memory");
    }
}
#endif

#ifndef PHASE_MASK
#define PHASE_MASK 0x1fff
#endif
#define PH_ON(k) (((PHASE_MASK) >> (k)) & 1)
typedef const __attribute__((address_space(4))) Args* KArgs;
#define PHASE_ENV() KArgs kap_ = (KArgs)__builtin_amdgcn_kernarg_segment_ptr(); asm volatile("" : "+s"(kap_)); const Args& args = *(const Args*)kap_; unsigned char* ws = args.ws; F.ws = ws; F.ctl = (gu32*)(ws + WS_CTL); \
    { int t_ = threadIdx.x; asm volatile("" : "+v"(t_)); F.tid = t_; F.lane = t_ & 63; F.wave = __builtin_amdgcn_readfirstlane(t_ >> 6); } \
    int bid = (int)blockIdx.x; asm volatile("" : "+s"(bid)); F.G = gridDim.x; F.vcu = (F.G % 8 == 0) ? (bid % 8) * (F.G / 8) + bid / 8 : bid; \
    const int gw = F.vcu * NWAVES + F.wave, NGW = F.G * NWAVES; (void)gw; (void)NGW; \
    unsigned char* wl = ws + WS_W + (size_t)l * WL_STRIDE; bf16* HB = (bf16*)(ws + WS_HB); float* HF = (float*)(ws + WS_HF); (void)wl; (void)HB; (void)HF
__global__ void __launch_bounds__(NWAVES * 64, 2) mk_fwd(Args args_) {
    extern __shared__ __attribute__((aligned(16))) unsigned char lds[];
    Frame F;
    F.lds = (LAS unsigned char*)lds;
    F.MISC = (volatile LAS unsigned*)(F.lds + MISC_OFF);
    F.tid = threadIdx.x; F.lane = F.tid & 63; F.wave = __builtin_amdgcn_readfirstlane(F.tid >> 6);
    F.G = gridDim.x; { const int bx = blockIdx.x; F.vcu = (F.G % 8 == 0) ? (bx % 8) * (F.G / 8) + bx / 8 : bx; }
    F.ws = args_.ws; F.ctl = (gu32*)(args_.ws + WS_CTL);
    for (int u = F.tid; u < (LDS_BYTES - LDSCTL_OFF) / 4; u += NWAVES * 64) ((LAS unsigned*)(F.lds + LDSCTL_OFF))[u] = 0u;
    __syncthreads();
    XcdBarrier bar; bar.bar = (unsigned*)(F.ctl + CW_BAR); bar.x = 0; bar.st = nullptr;
    if (N_LAUNCHES == 1) bar = xcd_barrier_post((unsigned*)(F.ctl + CW_BAR), F.MISC + 8);
#define GRID_BAR() do { if (N_LAUNCHES != 1) { if (F.tid == 0) __hip_atomic_store(F.ctl + CW_TMO, 0xBADBA0u, RLX_AGENT); } else { xcd_barrier(bar); } } while (0)
    const int lo = args_.ph_lo, hi = args_.ph_hi;
#define IN(k) (lo <= (k) && (k) < hi)
#define BOTH(k) (IN(k) && IN((k) + 1))

    if (PH_ON(0) && IN(0)) { const int l = 0; PHASE_ENV(); p0_prologue(F, args); if (BOTH(0)) GRID_BAR(); }

    for (int l = 0; l < NLAYER; ++l) {
        const int pb = 1 + 12 * l;
        if (PH_ON(1) && IN(pb + 0)) { PHASE_ENV();
            pg8::Gemm g{HB, (const bf16*)(wl + WL_IN), 1024, 1024, 1024}; pg8::StaticOrder S; S.init(MP, NP1, F.G, bid);
            pg8::EpiP1 E{(bf16*)(ws + WS_UC), (bf16*)(ws + WS_UMETA), (bf16*)(ws + WS_CONV), (bf16*)(ws + WS_Q), (bf16*)(ws + WS_K), (bf16*)(ws + WS_V), (bf16*)(ws + WS_GB), (const float*)(ws + WS_ROPE), args.in[I_GATEB] + (size_t)l * 3072};
            pg8::gemm_phase<pg8::EpiP1, pg8::StaticOrder, PG8_ALIGN, PG8_SP2>(F.lds + RING_OFF, g, S, E);
            if (BOTH(pb + 0)) GRID_BAR();
        }
        if (PH_ON(2) && IN(pb + 1)) { PHASE_ENV();
#if defined(SELFCHK)
            if (l == 0) chk_p1(F, args, l);
#endif
            pg8::Gemm g{(const bf16*)(ws + WS_UC), (const bf16*)(wl + WL_ST), 1152, 1024, 1024}; pg8::FirstN S{32, 1, F.G, bid};
            pg8::EpiSloc E{(float*)(ws + WS_SLOC)};
            pg8::gemm_phase<pg8::EpiSloc, pg8::FirstN, PG8_ALIGN, PG8_SP2>(F.lds + RING_OFF, g, S, E);
            conv_rows(F, args, l);
            for (int job = NGW - 1 - gw; job < 64; job += NGW) ssm_meta_job(F, args, l, job >> 5, job & 31);
            if (BOTH(pb + 1)) GRID_BAR();
        }
        if (PH_ON(3) && IN(pb + 2)) { PHASE_ENV(); ssm_carry(F, l); if (BOTH(pb + 2)) GRID_BAR(); }
        if (PH_ON(4) && IN(pb + 3)) { PHASE_ENV();
            { pg8::Gemm g{(const bf16*)(ws + WS_UC), (const bf16*)(wl + WL_TOE), 1152, 1152, 1152}; pg8::FirstN S{128, 4, F.G, bid};
              pg8::EpiY E{(bf16*)(ws + WS_YG)};
              pg8::gemm_phase<pg8::EpiY, pg8::FirstN, PG8_ALIGN, PG8_SP2>(F.lds + RING_OFF, g, S, E); }
            { const attn_body::AttnTensors AT{(const attn_body::bf16*)(ws + WS_Q), (const attn_body::bf16*)(ws + WS_K), (const attn_body::bf16*)(ws + WS_V), (attn_body::bf16*)(ws + WS_OC)};
              const attn_body::StaticOrder S((int)F.G, bid);
              attn_body::attn_phase<attn_body::StaticOrder>((char*)lds + RING_OFF, AT, S); }
            for (int job = gw; job < 256; job += NGW) attn_meta_job(F, job >> 3, job & 7);
            if (BOTH(pb + 3)) GRID_BAR();
        }
        if (PH_ON(5) && IN(pb + 4)) { PHASE_ENV();
            pg8::Gemm g{(const bf16*)(ws + WS_YG), (const bf16*)(wl + WL_GLU), 512, 512, 512}; pg8::StaticOrder S; S.init(MP, 512, F.G, bid);
            pg8::EpiGLU E{(const bf16*)(ws + WS_YG), (bf16*)(ws + WS_YS)};
            pg8::gemm_phase<pg8::EpiGLU, pg8::StaticOrder, PG8_ALIGN, PG8_SP2>(F.lds + RING_OFF, g, S, E);
            attn_combine_rows(F, args, l);
            if (BOTH(pb + 4)) GRID_BAR();
        }
        if (PH_ON(6) && IN(pb + 5)) { PHASE_ENV();
            pg8::StaticOrder S; S.init(MP, 1024, F.G, bid);
            { pg8::Gemm g{(const bf16*)(ws + WS_YS), (const bf16*)(wl + WL_SO), 512, 512, 512}; pg8::EpiMerge<0> E{(const bf16*)(ws + WS_GB), (bf16*)(ws + WS_MG)};
              pg8::gemm_phase<pg8::EpiMerge<0>, pg8::StaticOrder, PG8_ALIGN, PG8_SP2>(F.lds + RING_OFF, g, S, E); }
            { pg8::Gemm g{(const bf16*)(ws + WS_YC), (const bf16*)(wl + WL_CO), 512, 512, 512}; pg8::EpiMerge<1> E{(const bf16*)(ws + WS_GB), (bf16*)(ws + WS_MG)};
              pg8::gemm_phase<pg8::EpiMerge<1>, pg8::StaticOrder, PG8_ALIGN, PG8_SP2>(F.lds + RING_OFF, g, S, E); }
            { pg8::Gemm g{(const bf16*)(ws + WS_YA), (const bf16*)(wl + WL_AO), 1024, 1024, 1024}; pg8::EpiMerge<2> E{(const bf16*)(ws + WS_GB), (bf16*)(ws + WS_MG)};
              pg8::gemm_phase<pg8::EpiMerge<2>, pg8::StaticOrder, PG8_ALIGN, PG8_SP2>(F.lds + RING_OFF, g, S, E); }
            if (BOTH(pb + 5)) GRID_BAR();
        }
        if (PH_ON(7) && IN(pb + 6)) { PHASE_ENV();
            pg8::Gemm g{(const bf16*)(ws + WS_MG), (const bf16*)(wl + WL_WO), 1024, 1024, 1024}; pg8::StaticOrder S; S.init(MP, 1024, F.G, bid);
            pg8::EpiPre E{HF, (float*)(ws + WS_PRE), ALPHA};
            pg8::gemm_phase<pg8::EpiPre, pg8::StaticOrder, PG8_ALIGN, PG8_SP2>(F.lds + RING_OFF, g, S, E);
            if (BOTH(pb + 6)) GRID_BAR();
        }
#if defined(SELFCHK)
        if (l == 0 && lo == 1000 && args_.pad == 1) { PHASE_ENV(); chk_ssm_conv(F, args, l); chk_attn(F); chk_mix(F, args, l); }
        if (l == 0 && lo == 1000 && args_.pad == 2) { PHASE_ENV(); moe_tables(F, l); chk_moe(F, args, l); }
#endif
        if (PH_ON(8) && IN(pb + 7)) { PHASE_ENV();
            ln1_router(F, args, l); if (BOTH(pb + 7)) GRID_BAR(); }
        if (PH_ON(9) && IN(pb + 8)) { PHASE_ENV(); moe_tables(F, l); moe_gather(F); if (BOTH(pb + 8)) GRID_BAR(); }
        if (PH_ON(10) && IN(pb + 9)) { PHASE_ENV();
            moe_tables(F, l);
            pg8::Gemm g{(const bf16*)(ws + WS_XG), (const bf16*)(wl + WL_GU), 1024, 1024, 1024}; pg8::MoeOrder S{(const LAS int*)(F.lds + LDSCTL_OFF), 8, F.G, bid};
            pg8::EpiSwiGLU E{(bf16*)(ws + WS_HID), args.in[I_BGU] + (size_t)l * 32 * 2048};
            pg8::gemm_phase<pg8::EpiSwiGLU, pg8::MoeOrder, PG8_ALIGN, PG8_SP2>(F.lds + RING_OFF, g, S, E);
            if (BOTH(pb + 9)) GRID_BAR();
        }
        if (PH_ON(11) && IN(pb + 10)) { PHASE_ENV();
            moe_tables(F, l);
            pg8::Gemm g{(const bf16*)(ws + WS_HID), (const bf16*)(wl + WL_DN), 1024, 1024, 1024}; pg8::MoeOrder S{(const LAS int*)(F.lds + LDSCTL_OFF), 4, F.G, bid};
            pg8::EpiDown E{(bf16*)(ws + WS_OUTS), args.in[I_BDN] + (size_t)l * 32 * 1024};
            pg8::gemm_phase<pg8::EpiDown, pg8::MoeOrder, PG8_ALIGN, PG8_SP2>(F.lds + RING_OFF, g, S, E);
            if (BOTH(pb + 10)) GRID_BAR();
        }
        if (PH_ON(12) && IN(pb + 11)) { PHASE_ENV(); moe_tables(F, l);
            ln2_rows(F, args, l); if (BOTH(pb + 11)) GRID_BAR(); }
    }
#undef IN
#undef BOTH
}

extern "C" void kernel_launch(void* const* d_in, const int* in_sizes, int n_in, void* d_out, int out_size, void* d_ws, size_t ws_size, hipStream_t stream) {
    static int grid = 0;
    if (grid == 0) {
        if (n_in != N_IN || in_sizes[0] != MREAL * 1024 || out_size != MREAL * 1024 || ws_size < WS_END) { fprintf(stderr, "kernel_launch: unexpected shapes (n_in %d, in0 %d, out %d, ws %zu < %zu); nothing launched\n", n_in, n_in > 0 ? in_sizes[0] : -1, out_size, ws_size, (size_t)WS_END); grid = -1; return; }
        int dev = 0, cus = 0, per_cu = 0;
        if (hipGetDevice(&dev) != hipSuccess || hipDeviceGetAttribute(&cus, hipDeviceAttributeMultiprocessorCount, dev) != hipSuccess) { grid = -1; return; }
        if (hipFuncSetAttribute((const void*)mk_fwd, hipFuncAttributeMaxDynamicSharedMemorySize, LDS_BYTES) != hipSuccess) { fprintf(stderr, "kernel_launch: hipFuncSetAttribute failed\n"); grid = -1; return; }
        if (hipOccupancyMaxActiveBlocksPerMultiprocessor(&per_cu, (const void*)mk_fwd, NWAVES * 64, LDS_BYTES) != hipSuccess || per_cu < 1)
            fprintf(stderr, "kernel_launch: note: occupancy query reports %d workgroups per CU\n", per_cu);
        (void)hipGetLastError();
        grid = cus;
        if (grid != 256) fprintf(stderr, "kernel_launch: %d CUs; the unit orders assume 256\n", grid);
    }
    if (grid < 0) return;
    if (hipMemsetAsync((char*)d_ws + WS_CTL, 0, CTL_ZERO_BYTES, stream) != hipSuccess) return;
    Args a{};
    for (int i = 0; i < N_IN; ++i) a.in[i] = (const float*)d_in[i];
    a.out = (float*)d_out; a.ws = (unsigned char*)d_ws;
    for (int li = 0; li < N_LAUNCHES; ++li) {
        a.ph_lo = (N_LAUNCHES == 1) ? 0 : li; a.ph_hi = (N_LAUNCHES == 1) ? NPH : li + 1; a.li = li; a.pad = 0;
        hipLaunchKernelGGL(mk_fwd, dim3(grid), dim3(NWAVES * 64), LDS_BYTES, stream, a);
        if (hipPeekAtLastError() != hipSuccess) { fprintf(stderr, "kernel_launch: launch %d failed\n", li); break; }
#if defined(SELFCHK)
        if (false && N_LAUNCHES == NPH && (li == 7 || li == 11)) {
 Args c = a; c.ph_lo = 1000; c.ph_hi = 1000; c.pad = (li == 7) ? 1 : 2; hipLaunchKernelGGL(mk_fwd, dim3(grid), dim3(NWAVES * 64), LDS_BYTES, stream, c); }
#endif
    }
}
```

```cpp
#include <hip/hip_runtime.h>
#include <cstdio>
#include <cstdint>
namespace pg8 {
#define PG8_LAS __attribute__((address_space(3)))
typedef unsigned short bf16_t;
typedef short bf16x8 __attribute__((ext_vector_type(8)));
typedef float f32x4 __attribute__((ext_vector_type(4)));
typedef unsigned u32x4 __attribute__((ext_vector_type(4)));
constexpr int BM = 256, BK = 64, HALF = 128, HTB = HALF * BK * 2  , STAGE_BYTES = 8 * HTB, NXCD = 8, WGM = 8;

__host__ __device__ __forceinline__ int lds_byte(int r, int c) { const int st = (r >> 4) * 2 + (c >> 5), rr = r & 15, cc = c & 31, ob = rr * 64 + cc * 2; return st * 1024 + (ob ^ (((ob >> 9) & 1) << 5)); }
__host__ __device__ __forceinline__ void stage_rc(int b, int& R, int& C) { const int st = b / 1024, sb = b % 1024, swz = sb ^ (((sb >> 9) & 1) << 5); R = (st >> 1) * 16 + swz / 64; C = (st & 1) * 32 + (swz % 64) / 2; }
__host__ __device__ __forceinline__ int perm32(int rho) { const int n = rho >> 4, i = rho & 15; return 8 * (i >> 2) + 4 * n + (i & 3); }

struct Unit { int pm, pn; };
struct Gemm { const bf16_t* A; const bf16_t* Bt; int lda, ldb, K; };

struct StaticOrder {
    int nM, nN, nwg, G, c;
    __host__ __device__ void init(int M, int N, int G_, int c_) { nM = M / BM; nN = N / BM; nwg = nM * nN; G = G_; c = c_; }
    __host__ __device__ bool next(int i, Unit& u) const {
        const long L = (long)i * G + c; if (L >= nwg) return false;
        int wgid = (int)L; { const int q = nwg / NXCD, r = nwg % NXCD, xcd = wgid % NXCD, off = wgid / NXCD; wgid = (xcd < r ? xcd * (q + 1) : r * (q + 1) + (xcd - r) * q) + off; }
        const int nig = WGM * nN, gid = wgid / nig, fm = gid * WGM, gsz = (nM - fm) < WGM ? (nM - fm) : WGM;
        u.pm = fm + ((wgid % nig) % gsz); u.pn = (wgid % nig) / gsz; return true;
    }
    __device__ __forceinline__ void a_ready(const Unit&) const {}
    __device__ __forceinline__ void done(const Unit&) const {}
};

typedef float cvt_f2_ __attribute__((ext_vector_type(2))); typedef __bf16 cvt_b2_ __attribute__((ext_vector_type(2)));
__device__ __forceinline__ unsigned cvt_pk_bf16(float lo, float hi) { const cvt_f2_ v = {lo, hi}; const cvt_b2_ b = __builtin_convertvector(v, cvt_b2_); return __builtin_bit_cast(unsigned, b); }
typedef float f32x2 __attribute__((ext_vector_type(2)));
typedef unsigned u32x2 __attribute__((ext_vector_type(2)));
__device__ __forceinline__ u32x4 pack8(f32x4 a, f32x4 b) { u32x4 w; w.x = cvt_pk_bf16(a[0], a[1]); w.y = cvt_pk_bf16(a[2], a[3]); w.z = cvt_pk_bf16(b[0], b[1]); w.w = cvt_pk_bf16(b[2], b[3]); return w; }
__device__ __forceinline__ u32x2 pack4(f32x4 a) { u32x2 w; w.x = cvt_pk_bf16(a[0], a[1]); w.y = cvt_pk_bf16(a[2], a[3]); return w; }
__device__ __forceinline__ float bf_lo(unsigned w) { return __uint_as_float(w << 16); }
__device__ __forceinline__ float bf_hi(unsigned w) { return __uint_as_float(w & 0xffff0000u); }
__device__ __forceinline__ void unpack8(u32x4 w, f32x4& a, f32x4& b) { a = (f32x4){bf_lo(w.x), bf_hi(w.x), bf_lo(w.y), bf_hi(w.y)}; b = (f32x4){bf_lo(w.z), bf_hi(w.z), bf_lo(w.w), bf_hi(w.w)}; }
__device__ __forceinline__ float sigm(float x) { return __builtin_amdgcn_rcpf(1.0f + __builtin_amdgcn_exp2f(-1.4426950408889634f * x)); }
__device__ __forceinline__ f32x4 sigm4(f32x4 v) { return (f32x4){sigm(v[0]), sigm(v[1]), sigm(v[2]), sigm(v[3])}; }
__device__ __forceinline__ float gelu_t(float x) { const float u = 0.7978845608028654f * (x + 0.044715f * x * x * x); return x * sigm(2.0f * u); }
__device__ __forceinline__ f32x4 gelu4(f32x4 v) { return (f32x4){gelu_t(v[0]), gelu_t(v[1]), gelu_t(v[2]), gelu_t(v[3])}; }

constexpr int MREAL = 16384, MVALID = 16416;
constexpr float QSCALE = 0.125f * 1.4426950408889634f;
__device__ __forceinline__ int kv_row(int R) { return R < MREAL ? (R >> 13) * 8320 + (R & 8191) : ((R - MREAL) >> 4) * 8320 + 8256 + ((R - MREAL) & 15); }

#define EPI_ROWS(R) _Pragma("unroll") for (int ai = 0; ai < 2; ++ai) _Pragma("unroll") for (int m = 0; m < 4; ++m) { const int R = rbase + ai * HALF + m * 16;
#define EPI_COLS _Pragma("unroll") for (int bj = 0; bj < 2; ++bj) {
#define EPI_END }

struct EpiP1 {
    static constexpr bool PERM = true, AFTER_DRAIN = false;
    bf16_t *UC, *UMETA, *CONVB, *Q, *K, *V, *GB; const float* rope; const float* gate_b;
    __device__ __forceinline__ void operator()(const f32x4 (&acc)[2][2][4][2], const Unit& u, int wr, int wc, int fr, int fq) const {
        const int pn = u.pn, rbase = u.pm * BM + wr * 64 + fr, cw = wc * 32 + 8 * fq;
        if (pn < 2) {
            EPI_ROWS(R)
                if (R < MREAL) { const int chunkrow = (R >> 13) * 128 + ((R & 8191) >> 6), s = R & 63;
                    EPI_COLS const int c = pn * 256 + bj * HALF + cw; *(u32x4*)(UC + ((size_t)((c >> 4) * 256 + chunkrow) * 1152 + s * 16 + (c & 15))) = pack8(acc[ai][bj][m][0], acc[ai][bj][m][1]); EPI_END }
                else if (R < MVALID) {
                    EPI_COLS const int c = pn * 256 + bj * HALF + cw; *(u32x4*)(UMETA + (size_t)(R - MREAL) * 512 + c) = pack8(acc[ai][bj][m][0], acc[ai][bj][m][1]); EPI_END }
            EPI_END
        } else if (pn < 8) {
            EPI_ROWS(R)
                if (R < MVALID) { EPI_COLS const int c = (pn - 2) * 256 + bj * HALF + cw; *(u32x4*)(CONVB + (size_t)R * 1536 + c) = pack8(acc[ai][bj][m][0], acc[ai][bj][m][1]); EPI_END }
            EPI_END
        } else if (pn < 16) {
            const bool isq = pn < 12; const int ct = (pn - (isq ? 8 : 12)) * 256; bf16_t* dstb = isq ? Q : K; const float sc = isq ? QSCALE : 1.0f;
            EPI_ROWS(R)
                if (R < MVALID) { const int pos = R < MREAL ? 16 + (R & 8191) : ((R - MREAL) & 15); const size_t drow = isq ? (size_t)R : (size_t)kv_row(R);
                    EPI_COLS const int c = ct + bj * HALF + cw, hh = c >> 6, gq = (c & 63) >> 3;
                        const f32x4 cs = *(const f32x4*)(rope + (size_t)pos * 64 + 4 * gq), sn = *(const f32x4*)(rope + (size_t)pos * 64 + 32 + 4 * gq);
                        const f32x4 x0 = acc[ai][bj][m][0], x1 = acc[ai][bj][m][1];
                        const f32x4 lo = (x0 * cs - x1 * sn) * sc, hi = (x1 * cs + x0 * sn) * sc;
                        bf16_t* d = dstb + drow * 1024 + hh * 64 + 4 * gq; *(u32x2*)d = pack4(lo); *(u32x2*)(d + 32) = pack4(hi); EPI_END }
            EPI_END
        } else if (pn < 20) {
            EPI_ROWS(R)
                if (R < MVALID) { const size_t drow = (size_t)kv_row(R);
                    EPI_COLS const int c = (pn - 16) * 256 + bj * HALF + cw; *(u32x4*)(V + drow * 1024 + c) = pack8(acc[ai][bj][m][0], acc[ai][bj][m][1]); EPI_END }
            EPI_END
        } else {
            f32x4 b0[2], b1[2];
#pragma unroll
            for (int bj = 0; bj < 2; ++bj) { const int c = (pn - 20) * 256 + bj * HALF + cw; b0[bj] = *(const f32x4*)(gate_b + c); b1[bj] = *(const f32x4*)(gate_b + c + 4); }
            EPI_ROWS(R)
                if (R < MVALID) { EPI_COLS const int c = (pn - 20) * 256 + bj * HALF + cw;
                    *(u32x4*)(GB + (size_t)R * 3072 + c) = pack8(sigm4(acc[ai][bj][m][0] + b0[bj]), sigm4(acc[ai][bj][m][1] + b1[bj])); EPI_END }
            EPI_END
        }
    }
};
struct EpiSloc {
    static constexpr bool PERM = false, AFTER_DRAIN = false;
    float* SL;
    __device__ __forceinline__ void operator()(const f32x4 (&acc)[2][2][4][2], const Unit& u, int wr, int wc, int fr, int fq) const {
        const int rbase = u.pm * BM + wr * 64 + fr, col0 = wc * 32 + 4 * fq;
        EPI_ROWS(R)
            float* rowp = SL + (size_t)R * 128 + col0;
#pragma unroll
            for (int n = 0; n < 2; ++n) *(f32x4*)(rowp + n * 16) = acc[ai][0][m][n];
        EPI_END
    }
};
struct EpiY {
    static constexpr bool PERM = true, AFTER_DRAIN = false;
    bf16_t* YG;
    __device__ __forceinline__ void operator()(const f32x4 (&acc)[2][2][4][2], const Unit& u, int wr, int wc, int fr, int fq) const {
        const int g = u.pm, nt = u.pn & 3, rbase = wr * 64 + fr, cw = wc * 32 + 8 * fq;
        EPI_ROWS(R)
            const int b = R >> 7, k = R & 127;
            EPI_COLS const int n = nt * 256 + bj * HALF + cw, t = n >> 4, co0 = n & 15; const size_t row = (size_t)b * 8192 + k * 64 + t;
                *(u32x4*)(YG + row * 512 + g * 16 + co0) = pack8(gelu4(acc[ai][bj][m][0]), gelu4(acc[ai][bj][m][1])); EPI_END
        EPI_END
    }
};
struct EpiGLU {
    static constexpr bool PERM = true, AFTER_DRAIN = false;
    const bf16_t* YG; bf16_t* YS;
    __device__ __forceinline__ void operator()(const f32x4 (&acc)[2][2][4][2], const Unit& u, int wr, int wc, int fr, int fq) const {
        const int rbase = u.pm * BM + wr * 64 + fr, cw = wc * 32 + 8 * fq;
        EPI_ROWS(R)
            EPI_COLS const int c = u.pn * 256 + bj * HALF + cw; f32x4 ya, yb; unpack8(*(const u32x4*)(YG + (size_t)R * 512 + c), ya, yb);
                *(u32x4*)(YS + (size_t)R * 512 + c) = pack8(ya * sigm4(acc[ai][bj][m][0]), yb * sigm4(acc[ai][bj][m][1])); EPI_END
        EPI_END
    }
};
template <int I> struct EpiMerge {
    static constexpr bool PERM = true, AFTER_DRAIN = false;
    const bf16_t* GB; bf16_t* MG;
    __device__ __forceinline__ void operator()(const f32x4 (&acc)[2][2][4][2], const Unit& u, int wr, int wc, int fr, int fq) const {
        const int rbase = u.pm * BM + wr * 64 + fr, cw = wc * 32 + 8 * fq;
        EPI_ROWS(R)
            EPI_COLS const int c = u.pn * 256 + bj * HALF + cw; f32x4 ga, gb; unpack8(*(const u32x4*)(GB + (size_t)R * 3072 + I * 1024 + c), ga, gb);
                f32x4 oa = ga * acc[ai][bj][m][0], ob = gb * acc[ai][bj][m][1];
                if (I > 0) { f32x4 pa, pb; unpack8(*(const u32x4*)(MG + (size_t)R * 1024 + c), pa, pb); oa += pa; ob += pb; }
                *(u32x4*)(MG + (size_t)R * 1024 + c) = pack8(oa, ob); EPI_END
        EPI_END
    }
};
struct EpiPre {
    static constexpr bool PERM = false, AFTER_DRAIN = false;
    const float* HF; float* PRE; float alpha;
    __device__ __forceinline__ void operator()(const f32x4 (&acc)[2][2][4][2], const Unit& u, int wr, int wc, int fr, int fq) const {
        const int rbase = u.pm * BM + wr * 64 + fr, col0 = u.pn * BM + wc * 32 + 4 * fq;
        EPI_ROWS(R)
            EPI_COLS
#pragma unroll
                for (int n = 0; n < 2; ++n) { const size_t off = (size_t)R * 1024 + col0 + bj * HALF + n * 16; *(f32x4*)(PRE + off) = *(const f32x4*)(HF + off) * alpha + acc[ai][bj][m][n]; }
            EPI_END
        EPI_END
    }
};
struct EpiSwiGLU {
    static constexpr bool PERM = true, AFTER_DRAIN = false;
    bf16_t* HID; const float* bgu;
    __device__ __forceinline__ void operator()(const f32x4 (&acc)[2][2][4][2], const Unit& u, int wr, int wc, int fr, int fq) const {
        const int e = u.pn >> 3, nt = u.pn & 7, rbase = u.pm * BM + wr * 64 + fr, hw = wc * 16 + 4 * fq;
        f32x4 bg[2], bu[2];
#pragma unroll
        for (int bj = 0; bj < 2; ++bj) { const int hcol = nt * 128 + bj * 64 + hw; bg[bj] = *(const f32x4*)(bgu + (size_t)e * 2048 + hcol); bu[bj] = *(const f32x4*)(bgu + (size_t)e * 2048 + 1024 + hcol); }
        EPI_ROWS(R)
            EPI_COLS const int hcol = nt * 128 + bj * 64 + hw; const f32x4 gt = acc[ai][bj][m][0] + bg[bj], up = acc[ai][bj][m][1] + bu[bj]; f32x4 h;
#pragma unroll
                for (int i = 0; i < 4; ++i) { const float gg = fminf(gt[i], 7.0f), uu = fminf(fmaxf(up[i], -7.0f), 7.0f); h[i] = (uu + 1.0f) * gg * sigm(1.702f * gg); }
                *(u32x2*)(HID + (size_t)R * 1024 + hcol) = pack4(h); EPI_END
        EPI_END
    }
};
struct EpiDown {
    static constexpr bool PERM = true, AFTER_DRAIN = false;
    bf16_t* OUTS; const float* bdn;
    __device__ __forceinline__ void operator()(const f32x4 (&acc)[2][2][4][2], const Unit& u, int wr, int wc, int fr, int fq) const {
        const int e = u.pn >> 2, nt = u.pn & 3, rbase = u.pm * BM + wr * 64 + fr, cw = wc * 32 + 8 * fq;
        f32x4 b0[2], b1[2];
#pragma unroll
        for (int bj = 0; bj < 2; ++bj) { const int c = nt * 256 + bj * HALF + cw; b0[bj] = *(const f32x4*)(bdn + (size_t)e * 1024 + c); b1[bj] = *(const f32x4*)(bdn + (size_t)e * 1024 + c + 4); }
        EPI_ROWS(R)
            EPI_COLS const int c = nt * 256 + bj * HALF + cw; *(u32x4*)(OUTS + (size_t)R * 1024 + c) = pack8(acc[ai][bj][m][0] + b0[bj], acc[ai][bj][m][1] + b1[bj]); EPI_END
        EPI_END
    }
};
struct FirstN {
    int n, div, G, c;
    __device__ __forceinline__ bool next(int i, Unit& u) const { const int L = i * G + c; if (L >= n) return false; u.pm = L / div; u.pn = L; return true; }
    __device__ __forceinline__ void a_ready(const Unit&) const {}
    __device__ __forceinline__ void done(const Unit&) const {}
};
struct MoeOrder {
    const PG8_LAS int* tb; int nN, G, c;
    __device__ __forceinline__ bool next(int i, Unit& u) const {
        const int L = i * G + c, mtg = L / nN; if (mtg >= tb[32]) return false;
        int e = 0; while (tb[e + 1] <= mtg) ++e;
        u.pm = mtg; u.pn = e * nN + (L - mtg * nN); return true; }
    __device__ __forceinline__ void a_ready(const Unit&) const {}
    __device__ __forceinline__ void done(const Unit&) const {}
};
template <class Epi, class Sched, bool ALIGN_EPI = false, bool SP2 = false>
__device__ __forceinline__ void gemm_phase(PG8_LAS unsigned char* lds, const Gemm g, const Sched& S, const Epi& E) {
    int tid_ = threadIdx.x; asm volatile("" : "+v"(tid_));
    const int tid = tid_, wid = __builtin_amdgcn_readfirstlane(tid >> 6), lane = tid & 63, wr = wid >> 2, wc = wid & 3, fr = lane & 15, fq = lane >> 4;
    const int K = g.K, nt = K / BK;
    unsigned voffA[2], voffB[2];
#pragma unroll
    for (int i = 0; i < 2; ++i) { int R, C; stage_rc(tid * 16 + i * 8192, R, C); const int Rb = Epi::PERM ? ((R & ~31) + perm32(R & 31)) : R;
        voffA[i] = (unsigned)(R * g.lda + C) * 2u; voffB[i] = (unsigned)(Rb * g.ldb + C) * 2u; }
    const size_t kstep = (size_t)(BK * 2);
    const size_t hstepA = (size_t)HALF * g.lda * 2, hstepB = (size_t)HALF * g.ldb * 2;
    const size_t tstepA = 2 * hstepA, tstepB = 2 * hstepB;
    const unsigned ldsw = (unsigned)wid * 1024u;
    const int aoff = lds_byte(wr * 64 + fr, fq * 8), boff = lds_byte(wc * 32 + fr, fq * 8);
#define PG8_SA(b, h) (((b) * 2 + (h)) * HTB)
#define PG8_SB(b, h) ((4 + (b) * 2 + (h)) * HTB)
#define PG8_STAGE(bufoff, gbase, voff) do { _Pragma("unroll") for (int _i = 0; _i < 2; ++_i) \
        __builtin_amdgcn_global_load_lds((const unsigned*)((const char*)(gbase) + (voff)[_i]), (PG8_LAS unsigned*)(lds + (bufoff) + ldsw + _i * 8192), 16, 0, 0); } while (0)
#define PG8_LDA(dst, b, h) do { _Pragma("unroll") for (int m = 0; m < 4; ++m) _Pragma("unroll") for (int k = 0; k < 2; ++k) dst[m][k] = *(const PG8_LAS bf16x8*)(lds + PG8_SA(b, h) + aoff + m * 2048 + k * 1024); } while (0)
#define PG8_LDB(dst, b, h) do { _Pragma("unroll") for (int n = 0; n < 2; ++n) _Pragma("unroll") for (int k = 0; k < 2; ++k) dst[n][k] = *(const PG8_LAS bf16x8*)(lds + PG8_SB(b, h) + boff + n * 2048 + k * 1024); } while (0)
#define PG8_MMA(ai, bj, At, Bt) do { __builtin_amdgcn_s_setprio(1); _Pragma("unroll") for (int m = 0; m < 4; ++m) _Pragma("unroll") for (int n = 0; n < 2; ++n) _Pragma("unroll") for (int k = 0; k < 2; ++k) \
        acc[ai][bj][m][n] = __builtin_amdgcn_mfma_f32_16x16x32_bf16(Bt[n][k], At[m][k], acc[ai][bj][m][n], 0, 0, 0); __builtin_amdgcn_s_setprio(0); } while (0)
#define PG8_WAIT_V(n) asm volatile("s_waitcnt vmcnt(" #n ")" ::: "memory")
#define PG8_WAIT_L(n) asm volatile("s_waitcnt lgkmcnt(" #n ")" ::: "memory")
#define PG8_BAR __builtin_amdgcn_s_barrier()
#define PG8_SCHED __builtin_amdgcn_sched_barrier(0)
    Unit cur, nxt; int ui = 0;
    if (!S.next(0, cur)) return;
    f32x4 acc[2][2][4][2];
#pragma unroll
    for (int a = 0; a < 2; ++a)
#pragma unroll
        for (int b = 0; b < 2; ++b)
#pragma unroll
            for (int m = 0; m < 4; ++m)
#pragma unroll
                for (int n = 0; n < 2; ++n) acc[a][b][m][n] = (f32x4){0.f, 0.f, 0.f, 0.f};
    bf16x8 At[4][2], B0[2][2], B1[2][2];
    const char* cA = (const char*)g.A + (size_t)cur.pm * tstepA; const char* cB = (const char*)g.Bt + (size_t)cur.pn * tstepB;
    S.a_ready(cur);
    if constexpr (SP2) {
        PG8_STAGE(PG8_SB(0, 0), cB, voffB); PG8_STAGE(PG8_SB(0, 1), cB + hstepB, voffB); PG8_STAGE(PG8_SA(0, 0), cA, voffA); PG8_STAGE(PG8_SA(0, 1), cA + hstepA, voffA);
        if (wr == 1) PG8_BAR;
        PG8_WAIT_V(2); PG8_BAR;
        PG8_STAGE(PG8_SB(1, 0), cB + kstep, voffB); PG8_STAGE(PG8_SA(1, 0), cA + kstep, voffA); PG8_STAGE(PG8_SB(1, 1), cB + hstepB + kstep, voffB);
        PG8_WAIT_V(6); PG8_BAR;
    } else {
        PG8_STAGE(PG8_SB(0, 0), cB, voffB); PG8_STAGE(PG8_SA(0, 0), cA, voffA); PG8_STAGE(PG8_SB(0, 1), cB + hstepB, voffB); PG8_STAGE(PG8_SA(0, 1), cA + hstepA, voffA);
        if (wr == 1) PG8_BAR;
        PG8_WAIT_V(4); PG8_BAR;
        PG8_STAGE(PG8_SB(1, 0), cB + kstep, voffB); PG8_STAGE(PG8_SA(1, 0), cA + kstep, voffA); PG8_STAGE(PG8_SB(1, 1), cB + hstepB + kstep, voffB);
        PG8_WAIT_V(6); PG8_BAR;
    }
    for (;;) {
        const bool has_next = S.next(ui + 1, nxt);
        const char* nA = has_next ? (const char*)g.A + (size_t)nxt.pm * tstepA : cA; const char* nB = has_next ? (const char*)g.Bt + (size_t)nxt.pn * tstepB : cB;
        for (int t = 0; t < nt; t += 2) {
            const bool last = (t == nt - 2);
            const char* a1 = cA + (size_t)(t + 1) * kstep;
            const char* a2 = last ? nA : cA + (size_t)(t + 2) * kstep; const char* b2 = last ? nB : cB + (size_t)(t + 2) * kstep;
            const char* a3 = a2 + kstep; const char* b3 = b2 + kstep;
            if (last && has_next) S.a_ready(nxt);
            if constexpr (SP2) {
            PG8_LDB(B0, 0, 0); PG8_LDB(B1, 0, 1); PG8_SCHED; PG8_LDA(At, 0, 0); PG8_STAGE(PG8_SA(1, 1), a1 + hstepA, voffA);
            PG8_WAIT_V(8); PG8_WAIT_L(0); PG8_BAR; PG8_MMA(0, 0, At, B0); PG8_MMA(0, 1, At, B1); PG8_BAR; PG8_SCHED;
            PG8_LDA(At, 0, 1); PG8_STAGE(PG8_SB(0, 0), b2, voffB); PG8_STAGE(PG8_SB(0, 1), b2 + hstepB, voffB); PG8_STAGE(PG8_SA(0, 0), a2, voffA);
            PG8_WAIT_V(8); PG8_WAIT_L(0); PG8_BAR; PG8_MMA(1, 0, At, B0); PG8_MMA(1, 1, At, B1); PG8_BAR; PG8_SCHED;
            PG8_LDB(B0, 1, 0); PG8_LDB(B1, 1, 1); PG8_SCHED; PG8_LDA(At, 1, 0); PG8_STAGE(PG8_SA(0, 1), a2 + hstepA, voffA);
            PG8_WAIT_V(8); PG8_WAIT_L(0); PG8_BAR; PG8_MMA(0, 0, At, B0); PG8_MMA(0, 1, At, B1); PG8_BAR; PG8_SCHED;
            PG8_LDA(At, 1, 1); PG8_STAGE(PG8_SB(1, 0), b3, voffB); PG8_STAGE(PG8_SB(1, 1), b3 + hstepB, voffB); PG8_STAGE(PG8_SA(1, 0), a3, voffA);
            PG8_WAIT_V(8); PG8_WAIT_L(0); PG8_BAR; PG8_MMA(1, 0, At, B0); PG8_MMA(1, 1, At, B1); PG8_BAR; PG8_SCHED;
            } else {
            PG8_LDB(B0, 0, 0); PG8_SCHED; PG8_LDA(At, 0, 0); PG8_STAGE(PG8_SA(1, 1), a1 + hstepA, voffA);
            PG8_WAIT_L(8); PG8_BAR; PG8_WAIT_L(0); PG8_MMA(0, 0, At, B0); PG8_BAR; PG8_SCHED;
            PG8_LDB(B1, 0, 1); PG8_STAGE(PG8_SB(0, 0), b2, voffB);
            PG8_BAR; PG8_WAIT_L(0); PG8_MMA(0, 1, At, B1); PG8_BAR;
            PG8_LDA(At, 0, 1); PG8_STAGE(PG8_SA(0, 0), a2, voffA);
            PG8_BAR; PG8_WAIT_L(0); PG8_MMA(1, 0, At, B0); PG8_BAR; PG8_SCHED;
            PG8_STAGE(PG8_SB(0, 1), b2 + hstepB, voffB);
            PG8_WAIT_V(6); PG8_BAR; PG8_MMA(1, 1, At, B1); PG8_BAR;
            PG8_LDB(B0, 1, 0); PG8_SCHED; PG8_LDA(At, 1, 0); PG8_STAGE(PG8_SA(0, 1), a2 + hstepA, voffA);
            PG8_WAIT_L(8); PG8_BAR; PG8_WAIT_L(0); PG8_MMA(0, 0, At, B0); PG8_BAR; PG8_SCHED;
            PG8_LDB(B1, 1, 1); PG8_STAGE(PG8_SB(1, 0), b3, voffB);
            PG8_BAR; PG8_WAIT_L(0); PG8_MMA(0, 1, At, B1); PG8_BAR;
            PG8_LDA(At, 1, 1); PG8_STAGE(PG8_SA(1, 0), a3, voffA);
            PG8_BAR; PG8_WAIT_L(0); PG8_MMA(1, 0, At, B0); PG8_BAR; PG8_SCHED;
            PG8_STAGE(PG8_SB(1, 1), b3 + hstepB, voffB);
            PG8_WAIT_V(6); PG8_BAR; PG8_MMA(1, 1, At, B1); PG8_BAR;
            }
        }
        if constexpr (ALIGN_EPI) { if (wr == 0) PG8_BAR; }
        if constexpr (!Epi::AFTER_DRAIN) { E(acc, cur, wr, wc, fr, fq); S.done(cur); }
        if (!has_next) break;
#pragma unroll
        for (int a = 0; a < 2; ++a)
#pragma unroll
            for (int b = 0; b < 2; ++b)
#pragma unroll
                for (int m = 0; m < 4; ++m)
#pragma unroll
                    for (int n = 0; n < 2; ++n) acc[a][b][m][n] = (f32x4){0.f, 0.f, 0.f, 0.f};
        cur = nxt; cA = nA; cB = nB; ++ui;
        if constexpr (ALIGN_EPI) { if (wr == 1) PG8_BAR; }
    }
    PG8_WAIT_V(0);
    if constexpr (!ALIGN_EPI) { if (wr == 0) PG8_BAR; }
    PG8_BAR;
    if constexpr (Epi::AFTER_DRAIN) { E.fused(acc, cur, wr, wc, fr, fq, lds, wid, lane); S.done(cur); }
#undef PG8_SA
#undef PG8_SB
#undef PG8_STAGE
#undef PG8_LDA
#undef PG8_LDB
#undef PG8_MMA
#undef PG8_WAIT_V
#undef PG8_WAIT_L
#undef PG8_BAR
#undef PG8_SCHED
}
}

#ifndef PG8_SP2
#define PG8_SP2 true
#endif
#ifndef PG8_ALIGN
#define PG8_ALIGN true
#endif
#include <hip/hip_bf16.h>
#include <cmath>
namespace attn_body {
using bf16=__hip_bfloat16;
using bf16x8=__attribute__((ext_vector_type(8)))short;
using s16x4=__attribute__((ext_vector_type(4)))short;
using f32x16=__attribute__((ext_vector_type(16)))float;
using u32x4=__attribute__((ext_vector_type(4)))unsigned;
constexpr int BATCH=2,NHEAD=16,SEQ=8192,D=64,DM=NHEAD*D;
constexpr int NW=8,QBLK=32,QB=QBLK*NW,KVBLK=64,NQB=SEQ/QB;
constexpr int ATTN_PITCH=DM, ATTN_UNIT_ROWS=QB, OPITCH=2048, KVROWS=8320, NVH=32;
__device__ __forceinline__ int crow(int r,int hi){return (r&3)+8*(r>>2)+4*hi;}
#define SBAR() __builtin_amdgcn_sched_barrier(0)
__device__ __forceinline__ void cmask(f32x16&p0,f32x16&p1,int jb,int qrel,int hi){
  const float NEG=-INFINITY;
  if(jb<4){ if(jb>(qrel>>6)){
    #pragma unroll
    for(int r=0;r<16;++r){p0[r]=NEG;p1[r]=NEG;} } }
  else if(jb==4){
    #pragma unroll
    for(int r=0;r<16;++r){p0[r]=NEG;p1[r]=NEG;} }
  else{
    #pragma unroll
    for(int r=0;r<16;++r){ if(r>=8)p0[r]=NEG; p1[r]=NEG; } }
}

constexpr int NSLOT=3, SLOTB=8192;
constexpr int LDS_K=0, LDS_V=NSLOT*SLOTB, LDS_WS=2*NSLOT*SLOTB, LDS_OST=LDS_WS+NW*64*4, LDS_BYTES=LDS_OST+NW*4096;
constexpr float C2=0.125f*1.4426950408889634f;
__device__ __forceinline__ void glds16(const void*gsrc,unsigned lds_dst){unsigned keep;
  asm volatile("s_mov_b32 %0, m0\n\ts_mov_b32 m0, %2\n\ts_nop 0\n\tglobal_load_lds_dwordx4 %1, off\n\ts_mov_b32 m0, %0":"=&s"(keep):"v"(gsrc),"s"(lds_dst):"memory");}
__device__ __forceinline__ float max3f(float a,float b,float c){float r;asm("v_max3_f32 %0, %1, %2, %3":"=v"(r):"v"(a),"v"(b),"v"(c));return r;}
__device__ __forceinline__ float max2f(float a,float b){float r;asm("v_max_f32_e32 %0, %1, %2":"=v"(r):"v"(a),"v"(b));return r;}
__device__ __forceinline__ float fadd_s(float a,float b){float r;asm("v_add_f32_e32 %0, %1, %2":"=v"(r):"v"(a),"v"(b));return r;}
__device__ __forceinline__ float fsub_s(float a,float b){float r;asm("v_sub_f32_e32 %0, %1, %2":"=v"(r):"v"(a),"v"(b));return r;}
typedef float f32x2_t __attribute__((ext_vector_type(2))); typedef __bf16 bf16x2_t __attribute__((ext_vector_type(2)));
__device__ __forceinline__ unsigned cvtpk_s(float lo,float hi){f32x2_t v={lo,hi};bf16x2_t b=__builtin_convertvector(v,bf16x2_t);return __builtin_bit_cast(unsigned,b);}
#define WAIT_BAR(N) asm volatile("s_waitcnt vmcnt(" #N ") lgkmcnt(0)\n\ts_barrier":::"memory")

__device__ __forceinline__ void qkt(f32x16&p0,f32x16&p1,const char*Kslot,const bf16x8*qr,const f32x16&negm,int r32,int hi){
  const char*kb=Kslot+hi*1024+r32*16;
  #pragma unroll
  for(int d0=0;d0<4;++d0){
    const bf16x8 b0=*reinterpret_cast<const bf16x8*>(kb+d0*2048);
    const bf16x8 b1=*reinterpret_cast<const bf16x8*>(kb+d0*2048+512);
    if(d0==0){p0=__builtin_amdgcn_mfma_f32_32x32x16_bf16(b0,qr[0],negm,0,0,0);p1=__builtin_amdgcn_mfma_f32_32x32x16_bf16(b1,qr[0],negm,0,0,0);}
    else{p0=__builtin_amdgcn_mfma_f32_32x32x16_bf16(b0,qr[d0],p0,0,0,0);p1=__builtin_amdgcn_mfma_f32_32x32x16_bf16(b1,qr[d0],p1,0,0,0);}}
}
typedef __attribute__((address_space(3))) const char* lds_cptr;
typedef short v4i16_t __attribute__((ext_vector_type(4)));
__device__ __forceinline__ void kload8(bf16x8*kf,lds_cptr kp){
  kf[0]=*(const __attribute__((address_space(3))) bf16x8*)(kp);      kf[1]=*(const __attribute__((address_space(3))) bf16x8*)(kp+512);
  kf[2]=*(const __attribute__((address_space(3))) bf16x8*)(kp+2048); kf[3]=*(const __attribute__((address_space(3))) bf16x8*)(kp+2560);
  kf[4]=*(const __attribute__((address_space(3))) bf16x8*)(kp+4096); kf[5]=*(const __attribute__((address_space(3))) bf16x8*)(kp+4608);
  kf[6]=*(const __attribute__((address_space(3))) bf16x8*)(kp+6144); kf[7]=*(const __attribute__((address_space(3))) bf16x8*)(kp+6656);
}
__device__ __forceinline__ void kload2(bf16x8*kf,lds_cptr kp,int j){ kf[2*j]=*(const __attribute__((address_space(3))) bf16x8*)(kp+j*2048); kf[2*j+1]=*(const __attribute__((address_space(3))) bf16x8*)(kp+j*2048+512); }
__device__ __forceinline__ s16x4 vtr(lds_cptr p){ return __builtin_bit_cast(s16x4,__builtin_amdgcn_ds_read_tr16_b64_v4i16((__attribute__((address_space(3))) v4i16_t*)p)); }
__device__ __forceinline__ float rowmax(const f32x16&p0,const f32x16&p1){
  float a=max3f(p0[0],p0[1],p1[0]),b=max3f(p0[2],p0[3],p1[1]);a=max3f(a,p1[2],p1[3]);
  #pragma unroll
  for(int r=4;r<16;r+=4){a=max3f(a,p0[r],p0[r+1]);b=max3f(b,p0[r+2],p0[r+3]);a=max3f(a,p1[r],p1[r+1]);b=max3f(b,p1[r+2],p1[r+3]);}
  const float m=max2f(a,b);
  auto rr=__builtin_amdgcn_permlane32_swap(__float_as_uint(m),__float_as_uint(m),false,false);
  return max2f(__uint_as_float(rr[0]),__uint_as_float(rr[1]));
}
__device__ __forceinline__ void pv(f32x16*o,int vb,bf16x8 pa0,bf16x8 pa1,bf16x8 pa2,bf16x8 pa3){
  #pragma unroll
  for(int d0=0;d0<2;++d0){s16x4 lo[4],hi[4];
    #pragma unroll
    for(int ks=0;ks<4;++ks){
      asm volatile("ds_read_b64_tr_b16 %0,%1 offset:%c2":"=&v"(lo[ks]):"v"(vb),"i"(d0*4096+ks*1024):"memory");
      asm volatile("ds_read_b64_tr_b16 %0,%1 offset:%c2":"=&v"(hi[ks]):"v"(vb),"i"(d0*4096+ks*1024+512):"memory");}
    asm volatile("s_waitcnt lgkmcnt(0)":::"memory");SBAR();
    #define PK(k) (bf16x8){lo[k][0],lo[k][1],lo[k][2],lo[k][3],hi[k][0],hi[k][1],hi[k][2],hi[k][3]}
    o[d0]=__builtin_amdgcn_mfma_f32_32x32x16_bf16(pa0,PK(0),o[d0],0,0,0);
    o[d0]=__builtin_amdgcn_mfma_f32_32x32x16_bf16(pa1,PK(1),o[d0],0,0,0);
    o[d0]=__builtin_amdgcn_mfma_f32_32x32x16_bf16(pa2,PK(2),o[d0],0,0,0);
    o[d0]=__builtin_amdgcn_mfma_f32_32x32x16_bf16(pa3,PK(3),o[d0],0,0,0);
    #undef PK
  }
}

#ifndef ATTN_STORE16
#define ATTN_STORE16(p,v) (*(u32x4*)(p)=(v))
#endif
template<int THRL> __device__ __forceinline__ void attn_unit(int b,int vh,int qb,const bf16*Q,const bf16*__restrict__ K,const bf16*__restrict__ V,bf16*O,char*shm){
  int tid_=threadIdx.x; asm volatile("":"+v"(tid_));
  const int tid=tid_,lane=tid&63,r32=lane&31,hi=lane>>5; const int wid=__builtin_amdgcn_readfirstlane(tid>>6);
  const long rowbase=(long)b*SEQ, kvbase=(long)b*KVROWS; const int q0=qb*QB; const int hc=vh>>1;
  const bf16*Qw=Q+(rowbase+q0+wid*QBLK)*DM+hc*D;
  const bf16*Kh=K+kvbase*DM+hc*D,*Vh=V+kvbase*DM+(vh>>2)*128+(vh&1)*64;
  const unsigned lds0=(unsigned)(uintptr_t)shm;
  float*wsf=(float*)(shm+LDS_WS)+wid*64;
  const bf16*ksrc=Kh+(long)lane*DM+wid*8;
  const bf16*vsrc=Vh+(long)(16*(wid&3)+(lane>>2))*DM+(wid>>2)*32+(lane&3)*8;
  const unsigned kdst=lds0+LDS_K+wid*1024, vdst=lds0+LDS_V+wid*1024;
  #define TROW(t) (((t)<NT-2)?(long)(t)*KVBLK:(long)(8192+((t)-(NT-2))*KVBLK))
  #define DMA_K(t,slot) glds16(ksrc+TROW(t)*DM,(unsigned)__builtin_amdgcn_readfirstlane(kdst+(slot)))
  #define DMA_V(t,slot) glds16(vsrc+TROW(t)*DM,(unsigned)__builtin_amdgcn_readfirstlane(vdst+(slot)))
  const int vb0=(int)(lds0+LDS_V)+((lane>>4)&1)*32+(lane&3)*8+(4*hi+((lane&15)>>2))*64;
  const char*Kbase=shm+LDS_K; bf16x8 kf[8];
  const lds_cptr shm3=(lds_cptr)shm; const lds_cptr kp0=shm3+LDS_K+hi*1024+r32*16; const lds_cptr vp0=shm3+LDS_V+((lane>>4)&1)*32+(lane&3)*8+(4*hi+((lane&15)>>2))*64;
  const int NT=(q0+QB)/KVBLK+2;
  DMA_K(0,0);DMA_V(0,0);DMA_K(1,SLOTB);
  bf16x8 qr[4];
  #pragma unroll
  for(int d0=0;d0<4;++d0)qr[d0]=*reinterpret_cast<const bf16x8*>(&Qw[(long)r32*DM+d0*16+hi*8]);
  float mhat=0.f,l_reg=0.f;f32x16 o[2];o[0]=f32x16{};o[1]=f32x16{};f32x16 negm=f32x16{};asm volatile("":"+v"(negm));
  const int qrel=wid*QBLK+r32;
  #define CMASK(P0,P1,t) do{int jb_=(t)-(NT-6); if(jb_>=0)cmask(P0,P1,jb_,qrel,hi);}while(0)
  bool resc=false;
  #define START(P0,P1) do{ const float rm=rowmax(P0,P1); resc=false; \
    { const float dl=rm; mhat=fadd_s(mhat,dl); \
      _Pragma("unroll") for(int r=0;r<16;++r){P0[r]=fsub_s(P0[r],dl);P1[r]=fsub_s(P1[r],dl);} \
      _Pragma("unroll") for(int r=0;r<16;++r)negm[r]=-mhat; asm volatile("":"+v"(negm)); } \
    _Pragma("unroll") for(int r=0;r<16;++r)P0[r]=__builtin_amdgcn_exp2f(P0[r]); }while(0)
  #define RESC() do{ if(resc){ asm volatile("s_waitcnt lgkmcnt(0)":::"memory"); \
      _Pragma("unroll") for(int d_=0;d_<2;++d_) _Pragma("unroll") for(int r=0;r<16;++r)o[d_][r]*=wsf[crow(r,hi)]; } }while(0)
  f32x16 pA0,pA1,pB0,pB1;
  int sl_prev=0,sl_cur=0,sl_next=SLOTB;
  #define ROT() do{sl_prev=sl_cur;sl_cur=sl_next;sl_next=(sl_next==(NSLOT-1)*SLOTB)?0:sl_next+SLOTB;}while(0)
  DMA_K(2,2*SLOTB);
  WAIT_BAR(3);
  qkt(pA0,pA1,Kbase,qr,negm,r32,hi);asm volatile("s_nop 15\n\ts_nop 7":"+v"(pA0),"+v"(pA1));CMASK(pA0,pA1,0);
  START(pA0,pA1);
  _Pragma("unroll") for(int r=0;r<16;++r)pA1[r]=__builtin_amdgcn_exp2f(pA1[r]);
  WAIT_BAR(0);
  DMA_K(3,0);DMA_V(1,SLOTB);
  ROT();
  kload8(kf,kp0+sl_cur);
  WAIT_BAR(2);
  s16x4 vlo[8],vhi[8]; u32x4 pw0,pw1,pw2,pw3;
  #define PKW(P,B) cvtpk_s(P[B],P[B+1])
  #define PAF(k) __builtin_bit_cast(bf16x8,pw##k)
  #define VFR(i) (bf16x8){vlo[i][0],vlo[i][1],vlo[i][2],vlo[i][3],vhi[i][0],vhi[i][1],vhi[i][2],vhi[i][3]}
  #define PIN(x) asm volatile("":"+v"(x))
  #define MX3(a,b,c) __builtin_fmaxf(__builtin_fmaxf((a),(b)),(c))
  #define GAPA(MF,A0,A1,A2,A3,W0,W1,PW) do{ MF; sacc+=A0; sacc+=A1; sacc+=A2; sacc+=A3; PIN(sacc); W0; W1; PIN(PW); SBAR(); }while(0)
  #define EX(v) __builtin_amdgcn_exp2f(v)
  #define GAPB(MF,X,B) do{ MF; X[B]=EX(X[B]); X[B+1]=EX(X[B+1]); X[B+2]=EX(X[B+2]); X[B+3]=EX(X[B+3]); PIN(X); SBAR(); }while(0)
  #define VRD(i) do{ vlo[i]=vtr(vp_+(((i)>>2)*4096+((i)&3)*1024)); vhi[i]=vtr(vp_+(((i)>>2)*4096+((i)&3)*1024+512)); }while(0)
  #define KRD(G,j) do{ if(G){ kload2(kf,kp0+sl_next,j); SBAR(); } }while(0)
  #define STEP(C0,C1,P0,P1,t,GK,GV,GL) do{ SBAR(); \
    const lds_cptr vp_=vp0+sl_prev; \
    VRD(0); SBAR(); float sacc=(P0[0]+P0[1]); \
    GAPA(C0=__builtin_amdgcn_mfma_f32_32x32x16_bf16(kf[0],qr[0],negm,0,0,0), P0[2],P0[3],P0[4],P0[5],     pw0[0]=PKW(P0,0), pw0[1]=PKW(P0,2), pw0); \
    VRD(4); SBAR(); GAPA(C1=__builtin_amdgcn_mfma_f32_32x32x16_bf16(kf[1],qr[0],negm,0,0,0), P0[6],P0[7],P0[8],P0[9],     pw0[2]=PKW(P0,4), pw0[3]=PKW(P0,6), pw0); \
    VRD(1); SBAR(); GAPA(C0=__builtin_amdgcn_mfma_f32_32x32x16_bf16(kf[2],qr[1],C0,0,0,0),   P0[10],P0[11],P0[12],P0[13], pw1[0]=PKW(P0,8), pw1[1]=PKW(P0,10), pw1); \
    VRD(5); SBAR(); GAPA(C1=__builtin_amdgcn_mfma_f32_32x32x16_bf16(kf[3],qr[1],C1,0,0,0),   P0[14],P0[15],P1[0],P1[1],   pw1[2]=PKW(P0,12),pw1[3]=PKW(P0,14), pw1); \
    VRD(2); SBAR(); GAPA(C0=__builtin_amdgcn_mfma_f32_32x32x16_bf16(kf[4],qr[2],C0,0,0,0),   P1[2],P1[3],P1[4],P1[5],     pw2[0]=PKW(P1,0), pw2[1]=PKW(P1,2), pw2); \
    VRD(6); SBAR(); GAPA(C1=__builtin_amdgcn_mfma_f32_32x32x16_bf16(kf[5],qr[2],C1,0,0,0),   P1[6],P1[7],P1[8],P1[9],     pw2[2]=PKW(P1,4), pw2[3]=PKW(P1,6), pw2); \
    VRD(3); SBAR(); GAPA(C0=__builtin_amdgcn_mfma_f32_32x32x16_bf16(kf[6],qr[3],C0,0,0,0),   P1[10],P1[11],P1[12],P1[13], pw3[0]=PKW(P1,8), pw3[1]=PKW(P1,10), pw3); \
    VRD(7); SBAR(); GAPA(C1=__builtin_amdgcn_mfma_f32_32x32x16_bf16(kf[7],qr[3],C1,0,0,0),   P1[14],P1[15],0.f,0.f,       pw3[2]=PKW(P1,12),pw3[3]=PKW(P1,14), pw3); \
    l_reg+=sacc; \
    if(GK){DMA_K((t)+3,sl_cur);} if(GV){DMA_V((t)+1,sl_next);} \
    CMASK(C0,C1,t); \
    { float a=MX3(C0[0],C0[1],C1[0]),b=MX3(C0[2],C0[3],C1[1]); a=MX3(a,C1[2],C1[3]); \
      _Pragma("unroll") for(int r=4;r<16;r+=4){a=MX3(a,C0[r],C0[r+1]);b=MX3(b,C0[r+2],C0[r+3]);a=MX3(a,C1[r],C1[r+1]);b=MX3(b,C1[r+2],C1[r+3]);} \
      float rm=__builtin_fmaxf(a,b); { auto rr=__builtin_amdgcn_permlane32_swap(__float_as_uint(rm),__float_as_uint(rm),false,false); rm=__builtin_fmaxf(__uint_as_float(rr[0]),__uint_as_float(rr[1])); } \
      resc=false; \
      if(__builtin_expect(__any(rm>(float)THRL),0)){ const float dl=__builtin_fmaxf(rm,0.f); mhat+=dl; \
        _Pragma("unroll") for(int r=0;r<16;++r){C0[r]-=dl;C1[r]-=dl;} \
        _Pragma("unroll") for(int r=0;r<16;++r)negm[r]=-mhat; asm volatile("":"+v"(negm)); \
        const float f=__builtin_amdgcn_exp2f(-dl); l_reg*=f; if(hi==0)wsf[r32]=f; resc=true; } } \
    SBAR(); \
    GAPB(o[0]=__builtin_amdgcn_mfma_f32_32x32x16_bf16(PAF(0),VFR(0),o[0],0,0,0), C0,0); \
    GAPB(o[1]=__builtin_amdgcn_mfma_f32_32x32x16_bf16(PAF(0),VFR(4),o[1],0,0,0), C0,4); \
    KRD(GL,0); GAPB(o[0]=__builtin_amdgcn_mfma_f32_32x32x16_bf16(PAF(1),VFR(1),o[0],0,0,0), C0,8); \
    KRD(GL,1); GAPB(o[1]=__builtin_amdgcn_mfma_f32_32x32x16_bf16(PAF(1),VFR(5),o[1],0,0,0), C0,12); \
    KRD(GL,2); GAPB(o[0]=__builtin_amdgcn_mfma_f32_32x32x16_bf16(PAF(2),VFR(2),o[0],0,0,0), C1,0); \
    KRD(GL,3); GAPB(o[1]=__builtin_amdgcn_mfma_f32_32x32x16_bf16(PAF(2),VFR(6),o[1],0,0,0), C1,4); \
    GAPB(o[0]=__builtin_amdgcn_mfma_f32_32x32x16_bf16(PAF(3),VFR(3),o[0],0,0,0), C1,8); \
    GAPB(o[1]=__builtin_amdgcn_mfma_f32_32x32x16_bf16(PAF(3),VFR(7),o[1],0,0,0), C1,12); \
    }while(0)
  int t=1;
  #undef CMASK
  #define CMASK(P0,P1,t) do{}while(0)
  for(;t+7<NT;t+=2){
    STEP(pB0,pB1,pA0,pA1,t,true,true,true);     WAIT_BAR(2); RESC(); ROT();
    STEP(pA0,pA1,pB0,pB1,t+1,true,true,true);   WAIT_BAR(2); RESC(); ROT();
  }
  #undef CMASK
  #define CMASK(P0,P1,t) do{int jb_=(t)-(NT-6); if(jb_>=0)cmask(P0,P1,jb_,qrel,hi);}while(0)
  #define ENDW(tt) do{ if((tt)+3<NT){WAIT_BAR(2);} else if((tt)+2<NT){WAIT_BAR(1);} else {WAIT_BAR(0);} }while(0)
  for(;t+1<NT;t+=2){
    STEP(pB0,pB1,pA0,pA1,t,(t+3<NT),(t+1<NT),(t+1<NT));       ENDW(t);   RESC(); ROT();
    STEP(pA0,pA1,pB0,pB1,t+1,(t+4<NT),(t+2<NT),(t+2<NT));     ENDW(t+1); RESC(); ROT();
  }
  STEP(pB0,pB1,pA0,pA1,NT-1,false,false,false); RESC();
  { float sacc=pB0[0]+pB0[1]; _Pragma("unroll") for(int r=2;r<16;++r)sacc+=pB0[r]; _Pragma("unroll") for(int r=0;r<16;++r)sacc+=pB1[r]; l_reg+=sacc;
    pw0=(u32x4){PKW(pB0,0),PKW(pB0,2),PKW(pB0,4),PKW(pB0,6)};pw1=(u32x4){PKW(pB0,8),PKW(pB0,10),PKW(pB0,12),PKW(pB0,14)};pw2=(u32x4){PKW(pB1,0),PKW(pB1,2),PKW(pB1,4),PKW(pB1,6)};pw3=(u32x4){PKW(pB1,8),PKW(pB1,10),PKW(pB1,12),PKW(pB1,14)};
    SBAR(); pv(o,vb0+sl_cur,PAF(0),PAF(1),PAF(2),PAF(3)); }
  #undef PKW
  #undef PAF
  #undef VFR
  #undef PIN
  #undef MX3
  #undef GAPA
  #undef GAPB
  #undef EX
  #undef VRD
  #undef KRD
  #undef STEP
  #undef ENDW
  {auto rr=__builtin_amdgcn_permlane32_swap(__float_as_uint(l_reg),__float_as_uint(l_reg),false,false);l_reg=__uint_as_float(rr[0])+__uint_as_float(rr[1]);}
  if(hi==0)wsf[32+r32]=l_reg;asm volatile("s_waitcnt lgkmcnt(0)":::"memory");
  float rli[16];
  #pragma unroll
  for(int r=0;r<16;++r)rli[r]=__builtin_amdgcn_rcpf(wsf[32+crow(r,hi)]);
  bf16*Ow=O+(rowbase+q0+wid*QBLK)*OPITCH+vh*D;
  { bf16*stg=(bf16*)(shm+LDS_OST)+wid*2048;
    #pragma unroll
    for(int r=0;r<16;++r){const int orow=crow(r,hi);
      #pragma unroll
      for(int d0=0;d0<2;++d0)stg[orow*64+d0*32+r32]=__float2bfloat16(o[d0][r]*rli[r]);}
    asm volatile("s_waitcnt lgkmcnt(0)":::"memory");
    #pragma unroll
    for(int i=0;i<4;++i){const int row=i*8+(lane>>3),ch=lane&7; const u32x4 v=*(const u32x4*)(stg+row*64+ch*8); ATTN_STORE16(Ow+(long)row*OPITCH+ch*8,v);} }
  asm volatile("s_waitcnt lgkmcnt(0)\n\ts_barrier":::"memory");
  #undef DMA_K
  #undef TROW
  #undef DMA_V
  #undef CMASK
  #undef START
  #undef RESC
  #undef ROT
}
constexpr int ATTN_LDS_BYTES=LDS_BYTES;
struct AttnTensors { const bf16* Q; const bf16* K; const bf16* V; bf16* O; };
struct AttnUnit { int bh; int qb; };
struct StaticOrder {
  int vcu;
  __device__ __forceinline__ explicit StaticOrder(int grid,int block):vcu((block%8)*(grid/8)+block/8){}
  __device__ __forceinline__ bool next(int i,AttnUnit&u)const{ if(i>=8)return false; const int s=vcu&3; u.bh=vcu>>2; u.qb=(i&1)?(4*i+3-s):(4*i+s); return true; }
  __device__ __forceinline__ void a_ready(const AttnUnit&)const{}
  __device__ __forceinline__ void done(const AttnUnit&)const{}
};
template<class Sched,int THRL=8> __device__ __forceinline__ void attn_phase(char*lds,const AttnTensors&T,const Sched&S){
  AttnUnit u;
  for(int i=0;S.next(i,u);++i){ S.a_ready(u); attn_unit<THRL>(u.bh/NVH,u.bh%NVH,u.qb,T.Q,T.K,T.V,T.O,lds); S.done(u); }
}
#undef SBAR
#undef WAIT_BAR
}
#define GAS __attribute__((address_space(1)))
#define LAS __attribute__((address_space(3)))
typedef unsigned short bf16;
typedef unsigned v4u __attribute__((ext_vector_type(4)));
typedef float f32x4 __attribute__((ext_vector_type(4)));
typedef short bf16x8 __attribute__((ext_vector_type(8)));
typedef GAS unsigned gu32;
typedef GAS unsigned long long gu64;
#define RLX_AGENT __ATOMIC_RELAXED, __HIP_MEMORY_SCOPE_AGENT
#define LDS_WAIT() asm volatile("s_waitcnt lgkmcnt(0)" ::: "memory")
#define VM_WAIT() asm volatile("s_waitcnt vmcnt(0)" ::: "memory")
__device__ __forceinline__ unsigned long long rt() { return __builtin_amdgcn_s_memrealtime(); }
__device__ __forceinline__ unsigned f2bf(float f) { unsigned u = __builtin_bit_cast(unsigned, f); return (u + 0x7fffu + ((u >> 16) & 1u)) >> 16; }
__device__ __forceinline__ unsigned pk2(float lo, float hi) { return f2bf(lo) | (f2bf(hi) << 16); }

#define XB_TMO      128
#define XB_XCNT(j)  (256  + 64 * (j))
#define XB_XSUB(j)  (1280 + 64 * (j))
#define XB_XGEN(j)  (2304 + 64 * (j))
#define XB_TOP      3328
#define XB_TOPGEN   3392
#define XCD_BAR_WORDS 3456
#define XB_SPIN_CAP (1u << 18)

__device__ __forceinline__ unsigned xb_ld(unsigned* p)              { return __hip_atomic_load(p, __ATOMIC_RELAXED, __HIP_MEMORY_SCOPE_AGENT); }
__device__ __forceinline__ unsigned xb_add(unsigned* p, unsigned v) { return __hip_atomic_fetch_add(p, v, __ATOMIC_RELAXED, __HIP_MEMORY_SCOPE_AGENT); }
__device__ __forceinline__ unsigned xb_xcc_id() { return (unsigned)__builtin_amdgcn_s_getreg((3 << 11) | 20) & 0xFu; }
#define XB_SPIN(cond, bar) do { unsigned _sp = 0; while (cond) { __builtin_amdgcn_s_sleep(1); \
    if ((++_sp & 255u) == 0u) { if (xb_ld(&(bar)[XB_TMO])) break; if (_sp > XB_SPIN_CAP) { atomicAdd(&(bar)[XB_TMO], 1u); break; } } } } while (0)

struct XcdBarrier {
    unsigned* bar; unsigned x;
    volatile LAS unsigned* st;
};

__device__ __forceinline__ XcdBarrier xcd_barrier_post(unsigned* bar, volatile LAS unsigned* st) {
    XcdBarrier b; b.bar = bar; b.x = xb_xcc_id(); b.st = st;
    if (threadIdx.x == 0) (void)xb_add(&bar[XB_XCNT(b.x)], 1u);
    return b;
}
__device__ __forceinline__ void xcd_barrier_complete(unsigned* bar, unsigned x, unsigned& nloc, unsigned& nx) {
    const unsigned G = gridDim.x * gridDim.y * gridDim.z;
    unsigned sum, cnt, mine, sp = 0u;
    for (;;) {
        sum = 0u; cnt = 0u; mine = 0u;
#pragma unroll
        for (unsigned j = 0; j < 16; ++j) { const unsigned c = xb_ld(&bar[XB_XCNT(j)]); sum += c; cnt += (c > 0u) ? 1u : 0u; mine = (j == x) ? c : mine; }
        if (sum == G) break;
        __builtin_amdgcn_s_sleep(1);
        if ((++sp & 255u) == 0u) { if (xb_ld(&bar[XB_TMO])) break; if (sp > XB_SPIN_CAP) { atomicAdd(&bar[XB_TMO], 1u); break; } }
    }
    nloc = mine > 0u ? mine : 1u; nx = cnt > 0u ? cnt : 1u;
}

__device__ __forceinline__ void xcd_barrier(const XcdBarrier& b) {
    asm volatile("s_waitcnt vmcnt(0)" ::: "memory");
    __syncthreads();
    if (threadIdx.x == 0) {
        unsigned* bar = b.bar;
        __builtin_amdgcn_s_waitcnt(0);
        unsigned nloc = b.st[0], nx = b.st[1];
        if (nloc == 0u) { xcd_barrier_complete(bar, b.x, nloc, nx); b.st[0] = nloc; b.st[1] = nx; }
        const unsigned old = xb_add(&bar[XB_XSUB(b.x)], 1u);
        const unsigned gen = old / nloc;
        if (old + 1u == (gen + 1u) * nloc) {
            __builtin_amdgcn_fence(__ATOMIC_RELEASE, "agent");
            asm volatile("s_waitcnt vmcnt(0)" ::: "memory");
            const unsigned og = xb_add(&bar[XB_TOP], 1u);
            const unsigned tg = og / nx;
            if (og + 1u == (tg + 1u) * nx) xb_add(&bar[XB_TOPGEN], 1u);
            else XB_SPIN(xb_ld(&bar[XB_TOPGEN]) == tg, bar);
            __builtin_amdgcn_fence(__ATOMIC_ACQUIRE, "agent");
            xb_add(&bar[XB_XGEN(b.x)], 1u);
            asm volatile("s_waitcnt vmcnt(0)" ::: "memory");
        } else {
            XB_SPIN(xb_ld(&bar[XB_XGEN(b.x)]) == gen, bar);
            __builtin_amdgcn_fence(__ATOMIC_ACQUIRE, "agent");
            asm volatile("s_waitcnt vmcnt(0)" ::: "memory");
        }
    }
    __syncthreads();
}

constexpr int NWAVES = 8;
#ifndef MK_N_LAUNCHES
#define MK_N_LAUNCHES 1
#endif
constexpr int NPH = 25;
constexpr int N_LAUNCHES = MK_N_LAUNCHES;
static_assert(N_LAUNCHES == 1 || N_LAUNCHES == NPH, "MK_N_LAUNCHES is 1 or 25");

constexpr int DM_ = 1024, NLAYER = 2, NMETA = 16, SEQ_ = 8192;
constexpr int MREAL = pg8::MREAL, MVALID = pg8::MVALID, MP = 16640;
constexpr int NP1 = 8192;
constexpr int MOE_ROWS = 74240;
constexpr int CAP = 16416;
constexpr float LN_EPS = 1e-5f, ALPHA = 1.4142135623730951f;

constexpr size_t MiB = 1u << 20;
constexpr size_t WS_CTL = 0, CTL_ZERO_BYTES = 1 * MiB;
constexpr size_t WL_IN = 0, WL_GLU = 16 * MiB, WL_SO = 17 * MiB, WL_CO = 18 * MiB, WL_AO = 19 * MiB, WL_WO = 21 * MiB, WL_GU = 23 * MiB, WL_DN = 151 * MiB, WL_ST = 215 * MiB, WL_TOE = 231 * MiB, WL_STRIDE = 304 * MiB;
constexpr size_t WS_W = 2 * MiB;
constexpr size_t WS_SSMC = WS_W + NLAYER * WL_STRIDE;
constexpr size_t WS_ROPE = WS_SSMC + 2 * MiB;
constexpr size_t WS_HF = WS_ROPE + 3 * MiB;
constexpr size_t WS_HB = WS_HF + 65 * MiB;
constexpr size_t WS_UC = WS_HB + 33 * MiB;
constexpr size_t WS_UMETA = WS_UC + 18 * MiB;
constexpr size_t WS_CONV = WS_UMETA + 1 * MiB;
constexpr size_t WS_Q = WS_CONV + 49 * MiB;
constexpr size_t WS_K = WS_Q + 33 * MiB;
constexpr size_t WS_V = WS_K + 33 * MiB;
constexpr size_t WS_GB = WS_V + 33 * MiB;
constexpr size_t WS_SLOC = WS_GB + 98 * MiB;
constexpr size_t WS_SM = WS_SLOC + 4 * MiB;
constexpr size_t WS_OC = WS_SM + 1 * MiB;
constexpr size_t WS_YG = WS_OC + 65 * MiB;
constexpr size_t WS_YS = WS_YG + 17 * MiB;
constexpr size_t WS_YC = WS_YS + 17 * MiB;
constexpr size_t WS_YA = WS_YC + 17 * MiB;
constexpr size_t WS_MG = WS_YA + 33 * MiB;
constexpr size_t WS_PRE = WS_MG + 33 * MiB;
constexpr size_t WS_XG = WS_PRE + 65 * MiB;
constexpr size_t WS_HID = WS_XG + 145 * MiB;
constexpr size_t WS_OUTS = WS_HID + 145 * MiB;
constexpr size_t WS_ROWIDX = WS_OUTS + 145 * MiB;
constexpr size_t WS_TOKE = WS_ROWIDX + 3 * MiB;
constexpr size_t WS_TOKW = WS_TOKE + 1 * MiB;
constexpr size_t WS_END = WS_TOKW + 1 * MiB;
static_assert((size_t)MOE_ROWS * 1024 * 2 <= 145 * MiB && (size_t)MP * 3072 * 2 <= 98 * MiB && (size_t)MP * 1536 * 2 <= 49 * MiB && (size_t)MP * 4096 <= 65 * MiB && (size_t)32 * 1024 * 1152 * 2 <= 73 * MiB, "d_ws map");
constexpr int CW_TMO = 0, CW_CODE = 1;
constexpr int CW_BAR = 4096;
constexpr int CW_CNT = 16384;
static_assert((CW_CNT + NLAYER * 32 * 64) * 4 <= (int)CTL_ZERO_BYTES, "CTL words inside the memset region");

constexpr int RING_OFF = 0, RING_BYTES = 131072;
constexpr int LDSCTL_OFF = RING_BYTES, MISC_OFF = LDSCTL_OFF + 320;
constexpr int REC_OFF = MISC_OFF + 192;
constexpr int LDS_BYTES = 147456;
static_assert(REC_OFF + 8 * 40 * 8 <= LDS_BYTES && (REC_OFF % 16) == 0, "LDS map");

enum InIdx { I_X = 0, I_META, I_LNIN_G, I_LNIN_B, I_WIN, I_LAMRE, I_LAMIM, I_LOGDT, I_BRE, I_BIM, I_CRE, I_CIM, I_SSMD, I_WGLU, I_SSMWO, I_CONVW, I_CONVWO,
             I_LQ1, I_LK1, I_LQ2, I_LK2, I_SUBLN, I_ATTNWO, I_GATEW, I_GATEB, I_WO, I_LN1G, I_LN1B, I_RW, I_RB, I_WGU, I_BGU, I_WDN, I_BDN, I_LN2G, I_LN2B, N_IN };
struct Args { const float* in[N_IN]; float* out; unsigned char* ws; int ph_lo, ph_hi, li, pad; };
struct Frame {
    LAS unsigned char* lds;
    volatile LAS unsigned* MISC;
    gu32* ctl;
    unsigned char* ws;
    int tid, lane, wave;
    int vcu, G;
    int chk_l;
};
__device__ __forceinline__ float wave_sum_slow(float v) {
#pragma unroll
    for (int o = 1; o < 64; o <<= 1) v += __shfl_xor(v, o);
    return v;
}
#define DPPF(x, ctrl) __builtin_bit_cast(float, __builtin_amdgcn_mov_dpp(__builtin_bit_cast(int, (x)), (ctrl), 0xf, 0xf, true))
__device__ __forceinline__ float wave_sum(float v) {
    v += DPPF(v, 0xB1); v += DPPF(v, 0x4E); v += DPPF(v, 0x141); v += DPPF(v, 0x140);
    const int iv = __builtin_bit_cast(int, v);
    const float r0 = __builtin_bit_cast(float, __builtin_amdgcn_readlane(iv, 0)), r1 = __builtin_bit_cast(float, __builtin_amdgcn_readlane(iv, 16)),
                r2 = __builtin_bit_cast(float, __builtin_amdgcn_readlane(iv, 32)), r3 = __builtin_bit_cast(float, __builtin_amdgcn_readlane(iv, 48));
    return (r0 + r1) + (r2 + r3);
}
__device__ __forceinline__ float wave_max(float v) {
#pragma unroll
    for (int o = 1; o < 64; o <<= 1) v = fmaxf(v, __shfl_xor(v, o));
    return v;
}
__device__ __forceinline__ int wave_min_i(int v) {
#pragma unroll
    for (int o = 1; o < 64; o <<= 1) { const int w = __shfl_xor(v, o); v = w < v ? w : v; }
    return v;
}
__device__ __forceinline__ float bflo(unsigned w) { return __uint_as_float(w << 16); }
__device__ __forceinline__ float bfhi(unsigned w) { return __uint_as_float(w & 0xffff0000u); }
__device__ __forceinline__ void unpk8(v4u w, float (&f)[8]) { f[0] = bflo(w.x); f[1] = bfhi(w.x); f[2] = bflo(w.y); f[3] = bfhi(w.y); f[4] = bflo(w.z); f[5] = bfhi(w.z); f[6] = bflo(w.w); f[7] = bfhi(w.w); }
__device__ __forceinline__ v4u pk8(const float (&f)[8]) { v4u o; o.x = pk2(f[0], f[1]); o.y = pk2(f[2], f[3]); o.z = pk2(f[4], f[5]); o.w = pk2(f[6], f[7]); return o; }
__device__ __forceinline__ float sigm_(float x) { return 1.0f / (1.0f + __expf(-x)); }
__device__ __forceinline__ float gelu_(float x) { const float u = 0.7978845608028654f * (x + 0.044715f * x * x * x); return x * sigm_(2.0f * u); }

__device__ __forceinline__ int rowmap(int n, int mode) {
    if (mode == 1) { if (n >= 2048 && n < 4096) { const int d = n & 63; return (n & ~63) + (d < 32 ? 8 * (d >> 2) + (d & 3) : 8 * ((d - 32) >> 2) + 4 + (d & 3)); } return n; }
    if (mode == 2) { return n < 1024 ? 8 * (n >> 2) + (n & 3) : 8 * ((n - 1024) >> 2) + 4 + (n & 3); }
    return n;
}
__device__ __forceinline__ void transpose_item(const float* W, int K, int N, bf16* WT, int mode, LAS float* scr, int item, int lane) {
    const int nblk = N / 32, kb = item / nblk, nb = item - kb * nblk, k0 = 64 * kb, n0 = 32 * nb;
    typedef float f2 __attribute__((ext_vector_type(2)));
    f2 v[16];
    const int lr = lane >> 4, lc = 2 * (lane & 15);
#pragma unroll
    for (int i = 0; i < 16; ++i) v[i] = *(const GAS f2*)(W + (size_t)(k0 + 4 * i + lr) * N + n0 + lc);
#pragma unroll
    for (int i = 0; i < 16; ++i) { scr[(4 * i + lr) * 33 + lc] = v[i].x; scr[(4 * i + lr) * 33 + lc + 1] = v[i].y; }
    LDS_WAIT(); asm volatile("" ::: "memory");
    const int c = lane & 7;
#pragma unroll
    for (int j = 0; j < 4; ++j) { const int n = (lane >> 3) + 8 * j; const LAS float* s = scr + (8 * c) * 33 + n;
        v4u o; o.x = pk2(s[0 * 33], s[1 * 33]); o.y = pk2(s[2 * 33], s[3 * 33]); o.z = pk2(s[4 * 33], s[5 * 33]); o.w = pk2(s[6 * 33], s[7 * 33]);
        *(GAS v4u*)(WT + (size_t)rowmap(n0 + n, mode) * K + k0 + 8 * c) = o; }
    LDS_WAIT(); asm volatile("" ::: "memory");
}
__device__ __forceinline__ void ln16(f32x4 (&v)[4], const float* g, const float* b, int lane) {
    float s = 0.f;
#pragma unroll
    for (int j = 0; j < 4; ++j) s += (v[j].x + v[j].y) + (v[j].z + v[j].w);
    const float mean = wave_sum(s) * (1.f / 1024.f); float s2 = 0.f;
#pragma unroll
    for (int j = 0; j < 4; ++j) { v[j] = v[j] - mean; s2 += (v[j].x * v[j].x + v[j].y * v[j].y) + (v[j].z * v[j].z + v[j].w * v[j].w); }
    const float rstd = 1.f / sqrtf(wave_sum(s2) * (1.f / 1024.f) + LN_EPS);
#pragma unroll
    for (int j = 0; j < 4; ++j) { const f32x4 gg = *(const GAS f32x4*)(g + 256 * j + 4 * lane), bb = *(const GAS f32x4*)(b + 256 * j + 4 * lane); v[j] = v[j] * rstd * gg + bb; }
}
__device__ __forceinline__ void store_row_f32_bf16(const f32x4 (&v)[4], float* hf, bf16* hb, int lane) {
#pragma unroll
    for (int j = 0; j < 4; ++j) { if (hf) *(GAS f32x4*)(hf + 256 * j + 4 * lane) = v[j];
        *(GAS unsigned long long*)(hb + 256 * j + 4 * lane) = (unsigned long long)pk2(v[j].x, v[j].y) | ((unsigned long long)pk2(v[j].z, v[j].w) << 32); }
}

__device__ __forceinline__ void ssm_build(Frame& F, const Args& A, int l, int g) {
    LAS float* L = (LAS float*)(F.lds + RING_OFF);
    LAS float* AP_re = L; LAS float* AP_im = L + 4160; LAS float* BB_re = L + 8320; LAS float* BB_im = L + 9344; LAS float* CC_re = L + 10368; LAS float* CC_im = L + 11392; LAS float* KM = L + 12416;
    const int lg = l * 32 + g; const int tid = F.tid;
    const float dt = __expf(A.in[I_LOGDT][lg]);
    for (int idx = tid; idx < 65 * 64; idx += 512) { const int j = idx >> 6, p = idx & 63; const float lr = A.in[I_LAMRE][lg * 64 + p], li = A.in[I_LAMIM][lg * 64 + p];
        const float mag = expf(lr * dt * (float)j), ang = li * dt * (float)j; AP_re[idx] = mag * cosf(ang); AP_im[idx] = mag * sinf(ang); }
    __syncthreads();
    for (int idx = tid; idx < 1024; idx += 512) {
        { const int p = idx >> 4, c = idx & 15; const float lr = A.in[I_LAMRE][lg * 64 + p], li = A.in[I_LAMIM][lg * 64 + p];
          const float ar = AP_re[64 + p], ai = AP_im[64 + p], nr = ar - 1.0f, den = lr * lr + li * li;
          const float cr = (nr * lr + ai * li) / den, ci = (ai * lr - nr * li) / den;
          const float br = A.in[I_BRE][(size_t)(lg * 64 + p) * 16 + c], bi = A.in[I_BIM][(size_t)(lg * 64 + p) * 16 + c];
          BB_re[idx] = cr * br - ci * bi; BB_im[idx] = cr * bi + ci * br; }
        { CC_re[idx] = A.in[I_CRE][(size_t)lg * 1024 + idx]; CC_im[idx] = A.in[I_CIM][(size_t)lg * 1024 + idx]; }
    }
    __syncthreads();
    for (int idx = tid; idx < 16384; idx += 512) { const int j = idx >> 8, co = (idx >> 4) & 15, ci = idx & 15; float s = 0.f;
        for (int p = 0; p < 64; ++p) { const float Ar = AP_re[j * 64 + p], Ai = AP_im[j * 64 + p], Br = BB_re[p * 16 + ci], Bi = BB_im[p * 16 + ci];
            const float er = Ar * Br - Ai * Bi, ei = Ar * Bi + Ai * Br; s += CC_re[co * 64 + p] * er - CC_im[co * 64 + p] * ei; }
        if (j == 0 && co == ci) s += A.in[I_SSMD][l * 512 + g * 16 + co];
        KM[idx] = s; }
    __syncthreads();
    bf16* TOE = (bf16*)(F.ws + WS_W + (size_t)l * WL_STRIDE + WL_TOE) + (size_t)g * 1024 * 1152;
    for (int q = tid; q < 1024 * 144; q += 512) { const int n = q / 144, kc = q - n * 144, t = n >> 4, co = n & 15; float f[8];
        if (kc < 128) { const int s = kc >> 1, ci0 = (kc & 1) * 8;
            if (s <= t) {
#pragma unroll
                for (int i = 0; i < 8; ++i) f[i] = KM[(t - s) * 256 + co * 16 + ci0 + i]; }
            else {
#pragma unroll
                for (int i = 0; i < 8; ++i) f[i] = 0.f; } }
        else { const int p0 = (kc - 128) * 8;
#pragma unroll
            for (int i = 0; i < 8; ++i) { const int p = (p0 + i) & 63; const float Cr = CC_re[co * 64 + p], Ci = CC_im[co * 64 + p], Ar = AP_re[(t + 1) * 64 + p], Ai = AP_im[(t + 1) * 64 + p];
                f[i] = p0 < 64 ? (Cr * Ar - Ci * Ai) : -(Cr * Ai + Ci * Ar); } }
        *(GAS v4u*)(TOE + (size_t)n * 1152 + kc * 8) = pk8(f); }
    bf16* WST = (bf16*)(F.ws + WS_W + (size_t)l * WL_STRIDE + WL_ST) + (size_t)g * 256 * 1024;
    for (int q = tid; q < 256 * 128; q += 512) { const int n = q >> 7, kc = q & 127, s = kc >> 1, ci0 = (kc & 1) * 8; float f[8];
        if (n < 128) { const int p = n & 63; const float Ar = AP_re[(63 - s) * 64 + p], Ai = AP_im[(63 - s) * 64 + p];
#pragma unroll
            for (int i = 0; i < 8; ++i) { const float Br = BB_re[p * 16 + ci0 + i], Bi = BB_im[p * 16 + ci0 + i]; f[i] = n < 64 ? (Ar * Br - Ai * Bi) : (Ar * Bi + Ai * Br); } }
        else {
#pragma unroll
            for (int i = 0; i < 8; ++i) f[i] = 0.f; }
        *(GAS v4u*)(WST + (size_t)n * 1024 + kc * 8) = pk8(f); }
    float* SC = (float*)(F.ws + WS_SSMC + (size_t)l * MiB);
    if (tid < 64) { const int p = tid; SC[(lg * 64 + p) * 2] = AP_re[64 + p]; SC[(lg * 64 + p) * 2 + 1] = AP_im[64 + p];
        SC[16384 + (lg * 64 + p) * 2] = AP_re[64 * 64 + p]; SC[16384 + (lg * 64 + p) * 2 + 1] = AP_im[64 * 64 + p]; }
    for (int idx = tid; idx < 1024; idx += 512) { const int p = idx >> 4, c = idx & 15; SC[32768 + (size_t)(lg * 64 + p) * 32 + c] = BB_re[idx]; SC[32768 + (size_t)(lg * 64 + p) * 32 + 16 + c] = BB_im[idx]; }
    __syncthreads();
}

__device__ __forceinline__ void p0_prologue(Frame& F, const Args& A) {
    for (int job = F.vcu; job < NLAYER * 32; job += F.G) ssm_build(F, A, job >> 5, job & 31);
    const int gw = F.vcu * NWAVES + F.wave, NGW = F.G * NWAVES, lane = F.lane;
    float* HF = (float*)(F.ws + WS_HF); bf16* HB = (bf16*)(F.ws + WS_HB);
    for (int R = gw; R < MVALID; R += NGW) { const float* src = R < MREAL ? A.in[I_X] + (size_t)R * 1024 : A.in[I_META] + (size_t)((R - MREAL) & 15) * 1024;
        f32x4 v[4];
#pragma unroll
        for (int j = 0; j < 4; ++j) v[j] = *(const GAS f32x4*)(src + 256 * j + 4 * lane);
        ln16(v, A.in[I_LNIN_G], A.in[I_LNIN_B], lane); store_row_f32_bf16(v, HF + (size_t)R * 1024, HB + (size_t)R * 1024, lane); }
    { float* ROPE = (float*)(F.ws + WS_ROPE); const int gt = F.vcu * 512 + F.tid, NGT = F.G * 512;
      for (int idx = gt; idx < 8208 * 32; idx += NGT) { const int pos = idx >> 5, j = idx & 31; const float inv = exp2f(-(float)j * (13.287712379549449f / 32.0f)); const float ang = (float)pos * inv;
          ROPE[(size_t)pos * 64 + j] = cosf(ang); ROPE[(size_t)pos * 64 + 32 + j] = sinf(ang); } }
    { bf16* KB = (bf16*)(F.ws + WS_K); bf16* VB = (bf16*)(F.ws + WS_V);
      for (int r = gw; r < 512; r += NGW) { bf16* base = (r & 256) ? VB : KB; const int b = (r >> 7) & 1, rr = r & 127; GAS v4u* d = (GAS v4u*)(base + (size_t)(b * 8320 + 8192 + rr) * 1024);
          d[lane] = (v4u){0u, 0u, 0u, 0u}; d[64 + lane] = (v4u){0u, 0u, 0u, 0u}; } }
    LAS float* scr = (LAS float*)(F.lds + RING_OFF + F.wave * 16384);
    constexpr int IT_IN = 16 * 160, IT_GATE = 16 * 96, IT_GLU = 8 * 16, IT_SO = 8 * 32, IT_CO = 8 * 32, IT_AO = 16 * 32, IT_WO = 16 * 32, IT_GU1 = 16 * 64, IT_DN1 = 16 * 32;
    constexpr int IT_L = IT_IN + IT_GATE + IT_GLU + IT_SO + IT_CO + IT_AO + IT_WO + 32 * IT_GU1 + 32 * IT_DN1;
    for (int it = gw; it < NLAYER * IT_L; it += NGW) {
        const int l = it / IT_L; int r = it - l * IT_L; unsigned char* wl = F.ws + WS_W + (size_t)l * WL_STRIDE;
        if (r < IT_IN) { transpose_item(A.in[I_WIN] + (size_t)l * 1024 * 5120, 1024, 5120, (bf16*)(wl + WL_IN), 1, scr, r, lane); continue; } r -= IT_IN;
        if (r < IT_GATE) { transpose_item(A.in[I_GATEW] + (size_t)l * 1024 * 3072, 1024, 3072, (bf16*)(wl + WL_IN) + (size_t)5120 * 1024, 0, scr, r, lane); continue; } r -= IT_GATE;
        if (r < IT_GLU) { transpose_item(A.in[I_WGLU] + (size_t)l * 512 * 512, 512, 512, (bf16*)(wl + WL_GLU), 0, scr, r, lane); continue; } r -= IT_GLU;
        if (r < IT_SO) { transpose_item(A.in[I_SSMWO] + (size_t)l * 512 * 1024, 512, 1024, (bf16*)(wl + WL_SO), 0, scr, r, lane); continue; } r -= IT_SO;
        if (r < IT_CO) { transpose_item(A.in[I_CONVWO] + (size_t)l * 512 * 1024, 512, 1024, (bf16*)(wl + WL_CO), 0, scr, r, lane); continue; } r -= IT_CO;
        if (r < IT_AO) { transpose_item(A.in[I_ATTNWO] + (size_t)l * 1024 * 1024, 1024, 1024, (bf16*)(wl + WL_AO), 0, scr, r, lane); continue; } r -= IT_AO;
        if (r < IT_WO) { transpose_item(A.in[I_WO] + (size_t)l * 1024 * 1024, 1024, 1024, (bf16*)(wl + WL_WO), 0, scr, r, lane); continue; } r -= IT_WO;
        if (r < 32 * IT_GU1) { const int e = r / IT_GU1; transpose_item(A.in[I_WGU] + ((size_t)l * 32 + e) * 1024 * 2048, 1024, 2048, (bf16*)(wl + WL_GU) + (size_t)e * 2048 * 1024, 2, scr, r - e * IT_GU1, lane); continue; } r -= 32 * IT_GU1;
        { const int e = r / IT_DN1; transpose_item(A.in[I_WDN] + ((size_t)l * 32 + e) * 1024 * 1024, 1024, 1024, (bf16*)(wl + WL_DN) + (size_t)e * 1024 * 1024, 0, scr, r - e * IT_DN1, lane); }
    }
}

__device__ __forceinline__ int prev_row(int R, int k) {
    if (R < MREAL) { const int t = R & 8191, b = R >> 13; return t >= k ? R - k : MREAL + b * 16 + 16 - (k - t); }
    const int i = (R - MREAL) & 15; return i >= k ? R - k : -1;
}
__device__ __forceinline__ void conv_rows(Frame& F, const Args& A, int l) {
    const int gw = F.vcu * NWAVES + F.wave, NGW = F.G * NWAVES, lane = F.lane, c0 = 8 * lane;
    const bf16* CB = (const bf16*)(F.ws + WS_CONV); bf16* YC = (bf16*)(F.ws + WS_YC);
    float w0[8], w1[8], w2[8];
#pragma unroll
    for (int i = 0; i < 8; ++i) { w0[i] = A.in[I_CONVW][(size_t)l * 1536 + c0 + i]; w1[i] = A.in[I_CONVW][(size_t)l * 1536 + 512 + c0 + i]; w2[i] = A.in[I_CONVW][(size_t)l * 1536 + 1024 + c0 + i]; }
    for (int R = gw; R < MVALID; R += NGW) {
        const int r1 = prev_row(R, 1), r2 = prev_row(R, 2);
        float gb[8], a[8], h[8], z0[8], z1[8], z2[8];
        unpk8(*(const GAS v4u*)(CB + (size_t)R * 1536 + c0), gb);
        unpk8(*(const GAS v4u*)(CB + (size_t)R * 1536 + 512 + c0), a); unpk8(*(const GAS v4u*)(CB + (size_t)R * 1536 + 1024 + c0), h);
#pragma unroll
        for (int i = 0; i < 8; ++i) z0[i] = a[i] * h[i];
        if (r1 >= 0) { unpk8(*(const GAS v4u*)(CB + (size_t)r1 * 1536 + 512 + c0), a); unpk8(*(const GAS v4u*)(CB + (size_t)r1 * 1536 + 1024 + c0), h);
#pragma unroll
            for (int i = 0; i < 8; ++i) z1[i] = a[i] * h[i]; }
        else {
#pragma unroll
            for (int i = 0; i < 8; ++i) z1[i] = 0.f; }
        if (r2 >= 0) { unpk8(*(const GAS v4u*)(CB + (size_t)r2 * 1536 + 512 + c0), a); unpk8(*(const GAS v4u*)(CB + (size_t)r2 * 1536 + 1024 + c0), h);
#pragma unroll
            for (int i = 0; i < 8; ++i) z2[i] = a[i] * h[i]; }
        else {
#pragma unroll
            for (int i = 0; i < 8; ++i) z2[i] = 0.f; }
        float y[8];
#pragma unroll
        for (int i = 0; i < 8; ++i) y[i] = gb[i] * (w0[i] * z2[i] + w1[i] * z1[i] + w2[i] * z0[i]);
        *(GAS v4u*)(YC + (size_t)R * 512 + c0) = pk8(y);
    }
}
__device__ __forceinline__ void ssm_meta_job(Frame& F, const Args& A, int l, int bm, int g) {
    const int lane = F.lane, lg = l * 32 + g;
    const float* SC = (const float*)(F.ws + WS_SSMC + (size_t)l * MiB);
    const bf16* UM = (const bf16*)(F.ws + WS_UMETA); bf16* YG = (bf16*)(F.ws + WS_YG); float* SM = (float*)(F.ws + WS_SM);
    LAS float* scr = (LAS float*)(F.lds + RING_OFF + F.wave * 16384);
    LAS float* CR = scr + 2048; LAS float* CI = scr + 3072;
    { const GAS f32x4* cr = (const GAS f32x4*)(A.in[I_CRE] + (size_t)lg * 1024) + lane * 4; const GAS f32x4* ci = (const GAS f32x4*)(A.in[I_CIM] + (size_t)lg * 1024) + lane * 4;
      f32x4 t0[4], t1[4];
#pragma unroll
      for (int i = 0; i < 4; ++i) { t0[i] = cr[i]; t1[i] = ci[i]; }
#pragma unroll
      for (int i = 0; i < 4; ++i) { *(LAS f32x4*)(CR + lane * 16 + 4 * i) = t0[i]; *(LAS f32x4*)(CI + lane * 16 + 4 * i) = t1[i]; } }
    const float ar = SC[(lg * 64 + lane) * 2], ai = SC[(lg * 64 + lane) * 2 + 1];
    float bbr[16], bbi[16];
    { const GAS f32x4* bp = (const GAS f32x4*)(SC + 32768 + (size_t)(lg * 64 + lane) * 32);
#pragma unroll
      for (int i = 0; i < 4; ++i) { const f32x4 r = bp[i], m = bp[4 + i]; bbr[4 * i] = r.x; bbr[4 * i + 1] = r.y; bbr[4 * i + 2] = r.z; bbr[4 * i + 3] = r.w; bbi[4 * i] = m.x; bbi[4 * i + 1] = m.y; bbi[4 * i + 2] = m.z; bbi[4 * i + 3] = m.w; } }
    float xr = 0.f, xi = 0.f;
#pragma unroll
    for (int hh = 0; hh < 2; ++hh) { v4u ua[8], ub[8];
#pragma unroll
        for (int s = 0; s < 8; ++s) { const bf16* up = UM + (size_t)(bm * 16 + hh * 8 + s) * 512 + g * 16; ua[s] = *(const GAS v4u*)up; ub[s] = *(const GAS v4u*)(up + 8); }
#pragma unroll
        for (int s = 0; s < 8; ++s) { float fa[8], fb[8]; unpk8(ua[s], fa); unpk8(ub[s], fb); float bur = 0.f, bui = 0.f;
#pragma unroll
            for (int c = 0; c < 8; ++c) { bur += bbr[c] * fa[c] + bbr[8 + c] * fb[c]; bui += bbi[c] * fa[c] + bbi[8 + c] * fb[c]; }
            const float nr = ar * xr - ai * xi + bur, ni = ar * xi + ai * xr + bui; xr = nr; xi = ni;
            const int ss = hh * 8 + s; scr[ss * 128 + ((lane + ss) & 63)] = xr; scr[ss * 128 + 64 + ((lane + ss) & 63)] = xi; } }
    SM[(size_t)(bm * 32 + g) * 128 + lane] = xr; SM[(size_t)(bm * 32 + g) * 128 + 64 + lane] = xi;
    LDS_WAIT(); asm volatile("" ::: "memory");
    const int s = lane >> 2, coq = (lane & 3) * 4; float y[4] = {0.f, 0.f, 0.f, 0.f};
    for (int p = 0; p < 64; ++p) { const float vr = scr[s * 128 + ((p + s) & 63)], vi = scr[s * 128 + 64 + ((p + s) & 63)];
#pragma unroll
        for (int i = 0; i < 4; ++i) y[i] += CR[(coq + i) * 64 + p] * vr - CI[(coq + i) * 64 + p] * vi; }
    const unsigned long long uw = *(const GAS unsigned long long*)(UM + (size_t)(bm * 16 + s) * 512 + g * 16 + coq);
    const f32x4 dv = *(const GAS f32x4*)(A.in[I_SSMD] + l * 512 + g * 16 + coq);
    y[0] += dv.x * bflo((unsigned)uw); y[1] += dv.y * bfhi((unsigned)uw); y[2] += dv.z * bflo((unsigned)(uw >> 32)); y[3] += dv.w * bfhi((unsigned)(uw >> 32));
    const unsigned long long o = (unsigned long long)pk2(gelu_(y[0]), gelu_(y[1])) | ((unsigned long long)pk2(gelu_(y[2]), gelu_(y[3])) << 32);
    *(GAS unsigned long long*)(YG + (size_t)(MREAL + bm * 16 + s) * 512 + g * 16 + coq) = o;
    LDS_WAIT(); asm volatile("" ::: "memory");
}
__device__ __forceinline__ void ssm_carry(Frame& F, int l) {
    const int T = F.vcu * 512 + F.tid; if (T >= 4096) return;
    const int b = T >> 11, g = (T >> 6) & 31, p = T & 63, lg = l * 32 + g;
    const float* SC = (const float*)(F.ws + WS_SSMC + (size_t)l * MiB); const float* SM = (const float*)(F.ws + WS_SM); const float* SL = (const float*)(F.ws + WS_SLOC); bf16* UC = (bf16*)(F.ws + WS_UC);
    const float a64r = SC[16384 + (lg * 64 + p) * 2], a64i = SC[16384 + (lg * 64 + p) * 2 + 1];
    float Sr = SM[(size_t)(b * 32 + g) * 128 + p], Si = SM[(size_t)(b * 32 + g) * 128 + 64 + p];
    const size_t row0 = (size_t)g * 256 + b * 128;
    for (int k0 = 0; k0 < 128; k0 += 16) { float lr[16], li[16];
#pragma unroll
        for (int j = 0; j < 16; ++j) { lr[j] = *(const GAS float*)(SL + (row0 + k0 + j) * 128 + p); li[j] = *(const GAS float*)(SL + (row0 + k0 + j) * 128 + 64 + p); }
#pragma unroll
        for (int j = 0; j < 16; ++j) { const size_t row = row0 + k0 + j;
            *(GAS bf16*)(UC + row * 1152 + 1024 + p) = (bf16)f2bf(Sr); *(GAS bf16*)(UC + row * 1152 + 1088 + p) = (bf16)f2bf(Si);
            const float nr = a64r * Sr - a64i * Si + lr[j], ni = a64r * Si + a64i * Sr + li[j]; Sr = nr; Si = ni; } }
}
__device__ __forceinline__ void attn_meta_job(Frame& F, int Rm, int h) {
    const int lane = F.lane, bm = Rm >> 4, R = MREAL + Rm, j = lane >> 2, dq = lane & 3;
    const bf16* Q = (const bf16*)(F.ws + WS_Q); const bf16* K = (const bf16*)(F.ws + WS_K); const bf16* V = (const bf16*)(F.ws + WS_V); bf16* OC = (bf16*)(F.ws + WS_OC);
    const size_t krow = (size_t)bm * 8320 + 8256;
#pragma unroll
    for (int c = 0; c < 2; ++c) { const int hc = h * 2 + c; float qa[8], qb[8], ka[8], kb[8];
        unpk8(*(const GAS v4u*)(Q + (size_t)R * 1024 + hc * 64 + dq * 16), qa); unpk8(*(const GAS v4u*)(Q + (size_t)R * 1024 + hc * 64 + dq * 16 + 8), qb);
        unpk8(*(const GAS v4u*)(K + (krow + j) * 1024 + hc * 64 + dq * 16), ka); unpk8(*(const GAS v4u*)(K + (krow + j) * 1024 + hc * 64 + dq * 16 + 8), kb);
        float s = 0.f;
#pragma unroll
        for (int i = 0; i < 8; ++i) s += qa[i] * ka[i] + qb[i] * kb[i];
        s += __shfl_xor(s, 1); s += __shfl_xor(s, 2);
        float m = s;
#pragma unroll
        for (int o = 4; o < 64; o <<= 1) m = fmaxf(m, __shfl_xor(m, o));
        const float pj = exp2f(s - m); float lsum = pj;
#pragma unroll
        for (int o = 4; o < 64; o <<= 1) lsum += __shfl_xor(lsum, o);
        float o0 = 0.f, o1 = 0.f;
#pragma unroll
        for (int jj = 0; jj < 16; ++jj) { const float pp = __shfl(pj, 4 * jj); const unsigned vv = *(const GAS unsigned*)(V + (krow + jj) * 1024 + h * 128 + 2 * lane); o0 += pp * bflo(vv); o1 += pp * bfhi(vv); }
        const float rl = 1.0f / lsum;
        *(GAS unsigned*)(OC + (size_t)R * 2048 + hc * 128 + 2 * lane) = pk2(o0 * rl, o1 * rl); }
}
__device__ __forceinline__ void attn_combine_rows(Frame& F, const Args& A, int l) {
    const int gw = F.vcu * NWAVES + F.wave, NGW = F.G * NWAVES, lane = F.lane;
    const bf16* OC = (const bf16*)(F.ws + WS_OC); bf16* YA = (bf16*)(F.ws + WS_YA);
    const float lam_init = 0.8f - 0.6f * expf(-0.3f * (float)l);
    const float d1 = wave_sum(A.in[I_LQ1][l * 64 + lane] * A.in[I_LK1][l * 64 + lane]), d2 = wave_sum(A.in[I_LQ2][l * 64 + lane] * A.in[I_LK2][l * 64 + lane]);
    const float lam = expf(d1) - expf(d2) + lam_init;
    const int e0 = (lane & 15) * 8; float sg[8];
#pragma unroll
    for (int i = 0; i < 8; ++i) sg[i] = A.in[I_SUBLN][l * 128 + e0 + i] * (1.0f - lam_init);
    for (int R = gw; R < MVALID; R += NGW) {
#pragma unroll
        for (int pass = 0; pass < 2; ++pass) { const int h = pass * 4 + (lane >> 4); float a[8], b[8], d[8];
            unpk8(*(const GAS v4u*)(OC + (size_t)R * 2048 + (2 * h) * 128 + e0), a); unpk8(*(const GAS v4u*)(OC + (size_t)R * 2048 + (2 * h + 1) * 128 + e0), b);
            float ss = 0.f;
#pragma unroll
            for (int i = 0; i < 8; ++i) { d[i] = a[i] - lam * b[i]; ss += d[i] * d[i]; }
            ss += __shfl_xor(ss, 1); ss += __shfl_xor(ss, 2); ss += __shfl_xor(ss, 4); ss += __shfl_xor(ss, 8);
            const float rs = 1.0f / sqrtf(ss * (1.0f / 128.0f) + 1e-5f);
#pragma unroll
            for (int i = 0; i < 8; ++i) d[i] = d[i] * rs * sg[i];
            *(GAS v4u*)(YA + (size_t)R * 1024 + h * 128 + e0) = pk8(d); }
    }
}
__device__ __forceinline__ float router_reduce(const float (&acc)[32], int lane) {
    float a16[16], a8[8], a4[4], a2[2], a1;
    { const bool hi = lane & 32;
#pragma unroll
      for (int i = 0; i < 16; ++i) { const float keep = hi ? acc[i + 16] : acc[i], give = hi ? acc[i] : acc[i + 16]; a16[i] = keep + __shfl_xor(give, 32); } }
    { const bool hi = lane & 16;
#pragma unroll
      for (int i = 0; i < 8; ++i) { const float keep = hi ? a16[i + 8] : a16[i], give = hi ? a16[i] : a16[i + 8]; a8[i] = keep + __shfl_xor(give, 16); } }
    { const bool hi = lane & 8;
#pragma unroll
      for (int i = 0; i < 4; ++i) { const float keep = hi ? a8[i + 4] : a8[i], give = hi ? a8[i] : a8[i + 4]; a4[i] = keep + __shfl_xor(give, 8); } }
    { const bool hi = lane & 4;
#pragma unroll
      for (int i = 0; i < 2; ++i) { const float keep = hi ? a4[i + 2] : a4[i], give = hi ? a4[i] : a4[i + 2]; a2[i] = keep + __shfl_xor(give, 4); } }
    { const bool hi = lane & 2; const float keep = hi ? a2[1] : a2[0], give = hi ? a2[0] : a2[1]; a1 = keep + DPPF(give, 0x4E); }
    return a1 + DPPF(a1, 0xB1);
}
__device__ __forceinline__ void router_top4(float val, int R, int lane, float* TOKW, unsigned* recg, int nrec, int& ecnt) {
    const int e_me = lane >> 1, iv = __builtin_bit_cast(int, val); int rank = 0;
#pragma unroll
    for (int e = 0; e < 32; ++e) { const float s = __builtin_bit_cast(float, __builtin_amdgcn_readlane(iv, 2 * e)); rank += ((s > val) || (s == val && e < e_me)) ? 1 : 0; }
    float tv[4]; int te[4];
#pragma unroll
    for (int k = 0; k < 4; ++k) { const unsigned long long m = __ballot(rank == k && !(lane & 1)); const int L = __builtin_amdgcn_readfirstlane((int)__ffsll((long long)m) - 1);
        te[k] = L >> 1; tv[k] = __builtin_bit_cast(float, __builtin_amdgcn_readlane(iv, L)); }
    ecnt += (te[0] == lane) + (te[1] == lane) + (te[2] == lane) + (te[3] == lane);
    const float p1 = __expf(tv[1] - tv[0]), p2 = __expf(tv[2] - tv[0]), p3 = __expf(tv[3] - tv[0]), rs = 1.0f / (1.0f + p1 + p2 + p3);
    if (lane < 4) { const int k = lane; const int e = k == 0 ? te[0] : k == 1 ? te[1] : k == 2 ? te[2] : te[3]; const float w = (k == 0 ? 1.0f : k == 1 ? p1 : k == 2 ? p2 : p3) * rs;
        TOKW[(size_t)R * 4 + k] = w; recg[(nrec * 4 + k) * 2] = (unsigned)R; recg[(nrec * 4 + k) * 2 + 1] = (unsigned)e; }
}
__device__ __forceinline__ void ln1_router(Frame& F, const Args& A, int l) {
    const int tid = F.tid, lane = F.lane, wave = F.wave, gw = F.vcu * NWAVES + wave, NGW = F.G * NWAVES;
    LAS float* WT = (LAS float*)(F.lds + RING_OFF);
    const float* rw = A.in[I_RW] + (size_t)l * 1024 * 32;
    for (int idx = tid; idx < 32768; idx += 512) WT[(idx & 31) * 1024 + (idx >> 5)] = rw[idx];
    __syncthreads();
    const float* PRE = (const float*)(F.ws + WS_PRE); float* HF = (float*)(F.ws + WS_HF); bf16* HB = (bf16*)(F.ws + WS_HB);
    float* TOKW = (float*)(F.ws + WS_TOKW);
    unsigned* recg = (unsigned*)(F.ws + WS_ROWIDX + 131072) + (size_t)gw * 80;
    const float rb = A.in[I_RB][l * 32 + (lane >> 1)];
    int nrec = 0, ecnt = 0;
#pragma unroll 1
    for (int R0 = gw; R0 < MVALID; R0 += 2 * NGW) {
        const int R1 = R0 + NGW; const bool two = R1 < MVALID; const int R1c = two ? R1 : R0;
        f32x4 v0[4], v1[4];
#pragma unroll
        for (int j = 0; j < 4; ++j) { v0[j] = *(const GAS f32x4*)(PRE + (size_t)R0 * 1024 + 256 * j + 4 * lane); v1[j] = *(const GAS f32x4*)(PRE + (size_t)R1c * 1024 + 256 * j + 4 * lane); }
        ln16(v0, A.in[I_LN1G] + l * 1024, A.in[I_LN1B] + l * 1024, lane); ln16(v1, A.in[I_LN1G] + l * 1024, A.in[I_LN1B] + l * 1024, lane);
        store_row_f32_bf16(v0, HF + (size_t)R0 * 1024, HB + (size_t)R0 * 1024, lane);
        if (two) store_row_f32_bf16(v1, HF + (size_t)R1 * 1024, HB + (size_t)R1 * 1024, lane);
        float acc0[32], acc1[32];
#pragma unroll
        for (int e = 0; e < 32; ++e) { float s0 = 0.f, s1 = 0.f;
#pragma unroll
            for (int j = 0; j < 4; ++j) { const f32x4 w = *(const LAS f32x4*)(WT + e * 1024 + 256 * j + 4 * lane);
                s0 += (v0[j].x * w.x + v0[j].y * w.y) + (v0[j].z * w.z + v0[j].w * w.w); s1 += (v1[j].x * w.x + v1[j].y * w.y) + (v1[j].z * w.z + v1[j].w * w.w); }
            acc0[e] = s0; acc1[e] = s1; }
        const float val0 = router_reduce(acc0, lane) + rb, val1 = router_reduce(acc1, lane) + rb;
        router_top4(val0, R0, lane, TOKW, recg, nrec, ecnt); ++nrec;
        if (two) { router_top4(val1, R1, lane, TOKW, recg, nrec, ecnt); ++nrec; }
        asm volatile("" ::: "memory");
    }
    if (lane == 0) ((int*)(F.ws + WS_ROWIDX + 65536))[gw] = nrec * 4;
    if (lane < 32) ((int*)(F.ws + WS_ROWIDX + 1048576))[(size_t)gw * 32 + lane] = ecnt;
}
__device__ __forceinline__ void moe_tables(Frame& F, int l, bool with_bases = false) {
    LAS int* tb = (LAS int*)(F.lds + LDSCTL_OFF); LAS int* cn = tb + 34;
    LAS int* part = (LAS int*)(F.lds + RING_OFF);
    LAS int* wb = part + 1024;
    const int* WCNT = (const int*)(F.ws + WS_ROWIDX + 1048576);
    const int NGW = F.G * NWAVES, gw0 = F.vcu * NWAVES;
    __syncthreads();
    { const int e = F.tid & 31, pt = F.tid >> 5; int tot = 0, base = 0; const int per = NGW / 16;
      for (int w = pt * per; w < (pt + 1) * per; ++w) { const int c = WCNT[(size_t)w * 32 + e]; tot += c; if (w < gw0) base += c; }
      part[pt * 32 + e] = tot; part[512 + pt * 32 + e] = base; }
    __syncthreads();
    if (F.tid < 32) { int tot = 0, base = 0;
#pragma unroll
        for (int pt = 0; pt < 16; ++pt) { tot += part[pt * 32 + F.tid]; base += part[512 + pt * 32 + F.tid]; }
        cn[F.tid] = tot;
        if (with_bases) { for (int w = 0; w < NWAVES; ++w) { wb[w * 32 + F.tid] = base; base += WCNT[(size_t)(gw0 + w) * 32 + F.tid]; } } }
    __syncthreads();
    if (F.tid == 0) { int s = 0; for (int e = 0; e < 32; ++e) { tb[e] = s; s += (cn[e] + 255) >> 8; } tb[32] = s; }
    __syncthreads();
}
__device__ __forceinline__ void moe_gather(Frame& F) {
    const LAS int* tb = (const LAS int*)(F.lds + LDSCTL_OFF); const LAS int* wb = (const LAS int*)(F.lds + RING_OFF) + 1024 + F.wave * 32;
    const int gw = F.vcu * NWAVES + F.wave, lane = F.lane;
    const bf16* HB = (const bf16*)(F.ws + WS_HB); bf16* XG = (bf16*)(F.ws + WS_XG); unsigned* TOKE = (unsigned*)(F.ws + WS_TOKE);
    const unsigned* recg = (const unsigned*)(F.ws + WS_ROWIDX + 131072) + (size_t)gw * 80; const int n = ((const int*)(F.ws + WS_ROWIDX + 65536))[gw];
    const int my_e = lane < n ? (int)recg[lane * 2 + 1] : -1, my_R = lane < n ? (int)recg[lane * 2] : 0;
    int before = 0; for (int j = 0; j < n; ++j) { const int ej = __builtin_amdgcn_readlane(my_e, j); before += (j < lane && ej == my_e) ? 1 : 0; }
    const int my_pos = lane < n ? wb[my_e] + before : 0;
    if (lane < n) TOKE[(size_t)my_R * 4 + (lane & 3)] = (unsigned)my_e | ((unsigned)my_pos << 8);
    for (int i = 0; i < n; ++i) { const int e = __builtin_amdgcn_readlane(my_e, i), R = __builtin_amdgcn_readlane(my_R, i), pos = __builtin_amdgcn_readlane(my_pos, i);
        const size_t crow = (size_t)tb[e] * 256 + pos; const GAS v4u* sp = (const GAS v4u*)(HB + (size_t)R * 1024); GAS v4u* dp = (GAS v4u*)(XG + crow * 1024);
        const v4u a = sp[lane], b = sp[64 + lane]; dp[lane] = a; dp[64 + lane] = b; }
}
__device__ __forceinline__ void ln2_rows(Frame& F, const Args& A, int l) {
    const LAS int* tb = (const LAS int*)(F.lds + LDSCTL_OFF);
    const int gw = F.vcu * NWAVES + F.wave, NGW = F.G * NWAVES, lane = F.lane;
    float* HF = (float*)(F.ws + WS_HF); bf16* HB = (bf16*)(F.ws + WS_HB); const bf16* OUTS = (const bf16*)(F.ws + WS_OUTS);
    const float* TOKW = (const float*)(F.ws + WS_TOKW); const unsigned* TOKE = (const unsigned*)(F.ws + WS_TOKE);
    for (int R0 = gw; R0 < MVALID; R0 += 2 * NGW) {
        const int R1 = R0 + NGW; const bool two = R1 < MVALID; const int Rr[2] = {R0, two ? R1 : R0};
        f32x4 v[2][4]; unsigned long long o[2][4][4]; float w[2][4];
#pragma unroll
        for (int q = 0; q < 2; ++q) {
            const v4u te4 = *(const GAS v4u*)(TOKE + (size_t)Rr[q] * 4); const f32x4 w4 = *(const GAS f32x4*)(TOKW + (size_t)Rr[q] * 4);
            const unsigned te[4] = {te4.x, te4.y, te4.z, te4.w}; w[q][0] = w4.x; w[q][1] = w4.y; w[q][2] = w4.z; w[q][3] = w4.w;
#pragma unroll
            for (int j = 0; j < 4; ++j) v[q][j] = *(const GAS f32x4*)(HF + (size_t)Rr[q] * 1024 + 256 * j + 4 * lane);
#pragma unroll
            for (int k = 0; k < 4; ++k) { const size_t crow = (size_t)tb[te[k] & 255] * 256 + (te[k] >> 8);
#pragma unroll
                for (int j = 0; j < 4; ++j) o[q][k][j] = *(const GAS unsigned long long*)(OUTS + crow * 1024 + 256 * j + 4 * lane); } }
#pragma unroll
        for (int q = 0; q < 2; ++q) {
#pragma unroll
            for (int j = 0; j < 4; ++j) v[q][j] = v[q][j] * ALPHA;
#pragma unroll
            for (int k = 0; k < 4; ++k)
#pragma unroll
                for (int j = 0; j < 4; ++j) { const unsigned lo = (unsigned)o[q][k][j], hi = (unsigned)(o[q][k][j] >> 32); const float ww = w[q][k];
                    v[q][j].x += ww * bflo(lo); v[q][j].y += ww * bfhi(lo); v[q][j].z += ww * bflo(hi); v[q][j].w += ww * bfhi(hi); }
            ln16(v[q], A.in[I_LN2G] + l * 1024, A.in[I_LN2B] + l * 1024, lane);
#if defined(SELFCHK)
            if (l == NLAYER - 1) { const unsigned mask = __hip_atomic_load(F.ctl + 2048, RLX_AGENT); if (mask) { const float pv = (float)(1u << (__ffs((int)mask) - 1));
#pragma unroll
                for (int j = 0; j < 4; ++j) v[q][j] = (f32x4){pv, pv, pv, pv}; } }
#endif
            if (q == 0 || two) { const int R = Rr[q];
                if (l == NLAYER - 1) { if (R < MREAL) {
#pragma unroll
                        for (int j = 0; j < 4; ++j) *(GAS f32x4*)(A.out + (size_t)R * 1024 + 256 * j + 4 * lane) = v[q][j]; } }
                else store_row_f32_bf16(v[q], HF + (size_t)R * 1024, HB + (size_t)R * 1024, lane); }
        }
    }
}

typedef float f32x16 __attribute__((ext_vector_type(16)));
__device__ __forceinline__ f32x16 skinny32(const bf16* A, int lda, const bf16* Bt, int ldb, int K, int cb, int lane, f32x16 acc) {
    const int r32 = lane & 31, hi = lane >> 5;
    const GAS bf16x8* ap = (const GAS bf16x8*)(A + (size_t)r32 * lda + hi * 8);
    const GAS bf16x8* bp = (const GAS bf16x8*)(Bt + (size_t)(cb * 32 + r32) * ldb + hi * 8);
    for (int k0 = 0; k0 < K / 16; k0 += 8) { bf16x8 a[8], b[8];
#pragma unroll
        for (int i = 0; i < 8; ++i) { a[i] = ap[(k0 + i) * 2]; b[i] = bp[(k0 + i) * 2]; }
#pragma unroll
        for (int i = 0; i < 8; ++i) acc = __builtin_amdgcn_mfma_f32_32x32x16_bf16(a[i], b[i], acc, 0, 0, 0); }
    return acc;
}
__device__ __forceinline__ int mrow(int r, int hi) { return (r & 3) + 8 * (r >> 2) + 4 * hi; }
__device__ __forceinline__ void st_bf(bf16* p, float v) { *(GAS bf16*)p = (bf16)f2bf(v); }
__device__ __forceinline__ void skinny_p1(Frame& F, const Args& A, int l, int cb) {
    const int lane = F.lane, c = cb * 32 + (lane & 31), hi = lane >> 5;
    const bf16* HBm = (const bf16*)(F.ws + WS_HB) + (size_t)MREAL * 1024; const bf16* W = (const bf16*)(F.ws + WS_W + (size_t)l * WL_STRIDE + WL_IN);
    f32x16 acc = {}; acc = skinny32(HBm, 1024, W, 1024, 1024, cb, lane, acc);
    if (c < 512) { bf16* UM = (bf16*)(F.ws + WS_UMETA);
#pragma unroll
        for (int r = 0; r < 16; ++r) st_bf(UM + (size_t)mrow(r, hi) * 512 + c, acc[r]); }
    else if (c < 2048) { bf16* CB = (bf16*)(F.ws + WS_CONV);
#pragma unroll
        for (int r = 0; r < 16; ++r) st_bf(CB + (size_t)(MREAL + mrow(r, hi)) * 1536 + (c - 512), acc[r]); }
    else if (c < 4096) { const bool isq = c < 3072; const int cc = c - (isq ? 2048 : 3072), hh = cc >> 6, g = (cc & 63) >> 3, i8 = cc & 7, j = 4 * g + (i8 & 3), d = i8 < 4 ? j : 32 + j;
        const float* rope = (const float*)(F.ws + WS_ROPE); bf16* dst = isq ? (bf16*)(F.ws + WS_Q) : (bf16*)(F.ws + WS_K);
#pragma unroll
        for (int r = 0; r < 16; ++r) { const int m = mrow(r, hi), pos = m & 15; const float v = acc[r], pv = __shfl_xor(v, 4); const float cs = rope[(size_t)pos * 64 + j], sn = rope[(size_t)pos * 64 + 32 + j];
            float o = i8 < 4 ? v * cs - pv * sn : v * cs + pv * sn; if (isq) o *= pg8::QSCALE;
            const size_t drow = isq ? (size_t)(MREAL + m) : (size_t)pg8::kv_row(MREAL + m); st_bf(dst + drow * 1024 + hh * 64 + d, o); } }
    else if (c < 5120) { bf16* V = (bf16*)(F.ws + WS_V);
#pragma unroll
        for (int r = 0; r < 16; ++r) st_bf(V + (size_t)pg8::kv_row(MREAL + mrow(r, hi)) * 1024 + (c - 4096), acc[r]); }
    else { bf16* GB = (bf16*)(F.ws + WS_GB); const float gb = A.in[I_GATEB][(size_t)l * 3072 + (c - 5120)];
#pragma unroll
        for (int r = 0; r < 16; ++r) st_bf(GB + (size_t)(MREAL + mrow(r, hi)) * 3072 + (c - 5120), sigm_(acc[r] + gb)); }
}
__device__ __forceinline__ void skinny_glu(Frame& F, int l, int cb) {
    const int lane = F.lane, c = cb * 32 + (lane & 31), hi = lane >> 5;
    const bf16* YG = (const bf16*)(F.ws + WS_YG); bf16* YS = (bf16*)(F.ws + WS_YS);
    f32x16 acc = {}; acc = skinny32(YG + (size_t)MREAL * 512, 512, (const bf16*)(F.ws + WS_W + (size_t)l * WL_STRIDE + WL_GLU), 512, 512, cb, lane, acc);
#pragma unroll
    for (int r = 0; r < 16; ++r) { const size_t R = MREAL + mrow(r, hi); const float y = __uint_as_float((unsigned)(*(const GAS bf16*)(YG + R * 512 + c)) << 16); st_bf(YS + R * 512 + c, y * sigm_(acc[r])); }
}
__device__ __forceinline__ void skinny_merge(Frame& F, int l, int cb) {
    const int lane = F.lane, c = cb * 32 + (lane & 31), hi = lane >> 5; unsigned char* wl = F.ws + WS_W + (size_t)l * WL_STRIDE;
    const bf16* GB = (const bf16*)(F.ws + WS_GB); bf16* MG = (bf16*)(F.ws + WS_MG);
    f32x16 z = {};
    const f32x16 a0 = skinny32((const bf16*)(F.ws + WS_YS) + (size_t)MREAL * 512, 512, (const bf16*)(wl + WL_SO), 512, 512, cb, lane, z);
    const f32x16 a1 = skinny32((const bf16*)(F.ws + WS_YC) + (size_t)MREAL * 512, 512, (const bf16*)(wl + WL_CO), 512, 512, cb, lane, z);
    const f32x16 a2 = skinny32((const bf16*)(F.ws + WS_YA) + (size_t)MREAL * 1024, 1024, (const bf16*)(wl + WL_AO), 1024, 1024, cb, lane, z);
#pragma unroll
    for (int r = 0; r < 16; ++r) { const size_t R = MREAL + mrow(r, hi); const bf16* g = GB + R * 3072 + c;
        const float g0 = __uint_as_float((unsigned)(*(const GAS bf16*)g) << 16), g1 = __uint_as_float((unsigned)(*(const GAS bf16*)(g + 1024)) << 16), g2 = __uint_as_float((unsigned)(*(const GAS bf16*)(g + 2048)) << 16);
        st_bf(MG + R * 1024 + c, g0 * a0[r] + g1 * a1[r] + g2 * a2[r]); }
}
__device__ __forceinline__ void skinny_pre(Frame& F, int l, int cb) {
    const int lane = F.lane, c = cb * 32 + (lane & 31), hi = lane >> 5;
    const float* HF = (const float*)(F.ws + WS_HF); float* PRE = (float*)(F.ws + WS_PRE);
    f32x16 acc = {}; acc = skinny32((const bf16*)(F.ws + WS_MG) + (size_t)MREAL * 1024, 1024, (const bf16*)(F.ws + WS_W + (size_t)l * WL_STRIDE + WL_WO), 1024, 1024, cb, lane, acc);
#pragma unroll
    for (int r = 0; r < 16; ++r) { const size_t R = MREAL + mrow(r, hi); *(GAS float*)(PRE + R * 1024 + c) = ALPHA * *(const GAS float*)(HF + R * 1024 + c) + acc[r]; }
}
#define SKINNY_JOBS(n, call) do { for (int j_ = F.vcu + F.G * F.wave; j_ < (n); j_ += F.G * NWAVES) { const int cb = j_; call; } } while (0)

#if defined(SELFCHK)
constexpr int CW_FAIL = 2048;
__device__ __forceinline__ void chk_report(Frame& F, int id, float got, float ref, float scale) {
    const float err = fabsf(got - ref);
    if (!(err <= 0.03f * fabsf(ref) + 0.03f * scale)) __hip_atomic_fetch_or(F.ctl + CW_FAIL, 1u << (id + F.chk_l * 16), RLX_AGENT);
}
__device__ __forceinline__ float bfr(float x) { return __uint_as_float(f2bf(x) << 16); }
__device__ __forceinline__ float ldbf(const bf16* p) { return __uint_as_float((unsigned)(*(const GAS bf16*)p) << 16); }
__device__ __forceinline__ float dot_bf_w(const bf16* a, const float* W, int K, int ldw, int col, int lane) {
    float s = 0.f; for (int k = lane; k < K; k += 64) s += ldbf(a + k) * bfr(W[(size_t)k * ldw + col]); return wave_sum(s);
}
__constant__ int SMP_ROWS[16] = {0, 1, 2, 63, 64, 100, 255, 256, 8191, 8192, 8193, 12345, 16383, 16384, 16399, 16415};
__constant__ int SMP_SP[12] = {0, 15, 16, 17, 79, 80, 81, 143, 144, 1000, 4111, 8207};
__device__ __forceinline__ int smp_row(int i) { return SMP_ROWS[i]; }
__device__ __forceinline__ void chk_p1(Frame& F, const Args& A, int l) {
    const int gw = F.vcu * NWAVES + F.wave, NGW = F.G * NWAVES, lane = F.lane;
    const bf16* HB = (const bf16*)(F.ws + WS_HB); const float* Win = A.in[I_WIN] + (size_t)l * 1024 * 5120; const float* Wg = A.in[I_GATEW] + (size_t)l * 1024 * 3072;
    const float* ROPE = (const float*)(F.ws + WS_ROPE);
    for (int job = gw; job < 16 * 24; job += NGW) { const int R = smp_row(job / 24), ci = job % 24; const bf16* a = HB + (size_t)R * 1024;
        if (ci < 4) { const int c = (ci * 171 + 5) & 511; const float ref = dot_bf_w(a, Win, 1024, 5120, c, lane); float got;
            if (R < MREAL) { const int g = c >> 4, chunkrow = (R >> 13) * 128 + ((R & 8191) >> 6), s = R & 63; got = ldbf((const bf16*)(F.ws + WS_UC) + ((size_t)(g * 256 + chunkrow) * 1152 + s * 16 + (c & 15))); }
            else got = ldbf((const bf16*)(F.ws + WS_UMETA) + (size_t)(R - MREAL) * 512 + c);
            if (lane == 0) chk_report(F, 1, got, ref, 1.0f); }
        else if (ci < 8) { const int c = ((ci - 4) * 397 + 11) % 1536; const float ref = dot_bf_w(a, Win, 1024, 5120, 512 + c, lane); const float got = ldbf((const bf16*)(F.ws + WS_CONV) + (size_t)R * 1536 + c);
            if (lane == 0) chk_report(F, 1, got, ref, 1.0f); }
        else if (ci < 16) { const bool isq = ci < 12; const int cc = ((ci & 3) * 277 + 33) & 1023, hh = cc >> 6, d = cc & 63, j = d & 31;
            const int base = (isq ? 2048 : 3072) + hh * 64; const float xl = dot_bf_w(a, Win, 1024, 5120, base + j, lane), xh = dot_bf_w(a, Win, 1024, 5120, base + 32 + j, lane);
            const int pos = R < MREAL ? 16 + (R & 8191) : ((R - MREAL) & 15); const float cs = ROPE[(size_t)pos * 64 + j], sn = ROPE[(size_t)pos * 64 + 32 + j];
            float ref = d < 32 ? xl * cs - xh * sn : xh * cs + xl * sn; if (isq) ref *= pg8::QSCALE;
            const float got = isq ? ldbf((const bf16*)(F.ws + WS_Q) + (size_t)R * 1024 + cc) : ldbf((const bf16*)(F.ws + WS_K) + (size_t)pg8::kv_row(R) * 1024 + cc);
            if (lane == 0) chk_report(F, 2, got, ref, isq ? 0.2f : 1.0f); }
        else if (ci < 20) { const int c = ((ci - 16) * 301 + 7) & 1023; const float ref = dot_bf_w(a, Win, 1024, 5120, 4096 + c, lane); const float got = ldbf((const bf16*)(F.ws + WS_V) + (size_t)pg8::kv_row(R) * 1024 + c);
            if (lane == 0) chk_report(F, 3, got, ref, 0.5f); }
        else { const int c = ((ci - 20) * 811 + 3) % 3072; const float ref = sigm_(dot_bf_w(a, Wg, 1024, 3072, c, lane) + A.in[I_GATEB][(size_t)l * 3072 + c]); const float got = ldbf((const bf16*)(F.ws + WS_GB) + (size_t)R * 3072 + c);
            if (lane == 0) chk_report(F, 3, got, ref, 0.3f); }
    }
}
__device__ __forceinline__ float u_at(Frame& F, int b, int sp, int c) {
    if (sp < 16) return ldbf((const bf16*)(F.ws + WS_UMETA) + (size_t)(b * 16 + sp) * 512 + c);
    const int t = sp - 16; return ldbf((const bf16*)(F.ws + WS_UC) + ((size_t)((c >> 4) * 256 + b * 128 + (t >> 6)) * 1152 + (t & 63) * 16 + (c & 15)));
}
__device__ __forceinline__ int seq_row(int b, int sp) { return sp < 16 ? MREAL + b * 16 + sp : b * 8192 + (sp - 16); }
__device__ __forceinline__ void chk_ssm_conv(Frame& F, const Args& A, int l) {
    const int gw = F.vcu * NWAVES + F.wave, NGW = F.G * NWAVES, lane = F.lane;
    LAS float* scr = (LAS float*)(F.lds + RING_OFF + F.wave * 16384);
#pragma unroll 1
    for (int job = gw; job < 2 * 12 * 3; job += NGW) { const int b = job / 36, si = (job / 3) % 12, gi = job % 3; const int g = gi == 0 ? 0 : gi == 1 ? 13 : 31;
        const int sp = SMP_SP[si];
        const int lg = l * 32 + g, p = lane; const float lr = A.in[I_LAMRE][lg * 64 + p], li = A.in[I_LAMIM][lg * 64 + p], dt = expf(A.in[I_LOGDT][lg]);
        const float mag = __expf(lr * dt), ar = mag * __cosf(li * dt), ai = mag * __sinf(li * dt), nr = ar - 1.0f, den = lr * lr + li * li;
        const float cr = (nr * lr + ai * li) / den, ci = (ai * lr - nr * li) / den;
        float bbr[16], bbi[16];
#pragma unroll
        for (int c = 0; c < 16; ++c) { const float br = A.in[I_BRE][(size_t)(lg * 64 + p) * 16 + c], bi = A.in[I_BIM][(size_t)(lg * 64 + p) * 16 + c]; bbr[c] = cr * br - ci * bi; bbi[c] = cr * bi + ci * br; }
        float xr = 0.f, xi = 0.f;
#pragma unroll 1
        for (int s = 0; s <= sp; ++s) { float bur = 0.f, bui = 0.f, ua[8], ub[8];
            const bf16* up = s < 16 ? (const bf16*)(F.ws + WS_UMETA) + (size_t)(b * 16 + s) * 512 + g * 16 : (const bf16*)(F.ws + WS_UC) + ((size_t)(g * 256 + b * 128 + ((s - 16) >> 6)) * 1152 + ((s - 16) & 63) * 16);
            unpk8(*(const GAS v4u*)up, ua); unpk8(*(const GAS v4u*)(up + 8), ub);
#pragma unroll
            for (int c = 0; c < 8; ++c) { bur += bbr[c] * ua[c] + bbr[8 + c] * ub[c]; bui += bbi[c] * ua[c] + bbi[8 + c] * ub[c]; }
            const float n1 = ar * xr - ai * xi + bur, n2 = ar * xi + ai * xr + bui; xr = n1; xi = n2; }
        scr[lane] = xr; scr[64 + lane] = xi; LDS_WAIT(); asm volatile("" ::: "memory");
        if (lane < 16) { const int co = lane; float y = 0.f;
#pragma unroll 1
            for (int q = 0; q < 64; ++q) y += A.in[I_CRE][(size_t)(lg * 16 + co) * 64 + q] * scr[q] - A.in[I_CIM][(size_t)(lg * 16 + co) * 64 + q] * scr[64 + q];
            y += A.in[I_SSMD][l * 512 + g * 16 + co] * u_at(F, b, sp, g * 16 + co);
            const float ref = gelu_(y), got = ldbf((const bf16*)(F.ws + WS_YG) + (size_t)seq_row(b, sp) * 512 + g * 16 + co);
            chk_report(F, sp < 16 ? 4 : 5, got, ref, 0.3f); }
        LDS_WAIT(); asm volatile("" ::: "memory");
    }
    for (int job = gw; job < 16; job += NGW) { const int R = smp_row(job), c = (lane * 37 + 5) & 511; const bf16* CB = (const bf16*)(F.ws + WS_CONV);
        float y = 0.f;
#pragma unroll 1
        for (int k = 0; k < 3; ++k) { const int r = k == 0 ? R : prev_row(R, k); if (r >= 0) y += A.in[I_CONVW][(size_t)l * 1536 + (2 - k) * 512 + c] * ldbf(CB + (size_t)r * 1536 + 512 + c) * ldbf(CB + (size_t)r * 1536 + 1024 + c); }
        const float ref = y * ldbf(CB + (size_t)R * 1536 + c), got = ldbf((const bf16*)(F.ws + WS_YC) + (size_t)R * 512 + c);
        chk_report(F, 6, got, ref, 0.5f); }
}
__device__ __forceinline__ void chk_attn(Frame& F) {
    const int gw = F.vcu * NWAVES + F.wave, NGW = F.G * NWAVES, lane = F.lane;
    const bf16* Q = (const bf16*)(F.ws + WS_Q); const bf16* K = (const bf16*)(F.ws + WS_K); const bf16* V = (const bf16*)(F.ws + WS_V); const bf16* OC = (const bf16*)(F.ws + WS_OC);
    for (int job = gw; job < 16 * 3; job += NGW) { const int R = smp_row(job / 3), hi_ = job % 3, hc = hi_ == 0 ? 0 : hi_ == 1 ? 5 : 15, h = hc >> 1;
        const int b = R < MREAL ? (R >> 13) : ((R - MREAL) >> 4); const int nreal = R < MREAL ? (((R & 8191) >> 6) + 1) * 64 : 0, nk = 16 + nreal;
        const float q = ldbf(Q + (size_t)R * 1024 + hc * 64 + lane);
        float m = -INFINITY;
        for (int j = 0; j < nk; ++j) { const size_t kr = (size_t)b * 8320 + (j < 16 ? 8256 + j : j - 16); const float s = wave_sum(q * ldbf(K + kr * 1024 + hc * 64 + lane)); m = fmaxf(m, s); }
        float lsum = 0.f, o0 = 0.f, o1 = 0.f;
        for (int j = 0; j < nk; ++j) { const size_t kr = (size_t)b * 8320 + (j < 16 ? 8256 + j : j - 16); const float s = wave_sum(q * ldbf(K + kr * 1024 + hc * 64 + lane)); const float p = exp2f(s - m);
            lsum += p; o0 += p * ldbf(V + kr * 1024 + h * 128 + 2 * lane); o1 += p * ldbf(V + kr * 1024 + h * 128 + 2 * lane + 1); }
        const float g0 = ldbf(OC + (size_t)R * 2048 + hc * 128 + 2 * lane), g1 = ldbf(OC + (size_t)R * 2048 + hc * 128 + 2 * lane + 1);
        chk_report(F, R < MREAL ? 7 : 8, g0, o0 / lsum, 0.05f); chk_report(F, R < MREAL ? 7 : 8, g1, o1 / lsum, 0.05f); }
}
__device__ __forceinline__ void chk_mix(Frame& F, const Args& A, int l) {
    const int gw = F.vcu * NWAVES + F.wave, NGW = F.G * NWAVES, lane = F.lane;
    const bf16* YG = (const bf16*)(F.ws + WS_YG); const bf16* YS = (const bf16*)(F.ws + WS_YS); const bf16* YC = (const bf16*)(F.ws + WS_YC); const bf16* YA = (const bf16*)(F.ws + WS_YA);
    const bf16* GB = (const bf16*)(F.ws + WS_GB); const bf16* MG = (const bf16*)(F.ws + WS_MG); const bf16* OC = (const bf16*)(F.ws + WS_OC);
    for (int job = gw; job < 16 * 4; job += NGW) { const int R = smp_row(job >> 2), ci = job & 3;
        { const int c = (ci * 139 + 21) & 511; const float z = dot_bf_w(YG + (size_t)R * 512, A.in[I_WGLU] + (size_t)l * 512 * 512, 512, 512, c, lane); const float ref = ldbf(YG + (size_t)R * 512 + c) * sigm_(z);
          if (lane == 0) chk_report(F, 9, ldbf(YS + (size_t)R * 512 + c), ref, 0.2f); }
        { const int h = (ci * 3 + 1) & 7; const float lam_init = 0.8f - 0.6f * expf(-0.3f * (float)l);
          const float d1 = wave_sum(A.in[I_LQ1][l * 64 + lane] * A.in[I_LK1][l * 64 + lane]), d2 = wave_sum(A.in[I_LQ2][l * 64 + lane] * A.in[I_LK2][l * 64 + lane]); const float lam = expf(d1) - expf(d2) + lam_init;
          const float a0 = ldbf(OC + (size_t)R * 2048 + (2 * h) * 128 + lane) - lam * ldbf(OC + (size_t)R * 2048 + (2 * h + 1) * 128 + lane), a1 = ldbf(OC + (size_t)R * 2048 + (2 * h) * 128 + 64 + lane) - lam * ldbf(OC + (size_t)R * 2048 + (2 * h + 1) * 128 + 64 + lane);
          const float rs = 1.0f / sqrtf(wave_sum(a0 * a0 + a1 * a1) * (1.0f / 128.0f) + 1e-5f);
          chk_report(F, 10, ldbf(YA + (size_t)R * 1024 + h * 128 + lane), a0 * rs * A.in[I_SUBLN][l * 128 + lane] * (1.0f - lam_init), 0.3f);
          chk_report(F, 10, ldbf(YA + (size_t)R * 1024 + h * 128 + 64 + lane), a1 * rs * A.in[I_SUBLN][l * 128 + 64 + lane] * (1.0f - lam_init), 0.3f); }
        { const int c = (ci * 269 + 77) & 1023;
          const float p0 = dot_bf_w(YS + (size_t)R * 512, A.in[I_SSMWO] + (size_t)l * 512 * 1024, 512, 1024, c, lane), p1 = dot_bf_w(YC + (size_t)R * 512, A.in[I_CONVWO] + (size_t)l * 512 * 1024, 512, 1024, c, lane),
                      p2 = dot_bf_w(YA + (size_t)R * 1024, A.in[I_ATTNWO] + (size_t)l * 1024 * 1024, 1024, 1024, c, lane);
          const float ref = ldbf(GB + (size_t)R * 3072 + c) * p0 + ldbf(GB + (size_t)R * 3072 + 1024 + c) * p1 + ldbf(GB + (size_t)R * 3072 + 2048 + c) * p2;
          if (lane == 0) chk_report(F, 11, ldbf(MG + (size_t)R * 1024 + c), ref, 0.3f);
          const float pr = dot_bf_w(MG + (size_t)R * 1024, A.in[I_WO] + (size_t)l * 1024 * 1024, 1024, 1024, c, lane);
          if (lane == 0) chk_report(F, 12, ((const float*)(F.ws + WS_PRE))[(size_t)R * 1024 + c], ALPHA * ((const float*)(F.ws + WS_HF))[(size_t)R * 1024 + c] + pr, 0.5f); }
    }
}
__device__ __forceinline__ void chk_moe(Frame& F, const Args& A, int l) {
    const LAS int* tb = (const LAS int*)(F.lds + LDSCTL_OFF);
    const int gw = F.vcu * NWAVES + F.wave, NGW = F.G * NWAVES, lane = F.lane;
    const float* HF = (const float*)(F.ws + WS_HF); const bf16* HB = (const bf16*)(F.ws + WS_HB); const unsigned* TOKE = (const unsigned*)(F.ws + WS_TOKE); const float* TOKW = (const float*)(F.ws + WS_TOKW);
    LAS float* scr = (LAS float*)(F.lds + RING_OFF + F.wave * 16384);
    for (int job = gw; job < 16 * 4; job += NGW) { const int R = smp_row(job >> 2), k = job & 3;
        float lg_ = -INFINITY; if (lane < 32) { float s = 0.f; for (int q = 0; q < 1024; ++q) s += HF[(size_t)R * 1024 + q] * A.in[I_RW][(size_t)l * 32768 + q * 32 + lane]; lg_ = s + A.in[I_RB][l * 32 + lane]; }
        float val = lg_, tv[4]; int te[4];
#pragma unroll
        for (int kk = 0; kk < 4; ++kk) { const float m = wave_max(val); const int idx = wave_min_i(val == m ? lane : 99); tv[kk] = m; te[kk] = idx; if (lane == idx) val = -INFINITY; }
        const float den = 1.0f + expf(tv[1] - tv[0]) + expf(tv[2] - tv[0]) + expf(tv[3] - tv[0]);
        const unsigned tk = TOKE[(size_t)R * 4 + k]; const int e = tk & 255, pos = tk >> 8; const float w = TOKW[(size_t)R * 4 + k];
        const int ek = k == 0 ? te[0] : k == 1 ? te[1] : k == 2 ? te[2] : te[3]; const float wk = expf((k == 0 ? tv[0] : k == 1 ? tv[1] : k == 2 ? tv[2] : tv[3]) - tv[0]) / den;
        const float gap = tv[3] - wave_max(val);
        if (lane == 0 && gap > 1e-3f) { chk_report(F, 13, (float)e, (float)ek, 0.0f); chk_report(F, 13, w, wk, 0.01f); }
        if (((const int*)(F.ws + WS_ROWIDX))[(size_t)e * CAP + pos] != R && lane == 0) chk_report(F, 14, 1.0f, 0.0f, 0.0f);
        const float* wgu = A.in[I_WGU] + ((size_t)l * 32 + e) * 1024 * 2048; const float* bgu = A.in[I_BGU] + ((size_t)l * 32 + e) * 2048;
        for (int j = lane; j < 1024; j += 64) { float g = 0.f, u = 0.f; for (int q = 0; q < 1024; ++q) { const float x = ldbf(HB + (size_t)R * 1024 + q); g += x * bfr(wgu[(size_t)q * 2048 + j]); u += x * bfr(wgu[(size_t)q * 2048 + 1024 + j]); }
            g = fminf(g + bgu[j], 7.0f); u = fminf(fmaxf(u + bgu[1024 + j], -7.0f), 7.0f); scr[j] = bfr((u + 1.0f) * g * sigm_(1.702f * g)); }
        LDS_WAIT(); asm volatile("" ::: "memory");
        const float* wd = A.in[I_WDN] + ((size_t)l * 32 + e) * 1024 * 1024; const int c = (lane * 13 + k * 251) & 1023; float o = 0.f;
        for (int q = 0; q < 1024; ++q) o += scr[q] * bfr(wd[(size_t)q * 1024 + c]);
        o += A.in[I_BDN][((size_t)l * 32 + e) * 1024 + c];
        chk_report(F, 15, ldbf((const bf16*)(F.ws + WS_OUTS) + ((size_t)tb[e] * 256 + pos) * 1024 + c), o, 0.1f);
        LDS_WAIT(); asm volatile("" ::: "memory");
    }
}
#endif

#ifndef PHASE_MASK
#define PHASE_MASK 0x1fff
#endif
#define PH_ON(k) (((PHASE_MASK) >> (k)) & 1)
typedef const __attribute__((address_space(4))) Args* KArgs;
#define PHASE_ENV() KArgs kap_ = (KArgs)__builtin_amdgcn_kernarg_segment_ptr(); asm volatile("" : "+s"(kap_)); const Args& args = *(const Args*)kap_; unsigned char* ws = args.ws; F.ws = ws; F.ctl = (gu32*)(ws + WS_CTL); \
    { int t_ = threadIdx.x; asm volatile("" : "+v"(t_)); F.tid = t_; F.lane = t_ & 63; F.wave = __builtin_amdgcn_readfirstlane(t_ >> 6); } \
    int bid = (int)blockIdx.x; asm volatile("" : "+s"(bid)); F.G = gridDim.x; F.vcu = (F.G % 8 == 0) ? (bid % 8) * (F.G / 8) + bid / 8 : bid; \
    const int gw = F.vcu * NWAVES + F.wave, NGW = F.G * NWAVES; (void)gw; (void)NGW; \
    unsigned char* wl = ws + WS_W + (size_t)l * WL_STRIDE; bf16* HB = (bf16*)(ws + WS_HB); float* HF = (float*)(ws + WS_HF); (void)wl; (void)HB; (void)HF
__global__ void __launch_bounds__(NWAVES * 64, 2) mk_fwd(Args args_) {
    extern __shared__ __attribute__((aligned(16))) unsigned char lds[];
    Frame F;
    F.lds = (LAS unsigned char*)lds;
    F.MISC = (volatile LAS unsigned*)(F.lds + MISC_OFF);
    F.tid = threadIdx.x; F.lane = F.tid & 63; F.wave = __builtin_amdgcn_readfirstlane(F.tid >> 6);
    F.G = gridDim.x; { const int bx = blockIdx.x; F.vcu = (F.G % 8 == 0) ? (bx % 8) * (F.G / 8) + bx / 8 : bx; }
    F.ws = args_.ws; F.ctl = (gu32*)(args_.ws + WS_CTL);
    for (int u = F.tid; u < (LDS_BYTES - LDSCTL_OFF) / 4; u += NWAVES * 64) ((LAS unsigned*)(F.lds + LDSCTL_OFF))[u] = 0u;
    __syncthreads();
    XcdBarrier bar; bar.bar = (unsigned*)(F.ctl + CW_BAR); bar.x = 0; bar.st = nullptr;
    if (N_LAUNCHES == 1) bar = xcd_barrier_post((unsigned*)(F.ctl + CW_BAR), F.MISC + 8);
#define GRID_BAR() do { if (N_LAUNCHES != 1) { if (F.tid == 0) __hip_atomic_store(F.ctl + CW_TMO, 0xBADBA0u, RLX_AGENT); } else { xcd_barrier(bar); } } while (0)
    const int lo = args_.ph_lo, hi = args_.ph_hi;
#define IN(k) (lo <= (k) && (k) < hi)
#define BOTH(k) (IN(k) && IN((k) + 1))

    if (PH_ON(0) && IN(0)) { const int l = 0; PHASE_ENV(); p0_prologue(F, args); if (BOTH(0)) GRID_BAR(); }

    for (int l = 0; l < NLAYER; ++l) {
        const int pb = 1 + 12 * l;
        if (PH_ON(1) && IN(pb + 0)) { PHASE_ENV();
            pg8::Gemm g{HB, (const bf16*)(wl + WL_IN), 1024, 1024, 1024}; pg8::StaticOrder S; S.init(MREAL, NP1, F.G, bid);
            pg8::EpiP1 E{(bf16*)(ws + WS_UC), (bf16*)(ws + WS_UMETA), (bf16*)(ws + WS_CONV), (bf16*)(ws + WS_Q), (bf16*)(ws + WS_K), (bf16*)(ws + WS_V), (bf16*)(ws + WS_GB), (const float*)(ws + WS_ROPE), args.in[I_GATEB] + (size_t)l * 3072};
            pg8::gemm_phase<pg8::EpiP1, pg8::StaticOrder, PG8_ALIGN, PG8_SP2>(F.lds + RING_OFF, g, S, E);
            SKINNY_JOBS(256, skinny_p1(F, args, l, cb));
            if (BOTH(pb + 0)) GRID_BAR();
        }
        if (PH_ON(2) && IN(pb + 1)) { PHASE_ENV();
            pg8::Gemm g{(const bf16*)(ws + WS_UC), (const bf16*)(wl + WL_ST), 1152, 1024, 1024}; pg8::FirstN S{32, 1, F.G, bid};
            pg8::EpiSloc E{(float*)(ws + WS_SLOC)};
            pg8::gemm_phase<pg8::EpiSloc, pg8::FirstN, PG8_ALIGN, PG8_SP2>(F.lds + RING_OFF, g, S, E);
            conv_rows(F, args, l);
            for (int job = NGW - 1 - gw; job < 64; job += NGW) ssm_meta_job(F, args, l, job >> 5, job & 31);
            if (BOTH(pb + 1)) GRID_BAR();
        }
        if (PH_ON(3) && IN(pb + 2)) { PHASE_ENV(); ssm_carry(F, l); if (BOTH(pb + 2)) GRID_BAR(); }
        if (PH_ON(4) && IN(pb + 3)) { PHASE_ENV();
            { pg8::Gemm g{(const bf16*)(ws + WS_UC), (const bf16*)(wl + WL_TOE), 1152, 1152, 1152}; pg8::FirstN S{128, 4, F.G, bid};
              pg8::EpiY E{(bf16*)(ws + WS_YG)};
              pg8::gemm_phase<pg8::EpiY, pg8::FirstN, PG8_ALIGN, PG8_SP2>(F.lds + RING_OFF, g, S, E); }
            { const attn_body::AttnTensors AT{(const attn_body::bf16*)(ws + WS_Q), (const attn_body::bf16*)(ws + WS_K), (const attn_body::bf16*)(ws + WS_V), (attn_body::bf16*)(ws + WS_OC)};
              const attn_body::StaticOrder S((int)F.G, bid);
              attn_body::attn_phase<attn_body::StaticOrder>((char*)lds + RING_OFF, AT, S); }
            for (int job = gw; job < 256; job += NGW) attn_meta_job(F, job >> 3, job & 7);
            if (BOTH(pb + 3)) GRID_BAR();
        }
        if (PH_ON(5) && IN(pb + 4)) { PHASE_ENV();
            pg8::Gemm g{(const bf16*)(ws + WS_YG), (const bf16*)(wl + WL_GLU), 512, 512, 512}; pg8::StaticOrder S; S.init(MREAL, 512, F.G, bid);
            pg8::EpiGLU E{(const bf16*)(ws + WS_YG), (bf16*)(ws + WS_YS)};
            pg8::gemm_phase<pg8::EpiGLU, pg8::StaticOrder, PG8_ALIGN, PG8_SP2>(F.lds + RING_OFF, g, S, E);
            SKINNY_JOBS(16, skinny_glu(F, l, cb));
            attn_combine_rows(F, args, l);
            if (BOTH(pb + 4)) GRID_BAR();
        }
        if (PH_ON(6) && IN(pb + 5)) { PHASE_ENV();
            pg8::StaticOrder S; S.init(MREAL, 1024, F.G, bid);
            SKINNY_JOBS(32, skinny_merge(F, l, cb));
            { pg8::Gemm g{(const bf16*)(ws + WS_YS), (const bf16*)(wl + WL_SO), 512, 512, 512}; pg8::EpiMerge<0> E{(const bf16*)(ws + WS_GB), (bf16*)(ws + WS_MG)};
              pg8::gemm_phase<pg8::EpiMerge<0>, pg8::StaticOrder, PG8_ALIGN, PG8_SP2>(F.lds + RING_OFF, g, S, E); }
            { pg8::Gemm g{(const bf16*)(ws + WS_YC), (const bf16*)(wl + WL_CO), 512, 512, 512}; pg8::EpiMerge<1> E{(const bf16*)(ws + WS_GB), (bf16*)(ws + WS_MG)};
              pg8::gemm_phase<pg8::EpiMerge<1>, pg8::StaticOrder, PG8_ALIGN, PG8_SP2>(F.lds + RING_OFF, g, S, E); }
            { pg8::Gemm g{(const bf16*)(ws + WS_YA), (const bf16*)(wl + WL_AO), 1024, 1024, 1024}; pg8::EpiMerge<2> E{(const bf16*)(ws + WS_GB), (bf16*)(ws + WS_MG)};
              pg8::gemm_phase<pg8::EpiMerge<2>, pg8::StaticOrder, PG8_ALIGN, PG8_SP2>(F.lds + RING_OFF, g, S, E); }
            if (BOTH(pb + 5)) GRID_BAR();
        }
        if (PH_ON(7) && IN(pb + 6)) { PHASE_ENV();
            pg8::Gemm g{(const bf16*)(ws + WS_MG), (const bf16*)(wl + WL_WO), 1024, 1024, 1024}; pg8::StaticOrder S; S.init(MREAL, 1024, F.G, bid);
            pg8::EpiPre E{HF, (float*)(ws + WS_PRE), ALPHA};
            pg8::gemm_phase<pg8::EpiPre, pg8::StaticOrder, PG8_ALIGN, PG8_SP2>(F.lds + RING_OFF, g, S, E);
            SKINNY_JOBS(32, skinny_pre(F, l, cb));
            if (BOTH(pb + 6)) GRID_BAR();
        }
        if (PH_ON(8) && IN(pb + 7)) { PHASE_ENV();
            ln1_router(F, args, l); if (BOTH(pb + 7)) GRID_BAR(); }
        if (PH_ON(9) && IN(pb + 8)) { PHASE_ENV(); moe_tables(F, l, true); moe_gather(F); if (BOTH(pb + 8)) GRID_BAR(); }
        if (PH_ON(10) && IN(pb + 9)) { PHASE_ENV();
            moe_tables(F, l);
            pg8::Gemm g{(const bf16*)(ws + WS_XG), (const bf16*)(wl + WL_GU), 1024, 1024, 1024}; pg8::MoeOrder S{(const LAS int*)(F.lds + LDSCTL_OFF), 8, F.G, bid};
            pg8::EpiSwiGLU E{(bf16*)(ws + WS_HID), args.in[I_BGU] + (size_t)l * 32 * 2048};
            pg8::gemm_phase<pg8::EpiSwiGLU, pg8::MoeOrder, PG8_ALIGN, PG8_SP2>(F.lds + RING_OFF, g, S, E);
            if (BOTH(pb + 9)) GRID_BAR();
        }
        if (PH_ON(11) && IN(pb + 10)) { PHASE_ENV();
            moe_tables(F, l);
            pg8::Gemm g{(const bf16*)(ws + WS_HID), (const bf16*)(wl + WL_DN), 1024, 1024, 1024}; pg8::MoeOrder S{(const LAS int*)(F.lds + LDSCTL_OFF), 4, F.G, bid};
            pg8::EpiDown E{(bf16*)(ws + WS_OUTS), args.in[I_BDN] + (size_t)l * 32 * 1024};
            pg8::gemm_phase<pg8::EpiDown, pg8::MoeOrder, PG8_ALIGN, PG8_SP2>(F.lds + RING_OFF, g, S, E);
            if (BOTH(pb + 10)) GRID_BAR();
        }
        if (PH_ON(12) && IN(pb + 11)) { PHASE_ENV(); moe_tables(F, l);
            ln2_rows(F, args, l); if (BOTH(pb + 11)) GRID_BAR(); }
    }
#undef IN
#undef BOTH
}


#if defined(SELFCHK)
__global__ void __launch_bounds__(NWAVES * 64, 2) mk_chk(Args args_) {
    extern __shared__ __attribute__((aligned(16))) unsigned char lds[];
    Frame F;
    F.lds = (LAS unsigned char*)lds; F.MISC = (volatile LAS unsigned*)(F.lds + MISC_OFF);
    F.tid = threadIdx.x; F.lane = F.tid & 63; F.wave = __builtin_amdgcn_readfirstlane(F.tid >> 6);
    F.G = gridDim.x; { const int bx = blockIdx.x; F.vcu = (F.G % 8 == 0) ? (bx % 8) * (F.G / 8) + bx / 8 : bx; }
    F.ws = args_.ws; F.ctl = (gu32*)(args_.ws + WS_CTL);
    KArgs kap_ = (KArgs)__builtin_amdgcn_kernarg_segment_ptr(); const Args& args = *(const Args*)kap_; const int l = args_.li; F.chk_l = l;
    if (args_.pad == 1) { chk_p1(F, args, l); chk_ssm_conv(F, args, l); chk_attn(F); chk_mix(F, args, l); }
    if (args_.pad == 2) { moe_tables(F, l); chk_moe(F, args, l); }
}
#endif
extern "C" void kernel_launch(void* const* d_in, const int* in_sizes, int n_in, void* d_out, int out_size, void* d_ws, size_t ws_size, hipStream_t stream) {
    static int grid = 0;
    if (grid == 0) {
        if (n_in != N_IN || in_sizes[0] != MREAL * 1024 || out_size != MREAL * 1024 || ws_size < WS_END) { fprintf(stderr, "kernel_launch: unexpected shapes (n_in %d, in0 %d, out %d, ws %zu < %zu); nothing launched\n", n_in, n_in > 0 ? in_sizes[0] : -1, out_size, ws_size, (size_t)WS_END); grid = -1; return; }
        int dev = 0, cus = 0, per_cu = 0;
        if (hipGetDevice(&dev) != hipSuccess || hipDeviceGetAttribute(&cus, hipDeviceAttributeMultiprocessorCount, dev) != hipSuccess) { grid = -1; return; }
#if defined(SELFCHK)
        (void)hipFuncSetAttribute((const void*)mk_chk, hipFuncAttributeMaxDynamicSharedMemorySize, LDS_BYTES);
#endif
        if (hipFuncSetAttribute((const void*)mk_fwd, hipFuncAttributeMaxDynamicSharedMemorySize, LDS_BYTES) != hipSuccess) { fprintf(stderr, "kernel_launch: hipFuncSetAttribute failed\n"); grid = -1; return; }
        if (hipOccupancyMaxActiveBlocksPerMultiprocessor(&per_cu, (const void*)mk_fwd, NWAVES * 64, LDS_BYTES) != hipSuccess || per_cu < 1)
            fprintf(stderr, "kernel_launch: note: occupancy query reports %d workgroups per CU\n", per_cu);
        (void)hipGetLastError();
        grid = cus;
        if (grid != 256) fprintf(stderr, "kernel_launch: %d CUs; the unit orders assume 256\n", grid);
    }
    if (grid < 0) return;
    if (hipMemsetAsync((char*)d_ws + WS_CTL, 0, CTL_ZERO_BYTES, stream) != hipSuccess) return;
    Args a{};
    for (int i = 0; i < N_IN; ++i) a.in[i] = (const float*)d_in[i];
    a.out = (float*)d_out; a.ws = (unsigned char*)d_ws;
    for (int li = 0; li < N_LAUNCHES; ++li) {
        a.ph_lo = (N_LAUNCHES == 1) ? 0 : li; a.ph_hi = (N_LAUNCHES == 1) ? NPH : li + 1; a.li = li; a.pad = 0;
        hipLaunchKernelGGL(mk_fwd, dim3(grid), dim3(NWAVES * 64), LDS_BYTES, stream, a);
        if (hipPeekAtLastError() != hipSuccess) { fprintf(stderr, "kernel_launch: launch %d failed\n", li); break; }
#if defined(SELFCHK)
        if (N_LAUNCHES == NPH && (li == 7 || li == 11 || li == 19 || li == 23)) { Args c = a; c.ph_lo = 1000; c.ph_hi = 1000; c.pad = (li == 7 || li == 19) ? 1 : 2; c.li = li > 12 ? 1 : 0; hipLaunchKernelGGL(mk_chk, dim3(grid), dim3(NWAVES * 64), LDS_BYTES, stream, c); }
#endif
    }
}
```

```cpp
#include <hip/hip_runtime.h>
#include <cstdio>
#include <cstdint>
namespace pg8 {
#define PG8_LAS __attribute__((address_space(3)))
typedef unsigned short bf16_t;
typedef short bf16x8 __attribute__((ext_vector_type(8)));
typedef float f32x4 __attribute__((ext_vector_type(4)));
typedef unsigned u32x4 __attribute__((ext_vector_type(4)));
constexpr int BM = 256, BK = 64, HALF = 128, HTB = HALF * BK * 2  , STAGE_BYTES = 8 * HTB, NXCD = 8, WGM = 8;

__host__ __device__ __forceinline__ int lds_byte(int r, int c) { const int st = (r >> 4) * 2 + (c >> 5), rr = r & 15, cc = c & 31, ob = rr * 64 + cc * 2; return st * 1024 + (ob ^ (((ob >> 9) & 1) << 5)); }
__host__ __device__ __forceinline__ void stage_rc(int b, int& R, int& C) { const int st = b / 1024, sb = b % 1024, swz = sb ^ (((sb >> 9) & 1) << 5); R = (st >> 1) * 16 + swz / 64; C = (st & 1) * 32 + (swz % 64) / 2; }
__host__ __device__ __forceinline__ int perm32(int rho) { const int n = rho >> 4, i = rho & 15; return 8 * (i >> 2) + 4 * n + (i & 3); }

struct Unit { int pm, pn; };
struct Gemm { const bf16_t* A; const bf16_t* Bt; int lda, ldb, K; };

struct StaticOrder {
    int nM, nN, nwg, G, c;
    __host__ __device__ void init(int M, int N, int G_, int c_) { nM = M / BM; nN = N / BM; nwg = nM * nN; G = G_; c = c_; }
    __host__ __device__ bool next(int i, Unit& u) const {
        const long L = (long)i * G + c; if (L >= nwg) return false;
        int wgid = (int)L; { const int q = nwg / NXCD, r = nwg % NXCD, xcd = wgid % NXCD, off = wgid / NXCD; wgid = (xcd < r ? xcd * (q + 1) : r * (q + 1) + (xcd - r) * q) + off; }
        const int nig = WGM * nN, gid = wgid / nig, fm = gid * WGM, gsz = (nM - fm) < WGM ? (nM - fm) : WGM;
        u.pm = fm + ((wgid % nig) % gsz); u.pn = (wgid % nig) / gsz; return true;
    }
    __device__ __forceinline__ void a_ready(const Unit&) const {}
    __device__ __forceinline__ void done(const Unit&) const {}
};

typedef float cvt_f2_ __attribute__((ext_vector_type(2))); typedef __bf16 cvt_b2_ __attribute__((ext_vector_type(2)));
__device__ __forceinline__ unsigned cvt_pk_bf16(float lo, float hi) { const cvt_f2_ v = {lo, hi}; const cvt_b2_ b = __builtin_convertvector(v, cvt_b2_); return __builtin_bit_cast(unsigned, b); }
typedef float f32x2 __attribute__((ext_vector_type(2)));
typedef unsigned u32x2 __attribute__((ext_vector_type(2)));
__device__ __forceinline__ u32x4 pack8(f32x4 a, f32x4 b) { u32x4 w; w.x = cvt_pk_bf16(a[0], a[1]); w.y = cvt_pk_bf16(a[2], a[3]); w.z = cvt_pk_bf16(b[0], b[1]); w.w = cvt_pk_bf16(b[2], b[3]); return w; }
__device__ __forceinline__ u32x2 pack4(f32x4 a) { u32x2 w; w.x = cvt_pk_bf16(a[0], a[1]); w.y = cvt_pk_bf16(a[2], a[3]); return w; }
__device__ __forceinline__ float bf_lo(unsigned w) { return __uint_as_float(w << 16); }
__device__ __forceinline__ float bf_hi(unsigned w) { return __uint_as_float(w & 0xffff0000u); }
__device__ __forceinline__ void unpack8(u32x4 w, f32x4& a, f32x4& b) { a = (f32x4){bf_lo(w.x), bf_hi(w.x), bf_lo(w.y), bf_hi(w.y)}; b = (f32x4){bf_lo(w.z), bf_hi(w.z), bf_lo(w.w), bf_hi(w.w)}; }
__device__ __forceinline__ float sigm(float x) { return __builtin_amdgcn_rcpf(1.0f + __builtin_amdgcn_exp2f(-1.4426950408889634f * x)); }
__device__ __forceinline__ f32x4 sigm4(f32x4 v) { return (f32x4){sigm(v[0]), sigm(v[1]), sigm(v[2]), sigm(v[3])}; }
__device__ __forceinline__ float gelu_t(float x) { const float u = 0.7978845608028654f * (x + 0.044715f * x * x * x); return x * sigm(2.0f * u); }
__device__ __forceinline__ f32x4 gelu4(f32x4 v) { return (f32x4){gelu_t(v[0]), gelu_t(v[1]), gelu_t(v[2]), gelu_t(v[3])}; }

constexpr int MREAL = 16384, MVALID = 16416;
constexpr float QSCALE = 0.125f * 1.4426950408889634f;
__device__ __forceinline__ int kv_row(int R) { return R < MREAL ? (R >> 13) * 8320 + (R & 8191) : ((R - MREAL) >> 4) * 8320 + 8256 + ((R - MREAL) & 15); }

#define EPI_ROWS(R) _Pragma("unroll") for (int ai = 0; ai < 2; ++ai) _Pragma("unroll") for (int m = 0; m < 4; ++m) { const int R = rbase + ai * HALF + m * 16;
#define EPI_COLS _Pragma("unroll") for (int bj = 0; bj < 2; ++bj) {
#define EPI_END }

struct EpiP1 {
    static constexpr bool PERM = true, AFTER_DRAIN = false;
    bf16_t *UC, *UMETA, *CONVB, *Q, *K, *V, *GB; const float* rope; const float* gate_b;
    __device__ __forceinline__ void operator()(const f32x4 (&acc)[2][2][4][2], const Unit& u, int wr, int wc, int fr, int fq) const {
        const int pn = u.pn, rbase = u.pm * BM + wr * 64 + fr, cw = wc * 32 + 8 * fq;
        if (pn < 2) {
            EPI_ROWS(R)
                if (R < MREAL) { const int chunkrow = (R >> 13) * 128 + ((R & 8191) >> 6), s = R & 63;
                    EPI_COLS const int c = pn * 256 + bj * HALF + cw; *(u32x4*)(UC + ((size_t)((c >> 4) * 256 + chunkrow) * 1152 + s * 16 + (c & 15))) = pack8(acc[ai][bj][m][0], acc[ai][bj][m][1]); EPI_END }
                else if (R < MVALID) {
                    EPI_COLS const int c = pn * 256 + bj * HALF + cw; *(u32x4*)(UMETA + (size_t)(R - MREAL) * 512 + c) = pack8(acc[ai][bj][m][0], acc[ai][bj][m][1]); EPI_END }
            EPI_END
        } else if (pn < 8) {
            EPI_ROWS(R)
                if (R < MVALID) { EPI_COLS const int c = (pn - 2) * 256 + bj * HALF + cw; *(u32x4*)(CONVB + (size_t)R * 1536 + c) = pack8(acc[ai][bj][m][0], acc[ai][bj][m][1]); EPI_END }
            EPI_END
        } else if (pn < 16) {
            const bool isq = pn < 12; const int ct = (pn - (isq ? 8 : 12)) * 256; bf16_t* dstb = isq ? Q : K; const float sc = isq ? QSCALE : 1.0f;
            EPI_ROWS(R)
                if (R < MVALID) { const int pos = R < MREAL ? 16 + (R & 8191) : ((R - MREAL) & 15); const size_t drow = isq ? (size_t)R : (size_t)kv_row(R);
                    EPI_COLS const int c = ct + bj * HALF + cw, hh = c >> 6, gq = (c & 63) >> 3;
                        const f32x4 cs = *(const f32x4*)(rope + (size_t)pos * 64 + 4 * gq), sn = *(const f32x4*)(rope + (size_t)pos * 64 + 32 + 4 * gq);
                        const f32x4 x0 = acc[ai][bj][m][0], x1 = acc[ai][bj][m][1];
                        const f32x4 lo = (x0 * cs - x1 * sn) * sc, hi = (x1 * cs + x0 * sn) * sc;
                        bf16_t* d = dstb + drow * 1024 + hh * 64 + 4 * gq; *(u32x2*)d = pack4(lo); *(u32x2*)(d + 32) = pack4(hi); EPI_END }
            EPI_END
        } else if (pn < 20) {
            EPI_ROWS(R)
                if (R < MVALID) { const size_t drow = (size_t)kv_row(R);
                    EPI_COLS const int c = (pn - 16) * 256 + bj * HALF + cw; *(u32x4*)(V + drow * 1024 + c) = pack8(acc[ai][bj][m][0], acc[ai][bj][m][1]); EPI_END }
            EPI_END
        } else {
            f32x4 b0[2], b1[2];
#pragma unroll
            for (int bj = 0; bj < 2; ++bj) { const int c = (pn - 20) * 256 + bj * HALF + cw; b0[bj] = *(const f32x4*)(gate_b + c); b1[bj] = *(const f32x4*)(gate_b + c + 4); }
            EPI_ROWS(R)
                if (R < MVALID) { EPI_COLS const int c = (pn - 20) * 256 + bj * HALF + cw;
                    *(u32x4*)(GB + (size_t)R * 3072 + c) = pack8(sigm4(acc[ai][bj][m][0] + b0[bj]), sigm4(acc[ai][bj][m][1] + b1[bj])); EPI_END }
            EPI_END
        }
    }
};
struct EpiSloc {
    static constexpr bool PERM = false, AFTER_DRAIN = false;
    float* SL;
    __device__ __forceinline__ void operator()(const f32x4 (&acc)[2][2][4][2], const Unit& u, int wr, int wc, int fr, int fq) const {
        const int rbase = u.pm * BM + wr * 64 + fr, col0 = wc * 32 + 4 * fq;
        EPI_ROWS(R)
            float* rowp = SL + (size_t)R * 128 + col0;
#pragma unroll
            for (int n = 0; n < 2; ++n) *(f32x4*)(rowp + n * 16) = acc[ai][0][m][n];
        EPI_END
    }
};
struct EpiY {
    static constexpr bool PERM = true, AFTER_DRAIN = false;
    bf16_t* YG;
    __device__ __forceinline__ void operator()(const f32x4 (&acc)[2][2][4][2], const Unit& u, int wr, int wc, int fr, int fq) const {
        const int g = u.pm, nt = u.pn & 3, rbase = wr * 64 + fr, cw = wc * 32 + 8 * fq;
        EPI_ROWS(R)
            const int b = R >> 7, k = R & 127;
            EPI_COLS const int n = nt * 256 + bj * HALF + cw, t = n >> 4, co0 = n & 15; const size_t row = (size_t)b * 8192 + k * 64 + t;
                *(u32x4*)(YG + row * 512 + g * 16 + co0) = pack8(gelu4(acc[ai][bj][m][0]), gelu4(acc[ai][bj][m][1])); EPI_END
        EPI_END
    }
};
struct EpiGLU {
    static constexpr bool PERM = true, AFTER_DRAIN = false;
    const bf16_t* YG; bf16_t* YS;
    __device__ __forceinline__ void operator()(const f32x4 (&acc)[2][2][4][2], const Unit& u, int wr, int wc, int fr, int fq) const {
        const int rbase = u.pm * BM + wr * 64 + fr, cw = wc * 32 + 8 * fq;
        EPI_ROWS(R)
            EPI_COLS const int c = u.pn * 256 + bj * HALF + cw; f32x4 ya, yb; unpack8(*(const u32x4*)(YG + (size_t)R * 512 + c), ya, yb);
                *(u32x4*)(YS + (size_t)R * 512 + c) = pack8(ya * sigm4(acc[ai][bj][m][0]), yb * sigm4(acc[ai][bj][m][1])); EPI_END
        EPI_END
    }
};
template <int I> struct EpiMerge {
    static constexpr bool PERM = true, AFTER_DRAIN = false;
    const bf16_t* GB; bf16_t* MG;
    __device__ __forceinline__ void operator()(const f32x4 (&acc)[2][2][4][2], const Unit& u, int wr, int wc, int fr, int fq) const {
        const int rbase = u.pm * BM + wr * 64 + fr, cw = wc * 32 + 8 * fq;
        EPI_ROWS(R)
            EPI_COLS const int c = u.pn * 256 + bj * HALF + cw; f32x4 ga, gb; unpack8(*(const u32x4*)(GB + (size_t)R * 3072 + I * 1024 + c), ga, gb);
                f32x4 oa = ga * acc[ai][bj][m][0], ob = gb * acc[ai][bj][m][1];
                if (I > 0) { f32x4 pa, pb; unpack8(*(const u32x4*)(MG + (size_t)R * 1024 + c), pa, pb); oa += pa; ob += pb; }
                *(u32x4*)(MG + (size_t)R * 1024 + c) = pack8(oa, ob); EPI_END
        EPI_END
    }
};
struct EpiPre {
    static constexpr bool PERM = false, AFTER_DRAIN = false;
    const float* HF; float* PRE; float alpha;
    __device__ __forceinline__ void operator()(const f32x4 (&acc)[2][2][4][2], const Unit& u, int wr, int wc, int fr, int fq) const {
        const int rbase = u.pm * BM + wr * 64 + fr, col0 = u.pn * BM + wc * 32 + 4 * fq;
        EPI_ROWS(R)
            EPI_COLS
#pragma unroll
                for (int n = 0; n < 2; ++n) { const size_t off = (size_t)R * 1024 + col0 + bj * HALF + n * 16; *(f32x4*)(PRE + off) = *(const f32x4*)(HF + off) * alpha + acc[ai][bj][m][n]; }
            EPI_END
        EPI_END
    }
};
struct EpiSwiGLU {
    static constexpr bool PERM = true, AFTER_DRAIN = false;
    bf16_t* HID; const float* bgu;
    __device__ __forceinline__ void operator()(const f32x4 (&acc)[2][2][4][2], const Unit& u, int wr, int wc, int fr, int fq) const {
        const int e = u.pn >> 3, nt = u.pn & 7, rbase = u.pm * BM + wr * 64 + fr, hw = wc * 16 + 4 * fq;
        f32x4 bg[2], bu[2];
#pragma unroll
        for (int bj = 0; bj < 2; ++bj) { const int hcol = nt * 128 + bj * 64 + hw; bg[bj] = *(const f32x4*)(bgu + (size_t)e * 2048 + hcol); bu[bj] = *(const f32x4*)(bgu + (size_t)e * 2048 + 1024 + hcol); }
        EPI_ROWS(R)
            EPI_COLS const int hcol = nt * 128 + bj * 64 + hw; const f32x4 gt = acc[ai][bj][m][0] + bg[bj], up = acc[ai][bj][m][1] + bu[bj]; f32x4 h;
#pragma unroll
                for (int i = 0; i < 4; ++i) { const float gg = fminf(gt[i], 7.0f), uu = fminf(fmaxf(up[i], -7.0f), 7.0f); h[i] = (uu + 1.0f) * gg * sigm(1.702f * gg); }
                *(u32x2*)(HID + (size_t)R * 1024 + hcol) = pack4(h); EPI_END
        EPI_END
    }
};
struct EpiDown {
    static constexpr bool PERM = true, AFTER_DRAIN = false;
    bf16_t* OUTS; const float* bdn;
    __device__ __forceinline__ void operator()(const f32x4 (&acc)[2][2][4][2], const Unit& u, int wr, int wc, int fr, int fq) const {
        const int e = u.pn >> 2, nt = u.pn & 3, rbase = u.pm * BM + wr * 64 + fr, cw = wc * 32 + 8 * fq;
        f32x4 b0[2], b1[2];
#pragma unroll
        for (int bj = 0; bj < 2; ++bj) { const int c = nt * 256 + bj * HALF + cw; b0[bj] = *(const f32x4*)(bdn + (size_t)e * 1024 + c); b1[bj] = *(const f32x4*)(bdn + (size_t)e * 1024 + c + 4); }
        EPI_ROWS(R)
            EPI_COLS const int c = nt * 256 + bj * HALF + cw; *(u32x4*)(OUTS + (size_t)R * 1024 + c) = pack8(acc[ai][bj][m][0] + b0[bj], acc[ai][bj][m][1] + b1[bj]); EPI_END
        EPI_END
    }
};
struct FirstN {
    int n, div, G, c;
    __device__ __forceinline__ bool next(int i, Unit& u) const { const int L = i * G + c; if (L >= n) return false; u.pm = L / div; u.pn = L; return true; }
    __device__ __forceinline__ void a_ready(const Unit&) const {}
    __device__ __forceinline__ void done(const Unit&) const {}
};
struct MoeOrder {
    const PG8_LAS int* tb; int nN, G, c;
    __device__ __forceinline__ bool next(int i, Unit& u) const {
        const int L = i * G + c, mtg = L / nN; if (mtg >= tb[32]) return false;
        int e = 0; while (tb[e + 1] <= mtg) ++e;
        u.pm = mtg; u.pn = e * nN + (L - mtg * nN); return true; }
    __device__ __forceinline__ void a_ready(const Unit&) const {}
    __device__ __forceinline__ void done(const Unit&) const {}
};
template <class Epi, class Sched, bool ALIGN_EPI = false, bool SP2 = false>
__device__ __forceinline__ void gemm_phase(PG8_LAS unsigned char* lds, const Gemm g, const Sched& S, const Epi& E) {
    int tid_ = threadIdx.x; asm volatile("" : "+v"(tid_));
    const int tid = tid_, wid = __builtin_amdgcn_readfirstlane(tid >> 6), lane = tid & 63, wr = wid >> 2, wc = wid & 3, fr = lane & 15, fq = lane >> 4;
    const int K = g.K, nt = K / BK;
    unsigned voffA[2], voffB[2];
#pragma unroll
    for (int i = 0; i < 2; ++i) { int R, C; stage_rc(tid * 16 + i * 8192, R, C); const int Rb = Epi::PERM ? ((R & ~31) + perm32(R & 31)) : R;
        voffA[i] = (unsigned)(R * g.lda + C) * 2u; voffB[i] = (unsigned)(Rb * g.ldb + C) * 2u; }
    const size_t kstep = (size_t)(BK * 2);
    const size_t hstepA = (size_t)HALF * g.lda * 2, hstepB = (size_t)HALF * g.ldb * 2;
    const size_t tstepA = 2 * hstepA, tstepB = 2 * hstepB;
    const unsigned ldsw = (unsigned)wid * 1024u;
    const int aoff = lds_byte(wr * 64 + fr, fq * 8), boff = lds_byte(wc * 32 + fr, fq * 8);
#define PG8_SA(b, h) (((b) * 2 + (h)) * HTB)
#define PG8_SB(b, h) ((4 + (b) * 2 + (h)) * HTB)
#define PG8_STAGE(bufoff, gbase, voff) do { _Pragma("unroll") for (int _i = 0; _i < 2; ++_i) \
        __builtin_amdgcn_global_load_lds((const unsigned*)((const char*)(gbase) + (voff)[_i]), (PG8_LAS unsigned*)(lds + (bufoff) + ldsw + _i * 8192), 16, 0, 0); } while (0)
#define PG8_LDA(dst, b, h) do { _Pragma("unroll") for (int m = 0; m < 4; ++m) _Pragma("unroll") for (int k = 0; k < 2; ++k) dst[m][k] = *(const PG8_LAS bf16x8*)(lds + PG8_SA(b, h) + aoff + m * 2048 + k * 1024); } while (0)
#define PG8_LDB(dst, b, h) do { _Pragma("unroll") for (int n = 0; n < 2; ++n) _Pragma("unroll") for (int k = 0; k < 2; ++k) dst[n][k] = *(const PG8_LAS bf16x8*)(lds + PG8_SB(b, h) + boff + n * 2048 + k * 1024); } while (0)
#define PG8_MMA(ai, bj, At, Bt) do { __builtin_amdgcn_s_setprio(1); _Pragma("unroll") for (int m = 0; m < 4; ++m) _Pragma("unroll") for (int n = 0; n < 2; ++n) _Pragma("unroll") for (int k = 0; k < 2; ++k) \
        acc[ai][bj][m][n] = __builtin_amdgcn_mfma_f32_16x16x32_bf16(Bt[n][k], At[m][k], acc[ai][bj][m][n], 0, 0, 0); __builtin_amdgcn_s_setprio(0); } while (0)
#define PG8_WAIT_V(n) asm volatile("s_waitcnt vmcnt(" #n ")" ::: "memory")
#define PG8_WAIT_L(n) asm volatile("s_waitcnt lgkmcnt(" #n ")" ::: "memory")
#define PG8_BAR __builtin_amdgcn_s_barrier()
#define PG8_SCHED __builtin_amdgcn_sched_barrier(0)
    Unit cur, nxt; int ui = 0;
    if (!S.next(0, cur)) return;
    f32x4 acc[2][2][4][2];
#pragma unroll
    for (int a = 0; a < 2; ++a)
#pragma unroll
        for (int b = 0; b < 2; ++b)
#pragma unroll
            for (int m = 0; m < 4; ++m)
#pragma unroll
                for (int n = 0; n < 2; ++n) acc[a][b][m][n] = (f32x4){0.f, 0.f, 0.f, 0.f};
    bf16x8 At[4][2], B0[2][2], B1[2][2];
    const char* cA = (const char*)g.A + (size_t)cur.pm * tstepA; const char* cB = (const char*)g.Bt + (size_t)cur.pn * tstepB;
    S.a_ready(cur);
    if constexpr (SP2) {
        PG8_STAGE(PG8_SB(0, 0), cB, voffB); PG8_STAGE(PG8_SB(0, 1), cB + hstepB, voffB); PG8_STAGE(PG8_SA(0, 0), cA, voffA); PG8_STAGE(PG8_SA(0, 1), cA + hstepA, voffA);
        if (wr == 1) PG8_BAR;
        PG8_WAIT_V(2); PG8_BAR;
        PG8_STAGE(PG8_SB(1, 0), cB + kstep, voffB); PG8_STAGE(PG8_SA(1, 0), cA + kstep, voffA); PG8_STAGE(PG8_SB(1, 1), cB + hstepB + kstep, voffB);
        PG8_WAIT_V(6); PG8_BAR;
    } else {
        PG8_STAGE(PG8_SB(0, 0), cB, voffB); PG8_STAGE(PG8_SA(0, 0), cA, voffA); PG8_STAGE(PG8_SB(0, 1), cB + hstepB, voffB); PG8_STAGE(PG8_SA(0, 1), cA + hstepA, voffA);
        if (wr == 1) PG8_BAR;
        PG8_WAIT_V(4); PG8_BAR;
        PG8_STAGE(PG8_SB(1, 0), cB + kstep, voffB); PG8_STAGE(PG8_SA(1, 0), cA + kstep, voffA); PG8_STAGE(PG8_SB(1, 1), cB + hstepB + kstep, voffB);
        PG8_WAIT_V(6); PG8_BAR;
    }
    for (;;) {
        const bool has_next = S.next(ui + 1, nxt);
        const char* nA = has_next ? (const char*)g.A + (size_t)nxt.pm * tstepA : cA; const char* nB = has_next ? (const char*)g.Bt + (size_t)nxt.pn * tstepB : cB;
        for (int t = 0; t < nt; t += 2) {
            const bool last = (t == nt - 2);
            const char* a1 = cA + (size_t)(t + 1) * kstep;
            const char* a2 = last ? nA : cA + (size_t)(t + 2) * kstep; const char* b2 = last ? nB : cB + (size_t)(t + 2) * kstep;
            const char* a3 = a2 + kstep; const char* b3 = b2 + kstep;
            if (last && has_next) S.a_ready(nxt);
            if constexpr (SP2) {
            PG8_LDB(B0, 0, 0); PG8_LDB(B1, 0, 1); PG8_SCHED; PG8_LDA(At, 0, 0); PG8_STAGE(PG8_SA(1, 1), a1 + hstepA, voffA);
            PG8_WAIT_V(8); PG8_WAIT_L(0); PG8_BAR; PG8_MMA(0, 0, At, B0); PG8_MMA(0, 1, At, B1); PG8_BAR; PG8_SCHED;
            PG8_LDA(At, 0, 1); PG8_STAGE(PG8_SB(0, 0), b2, voffB); PG8_STAGE(PG8_SB(0, 1), b2 + hstepB, voffB); PG8_STAGE(PG8_SA(0, 0), a2, voffA);
            PG8_WAIT_V(8); PG8_WAIT_L(0); PG8_BAR; PG8_MMA(1, 0, At, B0); PG8_MMA(1, 1, At, B1); PG8_BAR; PG8_SCHED;
            PG8_LDB(B0, 1, 0); PG8_LDB(B1, 1, 1); PG8_SCHED; PG8_LDA(At, 1, 0); PG8_STAGE(PG8_SA(0, 1), a2 + hstepA, voffA);
            PG8_WAIT_V(8); PG8_WAIT_L(0); PG8_BAR; PG8_MMA(0, 0, At, B0); PG8_MMA(0, 1, At, B1); PG8_BAR; PG8_SCHED;
            PG8_LDA(At, 1, 1); PG8_STAGE(PG8_SB(1, 0), b3, voffB); PG8_STAGE(PG8_SB(1, 1), b3 + hstepB, voffB); PG8_STAGE(PG8_SA(1, 0), a3, voffA);
            PG8_WAIT_V(8); PG8_WAIT_L(0); PG8_BAR; PG8_MMA(1, 0, At, B0); PG8_MMA(1, 1, At, B1); PG8_BAR; PG8_SCHED;
            } else {
            PG8_LDB(B0, 0, 0); PG8_SCHED; PG8_LDA(At, 0, 0); PG8_STAGE(PG8_SA(1, 1), a1 + hstepA, voffA);
            PG8_WAIT_L(8); PG8_BAR; PG8_WAIT_L(0); PG8_MMA(0, 0, At, B0); PG8_BAR; PG8_SCHED;
            PG8_LDB(B1, 0, 1); PG8_STAGE(PG8_SB(0, 0), b2, voffB);
            PG8_BAR; PG8_WAIT_L(0); PG8_MMA(0, 1, At, B1); PG8_BAR;
            PG8_LDA(At, 0, 1); PG8_STAGE(PG8_SA(0, 0), a2, voffA);
            PG8_BAR; PG8_WAIT_L(0); PG8_MMA(1, 0, At, B0); PG8_BAR; PG8_SCHED;
            PG8_STAGE(PG8_SB(0, 1), b2 + hstepB, voffB);
            PG8_WAIT_V(6); PG8_BAR; PG8_MMA(1, 1, At, B1); PG8_BAR;
            PG8_LDB(B0, 1, 0); PG8_SCHED; PG8_LDA(At, 1, 0); PG8_STAGE(PG8_SA(0, 1), a2 + hstepA, voffA);
            PG8_WAIT_L(8); PG8_BAR; PG8_WAIT_L(0); PG8_MMA(0, 0, At, B0); PG8_BAR; PG8_SCHED;
            PG8_LDB(B1, 1, 1); PG8_STAGE(PG8_SB(1, 0), b3, voffB);
            PG8_BAR; PG8_WAIT_L(0); PG8_MMA(0, 1, At, B1); PG8_BAR;
            PG8_LDA(At, 1, 1); PG8_STAGE(PG8_SA(1, 0), a3, voffA);
            PG8_BAR; PG8_WAIT_L(0); PG8_MMA(1, 0, At, B0); PG8_BAR; PG8_SCHED;
            PG8_STAGE(PG8_SB(1, 1), b3 + hstepB, voffB);
            PG8_WAIT_V(6); PG8_BAR; PG8_MMA(1, 1, At, B1); PG8_BAR;
            }
        }
        if constexpr (ALIGN_EPI) { if (wr == 0) PG8_BAR; }
        if constexpr (!Epi::AFTER_DRAIN) { E(acc, cur, wr, wc, fr, fq); S.done(cur); }
        if (!has_next) break;
#pragma unroll
        for (int a = 0; a < 2; ++a)
#pragma unroll
            for (int b = 0; b < 2; ++b)
#pragma unroll
                for (int m = 0; m < 4; ++m)
#pragma unroll
                    for (int n = 0; n < 2; ++n) acc[a][b][m][n] = (f32x4){0.f, 0.f, 0.f, 0.f};
        cur = nxt; cA = nA; cB = nB; ++ui;
        if constexpr (ALIGN_EPI) { if (wr == 1) PG8_BAR; }
    }
    PG8_WAIT_V(0);
    if constexpr (!ALIGN_EPI) { if (wr == 0) PG8_BAR; }
    PG8_BAR;
    if constexpr (Epi::AFTER_DRAIN) { E.fused(acc, cur, wr, wc, fr, fq, lds, wid, lane); S.done(cur); }
#undef PG8_SA
#undef PG8_SB
#undef PG8_STAGE
#undef PG8_LDA
#undef PG8_LDB
#undef PG8_MMA
#undef PG8_WAIT_V
#undef PG8_WAIT_L
#undef PG8_BAR
#undef PG8_SCHED
}
}

#ifndef PG8_SP2
#define PG8_SP2 true
#endif
#ifndef PG8_ALIGN
#define PG8_ALIGN true
#endif
#include <hip/hip_bf16.h>
#include <cmath>
namespace attn_body {
using bf16=__hip_bfloat16;
using bf16x8=__attribute__((ext_vector_type(8)))short;
using s16x4=__attribute__((ext_vector_type(4)))short;
using f32x16=__attribute__((ext_vector_type(16)))float;
using u32x4=__attribute__((ext_vector_type(4)))unsigned;
constexpr int BATCH=2,NHEAD=16,SEQ=8192,D=64,DM=NHEAD*D;
constexpr int NW=8,QBLK=32,QB=QBLK*NW,KVBLK=64,NQB=SEQ/QB;
constexpr int ATTN_PITCH=DM, ATTN_UNIT_ROWS=QB, OPITCH=2048, KVROWS=8320, NVH=32;
__device__ __forceinline__ int crow(int r,int hi){return (r&3)+8*(r>>2)+4*hi;}
#define SBAR() __builtin_amdgcn_sched_barrier(0)
__device__ __forceinline__ void cmask(f32x16&p0,f32x16&p1,int jb,int qrel,int hi){
  const float NEG=-INFINITY;
  if(jb<4){ if(jb>(qrel>>6)){
    #pragma unroll
    for(int r=0;r<16;++r){p0[r]=NEG;p1[r]=NEG;} } }
  else if(jb==4){
    #pragma unroll
    for(int r=0;r<16;++r){p0[r]=NEG;p1[r]=NEG;} }
  else{
    #pragma unroll
    for(int r=0;r<16;++r){ if(r>=8)p0[r]=NEG; p1[r]=NEG; } }
}

constexpr int NSLOT=3, SLOTB=8192;
constexpr int LDS_K=0, LDS_V=NSLOT*SLOTB, LDS_WS=2*NSLOT*SLOTB, LDS_OST=LDS_WS+NW*64*4, LDS_BYTES=LDS_OST+NW*4096;
constexpr float C2=0.125f*1.4426950408889634f;
__device__ __forceinline__ void glds16(const void*gsrc,unsigned lds_dst){unsigned keep;
  asm volatile("s_mov_b32 %0, m0\n\ts_mov_b32 m0, %2\n\ts_nop 0\n\tglobal_load_lds_dwordx4 %1, off\n\ts_mov_b32 m0, %0":"=&s"(keep):"v"(gsrc),"s"(lds_dst):"memory");}
__device__ __forceinline__ float max3f(float a,float b,float c){float r;asm("v_max3_f32 %0, %1, %2, %3":"=v"(r):"v"(a),"v"(b),"v"(c));return r;}
__device__ __forceinline__ float max2f(float a,float b){float r;asm("v_max_f32_e32 %0, %1, %2":"=v"(r):"v"(a),"v"(b));return r;}
__device__ __forceinline__ float fadd_s(float a,float b){float r;asm("v_add_f32_e32 %0, %1, %2":"=v"(r):"v"(a),"v"(b));return r;}
__device__ __forceinline__ float fsub_s(float a,float b){float r;asm("v_sub_f32_e32 %0, %1, %2":"=v"(r):"v"(a),"v"(b));return r;}
typedef float f32x2_t __attribute__((ext_vector_type(2))); typedef __bf16 bf16x2_t __attribute__((ext_vector_type(2)));
__device__ __forceinline__ unsigned cvtpk_s(float lo,float hi){f32x2_t v={lo,hi};bf16x2_t b=__builtin_convertvector(v,bf16x2_t);return __builtin_bit_cast(unsigned,b);}
#define WAIT_BAR(N) asm volatile("s_waitcnt vmcnt(" #N ") lgkmcnt(0)\n\ts_barrier":::"memory")

__device__ __forceinline__ void qkt(f32x16&p0,f32x16&p1,const char*Kslot,const bf16x8*qr,const f32x16&negm,int r32,int hi){
  const char*kb=Kslot+hi*1024+r32*16;
  #pragma unroll
  for(int d0=0;d0<4;++d0){
    const bf16x8 b0=*reinterpret_cast<const bf16x8*>(kb+d0*2048);
    const bf16x8 b1=*reinterpret_cast<const bf16x8*>(kb+d0*2048+512);
    if(d0==0){p0=__builtin_amdgcn_mfma_f32_32x32x16_bf16(b0,qr[0],negm,0,0,0);p1=__builtin_amdgcn_mfma_f32_32x32x16_bf16(b1,qr[0],negm,0,0,0);}
    else{p0=__builtin_amdgcn_mfma_f32_32x32x16_bf16(b0,qr[d0],p0,0,0,0);p1=__builtin_amdgcn_mfma_f32_32x32x16_bf16(b1,qr[d0],p1,0,0,0);}}
}
typedef __attribute__((address_space(3))) const char* lds_cptr;
typedef short v4i16_t __attribute__((ext_vector_type(4)));
__device__ __forceinline__ void kload8(bf16x8*kf,lds_cptr kp){
  kf[0]=*(const __attribute__((address_space(3))) bf16x8*)(kp);      kf[1]=*(const __attribute__((address_space(3))) bf16x8*)(kp+512);
  kf[2]=*(const __attribute__((address_space(3))) bf16x8*)(kp+2048); kf[3]=*(const __attribute__((address_space(3))) bf16x8*)(kp+2560);
  kf[4]=*(const __attribute__((address_space(3))) bf16x8*)(kp+4096); kf[5]=*(const __attribute__((address_space(3))) bf16x8*)(kp+4608);
  kf[6]=*(const __attribute__((address_space(3))) bf16x8*)(kp+6144); kf[7]=*(const __attribute__((address_space(3))) bf16x8*)(kp+6656);
}
__device__ __forceinline__ void kload2(bf16x8*kf,lds_cptr kp,int j){ kf[2*j]=*(const __attribute__((address_space(3))) bf16x8*)(kp+j*2048); kf[2*j+1]=*(const __attribute__((address_space(3))) bf16x8*)(kp+j*2048+512); }
__device__ __forceinline__ s16x4 vtr(lds_cptr p){ return __builtin_bit_cast(s16x4,__builtin_amdgcn_ds_read_tr16_b64_v4i16((__attribute__((address_space(3))) v4i16_t*)p)); }
__device__ __forceinline__ float rowmax(const f32x16&p0,const f32x16&p1){
  float a=max3f(p0[0],p0[1],p1[0]),b=max3f(p0[2],p0[3],p1[1]);a=max3f(a,p1[2],p1[3]);
  #pragma unroll
  for(int r=4;r<16;r+=4){a=max3f(a,p0[r],p0[r+1]);b=max3f(b,p0[r+2],p0[r+3]);a=max3f(a,p1[r],p1[r+1]);b=max3f(b,p1[r+2],p1[r+3]);}
  const float m=max2f(a,b);
  auto rr=__builtin_amdgcn_permlane32_swap(__float_as_uint(m),__float_as_uint(m),false,false);
  return max2f(__uint_as_float(rr[0]),__uint_as_float(rr[1]));
}
__device__ __forceinline__ void pv(f32x16*o,int vb,bf16x8 pa0,bf16x8 pa1,bf16x8 pa2,bf16x8 pa3){
  #pragma unroll
  for(int d0=0;d0<2;++d0){s16x4 lo[4],hi[4];
    #pragma unroll
    for(int ks=0;ks<4;++ks){
      asm volatile("ds_read_b64_tr_b16 %0,%1 offset:%c2":"=&v"(lo[ks]):"v"(vb),"i"(d0*4096+ks*1024):"memory");
      asm volatile("ds_read_b64_tr_b16 %0,%1 offset:%c2":"=&v"(hi[ks]):"v"(vb),"i"(d0*4096+ks*1024+512):"memory");}
    asm volatile("s_waitcnt lgkmcnt(0)":::"memory");SBAR();
    #define PK(k) (bf16x8){lo[k][0],lo[k][1],lo[k][2],lo[k][3],hi[k][0],hi[k][1],hi[k][2],hi[k][3]}
    o[d0]=__builtin_amdgcn_mfma_f32_32x32x16_bf16(pa0,PK(0),o[d0],0,0,0);
    o[d0]=__builtin_amdgcn_mfma_f32_32x32x16_bf16(pa1,PK(1),o[d0],0,0,0);
    o[d0]=__builtin_amdgcn_mfma_f32_32x32x16_bf16(pa2,PK(2),o[d0],0,0,0);
    o[d0]=__builtin_amdgcn_mfma_f32_32x32x16_bf16(pa3,PK(3),o[d0],0,0,0);
    #undef PK
  }
}

#ifndef ATTN_STORE16
#define ATTN_STORE16(p,v) (*(u32x4*)(p)=(v))
#endif
template<int THRL> __device__ __forceinline__ void attn_unit(int b,int vh,int qb,const bf16*Q,const bf16*__restrict__ K,const bf16*__restrict__ V,bf16*O,char*shm){
  int tid_=threadIdx.x; asm volatile("":"+v"(tid_));
  const int tid=tid_,lane=tid&63,r32=lane&31,hi=lane>>5; const int wid=__builtin_amdgcn_readfirstlane(tid>>6);
  const long rowbase=(long)b*SEQ, kvbase=(long)b*KVROWS; const int q0=qb*QB; const int hc=vh>>1;
  const bf16*Qw=Q+(rowbase+q0+wid*QBLK)*DM+hc*D;
  const bf16*Kh=K+kvbase*DM+hc*D,*Vh=V+kvbase*DM+(vh>>2)*128+(vh&1)*64;
  const unsigned lds0=(unsigned)(uintptr_t)shm;
  float*wsf=(float*)(shm+LDS_WS)+wid*64;
  const bf16*ksrc=Kh+(long)lane*DM+wid*8;
  const bf16*vsrc=Vh+(long)(16*(wid&3)+(lane>>2))*DM+(wid>>2)*32+(lane&3)*8;
  const unsigned kdst=lds0+LDS_K+wid*1024, vdst=lds0+LDS_V+wid*1024;
  #define TROW(t) (((t)<NT-2)?(long)(t)*KVBLK:(long)(8192+((t)-(NT-2))*KVBLK))
  #define DMA_K(t,slot) glds16(ksrc+TROW(t)*DM,(unsigned)__builtin_amdgcn_readfirstlane(kdst+(slot)))
  #define DMA_V(t,slot) glds16(vsrc+TROW(t)*DM,(unsigned)__builtin_amdgcn_readfirstlane(vdst+(slot)))
  const int vb0=(int)(lds0+LDS_V)+((lane>>4)&1)*32+(lane&3)*8+(4*hi+((lane&15)>>2))*64;
  const char*Kbase=shm+LDS_K; bf16x8 kf[8];
  const lds_cptr shm3=(lds_cptr)shm; const lds_cptr kp0=shm3+LDS_K+hi*1024+r32*16; const lds_cptr vp0=shm3+LDS_V+((lane>>4)&1)*32+(lane&3)*8+(4*hi+((lane&15)>>2))*64;
  const int NT=(q0+QB)/KVBLK+2;
  DMA_K(0,0);DMA_V(0,0);DMA_K(1,SLOTB);
  bf16x8 qr[4];
  #pragma unroll
  for(int d0=0;d0<4;++d0)qr[d0]=*reinterpret_cast<const bf16x8*>(&Qw[(long)r32*DM+d0*16+hi*8]);
  float mhat=0.f,l_reg=0.f;f32x16 o[2];o[0]=f32x16{};o[1]=f32x16{};f32x16 negm=f32x16{};asm volatile("":"+v"(negm));
  const int qrel=wid*QBLK+r32;
  #define CMASK(P0,P1,t) do{int jb_=(t)-(NT-6); if(jb_>=0)cmask(P0,P1,jb_,qrel,hi);}while(0)
  bool resc=false;
  #define START(P0,P1) do{ const float rm=rowmax(P0,P1); resc=false; \
    { const float dl=rm; mhat=fadd_s(mhat,dl); \
      _Pragma("unroll") for(int r=0;r<16;++r){P0[r]=fsub_s(P0[r],dl);P1[r]=fsub_s(P1[r],dl);} \
      _Pragma("unroll") for(int r=0;r<16;++r)negm[r]=-mhat; asm volatile("":"+v"(negm)); } \
    _Pragma("unroll") for(int r=0;r<16;++r)P0[r]=__builtin_amdgcn_exp2f(P0[r]); }while(0)
  #define RESC() do{ if(resc){ asm volatile("s_waitcnt lgkmcnt(0)":::"memory"); \
      _Pragma("unroll") for(int d_=0;d_<2;++d_) _Pragma("unroll") for(int r=0;r<16;++r)o[d_][r]*=wsf[crow(r,hi)]; } }while(0)
  f32x16 pA0,pA1,pB0,pB1;
  int sl_prev=0,sl_cur=0,sl_next=SLOTB;
  #define ROT() do{sl_prev=sl_cur;sl_cur=sl_next;sl_next=(sl_next==(NSLOT-1)*SLOTB)?0:sl_next+SLOTB;}while(0)
  DMA_K(2,2*SLOTB);
  WAIT_BAR(3);
  qkt(pA0,pA1,Kbase,qr,negm,r32,hi);asm volatile("s_nop 15\n\ts_nop 7":"+v"(pA0),"+v"(pA1));CMASK(pA0,pA1,0);
  START(pA0,pA1);
  _Pragma("unroll") for(int r=0;r<16;++r)pA1[r]=__builtin_amdgcn_exp2f(pA1[r]);
  WAIT_BAR(0);
  DMA_K(3,0);DMA_V(1,SLOTB);
  ROT();
  kload8(kf,kp0+sl_cur);
  WAIT_BAR(2);
  s16x4 vlo[8],vhi[8]; u32x4 pw0,pw1,pw2,pw3;
  #define PKW(P,B) cvtpk_s(P[B],P[B+1])
  #define PAF(k) __builtin_bit_cast(bf16x8,pw##k)
  #define VFR(i) (bf16x8){vlo[i][0],vlo[i][1],vlo[i][2],vlo[i][3],vhi[i][0],vhi[i][1],vhi[i][2],vhi[i][3]}
  #define PIN(x) asm volatile("":"+v"(x))
  #define MX3(a,b,c) __builtin_fmaxf(__builtin_fmaxf((a),(b)),(c))
  #define GAPA(MF,A0,A1,A2,A3,W0,W1,PW) do{ MF; sacc+=A0; sacc+=A1; sacc+=A2; sacc+=A3; PIN(sacc); W0; W1; PIN(PW); SBAR(); }while(0)
  #define EX(v) __builtin_amdgcn_exp2f(v)
  #define GAPB(MF,X,B) do{ MF; X[B]=EX(X[B]); X[B+1]=EX(X[B+1]); X[B+2]=EX(X[B+2]); X[B+3]=EX(X[B+3]); PIN(X); SBAR(); }while(0)
  #define VRD(i) do{ vlo[i]=vtr(vp_+(((i)>>2)*4096+((i)&3)*1024)); vhi[i]=vtr(vp_+(((i)>>2)*4096+((i)&3)*1024+512)); }while(0)
  #define KRD(G,j) do{ if(G){ kload2(kf,kp0+sl_next,j); SBAR(); } }while(0)
  #define STEP(C0,C1,P0,P1,t,GK,GV,GL) do{ SBAR(); \
    const lds_cptr vp_=vp0+sl_prev; \
    VRD(0); SBAR(); float sacc=(P0[0]+P0[1]); \
    GAPA(C0=__builtin_amdgcn_mfma_f32_32x32x16_bf16(kf[0],qr[0],negm,0,0,0), P0[2],P0[3],P0[4],P0[5],     pw0[0]=PKW(P0,0), pw0[1]=PKW(P0,2), pw0); \
    VRD(4); SBAR(); GAPA(C1=__builtin_amdgcn_mfma_f32_32x32x16_bf16(kf[1],qr[0],negm,0,0,0), P0[6],P0[7],P0[8],P0[9],     pw0[2]=PKW(P0,4), pw0[3]=PKW(P0,6), pw0); \
    VRD(1); SBAR(); GAPA(C0=__builtin_amdgcn_mfma_f32_32x32x16_bf16(kf[2],qr[1],C0,0,0,0),   P0[10],P0[11],P0[12],P0[13], pw1[0]=PKW(P0,8), pw1[1]=PKW(P0,10), pw1); \
    VRD(5); SBAR(); GAPA(C1=__builtin_amdgcn_mfma_f32_32x32x16_bf16(kf[3],qr[1],C1,0,0,0),   P0[14],P0[15],P1[0],P1[1],   pw1[2]=PKW(P0,12),pw1[3]=PKW(P0,14), pw1); \
    VRD(2); SBAR(); GAPA(C0=__builtin_amdgcn_mfma_f32_32x32x16_bf16(kf[4],qr[2],C0,0,0,0),   P1[2],P1[3],P1[4],P1[5],     pw2[0]=PKW(P1,0), pw2[1]=PKW(P1,2), pw2); \
    VRD(6); SBAR(); GAPA(C1=__builtin_amdgcn_mfma_f32_32x32x16_bf16(kf[5],qr[2],C1,0,0,0),   P1[6],P1[7],P1[8],P1[9],     pw2[2]=PKW(P1,4), pw2[3]=PKW(P1,6), pw2); \
    VRD(3); SBAR(); GAPA(C0=__builtin_amdgcn_mfma_f32_32x32x16_bf16(kf[6],qr[3],C0,0,0,0),   P1[10],P1[11],P1[12],P1[13], pw3[0]=PKW(P1,8), pw3[1]=PKW(P1,10), pw3); \
    VRD(7); SBAR(); GAPA(C1=__builtin_amdgcn_mfma_f32_32x32x16_bf16(kf[7],qr[3],C1,0,0,0),   P1[14],P1[15],0.f,0.f,       pw3[2]=PKW(P1,12),pw3[3]=PKW(P1,14), pw3); \
    l_reg+=sacc; \
    if(GK){DMA_K((t)+3,sl_cur);} if(GV){DMA_V((t)+1,sl_next);} \
    CMASK(C0,C1,t); \
    { float a=MX3(C0[0],C0[1],C1[0]),b=MX3(C0[2],C0[3],C1[1]); a=MX3(a,C1[2],C1[3]); \
      _Pragma("unroll") for(int r=4;r<16;r+=4){a=MX3(a,C0[r],C0[r+1]);b=MX3(b,C0[r+2],C0[r+3]);a=MX3(a,C1[r],C1[r+1]);b=MX3(b,C1[r+2],C1[r+3]);} \
      float rm=__builtin_fmaxf(a,b); { auto rr=__builtin_amdgcn_permlane32_swap(__float_as_uint(rm),__float_as_uint(rm),false,false); rm=__builtin_fmaxf(__uint_as_float(rr[0]),__uint_as_float(rr[1])); } \
      resc=false; \
      if(__builtin_expect(__any(rm>(float)THRL),0)){ const float dl=__builtin_fmaxf(rm,0.f); mhat+=dl; \
        _Pragma("unroll") for(int r=0;r<16;++r){C0[r]-=dl;C1[r]-=dl;} \
        _Pragma("unroll") for(int r=0;r<16;++r)negm[r]=-mhat; asm volatile("":"+v"(negm)); \
        const float f=__builtin_amdgcn_exp2f(-dl); l_reg*=f; if(hi==0)wsf[r32]=f; resc=true; } } \
    SBAR(); \
    GAPB(o[0]=__builtin_amdgcn_mfma_f32_32x32x16_bf16(PAF(0),VFR(0),o[0],0,0,0), C0,0); \
    GAPB(o[1]=__builtin_amdgcn_mfma_f32_32x32x16_bf16(PAF(0),VFR(4),o[1],0,0,0), C0,4); \
    KRD(GL,0); GAPB(o[0]=__builtin_amdgcn_mfma_f32_32x32x16_bf16(PAF(1),VFR(1),o[0],0,0,0), C0,8); \
    KRD(GL,1); GAPB(o[1]=__builtin_amdgcn_mfma_f32_32x32x16_bf16(PAF(1),VFR(5),o[1],0,0,0), C0,12); \
    KRD(GL,2); GAPB(o[0]=__builtin_amdgcn_mfma_f32_32x32x16_bf16(PAF(2),VFR(2),o[0],0,0,0), C1,0); \
    KRD(GL,3); GAPB(o[1]=__builtin_amdgcn_mfma_f32_32x32x16_bf16(PAF(2),VFR(6),o[1],0,0,0), C1,4); \
    GAPB(o[0]=__builtin_amdgcn_mfma_f32_32x32x16_bf16(PAF(3),VFR(3),o[0],0,0,0), C1,8); \
    GAPB(o[1]=__builtin_amdgcn_mfma_f32_32x32x16_bf16(PAF(3),VFR(7),o[1],0,0,0), C1,12); \
    }while(0)
  int t=1;
  #undef CMASK
  #define CMASK(P0,P1,t) do{}while(0)
  for(;t+7<NT;t+=2){
    STEP(pB0,pB1,pA0,pA1,t,true,true,true);     WAIT_BAR(2); RESC(); ROT();
    STEP(pA0,pA1,pB0,pB1,t+1,true,true,true);   WAIT_BAR(2); RESC(); ROT();
  }
  #undef CMASK
  #define CMASK(P0,P1,t) do{int jb_=(t)-(NT-6); if(jb_>=0)cmask(P0,P1,jb_,qrel,hi);}while(0)
  #define ENDW(tt) do{ if((tt)+3<NT){WAIT_BAR(2);} else if((tt)+2<NT){WAIT_BAR(1);} else {WAIT_BAR(0);} }while(0)
  for(;t+1<NT;t+=2){
    STEP(pB0,pB1,pA0,pA1,t,(t+3<NT),(t+1<NT),(t+1<NT));       ENDW(t);   RESC(); ROT();
    STEP(pA0,pA1,pB0,pB1,t+1,(t+4<NT),(t+2<NT),(t+2<NT));     ENDW(t+1); RESC(); ROT();
  }
  STEP(pB0,pB1,pA0,pA1,NT-1,false,false,false); RESC();
  { float sacc=pB0[0]+pB0[1]; _Pragma("unroll") for(int r=2;r<16;++r)sacc+=pB0[r]; _Pragma("unroll") for(int r=0;r<16;++r)sacc+=pB1[r]; l_reg+=sacc;
    pw0=(u32x4){PKW(pB0,0),PKW(pB0,2),PKW(pB0,4),PKW(pB0,6)};pw1=(u32x4){PKW(pB0,8),PKW(pB0,10),PKW(pB0,12),PKW(pB0,14)};pw2=(u32x4){PKW(pB1,0),PKW(pB1,2),PKW(pB1,4),PKW(pB1,6)};pw3=(u32x4){PKW(pB1,8),PKW(pB1,10),PKW(pB1,12),PKW(pB1,14)};
    SBAR(); pv(o,vb0+sl_cur,PAF(0),PAF(1),PAF(2),PAF(3)); }
  #undef PKW
  #undef PAF
  #undef VFR
  #undef PIN
  #undef MX3
  #undef GAPA
  #undef GAPB
  #undef EX
  #undef VRD
  #undef KRD
  #undef STEP
  #undef ENDW
  {auto rr=__builtin_amdgcn_permlane32_swap(__float_as_uint(l_reg),__float_as_uint(l_reg),false,false);l_reg=__uint_as_float(rr[0])+__uint_as_float(rr[1]);}
  if(hi==0)wsf[32+r32]=l_reg;asm volatile("s_waitcnt lgkmcnt(0)":::"memory");
  float rli[16];
  #pragma unroll
  for(int r=0;r<16;++r)rli[r]=__builtin_amdgcn_rcpf(wsf[32+crow(r,hi)]);
  bf16*Ow=O+(rowbase+q0+wid*QBLK)*OPITCH+vh*D;
  { bf16*stg=(bf16*)(shm+LDS_OST)+wid*2048;
    #pragma unroll
    for(int r=0;r<16;++r){const int orow=crow(r,hi);
      #pragma unroll
      for(int d0=0;d0<2;++d0)stg[orow*64+d0*32+r32]=__float2bfloat16(o[d0][r]*rli[r]);}
    asm volatile("s_waitcnt lgkmcnt(0)":::"memory");
    #pragma unroll
    for(int i=0;i<4;++i){const int row=i*8+(lane>>3),ch=lane&7; const u32x4 v=*(const u32x4*)(stg+row*64+ch*8); ATTN_STORE16(Ow+(long)row*OPITCH+ch*8,v);} }
  asm volatile("s_waitcnt lgkmcnt(0)\n\ts_barrier":::"memory");
  #undef DMA_K
  #undef TROW
  #undef DMA_V
  #undef CMASK
  #undef START
  #undef RESC
  #undef ROT
}
constexpr int ATTN_LDS_BYTES=LDS_BYTES;
struct AttnTensors { const bf16* Q; const bf16* K; const bf16* V; bf16* O; };
struct AttnUnit { int bh; int qb; };
struct StaticOrder {
  int vcu;
  __device__ __forceinline__ explicit StaticOrder(int grid,int block):vcu((block%8)*(grid/8)+block/8){}
  __device__ __forceinline__ bool next(int i,AttnUnit&u)const{ if(i>=8)return false; const int s=vcu&3; u.bh=vcu>>2; u.qb=(i&1)?(4*i+3-s):(4*i+s); return true; }
  __device__ __forceinline__ void a_ready(const AttnUnit&)const{}
  __device__ __forceinline__ void done(const AttnUnit&)const{}
};
template<class Sched,int THRL=8> __device__ __forceinline__ void attn_phase(char*lds,const AttnTensors&T,const Sched&S){
  AttnUnit u;
  for(int i=0;S.next(i,u);++i){ S.a_ready(u); attn_unit<THRL>(u.bh/NVH,u.bh%NVH,u.qb,T.Q,T.K,T.V,T.O,lds); S.done(u); }
}
#undef SBAR
#undef WAIT_BAR
}
#define GAS __attribute__((address_space(1)))
#define LAS __attribute__((address_space(3)))
typedef unsigned short bf16;
typedef unsigned v4u __attribute__((ext_vector_type(4)));
typedef float f32x4 __attribute__((ext_vector_type(4)));
typedef short bf16x8 __attribute__((ext_vector_type(8)));
typedef GAS unsigned gu32;
typedef GAS unsigned long long gu64;
#define RLX_AGENT __ATOMIC_RELAXED, __HIP_MEMORY_SCOPE_AGENT
#define LDS_WAIT() asm volatile("s_waitcnt lgkmcnt(0)" ::: "memory")
#define VM_WAIT() asm volatile("s_waitcnt vmcnt(0)" ::: "memory")
__device__ __forceinline__ unsigned long long rt() { return __builtin_amdgcn_s_memrealtime(); }
__device__ __forceinline__ unsigned f2bf(float f) { unsigned u = __builtin_bit_cast(unsigned, f); return (u + 0x7fffu + ((u >> 16) & 1u)) >> 16; }
__device__ __forceinline__ unsigned pk2(float lo, float hi) { return f2bf(lo) | (f2bf(hi) << 16); }

#define XB_TMO      128
#define XB_XCNT(j)  (256  + 64 * (j))
#define XB_XSUB(j)  (1280 + 64 * (j))
#define XB_XGEN(j)  (2304 + 64 * (j))
#define XB_TOP      3328
#define XB_TOPGEN   3392
#define XCD_BAR_WORDS 3456
#define XB_SPIN_CAP (1u << 18)

__device__ __forceinline__ unsigned xb_ld(unsigned* p)              { return __hip_atomic_load(p, __ATOMIC_RELAXED, __HIP_MEMORY_SCOPE_AGENT); }
__device__ __forceinline__ unsigned xb_add(unsigned* p, unsigned v) { return __hip_atomic_fetch_add(p, v, __ATOMIC_RELAXED, __HIP_MEMORY_SCOPE_AGENT); }
__device__ __forceinline__ unsigned xb_xcc_id() { return (unsigned)__builtin_amdgcn_s_getreg((3 << 11) | 20) & 0xFu; }
#define XB_SPIN(cond, bar) do { unsigned _sp = 0; while (cond) { __builtin_amdgcn_s_sleep(1); \
    if ((++_sp & 255u) == 0u) { if (xb_ld(&(bar)[XB_TMO])) break; if (_sp > XB_SPIN_CAP) { atomicAdd(&(bar)[XB_TMO], 1u); break; } } } } while (0)

struct XcdBarrier {
    unsigned* bar; unsigned x;
    volatile LAS unsigned* st;
};

__device__ __forceinline__ XcdBarrier xcd_barrier_post(unsigned* bar, volatile LAS unsigned* st) {
    XcdBarrier b; b.bar = bar; b.x = xb_xcc_id(); b.st = st;
    if (threadIdx.x == 0) (void)xb_add(&bar[XB_XCNT(b.x)], 1u);
    return b;
}
__device__ __forceinline__ void xcd_barrier_complete(unsigned* bar, unsigned x, unsigned& nloc, unsigned& nx) {
    const unsigned G = gridDim.x * gridDim.y * gridDim.z;
    unsigned sum, cnt, mine, sp = 0u;
    for (;;) {
        sum = 0u; cnt = 0u; mine = 0u;
#pragma unroll
        for (unsigned j = 0; j < 16; ++j) { const unsigned c = xb_ld(&bar[XB_XCNT(j)]); sum += c; cnt += (c > 0u) ? 1u : 0u; mine = (j == x) ? c : mine; }
        if (sum == G) break;
        __builtin_amdgcn_s_sleep(1);
        if ((++sp & 255u) == 0u) { if (xb_ld(&bar[XB_TMO])) break; if (sp > XB_SPIN_CAP) { atomicAdd(&bar[XB_TMO], 1u); break; } }
    }
    nloc = mine > 0u ? mine : 1u; nx = cnt > 0u ? cnt : 1u;
}

__device__ __forceinline__ void xcd_barrier(const XcdBarrier& b) {
    asm volatile("s_waitcnt vmcnt(0)" ::: "memory");
    __syncthreads();
    if (threadIdx.x == 0) {
        unsigned* bar = b.bar;
        __builtin_amdgcn_s_waitcnt(0);
        unsigned nloc = b.st[0], nx = b.st[1];
        if (nloc == 0u) { xcd_barrier_complete(bar, b.x, nloc, nx); b.st[0] = nloc; b.st[1] = nx; }
        const unsigned old = xb_add(&bar[XB_XSUB(b.x)], 1u);
        const unsigned gen = old / nloc;
        if (old + 1u == (gen + 1u) * nloc) {
            __builtin_amdgcn_fence(__ATOMIC_RELEASE, "agent");
            asm volatile("s_waitcnt vmcnt(0)" ::: "memory");
            const unsigned og = xb_add(&bar[XB_TOP], 1u);
            const unsigned tg = og / nx;
            if (og + 1u == (tg + 1u) * nx) xb_add(&bar[XB_TOPGEN], 1u);
            else XB_SPIN(xb_ld(&bar[XB_TOPGEN]) == tg, bar);
            __builtin_amdgcn_fence(__ATOMIC_ACQUIRE, "agent");
            xb_add(&bar[XB_XGEN(b.x)], 1u);
            asm volatile("s_waitcnt vmcnt(0)" ::: "memory");
        } else {
            XB_SPIN(xb_ld(&bar[XB_XGEN(b.x)]) == gen, bar);
            __builtin_amdgcn_fence(__ATOMIC_ACQUIRE, "agent");
            asm volatile("s_waitcnt vmcnt(0)" ::: "memory");
        }
    }
    __syncthreads();
}

constexpr int NWAVES = 8;
#ifndef MK_N_LAUNCHES
#define MK_N_LAUNCHES 1
#endif
constexpr int NPH = 25;
constexpr int N_LAUNCHES = MK_N_LAUNCHES;
static_assert(N_LAUNCHES == 1 || N_LAUNCHES == NPH, "MK_N_LAUNCHES is 1 or 25");

constexpr int DM_ = 1024, NLAYER = 2, NMETA = 16, SEQ_ = 8192;
constexpr int MREAL = pg8::MREAL, MVALID = pg8::MVALID, MP = 16640;
constexpr int NP1 = 8192;
constexpr int MOE_ROWS = 74240;
constexpr int CAP = 16416;
constexpr float LN_EPS = 1e-5f, ALPHA = 1.4142135623730951f;

constexpr size_t MiB = 1u << 20;
constexpr size_t WS_CTL = 0, CTL_ZERO_BYTES = 1 * MiB;
constexpr size_t WL_IN = 0, WL_GLU = 16 * MiB, WL_SO = 17 * MiB, WL_CO = 18 * MiB, WL_AO = 19 * MiB, WL_WO = 21 * MiB, WL_GU = 23 * MiB, WL_DN = 151 * MiB, WL_ST = 215 * MiB, WL_TOE = 231 * MiB, WL_STRIDE = 304 * MiB;
constexpr size_t WS_W = 2 * MiB;
constexpr size_t WS_SSMC = WS_W + NLAYER * WL_STRIDE;
constexpr size_t WS_ROPE = WS_SSMC + 2 * MiB;
constexpr size_t WS_HF = WS_ROPE + 3 * MiB;
constexpr size_t WS_HB = WS_HF + 65 * MiB;
constexpr size_t WS_UC = WS_HB + 33 * MiB;
constexpr size_t WS_UMETA = WS_UC + 18 * MiB;
constexpr size_t WS_CONV = WS_UMETA + 1 * MiB;
constexpr size_t WS_Q = WS_CONV + 49 * MiB;
constexpr size_t WS_K = WS_Q + 33 * MiB;
constexpr size_t WS_V = WS_K + 33 * MiB;
constexpr size_t WS_GB = WS_V + 33 * MiB;
constexpr size_t WS_SLOC = WS_GB + 98 * MiB;
constexpr size_t WS_SM = WS_SLOC + 4 * MiB;
constexpr size_t WS_OC = WS_SM + 1 * MiB;
constexpr size_t WS_YG = WS_OC + 65 * MiB;
constexpr size_t WS_YS = WS_YG + 17 * MiB;
constexpr size_t WS_YC = WS_YS + 17 * MiB;
constexpr size_t WS_YA = WS_YC + 17 * MiB;
constexpr size_t WS_MG = WS_YA + 33 * MiB;
constexpr size_t WS_PRE = WS_MG + 33 * MiB;
constexpr size_t WS_XG = WS_PRE + 65 * MiB;
constexpr size_t WS_HID = WS_XG + 145 * MiB;
constexpr size_t WS_OUTS = WS_HID + 145 * MiB;
constexpr size_t WS_ROWIDX = WS_OUTS + 145 * MiB;
constexpr size_t WS_TOKE = WS_ROWIDX + 3 * MiB;
constexpr size_t WS_TOKW = WS_TOKE + 1 * MiB;
constexpr size_t WS_END = WS_TOKW + 1 * MiB;
static_assert((size_t)MOE_ROWS * 1024 * 2 <= 145 * MiB && (size_t)MP * 3072 * 2 <= 98 * MiB && (size_t)MP * 1536 * 2 <= 49 * MiB && (size_t)MP * 4096 <= 65 * MiB && (size_t)32 * 1024 * 1152 * 2 <= 73 * MiB, "d_ws map");
constexpr int CW_TMO = 0, CW_CODE = 1;
constexpr int CW_BAR = 4096;
constexpr int CW_CNT = 16384;
static_assert((CW_CNT + NLAYER * 32 * 64) * 4 <= (int)CTL_ZERO_BYTES, "CTL words inside the memset region");

constexpr int RING_OFF = 0, RING_BYTES = 131072;
constexpr int LDSCTL_OFF = RING_BYTES, MISC_OFF = LDSCTL_OFF + 320;
constexpr int REC_OFF = MISC_OFF + 192;
constexpr int LDS_BYTES = 147456;
static_assert(REC_OFF + 8 * 40 * 8 <= LDS_BYTES && (REC_OFF % 16) == 0, "LDS map");

enum InIdx { I_X = 0, I_META, I_LNIN_G, I_LNIN_B, I_WIN, I_LAMRE, I_LAMIM, I_LOGDT, I_BRE, I_BIM, I_CRE, I_CIM, I_SSMD, I_WGLU, I_SSMWO, I_CONVW, I_CONVWO,
             I_LQ1, I_LK1, I_LQ2, I_LK2, I_SUBLN, I_ATTNWO, I_GATEW, I_GATEB, I_WO, I_LN1G, I_LN1B, I_RW, I_RB, I_WGU, I_BGU, I_WDN, I_BDN, I_LN2G, I_LN2B, N_IN };
struct Args { const float* in[N_IN]; float* out; unsigned char* ws; int ph_lo, ph_hi, li, pad; };
struct Frame {
    LAS unsigned char* lds;
    volatile LAS unsigned* MISC;
    gu32* ctl;
    unsigned char* ws;
    int tid, lane, wave;
    int vcu, G;
    int chk_l;
};
__device__ __forceinline__ float wave_sum_slow(float v) {
#pragma unroll
    for (int o = 1; o < 64; o <<= 1) v += __shfl_xor(v, o);
    return v;
}
#define DPPF(x, ctrl) __builtin_bit_cast(float, __builtin_amdgcn_mov_dpp(__builtin_bit_cast(int, (x)), (ctrl), 0xf, 0xf, true))
__device__ __forceinline__ float wave_sum(float v) {
    v += DPPF(v, 0xB1); v += DPPF(v, 0x4E); v += DPPF(v, 0x141); v += DPPF(v, 0x140);
    const int iv = __builtin_bit_cast(int, v);
    const float r0 = __builtin_bit_cast(float, __builtin_amdgcn_readlane(iv, 0)), r1 = __builtin_bit_cast(float, __builtin_amdgcn_readlane(iv, 16)),
                r2 = __builtin_bit_cast(float, __builtin_amdgcn_readlane(iv, 32)), r3 = __builtin_bit_cast(float, __builtin_amdgcn_readlane(iv, 48));
    return (r0 + r1) + (r2 + r3);
}
__device__ __forceinline__ float wave_max(float v) {
#pragma unroll
    for (int o = 1; o < 64; o <<= 1) v = fmaxf(v, __shfl_xor(v, o));
    return v;
}
__device__ __forceinline__ int wave_min_i(int v) {
#pragma unroll
    for (int o = 1; o < 64; o <<= 1) { const int w = __shfl_xor(v, o); v = w < v ? w : v; }
    return v;
}
__device__ __forceinline__ float bflo(unsigned w) { return __uint_as_float(w << 16); }
__device__ __forceinline__ float bfhi(unsigned w) { return __uint_as_float(w & 0xffff0000u); }
__device__ __forceinline__ void unpk8(v4u w, float (&f)[8]) { f[0] = bflo(w.x); f[1] = bfhi(w.x); f[2] = bflo(w.y); f[3] = bfhi(w.y); f[4] = bflo(w.z); f[5] = bfhi(w.z); f[6] = bflo(w.w); f[7] = bfhi(w.w); }
__device__ __forceinline__ v4u pk8(const float (&f)[8]) { v4u o; o.x = pk2(f[0], f[1]); o.y = pk2(f[2], f[3]); o.z = pk2(f[4], f[5]); o.w = pk2(f[6], f[7]); return o; }
__device__ __forceinline__ float sigm_(float x) { return 1.0f / (1.0f + __expf(-x)); }
__device__ __forceinline__ float gelu_(float x) { const float u = 0.7978845608028654f * (x + 0.044715f * x * x * x); return x * sigm_(2.0f * u); }

__device__ __forceinline__ int rowmap(int n, int mode) {
    if (mode == 1) { if (n >= 2048 && n < 4096) { const int d = n & 63; return (n & ~63) + (d < 32 ? 8 * (d >> 2) + (d & 3) : 8 * ((d - 32) >> 2) + 4 + (d & 3)); } return n; }
    if (mode == 2) { return n < 1024 ? 8 * (n >> 2) + (n & 3) : 8 * ((n - 1024) >> 2) + 4 + (n & 3); }
    return n;
}
__device__ __forceinline__ void transpose_item(const float* W, int K, int N, bf16* WT, int mode, LAS float* scr, int item, int lane) {
    const int nblk = N / 32, kb = item / nblk, nb = item - kb * nblk, k0 = 64 * kb, n0 = 32 * nb;
    typedef float f2 __attribute__((ext_vector_type(2)));
    f2 v[16];
    const int lr = lane >> 4, lc = 2 * (lane & 15);
#pragma unroll
    for (int i = 0; i < 16; ++i) v[i] = *(const GAS f2*)(W + (size_t)(k0 + 4 * i + lr) * N + n0 + lc);
#pragma unroll
    for (int i = 0; i < 16; ++i) { scr[(4 * i + lr) * 33 + lc] = v[i].x; scr[(4 * i + lr) * 33 + lc + 1] = v[i].y; }
    LDS_WAIT(); asm volatile("" ::: "memory");
    const int c = lane & 7;
#pragma unroll
    for (int j = 0; j < 4; ++j) { const int n = (lane >> 3) + 8 * j; const LAS float* s = scr + (8 * c) * 33 + n;
        v4u o; o.x = pk2(s[0 * 33], s[1 * 33]); o.y = pk2(s[2 * 33], s[3 * 33]); o.z = pk2(s[4 * 33], s[5 * 33]); o.w = pk2(s[6 * 33], s[7 * 33]);
        *(GAS v4u*)(WT + (size_t)rowmap(n0 + n, mode) * K + k0 + 8 * c) = o; }
    LDS_WAIT(); asm volatile("" ::: "memory");
}
__device__ __forceinline__ void ln16(f32x4 (&v)[4], const float* g, const float* b, int lane) {
    float s = 0.f;
#pragma unroll
    for (int j = 0; j < 4; ++j) s += (v[j].x + v[j].y) + (v[j].z + v[j].w);
    const float mean = wave_sum(s) * (1.f / 1024.f); float s2 = 0.f;
#pragma unroll
    for (int j = 0; j < 4; ++j) { v[j] = v[j] - mean; s2 += (v[j].x * v[j].x + v[j].y * v[j].y) + (v[j].z * v[j].z + v[j].w * v[j].w); }
    const float rstd = 1.f / sqrtf(wave_sum(s2) * (1.f / 1024.f) + LN_EPS);
#pragma unroll
    for (int j = 0; j < 4; ++j) { const f32x4 gg = *(const GAS f32x4*)(g + 256 * j + 4 * lane), bb = *(const GAS f32x4*)(b + 256 * j + 4 * lane); v[j] = v[j] * rstd * gg + bb; }
}
__device__ __forceinline__ void store_row_f32_bf16(const f32x4 (&v)[4], float* hf, bf16* hb, int lane) {
#pragma unroll
    for (int j = 0; j < 4; ++j) { if (hf) *(GAS f32x4*)(hf + 256 * j + 4 * lane) = v[j];
        *(GAS unsigned long long*)(hb + 256 * j + 4 * lane) = (unsigned long long)pk2(v[j].x, v[j].y) | ((unsigned long long)pk2(v[j].z, v[j].w) << 32); }
}

__device__ __forceinline__ void ssm_build(Frame& F, const Args& A, int l, int g) {
    LAS float* L = (LAS float*)(F.lds + RING_OFF);
    LAS float* AP_re = L; LAS float* AP_im = L + 4160; LAS float* BB_re = L + 8320; LAS float* BB_im = L + 9344; LAS float* CC_re = L + 10368; LAS float* CC_im = L + 11392; LAS float* KM = L + 12416;
    const int lg = l * 32 + g; const int tid = F.tid;
    const float dt = __expf(A.in[I_LOGDT][lg]);
    for (int idx = tid; idx < 65 * 64; idx += 512) { const int j = idx >> 6, p = idx & 63; const float lr = A.in[I_LAMRE][lg * 64 + p], li = A.in[I_LAMIM][lg * 64 + p];
        const float mag = expf(lr * dt * (float)j), ang = li * dt * (float)j; AP_re[idx] = mag * cosf(ang); AP_im[idx] = mag * sinf(ang); }
    __syncthreads();
    for (int idx = tid; idx < 1024; idx += 512) {
        { const int p = idx >> 4, c = idx & 15; const float lr = A.in[I_LAMRE][lg * 64 + p], li = A.in[I_LAMIM][lg * 64 + p];
          const float ar = AP_re[64 + p], ai = AP_im[64 + p], nr = ar - 1.0f, den = lr * lr + li * li;
          const float cr = (nr * lr + ai * li) / den, ci = (ai * lr - nr * li) / den;
          const float br = A.in[I_BRE][(size_t)(lg * 64 + p) * 16 + c], bi = A.in[I_BIM][(size_t)(lg * 64 + p) * 16 + c];
          BB_re[idx] = cr * br - ci * bi; BB_im[idx] = cr * bi + ci * br; }
        { CC_re[idx] = A.in[I_CRE][(size_t)lg * 1024 + idx]; CC_im[idx] = A.in[I_CIM][(size_t)lg * 1024 + idx]; }
    }
    __syncthreads();
    for (int idx = tid; idx < 16384; idx += 512) { const int j = idx >> 8, co = (idx >> 4) & 15, ci = idx & 15; float s = 0.f;
        for (int p = 0; p < 64; ++p) { const float Ar = AP_re[j * 64 + p], Ai = AP_im[j * 64 + p], Br = BB_re[p * 16 + ci], Bi = BB_im[p * 16 + ci];
            const float er = Ar * Br - Ai * Bi, ei = Ar * Bi + Ai * Br; s += CC_re[co * 64 + p] * er - CC_im[co * 64 + p] * ei; }
        if (j == 0 && co == ci) s += A.in[I_SSMD][l * 512 + g * 16 + co];
        KM[idx] = s; }
    __syncthreads();
    bf16* TOE = (bf16*)(F.ws + WS_W + (size_t)l * WL_STRIDE + WL_TOE) + (size_t)g * 1024 * 1152;
    for (int q = tid; q < 1024 * 144; q += 512) { const int n = q / 144, kc = q - n * 144, t = n >> 4, co = n & 15; float f[8];
        if (kc < 128) { const int s = kc >> 1, ci0 = (kc & 1) * 8;
            if (s <= t) {
#pragma unroll
                for (int i = 0; i < 8; ++i) f[i] = KM[(t - s) * 256 + co * 16 + ci0 + i]; }
            else {
#pragma unroll
                for (int i = 0; i < 8; ++i) f[i] = 0.f; } }
        else { const int p0 = (kc - 128) * 8;
#pragma unroll
            for (int i = 0; i < 8; ++i) { const int p = (p0 + i) & 63; const float Cr = CC_re[co * 64 + p], Ci = CC_im[co * 64 + p], Ar = AP_re[(t + 1) * 64 + p], Ai = AP_im[(t + 1) * 64 + p];
                f[i] = p0 < 64 ? (Cr * Ar - Ci * Ai) : -(Cr * Ai + Ci * Ar); } }
        *(GAS v4u*)(TOE + (size_t)n * 1152 + kc * 8) = pk8(f); }
    bf16* WST = (bf16*)(F.ws + WS_W + (size_t)l * WL_STRIDE + WL_ST) + (size_t)g * 256 * 1024;
    for (int q = tid; q < 256 * 128; q += 512) { const int n = q >> 7, kc = q & 127, s = kc >> 1, ci0 = (kc & 1) * 8; float f[8];
        if (n < 128) { const int p = n & 63; const float Ar = AP_re[(63 - s) * 64 + p], Ai = AP_im[(63 - s) * 64 + p];
#pragma unroll
            for (int i = 0; i < 8; ++i) { const float Br = BB_re[p * 16 + ci0 + i], Bi = BB_im[p * 16 + ci0 + i]; f[i] = n < 64 ? (Ar * Br - Ai * Bi) : (Ar * Bi + Ai * Br); } }
        else {
#pragma unroll
            for (int i = 0; i < 8; ++i) f[i] = 0.f; }
        *(GAS v4u*)(WST + (size_t)n * 1024 + kc * 8) = pk8(f); }
    float* SC = (float*)(F.ws + WS_SSMC + (size_t)l * MiB);
    if (tid < 64) { const int p = tid; SC[(lg * 64 + p) * 2] = AP_re[64 + p]; SC[(lg * 64 + p) * 2 + 1] = AP_im[64 + p];
        SC[16384 + (lg * 64 + p) * 2] = AP_re[64 * 64 + p]; SC[16384 + (lg * 64 + p) * 2 + 1] = AP_im[64 * 64 + p]; }
    for (int idx = tid; idx < 1024; idx += 512) { const int p = idx >> 4, c = idx & 15; SC[32768 + (size_t)(lg * 64 + p) * 32 + c] = BB_re[idx]; SC[32768 + (size_t)(lg * 64 + p) * 32 + 16 + c] = BB_im[idx]; }
    __syncthreads();
}

__device__ __forceinline__ void p0_prologue(Frame& F, const Args& A) {
    for (int job = F.vcu; job < NLAYER * 32; job += F.G) ssm_build(F, A, job >> 5, job & 31);
    const int gw = F.vcu * NWAVES + F.wave, NGW = F.G * NWAVES, lane = F.lane;
    float* HF = (float*)(F.ws + WS_HF); bf16* HB = (bf16*)(F.ws + WS_HB);
    for (int R = gw; R < MVALID; R += NGW) { const float* src = R < MREAL ? A.in[I_X] + (size_t)R * 1024 : A.in[I_META] + (size_t)((R - MREAL) & 15) * 1024;
        f32x4 v[4];
#pragma unroll
        for (int j = 0; j < 4; ++j) v[j] = *(const GAS f32x4*)(src + 256 * j + 4 * lane);
        ln16(v, A.in[I_LNIN_G], A.in[I_LNIN_B], lane); store_row_f32_bf16(v, HF + (size_t)R * 1024, HB + (size_t)R * 1024, lane); }
    { float* ROPE = (float*)(F.ws + WS_ROPE); const int gt = F.vcu * 512 + F.tid, NGT = F.G * 512;
      for (int idx = gt; idx < 8208 * 32; idx += NGT) { const int pos = idx >> 5, j = idx & 31; const float inv = exp2f(-(float)j * (13.287712379549449f / 32.0f)); const float ang = (float)pos * inv;
          ROPE[(size_t)pos * 64 + j] = cosf(ang); ROPE[(size_t)pos * 64 + 32 + j] = sinf(ang); } }
    { bf16* KB = (bf16*)(F.ws + WS_K); bf16* VB = (bf16*)(F.ws + WS_V);
      for (int r = gw; r < 512; r += NGW) { bf16* base = (r & 256) ? VB : KB; const int b = (r >> 7) & 1, rr = r & 127; GAS v4u* d = (GAS v4u*)(base + (size_t)(b * 8320 + 8192 + rr) * 1024);
          d[lane] = (v4u){0u, 0u, 0u, 0u}; d[64 + lane] = (v4u){0u, 0u, 0u, 0u}; } }
    LAS float* scr = (LAS float*)(F.lds + RING_OFF + F.wave * 16384);
    constexpr int IT_IN = 16 * 160, IT_GATE = 16 * 96, IT_GLU = 8 * 16, IT_SO = 8 * 32, IT_CO = 8 * 32, IT_AO = 16 * 32, IT_WO = 16 * 32, IT_GU1 = 16 * 64, IT_DN1 = 16 * 32;
    constexpr int IT_L = IT_IN + IT_GATE + IT_GLU + IT_SO + IT_CO + IT_AO + IT_WO + 32 * IT_GU1 + 32 * IT_DN1;
    for (int it = gw; it < NLAYER * IT_L; it += NGW) {
        const int l = it / IT_L; int r = it - l * IT_L; unsigned char* wl = F.ws + WS_W + (size_t)l * WL_STRIDE;
        if (r < IT_IN) { transpose_item(A.in[I_WIN] + (size_t)l * 1024 * 5120, 1024, 5120, (bf16*)(wl + WL_IN), 1, scr, r, lane); continue; } r -= IT_IN;
        if (r < IT_GATE) { transpose_item(A.in[I_GATEW] + (size_t)l * 1024 * 3072, 1024, 3072, (bf16*)(wl + WL_IN) + (size_t)5120 * 1024, 0, scr, r, lane); continue; } r -= IT_GATE;
        if (r < IT_GLU) { transpose_item(A.in[I_WGLU] + (size_t)l * 512 * 512, 512, 512, (bf16*)(wl + WL_GLU), 0, scr, r, lane); continue; } r -= IT_GLU;
        if (r < IT_SO) { transpose_item(A.in[I_SSMWO] + (size_t)l * 512 * 1024, 512, 1024, (bf16*)(wl + WL_SO), 0, scr, r, lane); continue; } r -= IT_SO;
        if (r < IT_CO) { transpose_item(A.in[I_CONVWO] + (size_t)l * 512 * 1024, 512, 1024, (bf16*)(wl + WL_CO), 0, scr, r, lane); continue; } r -= IT_CO;
        if (r < IT_AO) { transpose_item(A.in[I_ATTNWO] + (size_t)l * 1024 * 1024, 1024, 1024, (bf16*)(wl + WL_AO), 0, scr, r, lane); continue; } r -= IT_AO;
        if (r < IT_WO) { transpose_item(A.in[I_WO] + (size_t)l * 1024 * 1024, 1024, 1024, (bf16*)(wl + WL_WO), 0, scr, r, lane); continue; } r -= IT_WO;
        if (r < 32 * IT_GU1) { const int e = r / IT_GU1; transpose_item(A.in[I_WGU] + ((size_t)l * 32 + e) * 1024 * 2048, 1024, 2048, (bf16*)(wl + WL_GU) + (size_t)e * 2048 * 1024, 2, scr, r - e * IT_GU1, lane); continue; } r -= 32 * IT_GU1;
        { const int e = r / IT_DN1; transpose_item(A.in[I_WDN] + ((size_t)l * 32 + e) * 1024 * 1024, 1024, 1024, (bf16*)(wl + WL_DN) + (size_t)e * 1024 * 1024, 0, scr, r - e * IT_DN1, lane); }
    }
}

__device__ __forceinline__ int prev_row(int R, int k) {
    if (R < MREAL) { const int t = R & 8191, b = R >> 13; return t >= k ? R - k : MREAL + b * 16 + 16 - (k - t); }
    const int i = (R - MREAL) & 15; return i >= k ? R - k : -1;
}
__device__ __forceinline__ void conv_rows(Frame& F, const Args& A, int l) {
    const int gw = F.vcu * NWAVES + F.wave, NGW = F.G * NWAVES, lane = F.lane, c0 = 8 * lane;
    const bf16* CB = (const bf16*)(F.ws + WS_CONV); bf16* YC = (bf16*)(F.ws + WS_YC);
    float w0[8], w1[8], w2[8];
#pragma unroll
    for (int i = 0; i < 8; ++i) { w0[i] = A.in[I_CONVW][(size_t)l * 1536 + c0 + i]; w1[i] = A.in[I_CONVW][(size_t)l * 1536 + 512 + c0 + i]; w2[i] = A.in[I_CONVW][(size_t)l * 1536 + 1024 + c0 + i]; }
    for (int R = gw; R < MVALID; R += NGW) {
        const int r1 = prev_row(R, 1), r2 = prev_row(R, 2);
        float gb[8], a[8], h[8], z0[8], z1[8], z2[8];
        unpk8(*(const GAS v4u*)(CB + (size_t)R * 1536 + c0), gb);
        unpk8(*(const GAS v4u*)(CB + (size_t)R * 1536 + 512 + c0), a); unpk8(*(const GAS v4u*)(CB + (size_t)R * 1536 + 1024 + c0), h);
#pragma unroll
        for (int i = 0; i < 8; ++i) z0[i] = a[i] * h[i];
        if (r1 >= 0) { unpk8(*(const GAS v4u*)(CB + (size_t)r1 * 1536 + 512 + c0), a); unpk8(*(const GAS v4u*)(CB + (size_t)r1 * 1536 + 1024 + c0), h);
#pragma unroll
            for (int i = 0; i < 8; ++i) z1[i] = a[i] * h[i]; }
        else {
#pragma unroll
            for (int i = 0; i < 8; ++i) z1[i] = 0.f; }
        if (r2 >= 0) { unpk8(*(const GAS v4u*)(CB + (size_t)r2 * 1536 + 512 + c0), a); unpk8(*(const GAS v4u*)(CB + (size_t)r2 * 1536 + 1024 + c0), h);
#pragma unroll
            for (int i = 0; i < 8; ++i) z2[i] = a[i] * h[i]; }
        else {
#pragma unroll
            for (int i = 0; i < 8; ++i) z2[i] = 0.f; }
        float y[8];
#pragma unroll
        for (int i = 0; i < 8; ++i) y[i] = gb[i] * (w0[i] * z2[i] + w1[i] * z1[i] + w2[i] * z0[i]);
        *(GAS v4u*)(YC + (size_t)R * 512 + c0) = pk8(y);
    }
}
__device__ __forceinline__ void ssm_meta_job(Frame& F, const Args& A, int l, int bm, int g) {
    const int lane = F.lane, lg = l * 32 + g;
    const float* SC = (const float*)(F.ws + WS_SSMC + (size_t)l * MiB);
    const bf16* UM = (const bf16*)(F.ws + WS_UMETA); bf16* YG = (bf16*)(F.ws + WS_YG); float* SM = (float*)(F.ws + WS_SM);
    LAS float* scr = (LAS float*)(F.lds + RING_OFF + F.wave * 16384);
    LAS float* CR = scr + 2048; LAS float* CI = scr + 3072;
    { const GAS f32x4* cr = (const GAS f32x4*)(A.in[I_CRE] + (size_t)lg * 1024) + lane * 4; const GAS f32x4* ci = (const GAS f32x4*)(A.in[I_CIM] + (size_t)lg * 1024) + lane * 4;
      f32x4 t0[4], t1[4];
#pragma unroll
      for (int i = 0; i < 4; ++i) { t0[i] = cr[i]; t1[i] = ci[i]; }
#pragma unroll
      for (int i = 0; i < 4; ++i) { *(LAS f32x4*)(CR + lane * 16 + 4 * i) = t0[i]; *(LAS f32x4*)(CI + lane * 16 + 4 * i) = t1[i]; } }
    const float ar = SC[(lg * 64 + lane) * 2], ai = SC[(lg * 64 + lane) * 2 + 1];
    float bbr[16], bbi[16];
    { const GAS f32x4* bp = (const GAS f32x4*)(SC + 32768 + (size_t)(lg * 64 + lane) * 32);
#pragma unroll
      for (int i = 0; i < 4; ++i) { const f32x4 r = bp[i], m = bp[4 + i]; bbr[4 * i] = r.x; bbr[4 * i + 1] = r.y; bbr[4 * i + 2] = r.z; bbr[4 * i + 3] = r.w; bbi[4 * i] = m.x; bbi[4 * i + 1] = m.y; bbi[4 * i + 2] = m.z; bbi[4 * i + 3] = m.w; } }
    float xr = 0.f, xi = 0.f;
#pragma unroll
    for (int hh = 0; hh < 2; ++hh) { v4u ua[8], ub[8];
#pragma unroll
        for (int s = 0; s < 8; ++s) { const bf16* up = UM + (size_t)(bm * 16 + hh * 8 + s) * 512 + g * 16; ua[s] = *(const GAS v4u*)up; ub[s] = *(const GAS v4u*)(up + 8); }
#pragma unroll
        for (int s = 0; s < 8; ++s) { float fa[8], fb[8]; unpk8(ua[s], fa); unpk8(ub[s], fb); float bur = 0.f, bui = 0.f;
#pragma unroll
            for (int c = 0; c < 8; ++c) { bur += bbr[c] * fa[c] + bbr[8 + c] * fb[c]; bui += bbi[c] * fa[c] + bbi[8 + c] * fb[c]; }
            const float nr = ar * xr - ai * xi + bur, ni = ar * xi + ai * xr + bui; xr = nr; xi = ni;
            const int ss = hh * 8 + s; scr[ss * 128 + ((lane + ss) & 63)] = xr; scr[ss * 128 + 64 + ((lane + ss) & 63)] = xi; } }
    SM[(size_t)(bm * 32 + g) * 128 + lane] = xr; SM[(size_t)(bm * 32 + g) * 128 + 64 + lane] = xi;
    LDS_WAIT(); asm volatile("" ::: "memory");
    const int s = lane >> 2, coq = (lane & 3) * 4; float y[4] = {0.f, 0.f, 0.f, 0.f};
    for (int p = 0; p < 64; ++p) { const float vr = scr[s * 128 + ((p + s) & 63)], vi = scr[s * 128 + 64 + ((p + s) & 63)];
#pragma unroll
        for (int i = 0; i < 4; ++i) y[i] += CR[(coq + i) * 64 + p] * vr - CI[(coq + i) * 64 + p] * vi; }
    const unsigned long long uw = *(const GAS unsigned long long*)(UM + (size_t)(bm * 16 + s) * 512 + g * 16 + coq);
    const f32x4 dv = *(const GAS f32x4*)(A.in[I_SSMD] + l * 512 + g * 16 + coq);
    y[0] += dv.x * bflo((unsigned)uw); y[1] += dv.y * bfhi((unsigned)uw); y[2] += dv.z * bflo((unsigned)(uw >> 32)); y[3] += dv.w * bfhi((unsigned)(uw >> 32));
    const unsigned long long o = (unsigned long long)pk2(gelu_(y[0]), gelu_(y[1])) | ((unsigned long long)pk2(gelu_(y[2]), gelu_(y[3])) << 32);
    *(GAS unsigned long long*)(YG + (size_t)(MREAL + bm * 16 + s) * 512 + g * 16 + coq) = o;
    LDS_WAIT(); asm volatile("" ::: "memory");
}
__device__ __forceinline__ void ssm_carry(Frame& F, int l) {
    const int T = F.vcu * 512 + F.tid; if (T >= 4096) return;
    const int b = T >> 11, g = (T >> 6) & 31, p = T & 63, lg = l * 32 + g;
    const float* SC = (const float*)(F.ws + WS_SSMC + (size_t)l * MiB); const float* SM = (const float*)(F.ws + WS_SM); const float* SL = (const float*)(F.ws + WS_SLOC); bf16* UC = (bf16*)(F.ws + WS_UC);
    const float a64r = SC[16384 + (lg * 64 + p) * 2], a64i = SC[16384 + (lg * 64 + p) * 2 + 1];
    float Sr = SM[(size_t)(b * 32 + g) * 128 + p], Si = SM[(size_t)(b * 32 + g) * 128 + 64 + p];
    const size_t row0 = (size_t)g * 256 + b * 128;
    for (int k0 = 0; k0 < 128; k0 += 16) { float lr[16], li[16];
#pragma unroll
        for (int j = 0; j < 16; ++j) { lr[j] = *(const GAS float*)(SL + (row0 + k0 + j) * 128 + p); li[j] = *(const GAS float*)(SL + (row0 + k0 + j) * 128 + 64 + p); }
#pragma unroll
        for (int j = 0; j < 16; ++j) { const size_t row = row0 + k0 + j;
            *(GAS bf16*)(UC + row * 1152 + 1024 + p) = (bf16)f2bf(Sr); *(GAS bf16*)(UC + row * 1152 + 1088 + p) = (bf16)f2bf(Si);
            const float nr = a64r * Sr - a64i * Si + lr[j], ni = a64r * Si + a64i * Sr + li[j]; Sr = nr; Si = ni; } }
}
__device__ __forceinline__ void attn_meta_job(Frame& F, int Rm, int h) {
    const int lane = F.lane, bm = Rm >> 4, R = MREAL + Rm, j = lane >> 2, dq = lane & 3;
    const bf16* Q = (const bf16*)(F.ws + WS_Q); const bf16* K = (const bf16*)(F.ws + WS_K); const bf16* V = (const bf16*)(F.ws + WS_V); bf16* OC = (bf16*)(F.ws + WS_OC);
    const size_t krow = (size_t)bm * 8320 + 8256;
#pragma unroll
    for (int c = 0; c < 2; ++c) { const int hc = h * 2 + c; float qa[8], qb[8], ka[8], kb[8];
        unpk8(*(const GAS v4u*)(Q + (size_t)R * 1024 + hc * 64 + dq * 16), qa); unpk8(*(const GAS v4u*)(Q + (size_t)R * 1024 + hc * 64 + dq * 16 + 8), qb);
        unpk8(*(const GAS v4u*)(K + (krow + j) * 1024 + hc * 64 + dq * 16), ka); unpk8(*(const GAS v4u*)(K + (krow + j) * 1024 + hc * 64 + dq * 16 + 8), kb);
        float s = 0.f;
#pragma unroll
        for (int i = 0; i < 8; ++i) s += qa[i] * ka[i] + qb[i] * kb[i];
        s += __shfl_xor(s, 1); s += __shfl_xor(s, 2);
        float m = s;
#pragma unroll
        for (int o = 4; o < 64; o <<= 1) m = fmaxf(m, __shfl_xor(m, o));
        const float pj = exp2f(s - m); float lsum = pj;
#pragma unroll
        for (int o = 4; o < 64; o <<= 1) lsum += __shfl_xor(lsum, o);
        float o0 = 0.f, o1 = 0.f;
#pragma unroll
        for (int jj = 0; jj < 16; ++jj) { const float pp = __shfl(pj, 4 * jj); const unsigned vv = *(const GAS unsigned*)(V + (krow + jj) * 1024 + h * 128 + 2 * lane); o0 += pp * bflo(vv); o1 += pp * bfhi(vv); }
        const float rl = 1.0f / lsum;
        *(GAS unsigned*)(OC + (size_t)R * 2048 + hc * 128 + 2 * lane) = pk2(o0 * rl, o1 * rl); }
}
__device__ __forceinline__ void attn_combine_rows(Frame& F, const Args& A, int l) {
    const int gw = F.vcu * NWAVES + F.wave, NGW = F.G * NWAVES, lane = F.lane;
    const bf16* OC = (const bf16*)(F.ws + WS_OC); bf16* YA = (bf16*)(F.ws + WS_YA);
    const float lam_init = 0.8f - 0.6f * expf(-0.3f * (float)l);
    const float d1 = wave_sum(A.in[I_LQ1][l * 64 + lane] * A.in[I_LK1][l * 64 + lane]), d2 = wave_sum(A.in[I_LQ2][l * 64 + lane] * A.in[I_LK2][l * 64 + lane]);
    const float lam = expf(d1) - expf(d2) + lam_init;
    const int e0 = (lane & 15) * 8; float sg[8];
#pragma unroll
    for (int i = 0; i < 8; ++i) sg[i] = A.in[I_SUBLN][l * 128 + e0 + i] * (1.0f - lam_init);
    for (int R = gw; R < MVALID; R += NGW) {
#pragma unroll
        for (int pass = 0; pass < 2; ++pass) { const int h = pass * 4 + (lane >> 4); float a[8], b[8], d[8];
            unpk8(*(const GAS v4u*)(OC + (size_t)R * 2048 + (2 * h) * 128 + e0), a); unpk8(*(const GAS v4u*)(OC + (size_t)R * 2048 + (2 * h + 1) * 128 + e0), b);
            float ss = 0.f;
#pragma unroll
            for (int i = 0; i < 8; ++i) { d[i] = a[i] - lam * b[i]; ss += d[i] * d[i]; }
            ss += __shfl_xor(ss, 1); ss += __shfl_xor(ss, 2); ss += __shfl_xor(ss, 4); ss += __shfl_xor(ss, 8);
            const float rs = 1.0f / sqrtf(ss * (1.0f / 128.0f) + 1e-5f);
#pragma unroll
            for (int i = 0; i < 8; ++i) d[i] = d[i] * rs * sg[i];
            *(GAS v4u*)(YA + (size_t)R * 1024 + h * 128 + e0) = pk8(d); }
    }
}
__device__ __forceinline__ float router_reduce(const float (&acc)[32], int lane) {
    float a16[16], a8[8], a4[4], a2[2], a1;
    { const bool hi = lane & 32;
#pragma unroll
      for (int i = 0; i < 16; ++i) { const float keep = hi ? acc[i + 16] : acc[i], give = hi ? acc[i] : acc[i + 16]; a16[i] = keep + __shfl_xor(give, 32); } }
    { const bool hi = lane & 16;
#pragma unroll
      for (int i = 0; i < 8; ++i) { const float keep = hi ? a16[i + 8] : a16[i], give = hi ? a16[i] : a16[i + 8]; a8[i] = keep + __shfl_xor(give, 16); } }
    { const bool hi = lane & 8;
#pragma unroll
      for (int i = 0; i < 4; ++i) { const float keep = hi ? a8[i + 4] : a8[i], give = hi ? a8[i] : a8[i + 4]; a4[i] = keep + __shfl_xor(give, 8); } }
    { const bool hi = lane & 4;
#pragma unroll
      for (int i = 0; i < 2; ++i) { const float keep = hi ? a4[i + 2] : a4[i], give = hi ? a4[i] : a4[i + 2]; a2[i] = keep + __shfl_xor(give, 4); } }
    { const bool hi = lane & 2; const float keep = hi ? a2[1] : a2[0], give = hi ? a2[0] : a2[1]; a1 = keep + DPPF(give, 0x4E); }
    return a1 + DPPF(a1, 0xB1);
}
__device__ __forceinline__ void router_top4(float val, int R, int lane, float* TOKW, unsigned* recg, int nrec, int& ecnt) {
    const int e_me = lane >> 1, iv = __builtin_bit_cast(int, val); int rank = 0;
#pragma unroll
    for (int e = 0; e < 32; ++e) { const float s = __builtin_bit_cast(float, __builtin_amdgcn_readlane(iv, 2 * e)); rank += ((s > val) || (s == val && e < e_me)) ? 1 : 0; }
    float tv[4]; int te[4];
#pragma unroll
    for (int k = 0; k < 4; ++k) { const unsigned long long m = __ballot(rank == k && !(lane & 1)); const int L = __builtin_amdgcn_readfirstlane((int)__ffsll((long long)m) - 1);
        te[k] = L >> 1; tv[k] = __builtin_bit_cast(float, __builtin_amdgcn_readlane(iv, L)); }
    ecnt += (te[0] == lane) + (te[1] == lane) + (te[2] == lane) + (te[3] == lane);
    const float p1 = __expf(tv[1] - tv[0]), p2 = __expf(tv[2] - tv[0]), p3 = __expf(tv[3] - tv[0]), rs = 1.0f / (1.0f + p1 + p2 + p3);
    if (lane < 4) { const int k = lane; const int e = k == 0 ? te[0] : k == 1 ? te[1] : k == 2 ? te[2] : te[3]; const float w = (k == 0 ? 1.0f : k == 1 ? p1 : k == 2 ? p2 : p3) * rs;
        TOKW[(size_t)R * 4 + k] = w; recg[(nrec * 4 + k) * 2] = (unsigned)R; recg[(nrec * 4 + k) * 2 + 1] = (unsigned)e; }
}
__device__ __forceinline__ void ln1_router(Frame& F, const Args& A, int l) {
    const int tid = F.tid, lane = F.lane, wave = F.wave, gw = F.vcu * NWAVES + wave, NGW = F.G * NWAVES;
    LAS float* WT = (LAS float*)(F.lds + RING_OFF);
    const float* rw = A.in[I_RW] + (size_t)l * 1024 * 32;
    for (int idx = tid; idx < 32768; idx += 512) WT[(idx & 31) * 1024 + (idx >> 5)] = rw[idx];
    __syncthreads();
    const float* PRE = (const float*)(F.ws + WS_PRE); float* HF = (float*)(F.ws + WS_HF); bf16* HB = (bf16*)(F.ws + WS_HB);
    float* TOKW = (float*)(F.ws + WS_TOKW);
    unsigned* recg = (unsigned*)(F.ws + WS_ROWIDX + 131072) + (size_t)gw * 80;
    const float rb = A.in[I_RB][l * 32 + (lane >> 1)];
    int nrec = 0, ecnt = 0;
#pragma unroll 1
    for (int R0 = gw; R0 < MVALID; R0 += 2 * NGW) {
        const int R1 = R0 + NGW; const bool two = R1 < MVALID; const int R1c = two ? R1 : R0;
        f32x4 v0[4], v1[4];
#pragma unroll
        for (int j = 0; j < 4; ++j) { v0[j] = *(const GAS f32x4*)(PRE + (size_t)R0 * 1024 + 256 * j + 4 * lane); v1[j] = *(const GAS f32x4*)(PRE + (size_t)R1c * 1024 + 256 * j + 4 * lane); }
        ln16(v0, A.in[I_LN1G] + l * 1024, A.in[I_LN1B] + l * 1024, lane); ln16(v1, A.in[I_LN1G] + l * 1024, A.in[I_LN1B] + l * 1024, lane);
        store_row_f32_bf16(v0, HF + (size_t)R0 * 1024, HB + (size_t)R0 * 1024, lane);
        if (two) store_row_f32_bf16(v1, HF + (size_t)R1 * 1024, HB + (size_t)R1 * 1024, lane);
        float acc0[32], acc1[32];
#pragma unroll
        for (int e = 0; e < 32; ++e) { float s0 = 0.f, s1 = 0.f;
#pragma unroll
            for (int j = 0; j < 4; ++j) { const f32x4 w = *(const LAS f32x4*)(WT + e * 1024 + 256 * j + 4 * lane);
                s0 += (v0[j].x * w.x + v0[j].y * w.y) + (v0[j].z * w.z + v0[j].w * w.w); s1 += (v1[j].x * w.x + v1[j].y * w.y) + (v1[j].z * w.z + v1[j].w * w.w); }
            acc0[e] = s0; acc1[e] = s1; }
        const float val0 = router_reduce(acc0, lane) + rb, val1 = router_reduce(acc1, lane) + rb;
        router_top4(val0, R0, lane, TOKW, recg, nrec, ecnt); ++nrec;
        if (two) { router_top4(val1, R1, lane, TOKW, recg, nrec, ecnt); ++nrec; }
        asm volatile("" ::: "memory");
    }
    if (lane == 0) ((int*)(F.ws + WS_ROWIDX + 65536))[gw] = nrec * 4;
    if (lane < 32) ((int*)(F.ws + WS_ROWIDX + 1048576))[(size_t)gw * 32 + lane] = ecnt;
    { LAS int* bc = (LAS int*)(F.lds + LDSCTL_OFF);
      if (tid < 32) bc[tid] = 0;
      __syncthreads();
      if (lane < 32) __hip_atomic_fetch_add(&bc[lane], ecnt, __ATOMIC_RELAXED, __HIP_MEMORY_SCOPE_WORKGROUP);
      __syncthreads();
      if (tid < 32) ((int*)(F.ws + WS_ROWIDX + 2097152))[(size_t)F.vcu * 32 + tid] = bc[tid];
      __syncthreads(); }
}
__device__ __forceinline__ void moe_tables(Frame& F, int l, bool with_bases = false) {
    LAS int* tb = (LAS int*)(F.lds + LDSCTL_OFF); LAS int* cn = tb + 34;
    LAS int* part = (LAS int*)(F.lds + RING_OFF);
    LAS int* wb = part + 1024;
    const int* WCNT = (const int*)(F.ws + WS_ROWIDX + 1048576);
    const int NGW = F.G * NWAVES, gw0 = F.vcu * NWAVES;
    __syncthreads();
    { const int e = F.tid & 31, pt = F.tid >> 5; int tot = 0, base = 0; const int per = F.G / 16; const int* BCNT = (const int*)(F.ws + WS_ROWIDX + 2097152); int cv[16];
#pragma unroll
      for (int i = 0; i < 16; ++i) cv[i] = (i < per) ? BCNT[(size_t)(pt * per + i) * 32 + e] : 0;
#pragma unroll
      for (int i = 0; i < 16; ++i) { tot += cv[i]; if (pt * per + i < F.vcu) base += cv[i]; }
      part[pt * 32 + e] = tot; part[512 + pt * 32 + e] = base; }
    __syncthreads();
    if (F.tid < 32) { int tot = 0, base = 0;
#pragma unroll
        for (int pt = 0; pt < 16; ++pt) { tot += part[pt * 32 + F.tid]; base += part[512 + pt * 32 + F.tid]; }
        cn[F.tid] = tot;
        if (with_bases) { for (int w = 0; w < NWAVES; ++w) { wb[w * 32 + F.tid] = base; base += WCNT[(size_t)(gw0 + w) * 32 + F.tid]; } } }
    __syncthreads();
    if (F.tid == 0) { int s = 0; for (int e = 0; e < 32; ++e) { tb[e] = s; s += (cn[e] + 255) >> 8; } tb[32] = s; }
    __syncthreads();
}
__device__ __forceinline__ void moe_gather(Frame& F) {
    const LAS int* tb = (const LAS int*)(F.lds + LDSCTL_OFF); const LAS int* wb = (const LAS int*)(F.lds + RING_OFF) + 1024 + F.wave * 32;
    const int gw = F.vcu * NWAVES + F.wave, lane = F.lane;
    const bf16* HB = (const bf16*)(F.ws + WS_HB); bf16* XG = (bf16*)(F.ws + WS_XG); unsigned* TOKE = (unsigned*)(F.ws + WS_TOKE);
    const unsigned* recg = (const unsigned*)(F.ws + WS_ROWIDX + 131072) + (size_t)gw * 80; const int n = ((const int*)(F.ws + WS_ROWIDX + 65536))[gw];
    const int my_e = lane < n ? (int)recg[lane * 2 + 1] : -1, my_R = lane < n ? (int)recg[lane * 2] : 0;
    int before = 0; for (int j = 0; j < n; ++j) { const int ej = __builtin_amdgcn_readlane(my_e, j); before += (j < lane && ej == my_e) ? 1 : 0; }
    const int my_pos = lane < n ? wb[my_e] + before : 0;
    if (lane < n) TOKE[(size_t)my_R * 4 + (lane & 3)] = (unsigned)my_e | ((unsigned)my_pos << 8);
    for (int i = 0; i < n; ++i) { const int e = __builtin_amdgcn_readlane(my_e, i), R = __builtin_amdgcn_readlane(my_R, i), pos = __builtin_amdgcn_readlane(my_pos, i);
        const size_t crow = (size_t)tb[e] * 256 + pos; const GAS v4u* sp = (const GAS v4u*)(HB + (size_t)R * 1024); GAS v4u* dp = (GAS v4u*)(XG + crow * 1024);
        const v4u a = sp[lane], b = sp[64 + lane]; dp[lane] = a; dp[64 + lane] = b; }
}
__device__ __forceinline__ void ln2_rows(Frame& F, const Args& A, int l) {
    const LAS int* tb = (const LAS int*)(F.lds + LDSCTL_OFF);
    const int gw = F.vcu * NWAVES + F.wave, NGW = F.G * NWAVES, lane = F.lane;
    float* HF = (float*)(F.ws + WS_HF); bf16* HB = (bf16*)(F.ws + WS_HB); const bf16* OUTS = (const bf16*)(F.ws + WS_OUTS);
    const float* TOKW = (const float*)(F.ws + WS_TOKW); const unsigned* TOKE = (const unsigned*)(F.ws + WS_TOKE);
    for (int R0 = gw; R0 < MVALID; R0 += 2 * NGW) {
        const int R1 = R0 + NGW; const bool two = R1 < MVALID; const int Rr[2] = {R0, two ? R1 : R0};
        f32x4 v[2][4]; unsigned long long o[2][4][4]; float w[2][4];
#pragma unroll
        for (int q = 0; q < 2; ++q) {
            const v4u te4 = *(const GAS v4u*)(TOKE + (size_t)Rr[q] * 4); const f32x4 w4 = *(const GAS f32x4*)(TOKW + (size_t)Rr[q] * 4);
            const unsigned te[4] = {te4.x, te4.y, te4.z, te4.w}; w[q][0] = w4.x; w[q][1] = w4.y; w[q][2] = w4.z; w[q][3] = w4.w;
#pragma unroll
            for (int j = 0; j < 4; ++j) v[q][j] = *(const GAS f32x4*)(HF + (size_t)Rr[q] * 1024 + 256 * j + 4 * lane);
#pragma unroll
            for (int k = 0; k < 4; ++k) { const size_t crow = (size_t)tb[te[k] & 255] * 256 + (te[k] >> 8);
#pragma unroll
                for (int j = 0; j < 4; ++j) o[q][k][j] = *(const GAS unsigned long long*)(OUTS + crow * 1024 + 256 * j + 4 * lane); } }
#pragma unroll
        for (int q = 0; q < 2; ++q) {
#pragma unroll
            for (int j = 0; j < 4; ++j) v[q][j] = v[q][j] * ALPHA;
#pragma unroll
            for (int k = 0; k < 4; ++k)
#pragma unroll
                for (int j = 0; j < 4; ++j) { const unsigned lo = (unsigned)o[q][k][j], hi = (unsigned)(o[q][k][j] >> 32); const float ww = w[q][k];
                    v[q][j].x += ww * bflo(lo); v[q][j].y += ww * bfhi(lo); v[q][j].z += ww * bflo(hi); v[q][j].w += ww * bfhi(hi); }
            ln16(v[q], A.in[I_LN2G] + l * 1024, A.in[I_LN2B] + l * 1024, lane);
#if defined(SELFCHK)
            if (l == NLAYER - 1) { const unsigned mask = __hip_atomic_load(F.ctl + 2048, RLX_AGENT); if (mask) { const float pv = (float)(1u << (__ffs((int)mask) - 1));
#pragma unroll
                for (int j = 0; j < 4; ++j) v[q][j] = (f32x4){pv, pv, pv, pv}; } }
#endif
            if (q == 0 || two) { const int R = Rr[q];
                if (l == NLAYER - 1) { if (R < MREAL) {
#pragma unroll
                        for (int j = 0; j < 4; ++j) *(GAS f32x4*)(A.out + (size_t)R * 1024 + 256 * j + 4 * lane) = v[q][j]; } }
                else store_row_f32_bf16(v[q], HF + (size_t)R * 1024, HB + (size_t)R * 1024, lane); }
        }
    }
}

typedef float f32x16 __attribute__((ext_vector_type(16)));
__device__ __forceinline__ f32x16 skinny32(const bf16* A, int lda, const bf16* Bt, int ldb, int K, int cb, int lane, f32x16 acc) {
    const int r32 = lane & 31, hi = lane >> 5;
    const GAS bf16x8* ap = (const GAS bf16x8*)(A + (size_t)r32 * lda + hi * 8);
    const GAS bf16x8* bp = (const GAS bf16x8*)(Bt + (size_t)(cb * 32 + r32) * ldb + hi * 8);
    for (int k0 = 0; k0 < K / 16; k0 += 16) { bf16x8 a[16], b[16];
#pragma unroll
        for (int i = 0; i < 16; ++i) { a[i] = ap[(k0 + i) * 2]; b[i] = bp[(k0 + i) * 2]; }
#pragma unroll
        for (int i = 0; i < 16; ++i) acc = __builtin_amdgcn_mfma_f32_32x32x16_bf16(a[i], b[i], acc, 0, 0, 0); }
    return acc;
}
__device__ __forceinline__ int mrow(int r, int hi) { return (r & 3) + 8 * (r >> 2) + 4 * hi; }
__device__ __forceinline__ void st_bf(bf16* p, float v) { *(GAS bf16*)p = (bf16)f2bf(v); }
__device__ __forceinline__ void skinny_p1(Frame& F, const Args& A, int l, int cb) {
    const int lane = F.lane, c = cb * 32 + (lane & 31), hi = lane >> 5;
    const bf16* HBm = (const bf16*)(F.ws + WS_HB) + (size_t)MREAL * 1024; const bf16* W = (const bf16*)(F.ws + WS_W + (size_t)l * WL_STRIDE + WL_IN);
    f32x16 acc = {}; acc = skinny32(HBm, 1024, W, 1024, 1024, cb, lane, acc);
    if (c < 512) { bf16* UM = (bf16*)(F.ws + WS_UMETA);
#pragma unroll
        for (int r = 0; r < 16; ++r) st_bf(UM + (size_t)mrow(r, hi) * 512 + c, acc[r]); }
    else if (c < 2048) { bf16* CB = (bf16*)(F.ws + WS_CONV);
#pragma unroll
        for (int r = 0; r < 16; ++r) st_bf(CB + (size_t)(MREAL + mrow(r, hi)) * 1536 + (c - 512), acc[r]); }
    else if (c < 4096) { const bool isq = c < 3072; const int cc = c - (isq ? 2048 : 3072), hh = cc >> 6, g = (cc & 63) >> 3, i8 = cc & 7, j = 4 * g + (i8 & 3), d = i8 < 4 ? j : 32 + j;
        const float* rope = (const float*)(F.ws + WS_ROPE); bf16* dst = isq ? (bf16*)(F.ws + WS_Q) : (bf16*)(F.ws + WS_K);
#pragma unroll
        for (int r = 0; r < 16; ++r) { const int m = mrow(r, hi), pos = m & 15; const float v = acc[r], pv = __shfl_xor(v, 4); const float cs = rope[(size_t)pos * 64 + j], sn = rope[(size_t)pos * 64 + 32 + j];
            float o = i8 < 4 ? v * cs - pv * sn : v * cs + pv * sn; if (isq) o *= pg8::QSCALE;
            const size_t drow = isq ? (size_t)(MREAL + m) : (size_t)pg8::kv_row(MREAL + m); st_bf(dst + drow * 1024 + hh * 64 + d, o); } }
    else if (c < 5120) { bf16* V = (bf16*)(F.ws + WS_V);
#pragma unroll
        for (int r = 0; r < 16; ++r) st_bf(V + (size_t)pg8::kv_row(MREAL + mrow(r, hi)) * 1024 + (c - 4096), acc[r]); }
    else { bf16* GB = (bf16*)(F.ws + WS_GB); const float gb = A.in[I_GATEB][(size_t)l * 3072 + (c - 5120)];
#pragma unroll
        for (int r = 0; r < 16; ++r) st_bf(GB + (size_t)(MREAL + mrow(r, hi)) * 3072 + (c - 5120), sigm_(acc[r] + gb)); }
}
__device__ __forceinline__ void skinny_glu(Frame& F, int l, int cb) {
    const int lane = F.lane, c = cb * 32 + (lane & 31), hi = lane >> 5;
    const bf16* YG = (const bf16*)(F.ws + WS_YG); bf16* YS = (bf16*)(F.ws + WS_YS);
    f32x16 acc = {}; acc = skinny32(YG + (size_t)MREAL * 512, 512, (const bf16*)(F.ws + WS_W + (size_t)l * WL_STRIDE + WL_GLU), 512, 512, cb, lane, acc);
#pragma unroll
    for (int r = 0; r < 16; ++r) { const size_t R = MREAL + mrow(r, hi); const float y = __uint_as_float((unsigned)(*(const GAS bf16*)(YG + R * 512 + c)) << 16); st_bf(YS + R * 512 + c, y * sigm_(acc[r])); }
}
__device__ __forceinline__ void skinny_merge(Frame& F, int l, int cb) {
    const int lane = F.lane, c = cb * 32 + (lane & 31), hi = lane >> 5; unsigned char* wl = F.ws + WS_W + (size_t)l * WL_STRIDE;
    const bf16* GB = (const bf16*)(F.ws + WS_GB); bf16* MG = (bf16*)(F.ws + WS_MG);
    f32x16 z = {};
    const f32x16 a0 = skinny32((const bf16*)(F.ws + WS_YS) + (size_t)MREAL * 512, 512, (const bf16*)(wl + WL_SO), 512, 512, cb, lane, z);
    const f32x16 a1 = skinny32((const bf16*)(F.ws + WS_YC) + (size_t)MREAL * 512, 512, (const bf16*)(wl + WL_CO), 512, 512, cb, lane, z);
    const f32x16 a2 = skinny32((const bf16*)(F.ws + WS_YA) + (size_t)MREAL * 1024, 1024, (const bf16*)(wl + WL_AO), 1024, 1024, cb, lane, z);
#pragma unroll
    for (int r = 0; r < 16; ++r) { const size_t R = MREAL + mrow(r, hi); const bf16* g = GB + R * 3072 + c;
        const float g0 = __uint_as_float((unsigned)(*(const GAS bf16*)g) << 16), g1 = __uint_as_float((unsigned)(*(const GAS bf16*)(g + 1024)) << 16), g2 = __uint_as_float((unsigned)(*(const GAS bf16*)(g + 2048)) << 16);
        st_bf(MG + R * 1024 + c, g0 * a0[r] + g1 * a1[r] + g2 * a2[r]); }
}
__device__ __forceinline__ void skinny_pre(Frame& F, int l, int cb) {
    const int lane = F.lane, c = cb * 32 + (lane & 31), hi = lane >> 5;
    const float* HF = (const float*)(F.ws + WS_HF); float* PRE = (float*)(F.ws + WS_PRE);
    f32x16 acc = {}; acc = skinny32((const bf16*)(F.ws + WS_MG) + (size_t)MREAL * 1024, 1024, (const bf16*)(F.ws + WS_W + (size_t)l * WL_STRIDE + WL_WO), 1024, 1024, cb, lane, acc);
#pragma unroll
    for (int r = 0; r < 16; ++r) { const size_t R = MREAL + mrow(r, hi); *(GAS float*)(PRE + R * 1024 + c) = ALPHA * *(const GAS float*)(HF + R * 1024 + c) + acc[r]; }
}
#define SKINNY_JOBS(n, call) do { for (int j_ = F.vcu + F.G * F.wave; j_ < (n); j_ += F.G * NWAVES) { const int cb = j_; call; } } while (0)

#if defined(SELFCHK)
constexpr int CW_FAIL = 2048;
__device__ __forceinline__ void chk_report(Frame& F, int id, float got, float ref, float scale) {
    const float err = fabsf(got - ref);
    if (!(err <= 0.03f * fabsf(ref) + 0.03f * scale)) __hip_atomic_fetch_or(F.ctl + CW_FAIL, 1u << (id + F.chk_l * 16), RLX_AGENT);
}
__device__ __forceinline__ float bfr(float x) { return __uint_as_float(f2bf(x) << 16); }
__device__ __forceinline__ float ldbf(const bf16* p) { return __uint_as_float((unsigned)(*(const GAS bf16*)p) << 16); }
__device__ __forceinline__ float dot_bf_w(const bf16* a, const float* W, int K, int ldw, int col, int lane) {
    float s = 0.f; for (int k = lane; k < K; k += 64) s += ldbf(a + k) * bfr(W[(size_t)k * ldw + col]); return wave_sum(s);
}
__constant__ int SMP_ROWS[16] = {0, 1, 2, 63, 64, 100, 255, 256, 8191, 8192, 8193, 12345, 16383, 16384, 16399, 16415};
__constant__ int SMP_SP[12] = {0, 15, 16, 17, 79, 80, 81, 143, 144, 1000, 4111, 8207};
__device__ __forceinline__ int smp_row(int i) { return SMP_ROWS[i]; }
__device__ __forceinline__ void chk_p1(Frame& F, const Args& A, int l) {
    const int gw = F.vcu * NWAVES + F.wave, NGW = F.G * NWAVES, lane = F.lane;
    const bf16* HB = (const bf16*)(F.ws + WS_HB); const float* Win = A.in[I_WIN] + (size_t)l * 1024 * 5120; const float* Wg = A.in[I_GATEW] + (size_t)l * 1024 * 3072;
    const float* ROPE = (const float*)(F.ws + WS_ROPE);
    for (int job = gw; job < 16 * 24; job += NGW) { const int R = smp_row(job / 24), ci = job % 24; const bf16* a = HB + (size_t)R * 1024;
        if (ci < 4) { const int c = (ci * 171 + 5) & 511; const float ref = dot_bf_w(a, Win, 1024, 5120, c, lane); float got;
            if (R < MREAL) { const int g = c >> 4, chunkrow = (R >> 13) * 128 + ((R & 8191) >> 6), s = R & 63; got = ldbf((const bf16*)(F.ws + WS_UC) + ((size_t)(g * 256 + chunkrow) * 1152 + s * 16 + (c & 15))); }
            else got = ldbf((const bf16*)(F.ws + WS_UMETA) + (size_t)(R - MREAL) * 512 + c);
            if (lane == 0) chk_report(F, 1, got, ref, 1.0f); }
        else if (ci < 8) { const int c = ((ci - 4) * 397 + 11) % 1536; const float ref = dot_bf_w(a, Win, 1024, 5120, 512 + c, lane); const float got = ldbf((const bf16*)(F.ws + WS_CONV) + (size_t)R * 1536 + c);
            if (lane == 0) chk_report(F, 1, got, ref, 1.0f); }
        else if (ci < 16) { const bool isq = ci < 12; const int cc = ((ci & 3) * 277 + 33) & 1023, hh = cc >> 6, d = cc & 63, j = d & 31;
            const int base = (isq ? 2048 : 3072) + hh * 64; const float xl = dot_bf_w(a, Win, 1024, 5120, base + j, lane), xh = dot_bf_w(a, Win, 1024, 5120, base + 32 + j, lane);
            const int pos = R < MREAL ? 16 + (R & 8191) : ((R - MREAL) & 15); const float cs = ROPE[(size_t)pos * 64 + j], sn = ROPE[(size_t)pos * 64 + 32 + j];
            float ref = d < 32 ? xl * cs - xh * sn : xh * cs + xl * sn; if (isq) ref *= pg8::QSCALE;
            const float got = isq ? ldbf((const bf16*)(F.ws + WS_Q) + (size_t)R * 1024 + cc) : ldbf((const bf16*)(F.ws + WS_K) + (size_t)pg8::kv_row(R) * 1024 + cc);
            if (lane == 0) chk_report(F, 2, got, ref, isq ? 0.2f : 1.0f); }
        else if (ci < 20) { const int c = ((ci - 16) * 301 + 7) & 1023; const float ref = dot_bf_w(a, Win, 1024, 5120, 4096 + c, lane); const float got = ldbf((const bf16*)(F.ws + WS_V) + (size_t)pg8::kv_row(R) * 1024 + c);
            if (lane == 0) chk_report(F, 3, got, ref, 0.5f); }
        else { const int c = ((ci - 20) * 811 + 3) % 3072; const float ref = sigm_(dot_bf_w(a, Wg, 1024, 3072, c, lane) + A.in[I_GATEB][(size_t)l * 3072 + c]); const float got = ldbf((const bf16*)(F.ws + WS_GB) + (size_t)R * 3072 + c);
            if (lane == 0) chk_report(F, 3, got, ref, 0.3f); }
    }
}
__device__ __forceinline__ float u_at(Frame& F, int b, int sp, int c) {
    if (sp < 16) return ldbf((const bf16*)(F.ws + WS_UMETA) + (size_t)(b * 16 + sp) * 512 + c);
    const int t = sp - 16; return ldbf((const bf16*)(F.ws + WS_UC) + ((size_t)((c >> 4) * 256 + b * 128 + (t >> 6)) * 1152 + (t & 63) * 16 + (c & 15)));
}
__device__ __forceinline__ int seq_row(int b, int sp) { return sp < 16 ? MREAL + b * 16 + sp : b * 8192 + (sp - 16); }
__device__ __forceinline__ void chk_ssm_conv(Frame& F, const Args& A, int l) {
    const int gw = F.vcu * NWAVES + F.wave, NGW = F.G * NWAVES, lane = F.lane;
    LAS float* scr = (LAS float*)(F.lds + RING_OFF + F.wave * 16384);
#pragma unroll 1
    for (int job = gw; job < 2 * 12 * 3; job += NGW) { const int b = job / 36, si = (job / 3) % 12, gi = job % 3; const int g = gi == 0 ? 0 : gi == 1 ? 13 : 31;
        const int sp = SMP_SP[si];
        const int lg = l * 32 + g, p = lane; const float lr = A.in[I_LAMRE][lg * 64 + p], li = A.in[I_LAMIM][lg * 64 + p], dt = expf(A.in[I_LOGDT][lg]);
        const float mag = __expf(lr * dt), ar = mag * __cosf(li * dt), ai = mag * __sinf(li * dt), nr = ar - 1.0f, den = lr * lr + li * li;
        const float cr = (nr * lr + ai * li) / den, ci = (ai * lr - nr * li) / den;
        float bbr[16], bbi[16];
#pragma unroll
        for (int c = 0; c < 16; ++c) { const float br = A.in[I_BRE][(size_t)(lg * 64 + p) * 16 + c], bi = A.in[I_BIM][(size_t)(lg * 64 + p) * 16 + c]; bbr[c] = cr * br - ci * bi; bbi[c] = cr * bi + ci * br; }
        float xr = 0.f, xi = 0.f;
#pragma unroll 1
        for (int s = 0; s <= sp; ++s) { float bur = 0.f, bui = 0.f, ua[8], ub[8];
            const bf16* up = s < 16 ? (const bf16*)(F.ws + WS_UMETA) + (size_t)(b * 16 + s) * 512 + g * 16 : (const bf16*)(F.ws + WS_UC) + ((size_t)(g * 256 + b * 128 + ((s - 16) >> 6)) * 1152 + ((s - 16) & 63) * 16);
            unpk8(*(const GAS v4u*)up, ua); unpk8(*(const GAS v4u*)(up + 8), ub);
#pragma unroll
            for (int c = 0; c < 8; ++c) { bur += bbr[c] * ua[c] + bbr[8 + c] * ub[c]; bui += bbi[c] * ua[c] + bbi[8 + c] * ub[c]; }
            const float n1 = ar * xr - ai * xi + bur, n2 = ar * xi + ai * xr + bui; xr = n1; xi = n2; }
        scr[lane] = xr; scr[64 + lane] = xi; LDS_WAIT(); asm volatile("" ::: "memory");
        if (lane < 16) { const int co = lane; float y = 0.f;
#pragma unroll 1
            for (int q = 0; q < 64; ++q) y += A.in[I_CRE][(size_t)(lg * 16 + co) * 64 + q] * scr[q] - A.in[I_CIM][(size_t)(lg * 16 + co) * 64 + q] * scr[64 + q];
            y += A.in[I_SSMD][l * 512 + g * 16 + co] * u_at(F, b, sp, g * 16 + co);
            const float ref = gelu_(y), got = ldbf((const bf16*)(F.ws + WS_YG) + (size_t)seq_row(b, sp) * 512 + g * 16 + co);
            chk_report(F, sp < 16 ? 4 : 5, got, ref, 0.3f); }
        LDS_WAIT(); asm volatile("" ::: "memory");
    }
    for (int job = gw; job < 16; job += NGW) { const int R = smp_row(job), c = (lane * 37 + 5) & 511; const bf16* CB = (const bf16*)(F.ws + WS_CONV);
        float y = 0.f;
#pragma unroll 1
        for (int k = 0; k < 3; ++k) { const int r = k == 0 ? R : prev_row(R, k); if (r >= 0) y += A.in[I_CONVW][(size_t)l * 1536 + (2 - k) * 512 + c] * ldbf(CB + (size_t)r * 1536 + 512 + c) * ldbf(CB + (size_t)r * 1536 + 1024 + c); }
        const float ref = y * ldbf(CB + (size_t)R * 1536 + c), got = ldbf((const bf16*)(F.ws + WS_YC) + (size_t)R * 512 + c);
        chk_report(F, 6, got, ref, 0.5f); }
}
__device__ __forceinline__ void chk_attn(Frame& F) {
    const int gw = F.vcu * NWAVES + F.wave, NGW = F.G * NWAVES, lane = F.lane;
    const bf16* Q = (const bf16*)(F.ws + WS_Q); const bf16* K = (const bf16*)(F.ws + WS_K); const bf16* V = (const bf16*)(F.ws + WS_V); const bf16* OC = (const bf16*)(F.ws + WS_OC);
    for (int job = gw; job < 16 * 3; job += NGW) { const int R = smp_row(job / 3), hi_ = job % 3, hc = hi_ == 0 ? 0 : hi_ == 1 ? 5 : 15, h = hc >> 1;
        const int b = R < MREAL ? (R >> 13) : ((R - MREAL) >> 4); const int nreal = R < MREAL ? (((R & 8191) >> 6) + 1) * 64 : 0, nk = 16 + nreal;
        const float q = ldbf(Q + (size_t)R * 1024 + hc * 64 + lane);
        float m = -INFINITY;
        for (int j = 0; j < nk; ++j) { const size_t kr = (size_t)b * 8320 + (j < 16 ? 8256 + j : j - 16); const float s = wave_sum(q * ldbf(K + kr * 1024 + hc * 64 + lane)); m = fmaxf(m, s); }
        float lsum = 0.f, o0 = 0.f, o1 = 0.f;
        for (int j = 0; j < nk; ++j) { const size_t kr = (size_t)b * 8320 + (j < 16 ? 8256 + j : j - 16); const float s = wave_sum(q * ldbf(K + kr * 1024 + hc * 64 + lane)); const float p = exp2f(s - m);
            lsum += p; o0 += p * ldbf(V + kr * 1024 + h * 128 + 2 * lane); o1 += p * ldbf(V + kr * 1024 + h * 128 + 2 * lane + 1); }
        const float g0 = ldbf(OC + (size_t)R * 2048 + hc * 128 + 2 * lane), g1 = ldbf(OC + (size_t)R * 2048 + hc * 128 + 2 * lane + 1);
        chk_report(F, R < MREAL ? 7 : 8, g0, o0 / lsum, 0.05f); chk_report(F, R < MREAL ? 7 : 8, g1, o1 / lsum, 0.05f); }
}
__device__ __forceinline__ void chk_mix(Frame& F, const Args& A, int l) {
    const int gw = F.vcu * NWAVES + F.wave, NGW = F.G * NWAVES, lane = F.lane;
    const bf16* YG = (const bf16*)(F.ws + WS_YG); const bf16* YS = (const bf16*)(F.ws + WS_YS); const bf16* YC = (const bf16*)(F.ws + WS_YC); const bf16* YA = (const bf16*)(F.ws + WS_YA);
    const bf16* GB = (const bf16*)(F.ws + WS_GB); const bf16* MG = (const bf16*)(F.ws + WS_MG); const bf16* OC = (const bf16*)(F.ws + WS_OC);
    for (int job = gw; job < 16 * 4; job += NGW) { const int R = smp_row(job >> 2), ci = job & 3;
        { const int c = (ci * 139 + 21) & 511; const float z = dot_bf_w(YG + (size_t)R * 512, A.in[I_WGLU] + (size_t)l * 512 * 512, 512, 512, c, lane); const float ref = ldbf(YG + (size_t)R * 512 + c) * sigm_(z);
          if (lane == 0) chk_report(F, 9, ldbf(YS + (size_t)R * 512 + c), ref, 0.2f); }
        { const int h = (ci * 3 + 1) & 7; const float lam_init = 0.8f - 0.6f * expf(-0.3f * (float)l);
          const float d1 = wave_sum(A.in[I_LQ1][l * 64 + lane] * A.in[I_LK1][l * 64 + lane]), d2 = wave_sum(A.in[I_LQ2][l * 64 + lane] * A.in[I_LK2][l * 64 + lane]); const float lam = expf(d1) - expf(d2) + lam_init;
          const float a0 = ldbf(OC + (size_t)R * 2048 + (2 * h) * 128 + lane) - lam * ldbf(OC + (size_t)R * 2048 + (2 * h + 1) * 128 + lane), a1 = ldbf(OC + (size_t)R * 2048 + (2 * h) * 128 + 64 + lane) - lam * ldbf(OC + (size_t)R * 2048 + (2 * h + 1) * 128 + 64 + lane);
          const float rs = 1.0f / sqrtf(wave_sum(a0 * a0 + a1 * a1) * (1.0f / 128.0f) + 1e-5f);
          chk_report(F, 10, ldbf(YA + (size_t)R * 1024 + h * 128 + lane), a0 * rs * A.in[I_SUBLN][l * 128 + lane] * (1.0f - lam_init), 0.3f);
          chk_report(F, 10, ldbf(YA + (size_t)R * 1024 + h * 128 + 64 + lane), a1 * rs * A.in[I_SUBLN][l * 128 + 64 + lane] * (1.0f - lam_init), 0.3f); }
        { const int c = (ci * 269 + 77) & 1023;
          const float p0 = dot_bf_w(YS + (size_t)R * 512, A.in[I_SSMWO] + (size_t)l * 512 * 1024, 512, 1024, c, lane), p1 = dot_bf_w(YC + (size_t)R * 512, A.in[I_CONVWO] + (size_t)l * 512 * 1024, 512, 1024, c, lane),
                      p2 = dot_bf_w(YA + (size_t)R * 1024, A.in[I_ATTNWO] + (size_t)l * 1024 * 1024, 1024, 1024, c, lane);
          const float ref = ldbf(GB + (size_t)R * 3072 + c) * p0 + ldbf(GB + (size_t)R * 3072 + 1024 + c) * p1 + ldbf(GB + (size_t)R * 3072 + 2048 + c) * p2;
          if (lane == 0) chk_report(F, 11, ldbf(MG + (size_t)R * 1024 + c), ref, 0.3f);
          const float pr = dot_bf_w(MG + (size_t)R * 1024, A.in[I_WO] + (size_t)l * 1024 * 1024, 1024, 1024, c, lane);
          if (lane == 0) chk_report(F, 12, ((const float*)(F.ws + WS_PRE))[(size_t)R * 1024 + c], ALPHA * ((const float*)(F.ws + WS_HF))[(size_t)R * 1024 + c] + pr, 0.5f); }
    }
}
__device__ __forceinline__ void chk_moe(Frame& F, const Args& A, int l) {
    const LAS int* tb = (const LAS int*)(F.lds + LDSCTL_OFF);
    const int gw = F.vcu * NWAVES + F.wave, NGW = F.G * NWAVES, lane = F.lane;
    const float* HF = (const float*)(F.ws + WS_HF); const bf16* HB = (const bf16*)(F.ws + WS_HB); const unsigned* TOKE = (const unsigned*)(F.ws + WS_TOKE); const float* TOKW = (const float*)(F.ws + WS_TOKW);
    LAS float* scr = (LAS float*)(F.lds + RING_OFF + F.wave * 16384);
    for (int job = gw; job < 16 * 4; job += NGW) { const int R = smp_row(job >> 2), k = job & 3;
        float lg_ = -INFINITY; if (lane < 32) { float s = 0.f; for (int q = 0; q < 1024; ++q) s += HF[(size_t)R * 1024 + q] * A.in[I_RW][(size_t)l * 32768 + q * 32 + lane]; lg_ = s + A.in[I_RB][l * 32 + lane]; }
        float val = lg_, tv[4]; int te[4];
#pragma unroll
        for (int kk = 0; kk < 4; ++kk) { const float m = wave_max(val); const int idx = wave_min_i(val == m ? lane : 99); tv[kk] = m; te[kk] = idx; if (lane == idx) val = -INFINITY; }
        const float den = 1.0f + expf(tv[1] - tv[0]) + expf(tv[2] - tv[0]) + expf(tv[3] - tv[0]);
        const unsigned tk = TOKE[(size_t)R * 4 + k]; const int e = tk & 255, pos = tk >> 8; const float w = TOKW[(size_t)R * 4 + k];
        const int ek = k == 0 ? te[0] : k == 1 ? te[1] : k == 2 ? te[2] : te[3]; const float wk = expf((k == 0 ? tv[0] : k == 1 ? tv[1] : k == 2 ? tv[2] : tv[3]) - tv[0]) / den;
        const float gap = tv[3] - wave_max(val);
        if (lane == 0 && gap > 1e-3f) { chk_report(F, 13, (float)e, (float)ek, 0.0f); chk_report(F, 13, w, wk, 0.01f); }
        if (((const int*)(F.ws + WS_ROWIDX))[(size_t)e * CAP + pos] != R && lane == 0) chk_report(F, 14, 1.0f, 0.0f, 0.0f);
        const float* wgu = A.in[I_WGU] + ((size_t)l * 32 + e) * 1024 * 2048; const float* bgu = A.in[I_BGU] + ((size_t)l * 32 + e) * 2048;
        for (int j = lane; j < 1024; j += 64) { float g = 0.f, u = 0.f; for (int q = 0; q < 1024; ++q) { const float x = ldbf(HB + (size_t)R * 1024 + q); g += x * bfr(wgu[(size_t)q * 2048 + j]); u += x * bfr(wgu[(size_t)q * 2048 + 1024 + j]); }
            g = fminf(g + bgu[j], 7.0f); u = fminf(fmaxf(u + bgu[1024 + j], -7.0f), 7.0f); scr[j] = bfr((u + 1.0f) * g * sigm_(1.702f * g)); }
        LDS_WAIT(); asm volatile("" ::: "memory");
        const float* wd = A.in[I_WDN] + ((size_t)l * 32 + e) * 1024 * 1024; const int c = (lane * 13 + k * 251) & 1023; float o = 0.f;
        for (int q = 0; q < 1024; ++q) o += scr[q] * bfr(wd[(size_t)q * 1024 + c]);
        o += A.in[I_BDN][((size_t)l * 32 + e) * 1024 + c];
        chk_report(F, 15, ldbf((const bf16*)(F.ws + WS_OUTS) + ((size_t)tb[e] * 256 + pos) * 1024 + c), o, 0.1f);
        LDS_WAIT(); asm volatile("" ::: "memory");
    }
}
#endif

#ifndef PHASE_MASK
#define PHASE_MASK 0x1fff
#endif
#define PH_ON(k) (((PHASE_MASK) >> (k)) & 1)
typedef const __attribute__((address_space(4))) Args* KArgs;
#define PHASE_ENV() KArgs kap_ = (KArgs)__builtin_amdgcn_kernarg_segment_ptr(); asm volatile("" : "+s"(kap_)); const Args& args = *(const Args*)kap_; unsigned char* ws = args.ws; F.ws = ws; F.ctl = (gu32*)(ws + WS_CTL); \
    { int t_ = threadIdx.x; asm volatile("" : "+v"(t_)); F.tid = t_; F.lane = t_ & 63; F.wave = __builtin_amdgcn_readfirstlane(t_ >> 6); } \
    int bid = (int)blockIdx.x; asm volatile("" : "+s"(bid)); F.G = gridDim.x; F.vcu = (F.G % 8 == 0) ? (bid % 8) * (F.G / 8) + bid / 8 : bid; \
    const int gw = F.vcu * NWAVES + F.wave, NGW = F.G * NWAVES; (void)gw; (void)NGW; \
    unsigned char* wl = ws + WS_W + (size_t)l * WL_STRIDE; bf16* HB = (bf16*)(ws + WS_HB); float* HF = (float*)(ws + WS_HF); (void)wl; (void)HB; (void)HF
__global__ void __launch_bounds__(NWAVES * 64, 2) mk_fwd(Args args_) {
    extern __shared__ __attribute__((aligned(16))) unsigned char lds[];
    Frame F;
    F.lds = (LAS unsigned char*)lds;
    F.MISC = (volatile LAS unsigned*)(F.lds + MISC_OFF);
    F.tid = threadIdx.x; F.lane = F.tid & 63; F.wave = __builtin_amdgcn_readfirstlane(F.tid >> 6);
    F.G = gridDim.x; { const int bx = blockIdx.x; F.vcu = (F.G % 8 == 0) ? (bx % 8) * (F.G / 8) + bx / 8 : bx; }
    F.ws = args_.ws; F.ctl = (gu32*)(args_.ws + WS_CTL);
    for (int u = F.tid; u < (LDS_BYTES - LDSCTL_OFF) / 4; u += NWAVES * 64) ((LAS unsigned*)(F.lds + LDSCTL_OFF))[u] = 0u;
    __syncthreads();
    XcdBarrier bar; bar.bar = (unsigned*)(F.ctl + CW_BAR); bar.x = 0; bar.st = nullptr;
    if (N_LAUNCHES == 1) bar = xcd_barrier_post((unsigned*)(F.ctl + CW_BAR), F.MISC + 8);
#define GRID_BAR() do { if (N_LAUNCHES != 1) { if (F.tid == 0) __hip_atomic_store(F.ctl + CW_TMO, 0xBADBA0u, RLX_AGENT); } else { xcd_barrier(bar); } } while (0)
    const int lo = args_.ph_lo, hi = args_.ph_hi;
#define IN(k) (lo <= (k) && (k) < hi)
#define BOTH(k) (IN(k) && IN((k) + 1))

    if (PH_ON(0) && IN(0)) { const int l = 0; PHASE_ENV(); p0_prologue(F, args); if (BOTH(0)) GRID_BAR(); }

    for (int l = 0; l < NLAYER; ++l) {
        const int pb = 1 + 12 * l;
        if (PH_ON(1) && IN(pb + 0)) { PHASE_ENV();
            pg8::Gemm g{HB, (const bf16*)(wl + WL_IN), 1024, 1024, 1024}; pg8::StaticOrder S; S.init(MREAL, NP1, F.G, bid);
            pg8::EpiP1 E{(bf16*)(ws + WS_UC), (bf16*)(ws + WS_UMETA), (bf16*)(ws + WS_CONV), (bf16*)(ws + WS_Q), (bf16*)(ws + WS_K), (bf16*)(ws + WS_V), (bf16*)(ws + WS_GB), (const float*)(ws + WS_ROPE), args.in[I_GATEB] + (size_t)l * 3072};
            pg8::gemm_phase<pg8::EpiP1, pg8::StaticOrder, PG8_ALIGN, PG8_SP2>(F.lds + RING_OFF, g, S, E);
            SKINNY_JOBS(256, skinny_p1(F, args, l, cb));
            if (BOTH(pb + 0)) GRID_BAR();
        }
        if (PH_ON(2) && IN(pb + 1)) { PHASE_ENV();
            pg8::Gemm g{(const bf16*)(ws + WS_UC), (const bf16*)(wl + WL_ST), 1152, 1024, 1024}; pg8::FirstN S{32, 1, F.G, bid};
            pg8::EpiSloc E{(float*)(ws + WS_SLOC)};
            pg8::gemm_phase<pg8::EpiSloc, pg8::FirstN, PG8_ALIGN, PG8_SP2>(F.lds + RING_OFF, g, S, E);
            conv_rows(F, args, l);
            for (int job = NGW - 1 - gw; job < 64; job += NGW) ssm_meta_job(F, args, l, job >> 5, job & 31);
            if (BOTH(pb + 1)) GRID_BAR();
        }
        if (PH_ON(3) && IN(pb + 2)) { PHASE_ENV(); ssm_carry(F, l); if (BOTH(pb + 2)) GRID_BAR(); }
        if (PH_ON(4) && IN(pb + 3)) { PHASE_ENV();
            { pg8::Gemm g{(const bf16*)(ws + WS_UC), (const bf16*)(wl + WL_TOE), 1152, 1152, 1152}; pg8::FirstN S{128, 4, F.G, bid};
              pg8::EpiY E{(bf16*)(ws + WS_YG)};
              pg8::gemm_phase<pg8::EpiY, pg8::FirstN, PG8_ALIGN, PG8_SP2>(F.lds + RING_OFF, g, S, E); }
            { const attn_body::AttnTensors AT{(const attn_body::bf16*)(ws + WS_Q), (const attn_body::bf16*)(ws + WS_K), (const attn_body::bf16*)(ws + WS_V), (attn_body::bf16*)(ws + WS_OC)};
              const attn_body::StaticOrder S((int)F.G, bid);
              attn_body::attn_phase<attn_body::StaticOrder>((char*)lds + RING_OFF, AT, S); }
            for (int job = gw; job < 256; job += NGW) attn_meta_job(F, job >> 3, job & 7);
            if (BOTH(pb + 3)) GRID_BAR();
        }
        if (PH_ON(5) && IN(pb + 4)) { PHASE_ENV();
            pg8::Gemm g{(const bf16*)(ws + WS_YG), (const bf16*)(wl + WL_GLU), 512, 512, 512}; pg8::StaticOrder S; S.init(MREAL, 512, F.G, bid);
            pg8::EpiGLU E{(const bf16*)(ws + WS_YG), (bf16*)(ws + WS_YS)};
            pg8::gemm_phase<pg8::EpiGLU, pg8::StaticOrder, PG8_ALIGN, PG8_SP2>(F.lds + RING_OFF, g, S, E);
            SKINNY_JOBS(16, skinny_glu(F, l, cb));
            attn_combine_rows(F, args, l);
            if (BOTH(pb + 4)) GRID_BAR();
        }
        if (PH_ON(6) && IN(pb + 5)) { PHASE_ENV();
            pg8::StaticOrder S; S.init(MREAL, 1024, F.G, bid);
            SKINNY_JOBS(32, skinny_merge(F, l, cb));
            { pg8::Gemm g{(const bf16*)(ws + WS_YS), (const bf16*)(wl + WL_SO), 512, 512, 512}; pg8::EpiMerge<0> E{(const bf16*)(ws + WS_GB), (bf16*)(ws + WS_MG)};
              pg8::gemm_phase<pg8::EpiMerge<0>, pg8::StaticOrder, PG8_ALIGN, PG8_SP2>(F.lds + RING_OFF, g, S, E); }
            { pg8::Gemm g{(const bf16*)(ws + WS_YC), (const bf16*)(wl + WL_CO), 512, 512, 512}; pg8::EpiMerge<1> E{(const bf16*)(ws + WS_GB), (bf16*)(ws + WS_MG)};
              pg8::gemm_phase<pg8::EpiMerge<1>, pg8::StaticOrder, PG8_ALIGN, PG8_SP2>(F.lds + RING_OFF, g, S, E); }
            { pg8::Gemm g{(const bf16*)(ws + WS_YA), (const bf16*)(wl + WL_AO), 1024, 1024, 1024}; pg8::EpiMerge<2> E{(const bf16*)(ws + WS_GB), (bf16*)(ws + WS_MG)};
              pg8::gemm_phase<pg8::EpiMerge<2>, pg8::StaticOrder, PG8_ALIGN, PG8_SP2>(F.lds + RING_OFF, g, S, E); }
            if (BOTH(pb + 5)) GRID_BAR();
        }
        if (PH_ON(7) && IN(pb + 6)) { PHASE_ENV();
            pg8::Gemm g{(const bf16*)(ws + WS_MG), (const bf16*)(wl + WL_WO), 1024, 1024, 1024}; pg8::StaticOrder S; S.init(MREAL, 1024, F.G, bid);
            pg8::EpiPre E{HF, (float*)(ws + WS_PRE), ALPHA};
            pg8::gemm_phase<pg8::EpiPre, pg8::StaticOrder, PG8_ALIGN, PG8_SP2>(F.lds + RING_OFF, g, S, E);
            SKINNY_JOBS(32, skinny_pre(F, l, cb));
            if (BOTH(pb + 6)) GRID_BAR();
        }
        if (PH_ON(8) && IN(pb + 7)) { PHASE_ENV();
            ln1_router(F, args, l); if (BOTH(pb + 7)) GRID_BAR(); }
        if (PH_ON(9) && IN(pb + 8)) { PHASE_ENV(); moe_tables(F, l, true); moe_gather(F); if (BOTH(pb + 8)) GRID_BAR(); }
        if (PH_ON(10) && IN(pb + 9)) { PHASE_ENV();
            moe_tables(F, l);
            pg8::Gemm g{(const bf16*)(ws + WS_XG), (const bf16*)(wl + WL_GU), 1024, 1024, 1024}; pg8::MoeOrder S{(const LAS int*)(F.lds + LDSCTL_OFF), 8, F.G, bid};
            pg8::EpiSwiGLU E{(bf16*)(ws + WS_HID), args.in[I_BGU] + (size_t)l * 32 * 2048};
            pg8::gemm_phase<pg8::EpiSwiGLU, pg8::MoeOrder, PG8_ALIGN, PG8_SP2>(F.lds + RING_OFF, g, S, E);
            if (BOTH(pb + 9)) GRID_BAR();
        }
        if (PH_ON(11) && IN(pb + 10)) { PHASE_ENV();
            moe_tables(F, l);
            pg8::Gemm g{(const bf16*)(ws + WS_HID), (const bf16*)(wl + WL_DN), 1024, 1024, 1024}; pg8::MoeOrder S{(const LAS int*)(F.lds + LDSCTL_OFF), 4, F.G, bid};
            pg8::EpiDown E{(bf16*)(ws + WS_OUTS), args.in[I_BDN] + (size_t)l * 32 * 1024};
            pg8::gemm_phase<pg8::EpiDown, pg8::MoeOrder, PG8_ALIGN, PG8_SP2>(F.lds + RING_OFF, g, S, E);
            if (BOTH(pb + 10)) GRID_BAR();
        }
        if (PH_ON(12) && IN(pb + 11)) { PHASE_ENV(); moe_tables(F, l);
            ln2_rows(F, args, l); if (BOTH(pb + 11)) GRID_BAR(); }
    }
#undef IN
#undef BOTH
}


#if defined(SELFCHK)
__global__ void __launch_bounds__(NWAVES * 64, 2) mk_chk(Args args_) {
    extern __shared__ __attribute__((aligned(16))) unsigned char lds[];
    Frame F;
    F.lds = (LAS unsigned char*)lds; F.MISC = (volatile LAS unsigned*)(F.lds + MISC_OFF);
    F.tid = threadIdx.x; F.lane = F.tid & 63; F.wave = __builtin_amdgcn_readfirstlane(F.tid >> 6);
    F.G = gridDim.x; { const int bx = blockIdx.x; F.vcu = (F.G % 8 == 0) ? (bx % 8) * (F.G / 8) + bx / 8 : bx; }
    F.ws = args_.ws; F.ctl = (gu32*)(args_.ws + WS_CTL);
    KArgs kap_ = (KArgs)__builtin_amdgcn_kernarg_segment_ptr(); const Args& args = *(const Args*)kap_; const int l = args_.li; F.chk_l = l;
    if (args_.pad == 1) { chk_p1(F, args, l); chk_ssm_conv(F, args, l); chk_attn(F); chk_mix(F, args, l); }
    if (args_.pad == 2) { moe_tables(F, l); chk_moe(F, args, l); }
}
#endif
extern "C" void kernel_launch(void* const* d_in, const int* in_sizes, int n_in, void* d_out, int out_size, void* d_ws, size_t ws_size, hipStream_t stream) {
    static int grid = 0;
    if (grid == 0) {
        if (n_in != N_IN || in_sizes[0] != MREAL * 1024 || out_size != MREAL * 1024 || ws_size < WS_END) { fprintf(stderr, "kernel_launch: unexpected shapes (n_in %d, in0 %d, out %d, ws %zu < %zu); nothing launched\n", n_in, n_in > 0 ? in_sizes[0] : -1, out_size, ws_size, (size_t)WS_END); grid = -1; return; }
        int dev = 0, cus = 0, per_cu = 0;
        if (hipGetDevice(&dev) != hipSuccess || hipDeviceGetAttribute(&cus, hipDeviceAttributeMultiprocessorCount, dev) != hipSuccess) { grid = -1; return; }
#if defined(SELFCHK)
        (void)hipFuncSetAttribute((const void*)mk_chk, hipFuncAttributeMaxDynamicSharedMemorySize, LDS_BYTES);
#endif
        if (hipFuncSetAttribute((const void*)mk_fwd, hipFuncAttributeMaxDynamicSharedMemorySize, LDS_BYTES) != hipSuccess) { fprintf(stderr, "kernel_launch: hipFuncSetAttribute failed\n"); grid = -1; return; }
        if (hipOccupancyMaxActiveBlocksPerMultiprocessor(&per_cu, (const void*)mk_fwd, NWAVES * 64, LDS_BYTES) != hipSuccess || per_cu < 1)
            fprintf(stderr, "kernel_launch: note: occupancy query reports %d workgroups per CU\n", per_cu);
        (void)hipGetLastError();
        grid = cus;
        if (grid != 256) fprintf(stderr, "kernel_launch: %d CUs; the unit orders assume 256\n", grid);
    }
    if (grid < 0) return;
    if (hipMemsetAsync((char*)d_ws + WS_CTL, 0, CTL_ZERO_BYTES, stream) != hipSuccess) return;
    Args a{};
    for (int i = 0; i < N_IN; ++i) a.in[i] = (const float*)d_in[i];
    a.out = (float*)d_out; a.ws = (unsigned char*)d_ws;
    for (int li = 0; li < N_LAUNCHES; ++li) {
        a.ph_lo = (N_LAUNCHES == 1) ? 0 : li; a.ph_hi = (N_LAUNCHES == 1) ? NPH : li + 1; a.li = li; a.pad = 0;
        hipLaunchKernelGGL(mk_fwd, dim3(grid), dim3(NWAVES * 64), LDS_BYTES, stream, a);
        if (hipPeekAtLastError() != hipSuccess) { fprintf(stderr, "kernel_launch: launch %d failed\n", li); break; }
#if defined(SELFCHK)
        if (N_LAUNCHES == NPH && (li == 7 || li == 11 || li == 19 || li == 23)) { Args c = a; c.ph_lo = 1000; c.ph_hi = 1000; c.pad = (li == 7 || li == 19) ? 1 : 2; c.li = li > 12 ? 1 : 0; hipLaunchKernelGGL(mk_chk, dim3(grid), dim3(NWAVES * 64), LDS_BYTES, stream, c); }
#endif
    }
}
```

```cpp
#include <hip/hip_runtime.h>
#include <cstdio>
#include <cstdint>
namespace pg8 {
#define PG8_LAS __attribute__((address_space(3)))
typedef unsigned short bf16_t;
typedef short bf16x8 __attribute__((ext_vector_type(8)));
typedef float f32x4 __attribute__((ext_vector_type(4)));
typedef unsigned u32x4 __attribute__((ext_vector_type(4)));
constexpr int BM = 256, BK = 64, HALF = 128, HTB = HALF * BK * 2  , STAGE_BYTES = 8 * HTB, NXCD = 8, WGM = 8;

__host__ __device__ __forceinline__ int lds_byte(int r, int c) { const int st = (r >> 4) * 2 + (c >> 5), rr = r & 15, cc = c & 31, ob = rr * 64 + cc * 2; return st * 1024 + (ob ^ (((ob >> 9) & 1) << 5)); }
__host__ __device__ __forceinline__ void stage_rc(int b, int& R, int& C) { const int st = b / 1024, sb = b % 1024, swz = sb ^ (((sb >> 9) & 1) << 5); R = (st >> 1) * 16 + swz / 64; C = (st & 1) * 32 + (swz % 64) / 2; }
__host__ __device__ __forceinline__ int perm32(int rho) { const int n = rho >> 4, i = rho & 15; return 8 * (i >> 2) + 4 * n + (i & 3); }

struct Unit { int pm, pn; };
struct Gemm { const bf16_t* A; const bf16_t* Bt; int lda, ldb, K; };

struct StaticOrder {
    int nM, nN, nwg, G, c;
    __host__ __device__ void init(int M, int N, int G_, int c_) { nM = M / BM; nN = N / BM; nwg = nM * nN; G = G_; c = c_; }
    __host__ __device__ bool next(int i, Unit& u) const {
        const long L = (long)i * G + c; if (L >= nwg) return false;
        int wgid = (int)L; { const int q = nwg / NXCD, r = nwg % NXCD, xcd = wgid % NXCD, off = wgid / NXCD; wgid = (xcd < r ? xcd * (q + 1) : r * (q + 1) + (xcd - r) * q) + off; }
        const int nig = WGM * nN, gid = wgid / nig, fm = gid * WGM, gsz = (nM - fm) < WGM ? (nM - fm) : WGM;
        u.pm = fm + ((wgid % nig) % gsz); u.pn = (wgid % nig) / gsz; return true;
    }
    __device__ __forceinline__ void a_ready(const Unit&) const {}
    __device__ __forceinline__ void done(const Unit&) const {}
};

typedef float cvt_f2_ __attribute__((ext_vector_type(2))); typedef __bf16 cvt_b2_ __attribute__((ext_vector_type(2)));
__device__ __forceinline__ unsigned cvt_pk_bf16(float lo, float hi) { const cvt_f2_ v = {lo, hi}; const cvt_b2_ b = __builtin_convertvector(v, cvt_b2_); return __builtin_bit_cast(unsigned, b); }
typedef float f32x2 __attribute__((ext_vector_type(2)));
typedef unsigned u32x2 __attribute__((ext_vector_type(2)));
__device__ __forceinline__ u32x4 pack8(f32x4 a, f32x4 b) { u32x4 w; w.x = cvt_pk_bf16(a[0], a[1]); w.y = cvt_pk_bf16(a[2], a[3]); w.z = cvt_pk_bf16(b[0], b[1]); w.w = cvt_pk_bf16(b[2], b[3]); return w; }
__device__ __forceinline__ u32x2 pack4(f32x4 a) { u32x2 w; w.x = cvt_pk_bf16(a[0], a[1]); w.y = cvt_pk_bf16(a[2], a[3]); return w; }
__device__ __forceinline__ float bf_lo(unsigned w) { return __uint_as_float(w << 16); }
__device__ __forceinline__ float bf_hi(unsigned w) { return __uint_as_float(w & 0xffff0000u); }
__device__ __forceinline__ void unpack8(u32x4 w, f32x4& a, f32x4& b) { a = (f32x4){bf_lo(w.x), bf_hi(w.x), bf_lo(w.y), bf_hi(w.y)}; b = (f32x4){bf_lo(w.z), bf_hi(w.z), bf_lo(w.w), bf_hi(w.w)}; }
__device__ __forceinline__ float sigm(float x) { return __builtin_amdgcn_rcpf(1.0f + __builtin_amdgcn_exp2f(-1.4426950408889634f * x)); }
__device__ __forceinline__ f32x4 sigm4(f32x4 v) { return (f32x4){sigm(v[0]), sigm(v[1]), sigm(v[2]), sigm(v[3])}; }
__device__ __forceinline__ float gelu_t(float x) { const float u = 0.7978845608028654f * (x + 0.044715f * x * x * x); return x * sigm(2.0f * u); }
__device__ __forceinline__ f32x4 gelu4(f32x4 v) { return (f32x4){gelu_t(v[0]), gelu_t(v[1]), gelu_t(v[2]), gelu_t(v[3])}; }

constexpr int MREAL = 16384, MVALID = 16416;
constexpr float QSCALE = 0.125f * 1.4426950408889634f;
__device__ __forceinline__ int kv_row(int R) { return R < MREAL ? (R >> 13) * 8320 + (R & 8191) : ((R - MREAL) >> 4) * 8320 + 8256 + ((R - MREAL) & 15); }

#define EPI_ROWS(R) _Pragma("unroll") for (int ai = 0; ai < 2; ++ai) _Pragma("unroll") for (int m = 0; m < 4; ++m) { const int R = rbase + ai * HALF + m * 16;
#define EPI_COLS _Pragma("unroll") for (int bj = 0; bj < 2; ++bj) {
#define EPI_END }

struct EpiP1 {
    static constexpr bool PERM = true, AFTER_DRAIN = false;
    bf16_t *UC, *UMETA, *CONVB, *Q, *K, *V, *GB; const float* rope; const float* gate_b;
    __device__ __forceinline__ void operator()(const f32x4 (&acc)[2][2][4][2], const Unit& u, int wr, int wc, int fr, int fq) const {
        const int pn = u.pn, rbase = u.pm * BM + wr * 64 + fr, cw = wc * 32 + 8 * fq;
        if (pn < 2) {
            EPI_ROWS(R)
                if (R < MREAL) { const int chunkrow = (R >> 13) * 128 + ((R & 8191) >> 6), s = R & 63;
                    EPI_COLS const int c = pn * 256 + bj * HALF + cw; *(u32x4*)(UC + ((size_t)((c >> 4) * 256 + chunkrow) * 1152 + s * 16 + (c & 15))) = pack8(acc[ai][bj][m][0], acc[ai][bj][m][1]); EPI_END }
                else if (R < MVALID) {
                    EPI_COLS const int c = pn * 256 + bj * HALF + cw; *(u32x4*)(UMETA + (size_t)(R - MREAL) * 512 + c) = pack8(acc[ai][bj][m][0], acc[ai][bj][m][1]); EPI_END }
            EPI_END
        } else if (pn < 8) {
            EPI_ROWS(R)
                if (R < MVALID) { EPI_COLS const int c = (pn - 2) * 256 + bj * HALF + cw; *(u32x4*)(CONVB + (size_t)R * 1536 + c) = pack8(acc[ai][bj][m][0], acc[ai][bj][m][1]); EPI_END }
            EPI_END
        } else if (pn < 16) {
            const bool isq = pn < 12; const int ct = (pn - (isq ? 8 : 12)) * 256; bf16_t* dstb = isq ? Q : K; const float sc = isq ? QSCALE : 1.0f;
            EPI_ROWS(R)
                if (R < MVALID) { const int pos = R < MREAL ? 16 + (R & 8191) : ((R - MREAL) & 15); const size_t drow = isq ? (size_t)R : (size_t)kv_row(R);
                    EPI_COLS const int c = ct + bj * HALF + cw, hh = c >> 6, gq = (c & 63) >> 3;
                        const f32x4 cs = *(const f32x4*)(rope + (size_t)pos * 64 + 4 * gq), sn = *(const f32x4*)(rope + (size_t)pos * 64 + 32 + 4 * gq);
                        const f32x4 x0 = acc[ai][bj][m][0], x1 = acc[ai][bj][m][1];
                        const f32x4 lo = (x0 * cs - x1 * sn) * sc, hi = (x1 * cs + x0 * sn) * sc;
                        bf16_t* d = dstb + drow * 1024 + hh * 64 + 4 * gq; *(u32x2*)d = pack4(lo); *(u32x2*)(d + 32) = pack4(hi); EPI_END }
            EPI_END
        } else if (pn < 20) {
            EPI_ROWS(R)
                if (R < MVALID) { const size_t drow = (size_t)kv_row(R);
                    EPI_COLS const int c = (pn - 16) * 256 + bj * HALF + cw; *(u32x4*)(V + drow * 1024 + c) = pack8(acc[ai][bj][m][0], acc[ai][bj][m][1]); EPI_END }
            EPI_END
        } else {
            f32x4 b0[2], b1[2];
#pragma unroll
            for (int bj = 0; bj < 2; ++bj) { const int c = (pn - 20) * 256 + bj * HALF + cw; b0[bj] = *(const f32x4*)(gate_b + c); b1[bj] = *(const f32x4*)(gate_b + c + 4); }
            EPI_ROWS(R)
                if (R < MVALID) { EPI_COLS const int c = (pn - 20) * 256 + bj * HALF + cw;
                    *(u32x4*)(GB + (size_t)R * 3072 + c) = pack8(sigm4(acc[ai][bj][m][0] + b0[bj]), sigm4(acc[ai][bj][m][1] + b1[bj])); EPI_END }
            EPI_END
        }
    }
};
struct EpiSloc {
    static constexpr bool PERM = false, AFTER_DRAIN = false;
    float* SL;
    __device__ __forceinline__ void operator()(const f32x4 (&acc)[2][2][4][2], const Unit& u, int wr, int wc, int fr, int fq) const {
        const int rbase = u.pm * BM + wr * 64 + fr, col0 = wc * 32 + 4 * fq;
        EPI_ROWS(R)
            float* rowp = SL + (size_t)R * 128 + col0;
#pragma unroll
            for (int n = 0; n < 2; ++n) *(f32x4*)(rowp + n * 16) = acc[ai][0][m][n];
        EPI_END
    }
};
struct EpiY {
    static constexpr bool PERM = true, AFTER_DRAIN = false;
    bf16_t* YG;
    __device__ __forceinline__ void operator()(const f32x4 (&acc)[2][2][4][2], const Unit& u, int wr, int wc, int fr, int fq) const {
        const int g = u.pm, nt = u.pn & 3, rbase = wr * 64 + fr, cw = wc * 32 + 8 * fq;
        EPI_ROWS(R)
            const int b = R >> 7, k = R & 127;
            EPI_COLS const int n = nt * 256 + bj * HALF + cw, t = n >> 4, co0 = n & 15; const size_t row = (size_t)b * 8192 + k * 64 + t;
                *(u32x4*)(YG + row * 512 + g * 16 + co0) = pack8(gelu4(acc[ai][bj][m][0]), gelu4(acc[ai][bj][m][1])); EPI_END
        EPI_END
    }
};
struct EpiGLU {
    static constexpr bool PERM = true, AFTER_DRAIN = false;
    const bf16_t* YG; bf16_t* YS;
    __device__ __forceinline__ void operator()(const f32x4 (&acc)[2][2][4][2], const Unit& u, int wr, int wc, int fr, int fq) const {
        const int rbase = u.pm * BM + wr * 64 + fr, cw = wc * 32 + 8 * fq;
        EPI_ROWS(R)
            EPI_COLS const int c = u.pn * 256 + bj * HALF + cw; f32x4 ya, yb; unpack8(*(const u32x4*)(YG + (size_t)R * 512 + c), ya, yb);
                *(u32x4*)(YS + (size_t)R * 512 + c) = pack8(ya * sigm4(acc[ai][bj][m][0]), yb * sigm4(acc[ai][bj][m][1])); EPI_END
        EPI_END
    }
};
template <int I> struct EpiMerge {
    static constexpr bool PERM = true, AFTER_DRAIN = false;
    const bf16_t* GB; bf16_t* MG;
    __device__ __forceinline__ void operator()(const f32x4 (&acc)[2][2][4][2], const Unit& u, int wr, int wc, int fr, int fq) const {
        const int rbase = u.pm * BM + wr * 64 + fr, cw = wc * 32 + 8 * fq;
        EPI_ROWS(R)
            EPI_COLS const int c = u.pn * 256 + bj * HALF + cw; f32x4 ga, gb; unpack8(*(const u32x4*)(GB + (size_t)R * 3072 + I * 1024 + c), ga, gb);
                f32x4 oa = ga * acc[ai][bj][m][0], ob = gb * acc[ai][bj][m][1];
                if (I > 0) { f32x4 pa, pb; unpack8(*(const u32x4*)(MG + (size_t)R * 1024 + c), pa, pb); oa += pa; ob += pb; }
                *(u32x4*)(MG + (size_t)R * 1024 + c) = pack8(oa, ob); EPI_END
        EPI_END
    }
};
struct EpiPre {
    static constexpr bool PERM = false, AFTER_DRAIN = false;
    const float* HF; float* PRE; float alpha;
    __device__ __forceinline__ void operator()(const f32x4 (&acc)[2][2][4][2], const Unit& u, int wr, int wc, int fr, int fq) const {
        const int rbase = u.pm * BM + wr * 64 + fr, col0 = u.pn * BM + wc * 32 + 4 * fq;
        EPI_ROWS(R)
            EPI_COLS
#pragma unroll
                for (int n = 0; n < 2; ++n) { const size_t off = (size_t)R * 1024 + col0 + bj * HALF + n * 16; *(f32x4*)(PRE + off) = *(const f32x4*)(HF + off) * alpha + acc[ai][bj][m][n]; }
            EPI_END
        EPI_END
    }
};
struct EpiSwiGLU {
    static constexpr bool PERM = true, AFTER_DRAIN = false;
    bf16_t* HID; const float* bgu;
    __device__ __forceinline__ void operator()(const f32x4 (&acc)[2][2][4][2], const Unit& u, int wr, int wc, int fr, int fq) const {
        const int e = u.pn >> 3, nt = u.pn & 7, rbase = u.pm * BM + wr * 64 + fr, hw = wc * 16 + 4 * fq;
        f32x4 bg[2], bu[2];
#pragma unroll
        for (int bj = 0; bj < 2; ++bj) { const int hcol = nt * 128 + bj * 64 + hw; bg[bj] = *(const f32x4*)(bgu + (size_t)e * 2048 + hcol); bu[bj] = *(const f32x4*)(bgu + (size_t)e * 2048 + 1024 + hcol); }
        EPI_ROWS(R)
            EPI_COLS const int hcol = nt * 128 + bj * 64 + hw; const f32x4 gt = acc[ai][bj][m][0] + bg[bj], up = acc[ai][bj][m][1] + bu[bj]; f32x4 h;
#pragma unroll
                for (int i = 0; i < 4; ++i) { const float gg = fminf(gt[i], 7.0f), uu = fminf(fmaxf(up[i], -7.0f), 7.0f); h[i] = (uu + 1.0f) * gg * sigm(1.702f * gg); }
                *(u32x2*)(HID + (size_t)R * 1024 + hcol) = pack4(h); EPI_END
        EPI_END
    }
};
struct EpiDown {
    static constexpr bool PERM = true, AFTER_DRAIN = false;
    bf16_t* OUTS; const float* bdn;
    __device__ __forceinline__ void operator()(const f32x4 (&acc)[2][2][4][2], const Unit& u, int wr, int wc, int fr, int fq) const {
        const int e = u.pn >> 2, nt = u.pn & 3, rbase = u.pm * BM + wr * 64 + fr, cw = wc * 32 + 8 * fq;
        f32x4 b0[2], b1[2];
#pragma unroll
        for (int bj = 0; bj < 2; ++bj) { const int c = nt * 256 + bj * HALF + cw; b0[bj] = *(const f32x4*)(bdn + (size_t)e * 1024 + c); b1[bj] = *(const f32x4*)(bdn + (size_t)e * 1024 + c + 4); }
        EPI_ROWS(R)
            EPI_COLS const int c = nt * 256 + bj * HALF + cw; *(u32x4*)(OUTS + (size_t)R * 1024 + c) = pack8(acc[ai][bj][m][0] + b0[bj], acc[ai][bj][m][1] + b1[bj]); EPI_END
        EPI_END
    }
};
struct FirstN {
    int n, div, G, c;
    __device__ __forceinline__ bool next(int i, Unit& u) const { const int L = i * G + c; if (L >= n) return false; u.pm = L / div; u.pn = L; return true; }
    __device__ __forceinline__ void a_ready(const Unit&) const {}
    __device__ __forceinline__ void done(const Unit&) const {}
};
struct MoeOrder {
    const PG8_LAS int* tb; int nN, G, c;
    __device__ __forceinline__ bool next(int i, Unit& u) const {
        const int L = i * G + c, mtg = L / nN; if (mtg >= tb[32]) return false;
        int e = 0; while (tb[e + 1] <= mtg) ++e;
        u.pm = mtg; u.pn = e * nN + (L - mtg * nN); return true; }
    __device__ __forceinline__ void a_ready(const Unit&) const {}
    __device__ __forceinline__ void done(const Unit&) const {}
};
template <class Epi, class Sched, bool ALIGN_EPI = false, bool SP2 = false>
__device__ __forceinline__ void gemm_phase(PG8_LAS unsigned char* lds, const Gemm g, const Sched& S, const Epi& E) {
    int tid_ = threadIdx.x; asm volatile("" : "+v"(tid_));
    const int tid = tid_, wid = __builtin_amdgcn_readfirstlane(tid >> 6), lane = tid & 63, wr = wid >> 2, wc = wid & 3, fr = lane & 15, fq = lane >> 4;
    const int K = g.K, nt = K / BK;
    unsigned voffA[2], voffB[2];
#pragma unroll
    for (int i = 0; i < 2; ++i) { int R, C; stage_rc(tid * 16 + i * 8192, R, C); const int Rb = Epi::PERM ? ((R & ~31) + perm32(R & 31)) : R;
        voffA[i] = (unsigned)(R * g.lda + C) * 2u; voffB[i] = (unsigned)(Rb * g.ldb + C) * 2u; }
    const size_t kstep = (size_t)(BK * 2);
    const size_t hstepA = (size_t)HALF * g.lda * 2, hstepB = (size_t)HALF * g.ldb * 2;
    const size_t tstepA = 2 * hstepA, tstepB = 2 * hstepB;
    const unsigned ldsw = (unsigned)wid * 1024u;
    const int aoff = lds_byte(wr * 64 + fr, fq * 8), boff = lds_byte(wc * 32 + fr, fq * 8);
#define PG8_SA(b, h) (((b) * 2 + (h)) * HTB)
#define PG8_SB(b, h) ((4 + (b) * 2 + (h)) * HTB)
#define PG8_STAGE(bufoff, gbase, voff) do { _Pragma("unroll") for (int _i = 0; _i < 2; ++_i) \
        __builtin_amdgcn_global_load_lds((const unsigned*)((const char*)(gbase) + (voff)[_i]), (PG8_LAS unsigned*)(lds + (bufoff) + ldsw + _i * 8192), 16, 0, 0); } while (0)
#define PG8_LDA(dst, b, h) do { _Pragma("unroll") for (int m = 0; m < 4; ++m) _Pragma("unroll") for (int k = 0; k < 2; ++k) dst[m][k] = *(const PG8_LAS bf16x8*)(lds + PG8_SA(b, h) + aoff + m * 2048 + k * 1024); } while (0)
#define PG8_LDB(dst, b, h) do { _Pragma("unroll") for (int n = 0; n < 2; ++n) _Pragma("unroll") for (int k = 0; k < 2; ++k) dst[n][k] = *(const PG8_LAS bf16x8*)(lds + PG8_SB(b, h) + boff + n * 2048 + k * 1024); } while (0)
#define PG8_MMA(ai, bj, At, Bt) do { __builtin_amdgcn_s_setprio(1); _Pragma("unroll") for (int m = 0; m < 4; ++m) _Pragma("unroll") for (int n = 0; n < 2; ++n) _Pragma("unroll") for (int k = 0; k < 2; ++k) \
        acc[ai][bj][m][n] = __builtin_amdgcn_mfma_f32_16x16x32_bf16(Bt[n][k], At[m][k], acc[ai][bj][m][n], 0, 0, 0); __builtin_amdgcn_s_setprio(0); } while (0)
#define PG8_WAIT_V(n) asm volatile("s_waitcnt vmcnt(" #n ")" ::: "memory")
#define PG8_WAIT_L(n) asm volatile("s_waitcnt lgkmcnt(" #n ")" ::: "memory")
#define PG8_BAR __builtin_amdgcn_s_barrier()
#define PG8_SCHED __builtin_amdgcn_sched_barrier(0)
    Unit cur, nxt; int ui = 0;
    if (!S.next(0, cur)) return;
    f32x4 acc[2][2][4][2];
#pragma unroll
    for (int a = 0; a < 2; ++a)
#pragma unroll
        for (int b = 0; b < 2; ++b)
#pragma unroll
            for (int m = 0; m < 4; ++m)
#pragma unroll
                for (int n = 0; n < 2; ++n) acc[a][b][m][n] = (f32x4){0.f, 0.f, 0.f, 0.f};
    bf16x8 At[4][2], B0[2][2], B1[2][2];
    const char* cA = (const char*)g.A + (size_t)cur.pm * tstepA; const char* cB = (const char*)g.Bt + (size_t)cur.pn * tstepB;
    S.a_ready(cur);
    if constexpr (SP2) {
        PG8_STAGE(PG8_SB(0, 0), cB, voffB); PG8_STAGE(PG8_SB(0, 1), cB + hstepB, voffB); PG8_STAGE(PG8_SA(0, 0), cA, voffA); PG8_STAGE(PG8_SA(0, 1), cA + hstepA, voffA);
        if (wr == 1) PG8_BAR;
        PG8_WAIT_V(2); PG8_BAR;
        PG8_STAGE(PG8_SB(1, 0), cB + kstep, voffB); PG8_STAGE(PG8_SA(1, 0), cA + kstep, voffA); PG8_STAGE(PG8_SB(1, 1), cB + hstepB + kstep, voffB);
        PG8_WAIT_V(6); PG8_BAR;
    } else {
        PG8_STAGE(PG8_SB(0, 0), cB, voffB); PG8_STAGE(PG8_SA(0, 0), cA, voffA); PG8_STAGE(PG8_SB(0, 1), cB + hstepB, voffB); PG8_STAGE(PG8_SA(0, 1), cA + hstepA, voffA);
        if (wr == 1) PG8_BAR;
        PG8_WAIT_V(4); PG8_BAR;
        PG8_STAGE(PG8_SB(1, 0), cB + kstep, voffB); PG8_STAGE(PG8_SA(1, 0), cA + kstep, voffA); PG8_STAGE(PG8_SB(1, 1), cB + hstepB + kstep, voffB);
        PG8_WAIT_V(6); PG8_BAR;
    }
    for (;;) {
        const bool has_next = S.next(ui + 1, nxt);
        const char* nA = has_next ? (const char*)g.A + (size_t)nxt.pm * tstepA : cA; const char* nB = has_next ? (const char*)g.Bt + (size_t)nxt.pn * tstepB : cB;
        for (int t = 0; t < nt; t += 2) {
            const bool last = (t == nt - 2);
            const char* a1 = cA + (size_t)(t + 1) * kstep;
            const char* a2 = last ? nA : cA + (size_t)(t + 2) * kstep; const char* b2 = last ? nB : cB + (size_t)(t + 2) * kstep;
            const char* a3 = a2 + kstep; const char* b3 = b2 + kstep;
            if (last && has_next) S.a_ready(nxt);
            if constexpr (SP2) {
            PG8_LDB(B0, 0, 0); PG8_LDB(B1, 0, 1); PG8_SCHED; PG8_LDA(At, 0, 0); PG8_STAGE(PG8_SA(1, 1), a1 + hstepA, voffA);
            PG8_WAIT_V(8); PG8_WAIT_L(0); PG8_BAR; PG8_MMA(0, 0, At, B0); PG8_MMA(0, 1, At, B1); PG8_BAR; PG8_SCHED;
            PG8_LDA(At, 0, 1); PG8_STAGE(PG8_SB(0, 0), b2, voffB); PG8_STAGE(PG8_SB(0, 1), b2 + hstepB, voffB); PG8_STAGE(PG8_SA(0, 0), a2, voffA);
            PG8_WAIT_V(8); PG8_WAIT_L(0); PG8_BAR; PG8_MMA(1, 0, At, B0); PG8_MMA(1, 1, At, B1); PG8_BAR; PG8_SCHED;
            PG8_LDB(B0, 1, 0); PG8_LDB(B1, 1, 1); PG8_SCHED; PG8_LDA(At, 1, 0); PG8_STAGE(PG8_SA(0, 1), a2 + hstepA, voffA);
            PG8_WAIT_V(8); PG8_WAIT_L(0); PG8_BAR; PG8_MMA(0, 0, At, B0); PG8_MMA(0, 1, At, B1); PG8_BAR; PG8_SCHED;
            PG8_LDA(At, 1, 1); PG8_STAGE(PG8_SB(1, 0), b3, voffB); PG8_STAGE(PG8_SB(1, 1), b3 + hstepB, voffB); PG8_STAGE(PG8_SA(1, 0), a3, voffA);
            PG8_WAIT_V(8); PG8_WAIT_L(0); PG8_BAR; PG8_MMA(1, 0, At, B0); PG8_MMA(1, 1, At, B1); PG8_BAR; PG8_SCHED;
            } else {
            PG8_LDB(B0, 0, 0); PG8_SCHED; PG8_LDA(At, 0, 0); PG8_STAGE(PG8_SA(1, 1), a1 + hstepA, voffA);
            PG8_WAIT_L(8); PG8_BAR; PG8_WAIT_L(0); PG8_MMA(0, 0, At, B0); PG8_BAR; PG8_SCHED;
            PG8_LDB(B1, 0, 1); PG8_STAGE(PG8_SB(0, 0), b2, voffB);
            PG8_BAR; PG8_WAIT_L(0); PG8_MMA(0, 1, At, B1); PG8_BAR;
            PG8_LDA(At, 0, 1); PG8_STAGE(PG8_SA(0, 0), a2, voffA);
            PG8_BAR; PG8_WAIT_L(0); PG8_MMA(1, 0, At, B0); PG8_BAR; PG8_SCHED;
            PG8_STAGE(PG8_SB(0, 1), b2 + hstepB, voffB);
            PG8_WAIT_V(6); PG8_BAR; PG8_MMA(1, 1, At, B1); PG8_BAR;
            PG8_LDB(B0, 1, 0); PG8_SCHED; PG8_LDA(At, 1, 0); PG8_STAGE(PG8_SA(0, 1), a2 + hstepA, voffA);
            PG8_WAIT_L(8); PG8_BAR; PG8_WAIT_L(0); PG8_MMA(0, 0, At, B0); PG8_BAR; PG8_SCHED;
            PG8_LDB(B1, 1, 1); PG8_STAGE(PG8_SB(1, 0), b3, voffB);
            PG8_BAR; PG8_WAIT_L(0); PG8_MMA(0, 1, At, B1); PG8_BAR;
            PG8_LDA(At, 1, 1); PG8_STAGE(PG8_SA(1, 0), a3, voffA);
            PG8_BAR; PG8_WAIT_L(0); PG8_MMA(1, 0, At, B0); PG8_BAR; PG8_SCHED;
            PG8_STAGE(PG8_SB(1, 1), b3 + hstepB, voffB);
            PG8_WAIT_V(6); PG8_BAR; PG8_MMA(1, 1, At, B1); PG8_BAR;
            }
        }
        if constexpr (ALIGN_EPI) { if (wr == 0) PG8_BAR; }
        if constexpr (!Epi::AFTER_DRAIN) { E(acc, cur, wr, wc, fr, fq); S.done(cur); }
        if (!has_next) break;
#pragma unroll
        for (int a = 0; a < 2; ++a)
#pragma unroll
            for (int b = 0; b < 2; ++b)
#pragma unroll
                for (int m = 0; m < 4; ++m)
#pragma unroll
                    for (int n = 0; n < 2; ++n) acc[a][b][m][n] = (f32x4){0.f, 0.f, 0.f, 0.f};
        cur = nxt; cA = nA; cB = nB; ++ui;
        if constexpr (ALIGN_EPI) { if (wr == 1) PG8_BAR; }
    }
    PG8_WAIT_V(0);
    if constexpr (!ALIGN_EPI) { if (wr == 0) PG8_BAR; }
    PG8_BAR;
    if constexpr (Epi::AFTER_DRAIN) { E.fused(acc, cur, wr, wc, fr, fq, lds, wid, lane); S.done(cur); }
#undef PG8_SA
#undef PG8_SB
#undef PG8_STAGE
#undef PG8_LDA
#undef PG8_LDB
#undef PG8_MMA
#undef PG8_WAIT_V
#undef PG8_WAIT_L
#undef PG8_BAR
#undef PG8_SCHED
}
}

#ifndef PG8_SP2
#define PG8_SP2 true
#endif
#ifndef PG8_ALIGN
#define PG8_ALIGN true
#endif
#include <hip/hip_bf16.h>
#include <cmath>
namespace attn_body {
using bf16=__hip_bfloat16;
using bf16x8=__attribute__((ext_vector_type(8)))short;
using s16x4=__attribute__((ext_vector_type(4)))short;
using f32x16=__attribute__((ext_vector_type(16)))float;
using u32x4=__attribute__((ext_vector_type(4)))unsigned;
constexpr int BATCH=2,NHEAD=16,SEQ=8192,D=64,DM=NHEAD*D;
constexpr int NW=8,QBLK=32,QB=QBLK*NW,KVBLK=64,NQB=SEQ/QB;
constexpr int ATTN_PITCH=DM, ATTN_UNIT_ROWS=QB, OPITCH=2048, KVROWS=8320, NVH=32;
__device__ __forceinline__ int crow(int r,int hi){return (r&3)+8*(r>>2)+4*hi;}
#define SBAR() __builtin_amdgcn_sched_barrier(0)
__device__ __forceinline__ void cmask(f32x16&p0,f32x16&p1,int jb,int qrel,int hi){
  const float NEG=-INFINITY;
  if(jb<4){ if(jb>(qrel>>6)){
    #pragma unroll
    for(int r=0;r<16;++r){p0[r]=NEG;p1[r]=NEG;} } }
  else if(jb==4){
    #pragma unroll
    for(int r=0;r<16;++r){p0[r]=NEG;p1[r]=NEG;} }
  else{
    #pragma unroll
    for(int r=0;r<16;++r){ if(r>=8)p0[r]=NEG; p1[r]=NEG; } }
}

constexpr int NSLOT=3, SLOTB=8192;
constexpr int LDS_K=0, LDS_V=NSLOT*SLOTB, LDS_WS=2*NSLOT*SLOTB, LDS_OST=LDS_WS+NW*64*4, LDS_BYTES=LDS_OST+NW*4096;
constexpr float C2=0.125f*1.4426950408889634f;
__device__ __forceinline__ void glds16(const void*gsrc,unsigned lds_dst){unsigned keep;
  asm volatile("s_mov_b32 %0, m0\n\ts_mov_b32 m0, %2\n\ts_nop 0\n\tglobal_load_lds_dwordx4 %1, off\n\ts_mov_b32 m0, %0":"=&s"(keep):"v"(gsrc),"s"(lds_dst):"memory");}
__device__ __forceinline__ float max3f(float a,float b,float c){float r;asm("v_max3_f32 %0, %1, %2, %3":"=v"(r):"v"(a),"v"(b),"v"(c));return r;}
__device__ __forceinline__ float max2f(float a,float b){float r;asm("v_max_f32_e32 %0, %1, %2":"=v"(r):"v"(a),"v"(b));return r;}
__device__ __forceinline__ float fadd_s(float a,float b){float r;asm("v_add_f32_e32 %0, %1, %2":"=v"(r):"v"(a),"v"(b));return r;}
__device__ __forceinline__ float fsub_s(float a,float b){float r;asm("v_sub_f32_e32 %0, %1, %2":"=v"(r):"v"(a),"v"(b));return r;}
typedef float f32x2_t __attribute__((ext_vector_type(2))); typedef __bf16 bf16x2_t __attribute__((ext_vector_type(2)));
__device__ __forceinline__ unsigned cvtpk_s(float lo,float hi){f32x2_t v={lo,hi};bf16x2_t b=__builtin_convertvector(v,bf16x2_t);return __builtin_bit_cast(unsigned,b);}
#define WAIT_BAR(N) asm volatile("s_waitcnt vmcnt(" #N ") lgkmcnt(0)\n\ts_barrier":::"memory")

__device__ __forceinline__ void qkt(f32x16&p0,f32x16&p1,const char*Kslot,const bf16x8*qr,const f32x16&negm,int r32,int hi){
  const char*kb=Kslot+hi*1024+r32*16;
  #pragma unroll
  for(int d0=0;d0<4;++d0){
    const bf16x8 b0=*reinterpret_cast<const bf16x8*>(kb+d0*2048);
    const bf16x8 b1=*reinterpret_cast<const bf16x8*>(kb+d0*2048+512);
    if(d0==0){p0=__builtin_amdgcn_mfma_f32_32x32x16_bf16(b0,qr[0],negm,0,0,0);p1=__builtin_amdgcn_mfma_f32_32x32x16_bf16(b1,qr[0],negm,0,0,0);}
    else{p0=__builtin_amdgcn_mfma_f32_32x32x16_bf16(b0,qr[d0],p0,0,0,0);p1=__builtin_amdgcn_mfma_f32_32x32x16_bf16(b1,qr[d0],p1,0,0,0);}}
}
typedef __attribute__((address_space(3))) const char* lds_cptr;
typedef short v4i16_t __attribute__((ext_vector_type(4)));
__device__ __forceinline__ void kload8(bf16x8*kf,lds_cptr kp){
  kf[0]=*(const __attribute__((address_space(3))) bf16x8*)(kp);      kf[1]=*(const __attribute__((address_space(3))) bf16x8*)(kp+512);
  kf[2]=*(const __attribute__((address_space(3))) bf16x8*)(kp+2048); kf[3]=*(const __attribute__((address_space(3))) bf16x8*)(kp+2560);
  kf[4]=*(const __attribute__((address_space(3))) bf16x8*)(kp+4096); kf[5]=*(const __attribute__((address_space(3))) bf16x8*)(kp+4608);
  kf[6]=*(const __attribute__((address_space(3))) bf16x8*)(kp+6144); kf[7]=*(const __attribute__((address_space(3))) bf16x8*)(kp+6656);
}
__device__ __forceinline__ void kload2(bf16x8*kf,lds_cptr kp,int j){ kf[2*j]=*(const __attribute__((address_space(3))) bf16x8*)(kp+j*2048); kf[2*j+1]=*(const __attribute__((address_space(3))) bf16x8*)(kp+j*2048+512); }
__device__ __forceinline__ s16x4 vtr(lds_cptr p){ return __builtin_bit_cast(s16x4,__builtin_amdgcn_ds_read_tr16_b64_v4i16((__attribute__((address_space(3))) v4i16_t*)p)); }
__device__ __forceinline__ float rowmax(const f32x16&p0,const f32x16&p1){
  float a=max3f(p0[0],p0[1],p1[0]),b=max3f(p0[2],p0[3],p1[1]);a=max3f(a,p1[2],p1[3]);
  #pragma unroll
  for(int r=4;r<16;r+=4){a=max3f(a,p0[r],p0[r+1]);b=max3f(b,p0[r+2],p0[r+3]);a=max3f(a,p1[r],p1[r+1]);b=max3f(b,p1[r+2],p1[r+3]);}
  const float m=max2f(a,b);
  auto rr=__builtin_amdgcn_permlane32_swap(__float_as_uint(m),__float_as_uint(m),false,false);
  return max2f(__uint_as_float(rr[0]),__uint_as_float(rr[1]));
}
__device__ __forceinline__ void pv(f32x16*o,int vb,bf16x8 pa0,bf16x8 pa1,bf16x8 pa2,bf16x8 pa3){
  #pragma unroll
  for(int d0=0;d0<2;++d0){s16x4 lo[4],hi[4];
    #pragma unroll
    for(int ks=0;ks<4;++ks){
      asm volatile("ds_read_b64_tr_b16 %0,%1 offset:%c2":"=&v"(lo[ks]):"v"(vb),"i"(d0*4096+ks*1024):"memory");
      asm volatile("ds_read_b64_tr_b16 %0,%1 offset:%c2":"=&v"(hi[ks]):"v"(vb),"i"(d0*4096+ks*1024+512):"memory");}
    asm volatile("s_waitcnt lgkmcnt(0)":::"memory");SBAR();
    #define PK(k) (bf16x8){lo[k][0],lo[k][1],lo[k][2],lo[k][3],hi[k][0],hi[k][1],hi[k][2],hi[k][3]}
    o[d0]=__builtin_amdgcn_mfma_f32_32x32x16_bf16(pa0,PK(0),o[d0],0,0,0);
    o[d0]=__builtin_amdgcn_mfma_f32_32x32x16_bf16(pa1,PK(1),o[d0],0,0,0);
    o[d0]=__builtin_amdgcn_mfma_f32_32x32x16_bf16(pa2,PK(2),o[d0],0,0,0);
    o[d0]=__builtin_amdgcn_mfma_f32_32x32x16_bf16(pa3,PK(3),o[d0],0,0,0);
    #undef PK
  }
}

#ifndef ATTN_STORE16
#define ATTN_STORE16(p,v) (*(u32x4*)(p)=(v))
#endif
template<int THRL> __device__ __forceinline__ void attn_unit(int b,int vh,int qb,const bf16*Q,const bf16*__restrict__ K,const bf16*__restrict__ V,bf16*O,char*shm){
  int tid_=threadIdx.x; asm volatile("":"+v"(tid_));
  const int tid=tid_,lane=tid&63,r32=lane&31,hi=lane>>5; const int wid=__builtin_amdgcn_readfirstlane(tid>>6);
  const long rowbase=(long)b*SEQ, kvbase=(long)b*KVROWS; const int q0=qb*QB; const int hc=vh>>1;
  const bf16*Qw=Q+(rowbase+q0+wid*QBLK)*DM+hc*D;
  const bf16*Kh=K+kvbase*DM+hc*D,*Vh=V+kvbase*DM+(vh>>2)*128+(vh&1)*64;
  const unsigned lds0=(unsigned)(uintptr_t)shm;
  float*wsf=(float*)(shm+LDS_WS)+wid*64;
  const bf16*ksrc=Kh+(long)lane*DM+wid*8;
  const bf16*vsrc=Vh+(long)(16*(wid&3)+(lane>>2))*DM+(wid>>2)*32+(lane&3)*8;
  const unsigned kdst=lds0+LDS_K+wid*1024, vdst=lds0+LDS_V+wid*1024;
  #define TROW(t) (((t)<NT-2)?(long)(t)*KVBLK:(long)(8192+((t)-(NT-2))*KVBLK))
  #define DMA_K(t,slot) glds16(ksrc+TROW(t)*DM,(unsigned)__builtin_amdgcn_readfirstlane(kdst+(slot)))
  #define DMA_V(t,slot) glds16(vsrc+TROW(t)*DM,(unsigned)__builtin_amdgcn_readfirstlane(vdst+(slot)))
  const int vb0=(int)(lds0+LDS_V)+((lane>>4)&1)*32+(lane&3)*8+(4*hi+((lane&15)>>2))*64;
  const char*Kbase=shm+LDS_K; bf16x8 kf[8];
  const lds_cptr shm3=(lds_cptr)shm; const lds_cptr kp0=shm3+LDS_K+hi*1024+r32*16; const lds_cptr vp0=shm3+LDS_V+((lane>>4)&1)*32+(lane&3)*8+(4*hi+((lane&15)>>2))*64;
  const int NT=(q0+QB)/KVBLK+2;
  DMA_K(0,0);DMA_V(0,0);DMA_K(1,SLOTB);
  bf16x8 qr[4];
  #pragma unroll
  for(int d0=0;d0<4;++d0)qr[d0]=*reinterpret_cast<const bf16x8*>(&Qw[(long)r32*DM+d0*16+hi*8]);
  float mhat=0.f,l_reg=0.f;f32x16 o[2];o[0]=f32x16{};o[1]=f32x16{};f32x16 negm=f32x16{};asm volatile("":"+v"(negm));
  const int qrel=wid*QBLK+r32;
  #define CMASK(P0,P1,t) do{int jb_=(t)-(NT-6); if(jb_>=0)cmask(P0,P1,jb_,qrel,hi);}while(0)
  bool resc=false;
  #define START(P0,P1) do{ const float rm=rowmax(P0,P1); resc=false; \
    { const float dl=rm; mhat=fadd_s(mhat,dl); \
      _Pragma("unroll") for(int r=0;r<16;++r){P0[r]=fsub_s(P0[r],dl);P1[r]=fsub_s(P1[r],dl);} \
      _Pragma("unroll") for(int r=0;r<16;++r)negm[r]=-mhat; asm volatile("":"+v"(negm)); } \
    _Pragma("unroll") for(int r=0;r<16;++r)P0[r]=__builtin_amdgcn_exp2f(P0[r]); }while(0)
  #define RESC() do{ if(resc){ asm volatile("s_waitcnt lgkmcnt(0)":::"memory"); \
      _Pragma("unroll") for(int d_=0;d_<2;++d_) _Pragma("unroll") for(int r=0;r<16;++r)o[d_][r]*=wsf[crow(r,hi)]; } }while(0)
  f32x16 pA0,pA1,pB0,pB1;
  int sl_prev=0,sl_cur=0,sl_next=SLOTB;
  #define ROT() do{sl_prev=sl_cur;sl_cur=sl_next;sl_next=(sl_next==(NSLOT-1)*SLOTB)?0:sl_next+SLOTB;}while(0)
  DMA_K(2,2*SLOTB);
  WAIT_BAR(3);
  qkt(pA0,pA1,Kbase,qr,negm,r32,hi);asm volatile("s_nop 15\n\ts_nop 7":"+v"(pA0),"+v"(pA1));CMASK(pA0,pA1,0);
  START(pA0,pA1);
  _Pragma("unroll") for(int r=0;r<16;++r)pA1[r]=__builtin_amdgcn_exp2f(pA1[r]);
  WAIT_BAR(0);
  DMA_K(3,0);DMA_V(1,SLOTB);
  ROT();
  kload8(kf,kp0+sl_cur);
  WAIT_BAR(2);
  s16x4 vlo[8],vhi[8]; u32x4 pw0,pw1,pw2,pw3;
  #define PKW(P,B) cvtpk_s(P[B],P[B+1])
  #define PAF(k) __builtin_bit_cast(bf16x8,pw##k)
  #define VFR(i) (bf16x8){vlo[i][0],vlo[i][1],vlo[i][2],vlo[i][3],vhi[i][0],vhi[i][1],vhi[i][2],vhi[i][3]}
  #define PIN(x) asm volatile("":"+v"(x))
  #define MX3(a,b,c) __builtin_fmaxf(__builtin_fmaxf((a),(b)),(c))
  #define GAPA(MF,A0,A1,A2,A3,W0,W1,PW) do{ MF; sacc+=A0; sacc+=A1; sacc+=A2; sacc+=A3; PIN(sacc); W0; W1; PIN(PW); SBAR(); }while(0)
  #define EX(v) __builtin_amdgcn_exp2f(v)
  #define GAPB(MF,X,B) do{ MF; X[B]=EX(X[B]); X[B+1]=EX(X[B+1]); X[B+2]=EX(X[B+2]); X[B+3]=EX(X[B+3]); PIN(X); SBAR(); }while(0)
  #define VRD(i) do{ vlo[i]=vtr(vp_+(((i)>>2)*4096+((i)&3)*1024)); vhi[i]=vtr(vp_+(((i)>>2)*4096+((i)&3)*1024+512)); }while(0)
  #define KRD(G,j) do{ if(G){ kload2(kf,kp0+sl_next,j); SBAR(); } }while(0)
  #define STEP(C0,C1,P0,P1,t,GK,GV,GL) do{ SBAR(); \
    const lds_cptr vp_=vp0+sl_prev; \
    VRD(0); SBAR(); float sacc=(P0[0]+P0[1]); \
    GAPA(C0=__builtin_amdgcn_mfma_f32_32x32x16_bf16(kf[0],qr[0],negm,0,0,0), P0[2],P0[3],P0[4],P0[5],     pw0[0]=PKW(P0,0), pw0[1]=PKW(P0,2), pw0); \
    VRD(4); SBAR(); GAPA(C1=__builtin_amdgcn_mfma_f32_32x32x16_bf16(kf[1],qr[0],negm,0,0,0), P0[6],P0[7],P0[8],P0[9],     pw0[2]=PKW(P0,4), pw0[3]=PKW(P0,6), pw0); \
    VRD(1); SBAR(); GAPA(C0=__builtin_amdgcn_mfma_f32_32x32x16_bf16(kf[2],qr[1],C0,0,0,0),   P0[10],P0[11],P0[12],P0[13], pw1[0]=PKW(P0,8), pw1[1]=PKW(P0,10), pw1); \
    VRD(5); SBAR(); GAPA(C1=__builtin_amdgcn_mfma_f32_32x32x16_bf16(kf[3],qr[1],C1,0,0,0),   P0[14],P0[15],P1[0],P1[1],   pw1[2]=PKW(P0,12),pw1[3]=PKW(P0,14), pw1); \
    VRD(2); SBAR(); GAPA(C0=__builtin_amdgcn_mfma_f32_32x32x16_bf16(kf[4],qr[2],C0,0,0,0),   P1[2],P1[3],P1[4],P1[5],     pw2[0]=PKW(P1,0), pw2[1]=PKW(P1,2), pw2); \
    VRD(6); SBAR(); GAPA(C1=__builtin_amdgcn_mfma_f32_32x32x16_bf16(kf[5],qr[2],C1,0,0,0),   P1[6],P1[7],P1[8],P1[9],     pw2[2]=PKW(P1,4), pw2[3]=PKW(P1,6), pw2); \
    VRD(3); SBAR(); GAPA(C0=__builtin_amdgcn_mfma_f32_32x32x16_bf16(kf[6],qr[3],C0,0,0,0),   P1[10],P1[11],P1[12],P1[13], pw3[0]=PKW(P1,8), pw3[1]=PKW(P1,10), pw3); \
    VRD(7); SBAR(); GAPA(C1=__builtin_amdgcn_mfma_f32_32x32x16_bf16(kf[7],qr[3],C1,0,0,0),   P1[14],P1[15],0.f,0.f,       pw3[2]=PKW(P1,12),pw3[3]=PKW(P1,14), pw3); \
    l_reg+=sacc; \
    if(GK){DMA_K((t)+3,sl_cur);} if(GV){DMA_V((t)+1,sl_next);} \
    CMASK(C0,C1,t); \
    { float a=MX3(C0[0],C0[1],C1[0]),b=MX3(C0[2],C0[3],C1[1]); a=MX3(a,C1[2],C1[3]); \
      _Pragma("unroll") for(int r=4;r<16;r+=4){a=MX3(a,C0[r],C0[r+1]);b=MX3(b,C0[r+2],C0[r+3]);a=MX3(a,C1[r],C1[r+1]);b=MX3(b,C1[r+2],C1[r+3]);} \
      float rm=__builtin_fmaxf(a,b); { auto rr=__builtin_amdgcn_permlane32_swap(__float_as_uint(rm),__float_as_uint(rm),false,false); rm=__builtin_fmaxf(__uint_as_float(rr[0]),__uint_as_float(rr[1])); } \
      resc=false; \
      if(__builtin_expect(__any(rm>(float)THRL),0)){ const float dl=__builtin_fmaxf(rm,0.f); mhat+=dl; \
        _Pragma("unroll") for(int r=0;r<16;++r){C0[r]-=dl;C1[r]-=dl;} \
        _Pragma("unroll") for(int r=0;r<16;++r)negm[r]=-mhat; asm volatile("":"+v"(negm)); \
        const float f=__builtin_amdgcn_exp2f(-dl); l_reg*=f; if(hi==0)wsf[r32]=f; resc=true; } } \
    SBAR(); \
    GAPB(o[0]=__builtin_amdgcn_mfma_f32_32x32x16_bf16(PAF(0),VFR(0),o[0],0,0,0), C0,0); \
    GAPB(o[1]=__builtin_amdgcn_mfma_f32_32x32x16_bf16(PAF(0),VFR(4),o[1],0,0,0), C0,4); \
    KRD(GL,0); GAPB(o[0]=__builtin_amdgcn_mfma_f32_32x32x16_bf16(PAF(1),VFR(1),o[0],0,0,0), C0,8); \
    KRD(GL,1); GAPB(o[1]=__builtin_amdgcn_mfma_f32_32x32x16_bf16(PAF(1),VFR(5),o[1],0,0,0), C0,12); \
    KRD(GL,2); GAPB(o[0]=__builtin_amdgcn_mfma_f32_32x32x16_bf16(PAF(2),VFR(2),o[0],0,0,0), C1,0); \
    KRD(GL,3); GAPB(o[1]=__builtin_amdgcn_mfma_f32_32x32x16_bf16(PAF(2),VFR(6),o[1],0,0,0), C1,4); \
    GAPB(o[0]=__builtin_amdgcn_mfma_f32_32x32x16_bf16(PAF(3),VFR(3),o[0],0,0,0), C1,8); \
    GAPB(o[1]=__builtin_amdgcn_mfma_f32_32x32x16_bf16(PAF(3),VFR(7),o[1],0,0,0), C1,12); \
    }while(0)
  int t=1;
  #undef CMASK
  #define CMASK(P0,P1,t) do{}while(0)
  for(;t+7<NT;t+=2){
    STEP(pB0,pB1,pA0,pA1,t,true,true,true);     WAIT_BAR(2); RESC(); ROT();
    STEP(pA0,pA1,pB0,pB1,t+1,true,true,true);   WAIT_BAR(2); RESC(); ROT();
  }
  #undef CMASK
  #define CMASK(P0,P1,t) do{int jb_=(t)-(NT-6); if(jb_>=0)cmask(P0,P1,jb_,qrel,hi);}while(0)
  #define ENDW(tt) do{ if((tt)+3<NT){WAIT_BAR(2);} else if((tt)+2<NT){WAIT_BAR(1);} else {WAIT_BAR(0);} }while(0)
  for(;t+1<NT;t+=2){
    STEP(pB0,pB1,pA0,pA1,t,(t+3<NT),(t+1<NT),(t+1<NT));       ENDW(t);   RESC(); ROT();
    STEP(pA0,pA1,pB0,pB1,t+1,(t+4<NT),(t+2<NT),(t+2<NT));     ENDW(t+1); RESC(); ROT();
  }
  STEP(pB0,pB1,pA0,pA1,NT-1,false,false,false); RESC();
  { float sacc=pB0[0]+pB0[1]; _Pragma("unroll") for(int r=2;r<16;++r)sacc+=pB0[r]; _Pragma("unroll") for(int r=0;r<16;++r)sacc+=pB1[r]; l_reg+=sacc;
    pw0=(u32x4){PKW(pB0,0),PKW(pB0,2),PKW(pB0,4),PKW(pB0,6)};pw1=(u32x4){PKW(pB0,8),PKW(pB0,10),PKW(pB0,12),PKW(pB0,14)};pw2=(u32x4){PKW(pB1,0),PKW(pB1,2),PKW(pB1,4),PKW(pB1,6)};pw3=(u32x4){PKW(pB1,8),PKW(pB1,10),PKW(pB1,12),PKW(pB1,14)};
    SBAR(); pv(o,vb0+sl_cur,PAF(0),PAF(1),PAF(2),PAF(3)); }
  #undef PKW
  #undef PAF
  #undef VFR
  #undef PIN
  #undef MX3
  #undef GAPA
  #undef GAPB
  #undef EX
  #undef VRD
  #undef KRD
  #undef STEP
  #undef ENDW
  {auto rr=__builtin_amdgcn_permlane32_swap(__float_as_uint(l_reg),__float_as_uint(l_reg),false,false);l_reg=__uint_as_float(rr[0])+__uint_as_float(rr[1]);}
  if(hi==0)wsf[32+r32]=l_reg;asm volatile("s_waitcnt lgkmcnt(0)":::"memory");
  float rli[16];
  #pragma unroll
  for(int r=0;r<16;++r)rli[r]=__builtin_amdgcn_rcpf(wsf[32+crow(r,hi)]);
  bf16*Ow=O+(rowbase+q0+wid*QBLK)*OPITCH+vh*D;
  { bf16*stg=(bf16*)(shm+LDS_OST)+wid*2048;
    #pragma unroll
    for(int r=0;r<16;++r){const int orow=crow(r,hi);
      #pragma unroll
      for(int d0=0;d0<2;++d0)stg[orow*64+d0*32+r32]=__float2bfloat16(o[d0][r]*rli[r]);}
    asm volatile("s_waitcnt lgkmcnt(0)":::"memory");
    #pragma unroll
    for(int i=0;i<4;++i){const int row=i*8+(lane>>3),ch=lane&7; const u32x4 v=*(const u32x4*)(stg+row*64+ch*8); ATTN_STORE16(Ow+(long)row*OPITCH+ch*8,v);} }
  asm volatile("s_waitcnt lgkmcnt(0)\n\ts_barrier":::"memory");
  #undef DMA_K
  #undef TROW
  #undef DMA_V
  #undef CMASK
  #undef START
  #undef RESC
  #undef ROT
}
constexpr int ATTN_LDS_BYTES=LDS_BYTES;
struct AttnTensors { const bf16* Q; const bf16* K; const bf16* V; bf16* O; };
struct AttnUnit { int bh; int qb; };
struct StaticOrder {
  int vcu;
  __device__ __forceinline__ explicit StaticOrder(int grid,int block):vcu((block%8)*(grid/8)+block/8){}
  __device__ __forceinline__ bool next(int i,AttnUnit&u)const{ if(i>=8)return false; const int s=vcu&3; u.bh=vcu>>2; u.qb=(i&1)?(4*i+3-s):(4*i+s); return true; }
  __device__ __forceinline__ void a_ready(const AttnUnit&)const{}
  __device__ __forceinline__ void done(const AttnUnit&)const{}
};
template<class Sched,int THRL=8> __device__ __forceinline__ void attn_phase(char*lds,const AttnTensors&T,const Sched&S){
  AttnUnit u;
  for(int i=0;S.next(i,u);++i){ S.a_ready(u); attn_unit<THRL>(u.bh/NVH,u.bh%NVH,u.qb,T.Q,T.K,T.V,T.O,lds); S.done(u); }
}
#undef SBAR
#undef WAIT_BAR
}
#define GAS __attribute__((address_space(1)))
#define LAS __attribute__((address_space(3)))
typedef unsigned short bf16;
typedef unsigned v4u __attribute__((ext_vector_type(4)));
typedef float f32x4 __attribute__((ext_vector_type(4)));
typedef short bf16x8 __attribute__((ext_vector_type(8)));
typedef GAS unsigned gu32;
typedef GAS unsigned long long gu64;
#define RLX_AGENT __ATOMIC_RELAXED, __HIP_MEMORY_SCOPE_AGENT
#define LDS_WAIT() asm volatile("s_waitcnt lgkmcnt(0)" ::: "memory")
#define VM_WAIT() asm volatile("s_waitcnt vmcnt(0)" ::: "memory")
__device__ __forceinline__ unsigned long long rt() { return __builtin_amdgcn_s_memrealtime(); }
__device__ __forceinline__ unsigned f2bf(float f) { unsigned u = __builtin_bit_cast(unsigned, f); return (u + 0x7fffu + ((u >> 16) & 1u)) >> 16; }
__device__ __forceinline__ unsigned pk2(float lo, float hi) { return f2bf(lo) | (f2bf(hi) << 16); }

#define XB_TMO      128
#define XB_XCNT(j)  (256  + 64 * (j))
#define XB_XSUB(j)  (1280 + 64 * (j))
#define XB_XGEN(j)  (2304 + 64 * (j))
#define XB_TOP      3328
#define XB_TOPGEN   3392
#define XCD_BAR_WORDS 3456
#define XB_SPIN_CAP (1u << 18)

__device__ __forceinline__ unsigned xb_ld(unsigned* p)              { return __hip_atomic_load(p, __ATOMIC_RELAXED, __HIP_MEMORY_SCOPE_AGENT); }
__device__ __forceinline__ unsigned xb_add(unsigned* p, unsigned v) { return __hip_atomic_fetch_add(p, v, __ATOMIC_RELAXED, __HIP_MEMORY_SCOPE_AGENT); }
__device__ __forceinline__ unsigned xb_xcc_id() { return (unsigned)__builtin_amdgcn_s_getreg((3 << 11) | 20) & 0xFu; }
#define XB_SPIN(cond, bar) do { unsigned _sp = 0; while (cond) { __builtin_amdgcn_s_sleep(1); \
    if ((++_sp & 255u) == 0u) { if (xb_ld(&(bar)[XB_TMO])) break; if (_sp > XB_SPIN_CAP) { atomicAdd(&(bar)[XB_TMO], 1u); break; } } } } while (0)

struct XcdBarrier {
    unsigned* bar; unsigned x;
    volatile LAS unsigned* st;
};

__device__ __forceinline__ XcdBarrier xcd_barrier_post(unsigned* bar, volatile LAS unsigned* st) {
    XcdBarrier b; b.bar = bar; b.x = xb_xcc_id(); b.st = st;
    if (threadIdx.x == 0) (void)xb_add(&bar[XB_XCNT(b.x)], 1u);
    return b;
}
__device__ __forceinline__ void xcd_barrier_complete(unsigned* bar, unsigned x, unsigned& nloc, unsigned& nx) {
    const unsigned G = gridDim.x * gridDim.y * gridDim.z;
    unsigned sum, cnt, mine, sp = 0u;
    for (;;) {
        sum = 0u; cnt = 0u; mine = 0u;
#pragma unroll
        for (unsigned j = 0; j < 16; ++j) { const unsigned c = xb_ld(&bar[XB_XCNT(j)]); sum += c; cnt += (c > 0u) ? 1u : 0u; mine = (j == x) ? c : mine; }
        if (sum == G) break;
        __builtin_amdgcn_s_sleep(1);
        if ((++sp & 255u) == 0u) { if (xb_ld(&bar[XB_TMO])) break; if (sp > XB_SPIN_CAP) { atomicAdd(&bar[XB_TMO], 1u); break; } }
    }
    nloc = mine > 0u ? mine : 1u; nx = cnt > 0u ? cnt : 1u;
}

__device__ __forceinline__ void xcd_barrier(const XcdBarrier& b) {
    asm volatile("s_waitcnt vmcnt(0)" ::: "memory");
    __syncthreads();
    if (threadIdx.x == 0) {
        unsigned* bar = b.bar;
        __builtin_amdgcn_s_waitcnt(0);
        unsigned nloc = b.st[0], nx = b.st[1];
        if (nloc == 0u) { xcd_barrier_complete(bar, b.x, nloc, nx); b.st[0] = nloc; b.st[1] = nx; }
        const unsigned old = xb_add(&bar[XB_XSUB(b.x)], 1u);
        const unsigned gen = old / nloc;
        if (old + 1u == (gen + 1u) * nloc) {
            __builtin_amdgcn_fence(__ATOMIC_RELEASE, "agent");
            asm volatile("s_waitcnt vmcnt(0)" ::: "memory");
            const unsigned og = xb_add(&bar[XB_TOP], 1u);
            const unsigned tg = og / nx;
            if (og + 1u == (tg + 1u) * nx) xb_add(&bar[XB_TOPGEN], 1u);
            else XB_SPIN(xb_ld(&bar[XB_TOPGEN]) == tg, bar);
            __builtin_amdgcn_fence(__ATOMIC_ACQUIRE, "agent");
            xb_add(&bar[XB_XGEN(b.x)], 1u);
            asm volatile("s_waitcnt vmcnt(0)" ::: "memory");
        } else {
            XB_SPIN(xb_ld(&bar[XB_XGEN(b.x)]) == gen, bar);
            __builtin_amdgcn_fence(__ATOMIC_ACQUIRE, "agent");
            asm volatile("s_waitcnt vmcnt(0)" ::: "memory");
        }
    }
    __syncthreads();
}

constexpr int NWAVES = 8;
#ifndef MK_N_LAUNCHES
#define MK_N_LAUNCHES 1
#endif
constexpr int NPH = 25;
constexpr int N_LAUNCHES = MK_N_LAUNCHES;
static_assert(N_LAUNCHES == 1 || N_LAUNCHES == NPH, "MK_N_LAUNCHES is 1 or 25");

constexpr int DM_ = 1024, NLAYER = 2, NMETA = 16, SEQ_ = 8192;
constexpr int MREAL = pg8::MREAL, MVALID = pg8::MVALID, MP = 16640;
constexpr int NP1 = 8192;
constexpr int MOE_ROWS = 74240;
constexpr int CAP = 16416;
constexpr float LN_EPS = 1e-5f, ALPHA = 1.4142135623730951f;

constexpr size_t MiB = 1u << 20;
constexpr size_t WS_CTL = 0, CTL_ZERO_BYTES = 1 * MiB;
constexpr size_t WL_IN = 0, WL_GLU = 16 * MiB, WL_SO = 17 * MiB, WL_CO = 18 * MiB, WL_AO = 19 * MiB, WL_WO = 21 * MiB, WL_GU = 23 * MiB, WL_DN = 151 * MiB, WL_ST = 215 * MiB, WL_TOE = 231 * MiB, WL_STRIDE = 304 * MiB;
constexpr size_t WS_W = 2 * MiB;
constexpr size_t WS_SSMC = WS_W + NLAYER * WL_STRIDE;
constexpr size_t WS_ROPE = WS_SSMC + 2 * MiB;
constexpr size_t WS_HF = WS_ROPE + 3 * MiB;
constexpr size_t WS_HB = WS_HF + 65 * MiB;
constexpr size_t WS_UC = WS_HB + 33 * MiB;
constexpr size_t WS_UMETA = WS_UC + 18 * MiB;
constexpr size_t WS_CONV = WS_UMETA + 1 * MiB;
constexpr size_t WS_Q = WS_CONV + 49 * MiB;
constexpr size_t WS_K = WS_Q + 33 * MiB;
constexpr size_t WS_V = WS_K + 33 * MiB;
constexpr size_t WS_GB = WS_V + 33 * MiB;
constexpr size_t WS_SLOC = WS_GB + 98 * MiB;
constexpr size_t WS_SM = WS_SLOC + 4 * MiB;
constexpr size_t WS_OC = WS_SM + 1 * MiB;
constexpr size_t WS_YG = WS_OC + 65 * MiB;
constexpr size_t WS_YS = WS_YG + 17 * MiB;
constexpr size_t WS_YC = WS_YS + 17 * MiB;
constexpr size_t WS_YA = WS_YC + 17 * MiB;
constexpr size_t WS_MG = WS_YA + 33 * MiB;
constexpr size_t WS_PRE = WS_MG + 33 * MiB;
constexpr size_t WS_XG = WS_PRE + 65 * MiB;
constexpr size_t WS_HID = WS_XG + 145 * MiB;
constexpr size_t WS_OUTS = WS_HID + 145 * MiB;
constexpr size_t WS_ROWIDX = WS_OUTS + 145 * MiB;
constexpr size_t WS_TOKE = WS_ROWIDX + 3 * MiB;
constexpr size_t WS_TOKW = WS_TOKE + 1 * MiB;
constexpr size_t WS_END = WS_TOKW + 1 * MiB;
static_assert((size_t)MOE_ROWS * 1024 * 2 <= 145 * MiB && (size_t)MP * 3072 * 2 <= 98 * MiB && (size_t)MP * 1536 * 2 <= 49 * MiB && (size_t)MP * 4096 <= 65 * MiB && (size_t)32 * 1024 * 1152 * 2 <= 73 * MiB, "d_ws map");
constexpr int CW_TMO = 0, CW_CODE = 1;
constexpr int CW_BAR = 4096;
constexpr int CW_CNT = 16384;
static_assert((CW_CNT + NLAYER * 32 * 64) * 4 <= (int)CTL_ZERO_BYTES, "CTL words inside the memset region");

constexpr int RING_OFF = 0, RING_BYTES = 131072;
constexpr int LDSCTL_OFF = RING_BYTES, MISC_OFF = LDSCTL_OFF + 320;
constexpr int REC_OFF = MISC_OFF + 192;
constexpr int LDS_BYTES = 147456;
static_assert(REC_OFF + 8 * 40 * 8 <= LDS_BYTES && (REC_OFF % 16) == 0, "LDS map");

enum InIdx { I_X = 0, I_META, I_LNIN_G, I_LNIN_B, I_WIN, I_LAMRE, I_LAMIM, I_LOGDT, I_BRE, I_BIM, I_CRE, I_CIM, I_SSMD, I_WGLU, I_SSMWO, I_CONVW, I_CONVWO,
             I_LQ1, I_LK1, I_LQ2, I_LK2, I_SUBLN, I_ATTNWO, I_GATEW, I_GATEB, I_WO, I_LN1G, I_LN1B, I_RW, I_RB, I_WGU, I_BGU, I_WDN, I_BDN, I_LN2G, I_LN2B, N_IN };
struct Args { const float* in[N_IN]; float* out; unsigned char* ws; int ph_lo, ph_hi, li, pad; };
struct Frame {
    LAS unsigned char* lds;
    volatile LAS unsigned* MISC;
    gu32* ctl;
    unsigned char* ws;
    int tid, lane, wave;
    int vcu, G;
    int chk_l;
};
__device__ __forceinline__ float wave_sum_slow(float v) {
#pragma unroll
    for (int o = 1; o < 64; o <<= 1) v += __shfl_xor(v, o);
    return v;
}
#define DPPF(x, ctrl) __builtin_bit_cast(float, __builtin_amdgcn_mov_dpp(__builtin_bit_cast(int, (x)), (ctrl), 0xf, 0xf, true))
__device__ __forceinline__ float wave_sum(float v) {
    v += DPPF(v, 0xB1); v += DPPF(v, 0x4E); v += DPPF(v, 0x141); v += DPPF(v, 0x140);
    const int iv = __builtin_bit_cast(int, v);
    const float r0 = __builtin_bit_cast(float, __builtin_amdgcn_readlane(iv, 0)), r1 = __builtin_bit_cast(float, __builtin_amdgcn_readlane(iv, 16)),
                r2 = __builtin_bit_cast(float, __builtin_amdgcn_readlane(iv, 32)), r3 = __builtin_bit_cast(float, __builtin_amdgcn_readlane(iv, 48));
    return (r0 + r1) + (r2 + r3);
}
__device__ __forceinline__ float wave_max(float v) {
#pragma unroll
    for (int o = 1; o < 64; o <<= 1) v = fmaxf(v, __shfl_xor(v, o));
    return v;
}
__device__ __forceinline__ int wave_min_i(int v) {
#pragma unroll
    for (int o = 1; o < 64; o <<= 1) { const int w = __shfl_xor(v, o); v = w < v ? w : v; }
    return v;
}
__device__ __forceinline__ float bflo(unsigned w) { return __uint_as_float(w << 16); }
__device__ __forceinline__ float bfhi(unsigned w) { return __uint_as_float(w & 0xffff0000u); }
__device__ __forceinline__ void unpk8(v4u w, float (&f)[8]) { f[0] = bflo(w.x); f[1] = bfhi(w.x); f[2] = bflo(w.y); f[3] = bfhi(w.y); f[4] = bflo(w.z); f[5] = bfhi(w.z); f[6] = bflo(w.w); f[7] = bfhi(w.w); }
__device__ __forceinline__ v4u pk8(const float (&f)[8]) { v4u o; o.x = pk2(f[0], f[1]); o.y = pk2(f[2], f[3]); o.z = pk2(f[4], f[5]); o.w = pk2(f[6], f[7]); return o; }
__device__ __forceinline__ float sigm_(float x) { return 1.0f / (1.0f + __expf(-x)); }
__device__ __forceinline__ float gelu_(float x) { const float u = 0.7978845608028654f * (x + 0.044715f * x * x * x); return x * sigm_(2.0f * u); }

__device__ __forceinline__ int rowmap(int n, int mode) {
    if (mode == 1) { if (n >= 2048 && n < 4096) { const int d = n & 63; return (n & ~63) + (d < 32 ? 8 * (d >> 2) + (d & 3) : 8 * ((d - 32) >> 2) + 4 + (d & 3)); } return n; }
    if (mode == 2) { return n < 1024 ? 8 * (n >> 2) + (n & 3) : 8 * ((n - 1024) >> 2) + 4 + (n & 3); }
    return n;
}
__device__ __forceinline__ void transpose_item(const float* W, int K, int N, bf16* WT, int mode, LAS float* scr, int item, int lane) {
    const int nblk = N / 32, kb = item / nblk, nb = item - kb * nblk, k0 = 64 * kb, n0 = 32 * nb;
    typedef float f2 __attribute__((ext_vector_type(2)));
    f2 v[16];
    const int lr = lane >> 4, lc = 2 * (lane & 15);
#pragma unroll
    for (int i = 0; i < 16; ++i) v[i] = *(const GAS f2*)(W + (size_t)(k0 + 4 * i + lr) * N + n0 + lc);
#pragma unroll
    for (int i = 0; i < 16; ++i) { scr[(4 * i + lr) * 33 + lc] = v[i].x; scr[(4 * i + lr) * 33 + lc + 1] = v[i].y; }
    LDS_WAIT(); asm volatile("" ::: "memory");
    const int c = lane & 7;
#pragma unroll
    for (int j = 0; j < 4; ++j) { const int n = (lane >> 3) + 8 * j; const LAS float* s = scr + (8 * c) * 33 + n;
        v4u o; o.x = pk2(s[0 * 33], s[1 * 33]); o.y = pk2(s[2 * 33], s[3 * 33]); o.z = pk2(s[4 * 33], s[5 * 33]); o.w = pk2(s[6 * 33], s[7 * 33]);
        *(GAS v4u*)(WT + (size_t)rowmap(n0 + n, mode) * K + k0 + 8 * c) = o; }
    LDS_WAIT(); asm volatile("" ::: "memory");
}
__device__ __forceinline__ void ln16(f32x4 (&v)[4], const float* g, const float* b, int lane) {
    float s = 0.f;
#pragma unroll
    for (int j = 0; j < 4; ++j) s += (v[j].x + v[j].y) + (v[j].z + v[j].w);
    const float mean = wave_sum(s) * (1.f / 1024.f); float s2 = 0.f;
#pragma unroll
    for (int j = 0; j < 4; ++j) { v[j] = v[j] - mean; s2 += (v[j].x * v[j].x + v[j].y * v[j].y) + (v[j].z * v[j].z + v[j].w * v[j].w); }
    const float rstd = 1.f / sqrtf(wave_sum(s2) * (1.f / 1024.f) + LN_EPS);
#pragma unroll
    for (int j = 0; j < 4; ++j) { const f32x4 gg = *(const GAS f32x4*)(g + 256 * j + 4 * lane), bb = *(const GAS f32x4*)(b + 256 * j + 4 * lane); v[j] = v[j] * rstd * gg + bb; }
}
__device__ __forceinline__ void store_row_f32_bf16(const f32x4 (&v)[4], float* hf, bf16* hb, int lane) {
#pragma unroll
    for (int j = 0; j < 4; ++j) { if (hf) *(GAS f32x4*)(hf + 256 * j + 4 * lane) = v[j];
        *(GAS unsigned long long*)(hb + 256 * j + 4 * lane) = (unsigned long long)pk2(v[j].x, v[j].y) | ((unsigned long long)pk2(v[j].z, v[j].w) << 32); }
}

__device__ __forceinline__ void ssm_build(Frame& F, const Args& A, int l, int g) {
    LAS float* L = (LAS float*)(F.lds + RING_OFF);
    LAS float* AP_re = L; LAS float* AP_im = L + 4160; LAS float* BB_re = L + 8320; LAS float* BB_im = L + 9344; LAS float* CC_re = L + 10368; LAS float* CC_im = L + 11392; LAS float* KM = L + 12416;
    const int lg = l * 32 + g; const int tid = F.tid;
    const float dt = __expf(A.in[I_LOGDT][lg]);
    for (int idx = tid; idx < 65 * 64; idx += 512) { const int j = idx >> 6, p = idx & 63; const float lr = A.in[I_LAMRE][lg * 64 + p], li = A.in[I_LAMIM][lg * 64 + p];
        const float mag = expf(lr * dt * (float)j), ang = li * dt * (float)j; AP_re[idx] = mag * cosf(ang); AP_im[idx] = mag * sinf(ang); }
    __syncthreads();
    for (int idx = tid; idx < 1024; idx += 512) {
        { const int p = idx >> 4, c = idx & 15; const float lr = A.in[I_LAMRE][lg * 64 + p], li = A.in[I_LAMIM][lg * 64 + p];
          const float ar = AP_re[64 + p], ai = AP_im[64 + p], nr = ar - 1.0f, den = lr * lr + li * li;
          const float cr = (nr * lr + ai * li) / den, ci = (ai * lr - nr * li) / den;
          const float br = A.in[I_BRE][(size_t)(lg * 64 + p) * 16 + c], bi = A.in[I_BIM][(size_t)(lg * 64 + p) * 16 + c];
          BB_re[idx] = cr * br - ci * bi; BB_im[idx] = cr * bi + ci * br; }
        { CC_re[idx] = A.in[I_CRE][(size_t)lg * 1024 + idx]; CC_im[idx] = A.in[I_CIM][(size_t)lg * 1024 + idx]; }
    }
    __syncthreads();
    for (int idx = tid; idx < 16384; idx += 512) { const int j = idx >> 8, co = (idx >> 4) & 15, ci = idx & 15; float s = 0.f;
        for (int p = 0; p < 64; ++p) { const float Ar = AP_re[j * 64 + p], Ai = AP_im[j * 64 + p], Br = BB_re[p * 16 + ci], Bi = BB_im[p * 16 + ci];
            const float er = Ar * Br - Ai * Bi, ei = Ar * Bi + Ai * Br; s += CC_re[co * 64 + p] * er - CC_im[co * 64 + p] * ei; }
        if (j == 0 && co == ci) s += A.in[I_SSMD][l * 512 + g * 16 + co];
        KM[idx] = s; }
    __syncthreads();
    bf16* TOE = (bf16*)(F.ws + WS_W + (size_t)l * WL_STRIDE + WL_TOE) + (size_t)g * 1024 * 1152;
    for (int q = tid; q < 1024 * 144; q += 512) { const int n = q / 144, kc = q - n * 144, t = n >> 4, co = n & 15; float f[8];
        if (kc < 128) { const int s = kc >> 1, ci0 = (kc & 1) * 8;
            if (s <= t) {
#pragma unroll
                for (int i = 0; i < 8; ++i) f[i] = KM[(t - s) * 256 + co * 16 + ci0 + i]; }
            else {
#pragma unroll
                for (int i = 0; i < 8; ++i) f[i] = 0.f; } }
        else { const int p0 = (kc - 128) * 8;
#pragma unroll
            for (int i = 0; i < 8; ++i) { const int p = (p0 + i) & 63; const float Cr = CC_re[co * 64 + p], Ci = CC_im[co * 64 + p], Ar = AP_re[(t + 1) * 64 + p], Ai = AP_im[(t + 1) * 64 + p];
                f[i] = p0 < 64 ? (Cr * Ar - Ci * Ai) : -(Cr * Ai + Ci * Ar); } }
        *(GAS v4u*)(TOE + (size_t)n * 1152 + kc * 8) = pk8(f); }
    bf16* WST = (bf16*)(F.ws + WS_W + (size_t)l * WL_STRIDE + WL_ST) + (size_t)g * 256 * 1024;
    for (int q = tid; q < 256 * 128; q += 512) { const int n = q >> 7, kc = q & 127, s = kc >> 1, ci0 = (kc & 1) * 8; float f[8];
        if (n < 128) { const int p = n & 63; const float Ar = AP_re[(63 - s) * 64 + p], Ai = AP_im[(63 - s) * 64 + p];
#pragma unroll
            for (int i = 0; i < 8; ++i) { const float Br = BB_re[p * 16 + ci0 + i], Bi = BB_im[p * 16 + ci0 + i]; f[i] = n < 64 ? (Ar * Br - Ai * Bi) : (Ar * Bi + Ai * Br); } }
        else {
#pragma unroll
            for (int i = 0; i < 8; ++i) f[i] = 0.f; }
        *(GAS v4u*)(WST + (size_t)n * 1024 + kc * 8) = pk8(f); }
    float* SC = (float*)(F.ws + WS_SSMC + (size_t)l * MiB);
    if (tid < 64) { const int p = tid; SC[(lg * 64 + p) * 2] = AP_re[64 + p]; SC[(lg * 64 + p) * 2 + 1] = AP_im[64 + p];
        SC[16384 + (lg * 64 + p) * 2] = AP_re[64 * 64 + p]; SC[16384 + (lg * 64 + p) * 2 + 1] = AP_im[64 * 64 + p]; }
    for (int idx = tid; idx < 1024; idx += 512) { const int p = idx >> 4, c = idx & 15; SC[32768 + (size_t)(lg * 64 + p) * 32 + c] = BB_re[idx]; SC[32768 + (size_t)(lg * 64 + p) * 32 + 16 + c] = BB_im[idx]; }
    __syncthreads();
}

__device__ __forceinline__ void p0_prologue(Frame& F, const Args& A) {
    for (int job = F.vcu; job < NLAYER * 32; job += F.G) ssm_build(F, A, job >> 5, job & 31);
    const int gw = F.vcu * NWAVES + F.wave, NGW = F.G * NWAVES, lane = F.lane;
    float* HF = (float*)(F.ws + WS_HF); bf16* HB = (bf16*)(F.ws + WS_HB);
    for (int R = gw; R < MVALID; R += NGW) { const float* src = R < MREAL ? A.in[I_X] + (size_t)R * 1024 : A.in[I_META] + (size_t)((R - MREAL) & 15) * 1024;
        f32x4 v[4];
#pragma unroll
        for (int j = 0; j < 4; ++j) v[j] = *(const GAS f32x4*)(src + 256 * j + 4 * lane);
        ln16(v, A.in[I_LNIN_G], A.in[I_LNIN_B], lane); store_row_f32_bf16(v, HF + (size_t)R * 1024, HB + (size_t)R * 1024, lane); }
    { float* ROPE = (float*)(F.ws + WS_ROPE); const int gt = F.vcu * 512 + F.tid, NGT = F.G * 512;
      for (int idx = gt; idx < 8208 * 32; idx += NGT) { const int pos = idx >> 5, j = idx & 31; const float inv = exp2f(-(float)j * (13.287712379549449f / 32.0f)); const float ang = (float)pos * inv;
          ROPE[(size_t)pos * 64 + j] = cosf(ang); ROPE[(size_t)pos * 64 + 32 + j] = sinf(ang); } }
    { bf16* KB = (bf16*)(F.ws + WS_K); bf16* VB = (bf16*)(F.ws + WS_V);
      for (int r = gw; r < 512; r += NGW) { bf16* base = (r & 256) ? VB : KB; const int b = (r >> 7) & 1, rr = r & 127; GAS v4u* d = (GAS v4u*)(base + (size_t)(b * 8320 + 8192 + rr) * 1024);
          d[lane] = (v4u){0u, 0u, 0u, 0u}; d[64 + lane] = (v4u){0u, 0u, 0u, 0u}; } }
    LAS float* scr = (LAS float*)(F.lds + RING_OFF + F.wave * 16384);
    constexpr int IT_IN = 16 * 160, IT_GATE = 16 * 96, IT_GLU = 8 * 16, IT_SO = 8 * 32, IT_CO = 8 * 32, IT_AO = 16 * 32, IT_WO = 16 * 32, IT_GU1 = 16 * 64, IT_DN1 = 16 * 32;
    constexpr int IT_L = IT_IN + IT_GATE + IT_GLU + IT_SO + IT_CO + IT_AO + IT_WO + 32 * IT_GU1 + 32 * IT_DN1;
    for (int it = gw; it < NLAYER * IT_L; it += NGW) {
        const int l = it / IT_L; int r = it - l * IT_L; unsigned char* wl = F.ws + WS_W + (size_t)l * WL_STRIDE;
        if (r < IT_IN) { transpose_item(A.in[I_WIN] + (size_t)l * 1024 * 5120, 1024, 5120, (bf16*)(wl + WL_IN), 1, scr, r, lane); continue; } r -= IT_IN;
        if (r < IT_GATE) { transpose_item(A.in[I_GATEW] + (size_t)l * 1024 * 3072, 1024, 3072, (bf16*)(wl + WL_IN) + (size_t)5120 * 1024, 0, scr, r, lane); continue; } r -= IT_GATE;
        if (r < IT_GLU) { transpose_item(A.in[I_WGLU] + (size_t)l * 512 * 512, 512, 512, (bf16*)(wl + WL_GLU), 0, scr, r, lane); continue; } r -= IT_GLU;
        if (r < IT_SO) { transpose_item(A.in[I_SSMWO] + (size_t)l * 512 * 1024, 512, 1024, (bf16*)(wl + WL_SO), 0, scr, r, lane); continue; } r -= IT_SO;
        if (r < IT_CO) { transpose_item(A.in[I_CONVWO] + (size_t)l * 512 * 1024, 512, 1024, (bf16*)(wl + WL_CO), 0, scr, r, lane); continue; } r -= IT_CO;
        if (r < IT_AO) { transpose_item(A.in[I_ATTNWO] + (size_t)l * 1024 * 1024, 1024, 1024, (bf16*)(wl + WL_AO), 0, scr, r, lane); continue; } r -= IT_AO;
        if (r < IT_WO) { transpose_item(A.in[I_WO] + (size_t)l * 1024 * 1024, 1024, 1024, (bf16*)(wl + WL_WO), 0, scr, r, lane); continue; } r -= IT_WO;
        if (r < 32 * IT_GU1) { const int e = r / IT_GU1; transpose_item(A.in[I_WGU] + ((size_t)l * 32 + e) * 1024 * 2048, 1024, 2048, (bf16*)(wl + WL_GU) + (size_t)e * 2048 * 1024, 2, scr, r - e * IT_GU1, lane); continue; } r -= 32 * IT_GU1;
        { const int e = r / IT_DN1; transpose_item(A.in[I_WDN] + ((size_t)l * 32 + e) * 1024 * 1024, 1024, 1024, (bf16*)(wl + WL_DN) + (size_t)e * 1024 * 1024, 0, scr, r - e * IT_DN1, lane); }
    }
}

__device__ __forceinline__ int prev_row(int R, int k) {
    if (R < MREAL) { const int t = R & 8191, b = R >> 13; return t >= k ? R - k : MREAL + b * 16 + 16 - (k - t); }
    const int i = (R - MREAL) & 15; return i >= k ? R - k : -1;
}
__device__ __forceinline__ void conv_rows(Frame& F, const Args& A, int l) {
    const int bidc = (int)blockIdx.x; if (bidc < 128) return;
    const int gw = (bidc - 128) * NWAVES + F.wave, NGW = (F.G - 128) * NWAVES, lane = F.lane, c0 = 8 * lane;
    const bf16* CB = (const bf16*)(F.ws + WS_CONV); bf16* YC = (bf16*)(F.ws + WS_YC);
    float w0[8], w1[8], w2[8];
#pragma unroll
    for (int i = 0; i < 8; ++i) { w0[i] = A.in[I_CONVW][(size_t)l * 1536 + c0 + i]; w1[i] = A.in[I_CONVW][(size_t)l * 1536 + 512 + c0 + i]; w2[i] = A.in[I_CONVW][(size_t)l * 1536 + 1024 + c0 + i]; }
    for (int R = gw; R < MVALID; R += NGW) {
        const int r1 = prev_row(R, 1), r2 = prev_row(R, 2);
        float gb[8], a[8], h[8], z0[8], z1[8], z2[8];
        unpk8(*(const GAS v4u*)(CB + (size_t)R * 1536 + c0), gb);
        unpk8(*(const GAS v4u*)(CB + (size_t)R * 1536 + 512 + c0), a); unpk8(*(const GAS v4u*)(CB + (size_t)R * 1536 + 1024 + c0), h);
#pragma unroll
        for (int i = 0; i < 8; ++i) z0[i] = a[i] * h[i];
        if (r1 >= 0) { unpk8(*(const GAS v4u*)(CB + (size_t)r1 * 1536 + 512 + c0), a); unpk8(*(const GAS v4u*)(CB + (size_t)r1 * 1536 + 1024 + c0), h);
#pragma unroll
            for (int i = 0; i < 8; ++i) z1[i] = a[i] * h[i]; }
        else {
#pragma unroll
            for (int i = 0; i < 8; ++i) z1[i] = 0.f; }
        if (r2 >= 0) { unpk8(*(const GAS v4u*)(CB + (size_t)r2 * 1536 + 512 + c0), a); unpk8(*(const GAS v4u*)(CB + (size_t)r2 * 1536 + 1024 + c0), h);
#pragma unroll
            for (int i = 0; i < 8; ++i) z2[i] = a[i] * h[i]; }
        else {
#pragma unroll
            for (int i = 0; i < 8; ++i) z2[i] = 0.f; }
        float y[8];
#pragma unroll
        for (int i = 0; i < 8; ++i) y[i] = gb[i] * (w0[i] * z2[i] + w1[i] * z1[i] + w2[i] * z0[i]);
        *(GAS v4u*)(YC + (size_t)R * 512 + c0) = pk8(y);
    }
}
__device__ __forceinline__ void ssm_meta_job(Frame& F, const Args& A, int l, int bm, int g) {
    const int lane = F.lane, lg = l * 32 + g;
    const float* SC = (const float*)(F.ws + WS_SSMC + (size_t)l * MiB);
    const bf16* UM = (const bf16*)(F.ws + WS_UMETA); bf16* YG = (bf16*)(F.ws + WS_YG); float* SM = (float*)(F.ws + WS_SM);
    LAS float* scr = (LAS float*)(F.lds + RING_OFF + F.wave * 16384);
    LAS float* CR = scr + 2048; LAS float* CI = scr + 3072;
    { const GAS f32x4* cr = (const GAS f32x4*)(A.in[I_CRE] + (size_t)lg * 1024) + lane * 4; const GAS f32x4* ci = (const GAS f32x4*)(A.in[I_CIM] + (size_t)lg * 1024) + lane * 4;
      f32x4 t0[4], t1[4];
#pragma unroll
      for (int i = 0; i < 4; ++i) { t0[i] = cr[i]; t1[i] = ci[i]; }
#pragma unroll
      for (int i = 0; i < 4; ++i) { *(LAS f32x4*)(CR + lane * 16 + 4 * i) = t0[i]; *(LAS f32x4*)(CI + lane * 16 + 4 * i) = t1[i]; } }
    const float ar = SC[(lg * 64 + lane) * 2], ai = SC[(lg * 64 + lane) * 2 + 1];
    float bbr[16], bbi[16];
    { const GAS f32x4* bp = (const GAS f32x4*)(SC + 32768 + (size_t)(lg * 64 + lane) * 32);
#pragma unroll
      for (int i = 0; i < 4; ++i) { const f32x4 r = bp[i], m = bp[4 + i]; bbr[4 * i] = r.x; bbr[4 * i + 1] = r.y; bbr[4 * i + 2] = r.z; bbr[4 * i + 3] = r.w; bbi[4 * i] = m.x; bbi[4 * i + 1] = m.y; bbi[4 * i + 2] = m.z; bbi[4 * i + 3] = m.w; } }
    float xr = 0.f, xi = 0.f;
#pragma unroll
    for (int hh = 0; hh < 2; ++hh) { v4u ua[8], ub[8];
#pragma unroll
        for (int s = 0; s < 8; ++s) { const bf16* up = UM + (size_t)(bm * 16 + hh * 8 + s) * 512 + g * 16; ua[s] = *(const GAS v4u*)up; ub[s] = *(const GAS v4u*)(up + 8); }
#pragma unroll
        for (int s = 0; s < 8; ++s) { float fa[8], fb[8]; unpk8(ua[s], fa); unpk8(ub[s], fb); float bur = 0.f, bui = 0.f;
#pragma unroll
            for (int c = 0; c < 8; ++c) { bur += bbr[c] * fa[c] + bbr[8 + c] * fb[c]; bui += bbi[c] * fa[c] + bbi[8 + c] * fb[c]; }
            const float nr = ar * xr - ai * xi + bur, ni = ar * xi + ai * xr + bui; xr = nr; xi = ni;
            const int ss = hh * 8 + s; scr[ss * 128 + ((lane + ss) & 63)] = xr; scr[ss * 128 + 64 + ((lane + ss) & 63)] = xi; } }
    SM[(size_t)(bm * 32 + g) * 128 + lane] = xr; SM[(size_t)(bm * 32 + g) * 128 + 64 + lane] = xi;
    LDS_WAIT(); asm volatile("" ::: "memory");
    const int s = lane >> 2, coq = (lane & 3) * 4; float y[4] = {0.f, 0.f, 0.f, 0.f};
    for (int p = 0; p < 64; ++p) { const float vr = scr[s * 128 + ((p + s) & 63)], vi = scr[s * 128 + 64 + ((p + s) & 63)];
#pragma unroll
        for (int i = 0; i < 4; ++i) y[i] += CR[(coq + i) * 64 + p] * vr - CI[(coq + i) * 64 + p] * vi; }
    const unsigned long long uw = *(const GAS unsigned long long*)(UM + (size_t)(bm * 16 + s) * 512 + g * 16 + coq);
    const f32x4 dv = *(const GAS f32x4*)(A.in[I_SSMD] + l * 512 + g * 16 + coq);
    y[0] += dv.x * bflo((unsigned)uw); y[1] += dv.y * bfhi((unsigned)uw); y[2] += dv.z * bflo((unsigned)(uw >> 32)); y[3] += dv.w * bfhi((unsigned)(uw >> 32));
    const unsigned long long o = (unsigned long long)pk2(gelu_(y[0]), gelu_(y[1])) | ((unsigned long long)pk2(gelu_(y[2]), gelu_(y[3])) << 32);
    *(GAS unsigned long long*)(YG + (size_t)(MREAL + bm * 16 + s) * 512 + g * 16 + coq) = o;
    LDS_WAIT(); asm volatile("" ::: "memory");
}
__device__ __forceinline__ void ssm_carry(Frame& F, int l) {
    const int T = F.vcu * 512 + F.tid; if (T >= 4096) return;
    const int b = T >> 11, g = (T >> 6) & 31, p = T & 63, lg = l * 32 + g;
    const float* SC = (const float*)(F.ws + WS_SSMC + (size_t)l * MiB); const float* SM = (const float*)(F.ws + WS_SM); const float* SL = (const float*)(F.ws + WS_SLOC); bf16* UC = (bf16*)(F.ws + WS_UC);
    const float a64r = SC[16384 + (lg * 64 + p) * 2], a64i = SC[16384 + (lg * 64 + p) * 2 + 1];
    float Sr = SM[(size_t)(b * 32 + g) * 128 + p], Si = SM[(size_t)(b * 32 + g) * 128 + 64 + p];
    const size_t row0 = (size_t)g * 256 + b * 128;
    for (int k0 = 0; k0 < 128; k0 += 16) { float lr[16], li[16];
#pragma unroll
        for (int j = 0; j < 16; ++j) { lr[j] = *(const GAS float*)(SL + (row0 + k0 + j) * 128 + p); li[j] = *(const GAS float*)(SL + (row0 + k0 + j) * 128 + 64 + p); }
#pragma unroll
        for (int j = 0; j < 16; ++j) { const size_t row = row0 + k0 + j;
            *(GAS bf16*)(UC + row * 1152 + 1024 + p) = (bf16)f2bf(Sr); *(GAS bf16*)(UC + row * 1152 + 1088 + p) = (bf16)f2bf(Si);
            const float nr = a64r * Sr - a64i * Si + lr[j], ni = a64r * Si + a64i * Sr + li[j]; Sr = nr; Si = ni; } }
}
__device__ __forceinline__ void attn_meta_job(Frame& F, int Rm, int h) {
    const int lane = F.lane, bm = Rm >> 4, R = MREAL + Rm, j = lane >> 2, dq = lane & 3;
    const bf16* Q = (const bf16*)(F.ws + WS_Q); const bf16* K = (const bf16*)(F.ws + WS_K); const bf16* V = (const bf16*)(F.ws + WS_V); bf16* OC = (bf16*)(F.ws + WS_OC);
    const size_t krow = (size_t)bm * 8320 + 8256;
#pragma unroll
    for (int c = 0; c < 2; ++c) { const int hc = h * 2 + c; float qa[8], qb[8], ka[8], kb[8];
        unpk8(*(const GAS v4u*)(Q + (size_t)R * 1024 + hc * 64 + dq * 16), qa); unpk8(*(const GAS v4u*)(Q + (size_t)R * 1024 + hc * 64 + dq * 16 + 8), qb);
        unpk8(*(const GAS v4u*)(K + (krow + j) * 1024 + hc * 64 + dq * 16), ka); unpk8(*(const GAS v4u*)(K + (krow + j) * 1024 + hc * 64 + dq * 16 + 8), kb);
        float s = 0.f;
#pragma unroll
        for (int i = 0; i < 8; ++i) s += qa[i] * ka[i] + qb[i] * kb[i];
        s += __shfl_xor(s, 1); s += __shfl_xor(s, 2);
        float m = s;
#pragma unroll
        for (int o = 4; o < 64; o <<= 1) m = fmaxf(m, __shfl_xor(m, o));
        const float pj = exp2f(s - m); float lsum = pj;
#pragma unroll
        for (int o = 4; o < 64; o <<= 1) lsum += __shfl_xor(lsum, o);
        float o0 = 0.f, o1 = 0.f;
#pragma unroll
        for (int jj = 0; jj < 16; ++jj) { const float pp = __shfl(pj, 4 * jj); const unsigned vv = *(const GAS unsigned*)(V + (krow + jj) * 1024 + h * 128 + 2 * lane); o0 += pp * bflo(vv); o1 += pp * bfhi(vv); }
        const float rl = 1.0f / lsum;
        *(GAS unsigned*)(OC + (size_t)R * 2048 + hc * 128 + 2 * lane) = pk2(o0 * rl, o1 * rl); }
}
__device__ __forceinline__ void attn_combine_rows(Frame& F, const Args& A, int l) {
    const int gw = F.vcu * NWAVES + F.wave, NGW = F.G * NWAVES, lane = F.lane;
    const bf16* OC = (const bf16*)(F.ws + WS_OC); bf16* YA = (bf16*)(F.ws + WS_YA);
    const float lam_init = 0.8f - 0.6f * expf(-0.3f * (float)l);
    const float d1 = wave_sum(A.in[I_LQ1][l * 64 + lane] * A.in[I_LK1][l * 64 + lane]), d2 = wave_sum(A.in[I_LQ2][l * 64 + lane] * A.in[I_LK2][l * 64 + lane]);
    const float lam = expf(d1) - expf(d2) + lam_init;
    const int e0 = (lane & 15) * 8; float sg[8];
#pragma unroll
    for (int i = 0; i < 8; ++i) sg[i] = A.in[I_SUBLN][l * 128 + e0 + i] * (1.0f - lam_init);
    for (int R = gw; R < MVALID; R += NGW) {
#pragma unroll
        for (int pass = 0; pass < 2; ++pass) { const int h = pass * 4 + (lane >> 4); float a[8], b[8], d[8];
            unpk8(*(const GAS v4u*)(OC + (size_t)R * 2048 + (2 * h) * 128 + e0), a); unpk8(*(const GAS v4u*)(OC + (size_t)R * 2048 + (2 * h + 1) * 128 + e0), b);
            float ss = 0.f;
#pragma unroll
            for (int i = 0; i < 8; ++i) { d[i] = a[i] - lam * b[i]; ss += d[i] * d[i]; }
            ss += __shfl_xor(ss, 1); ss += __shfl_xor(ss, 2); ss += __shfl_xor(ss, 4); ss += __shfl_xor(ss, 8);
            const float rs = 1.0f / sqrtf(ss * (1.0f / 128.0f) + 1e-5f);
#pragma unroll
            for (int i = 0; i < 8; ++i) d[i] = d[i] * rs * sg[i];
            *(GAS v4u*)(YA + (size_t)R * 1024 + h * 128 + e0) = pk8(d); }
    }
}
__device__ __forceinline__ float router_reduce(const float (&acc)[32], int lane) {
    float a16[16], a8[8], a4[4], a2[2], a1;
    { const bool hi = lane & 32;
#pragma unroll
      for (int i = 0; i < 16; ++i) { const float keep = hi ? acc[i + 16] : acc[i], give = hi ? acc[i] : acc[i + 16]; a16[i] = keep + __shfl_xor(give, 32); } }
    { const bool hi = lane & 16;
#pragma unroll
      for (int i = 0; i < 8; ++i) { const float keep = hi ? a16[i + 8] : a16[i], give = hi ? a16[i] : a16[i + 8]; a8[i] = keep + __shfl_xor(give, 16); } }
    { const bool hi = lane & 8;
#pragma unroll
      for (int i = 0; i < 4; ++i) { const float keep = hi ? a8[i + 4] : a8[i], give = hi ? a8[i] : a8[i + 4]; a4[i] = keep + __shfl_xor(give, 8); } }
    { const bool hi = lane & 4;
#pragma unroll
      for (int i = 0; i < 2; ++i) { const float keep = hi ? a4[i + 2] : a4[i], give = hi ? a4[i] : a4[i + 2]; a2[i] = keep + __shfl_xor(give, 4); } }
    { const bool hi = lane & 2; const float keep = hi ? a2[1] : a2[0], give = hi ? a2[0] : a2[1]; a1 = keep + DPPF(give, 0x4E); }
    return a1 + DPPF(a1, 0xB1);
}
__device__ __forceinline__ void router_top4(float val, int R, int lane, float* TOKW, unsigned* recg, int nrec, int& ecnt) {
    const int e_me = lane >> 1, iv = __builtin_bit_cast(int, val); int rank = 0;
#pragma unroll
    for (int e = 0; e < 32; ++e) { const float s = __builtin_bit_cast(float, __builtin_amdgcn_readlane(iv, 2 * e)); rank += ((s > val) || (s == val && e < e_me)) ? 1 : 0; }
    float tv[4]; int te[4];
#pragma unroll
    for (int k = 0; k < 4; ++k) { const unsigned long long m = __ballot(rank == k && !(lane & 1)); const int L = __builtin_amdgcn_readfirstlane((int)__ffsll((long long)m) - 1);
        te[k] = L >> 1; tv[k] = __builtin_bit_cast(float, __builtin_amdgcn_readlane(iv, L)); }
    ecnt += (te[0] == lane) + (te[1] == lane) + (te[2] == lane) + (te[3] == lane);
    const float p1 = __expf(tv[1] - tv[0]), p2 = __expf(tv[2] - tv[0]), p3 = __expf(tv[3] - tv[0]), rs = 1.0f / (1.0f + p1 + p2 + p3);
    if (lane < 4) { const int k = lane; const int e = k == 0 ? te[0] : k == 1 ? te[1] : k == 2 ? te[2] : te[3]; const float w = (k == 0 ? 1.0f : k == 1 ? p1 : k == 2 ? p2 : p3) * rs;
        TOKW[(size_t)R * 4 + k] = w; recg[(nrec * 4 + k) * 2] = (unsigned)R; recg[(nrec * 4 + k) * 2 + 1] = (unsigned)e; }
}
__device__ __forceinline__ void ln1_router(Frame& F, const Args& A, int l) {
    const int tid = F.tid, lane = F.lane, wave = F.wave, gw = F.vcu * NWAVES + wave, NGW = F.G * NWAVES;
    LAS float* WT = (LAS float*)(F.lds + RING_OFF);
    const float* rw = A.in[I_RW] + (size_t)l * 1024 * 32;
    for (int idx = tid; idx < 32768; idx += 512) WT[(idx & 31) * 1024 + (idx >> 5)] = rw[idx];
    __syncthreads();
    const float* PRE = (const float*)(F.ws + WS_PRE); float* HF = (float*)(F.ws + WS_HF); bf16* HB = (bf16*)(F.ws + WS_HB);
    float* TOKW = (float*)(F.ws + WS_TOKW);
    unsigned* recg = (unsigned*)(F.ws + WS_ROWIDX + 131072) + (size_t)gw * 80;
    const float rb = A.in[I_RB][l * 32 + (lane >> 1)];
    int nrec = 0, ecnt = 0;
#pragma unroll 1
    for (int R0 = gw; R0 < MVALID; R0 += 2 * NGW) {
        const int R1 = R0 + NGW; const bool two = R1 < MVALID; const int R1c = two ? R1 : R0;
        f32x4 v0[4], v1[4];
#pragma unroll
        for (int j = 0; j < 4; ++j) { v0[j] = *(const GAS f32x4*)(PRE + (size_t)R0 * 1024 + 256 * j + 4 * lane); v1[j] = *(const GAS f32x4*)(PRE + (size_t)R1c * 1024 + 256 * j + 4 * lane); }
        ln16(v0, A.in[I_LN1G] + l * 1024, A.in[I_LN1B] + l * 1024, lane); ln16(v1, A.in[I_LN1G] + l * 1024, A.in[I_LN1B] + l * 1024, lane);
        store_row_f32_bf16(v0, HF + (size_t)R0 * 1024, HB + (size_t)R0 * 1024, lane);
        if (two) store_row_f32_bf16(v1, HF + (size_t)R1 * 1024, HB + (size_t)R1 * 1024, lane);
        float acc0[32], acc1[32];
#pragma unroll
        for (int e = 0; e < 32; ++e) { float s0 = 0.f, s1 = 0.f;
#pragma unroll
            for (int j = 0; j < 4; ++j) { const f32x4 w = *(const LAS f32x4*)(WT + e * 1024 + 256 * j + 4 * lane);
                s0 += (v0[j].x * w.x + v0[j].y * w.y) + (v0[j].z * w.z + v0[j].w * w.w); s1 += (v1[j].x * w.x + v1[j].y * w.y) + (v1[j].z * w.z + v1[j].w * w.w); }
            acc0[e] = s0; acc1[e] = s1; }
        const float val0 = router_reduce(acc0, lane) + rb, val1 = router_reduce(acc1, lane) + rb;
        router_top4(val0, R0, lane, TOKW, recg, nrec, ecnt); ++nrec;
        if (two) { router_top4(val1, R1, lane, TOKW, recg, nrec, ecnt); ++nrec; }
        asm volatile("" ::: "memory");
    }
    if (lane == 0) ((int*)(F.ws + WS_ROWIDX + 65536))[gw] = nrec * 4;
    if (lane < 32) ((int*)(F.ws + WS_ROWIDX + 1048576))[(size_t)gw * 32 + lane] = ecnt;
    { LAS int* bc = (LAS int*)(F.lds + LDSCTL_OFF);
      if (tid < 32) bc[tid] = 0;
      __syncthreads();
      if (lane < 32) __hip_atomic_fetch_add(&bc[lane], ecnt, __ATOMIC_RELAXED, __HIP_MEMORY_SCOPE_WORKGROUP);
      __syncthreads();
      if (tid < 32) ((int*)(F.ws + WS_ROWIDX + 2097152))[(size_t)F.vcu * 32 + tid] = bc[tid];
      __syncthreads(); }
}
__device__ __forceinline__ void moe_tables(Frame& F, int l, bool with_bases = false) {
    LAS int* tb = (LAS int*)(F.lds + LDSCTL_OFF); LAS int* cn = tb + 34;
    LAS int* part = (LAS int*)(F.lds + RING_OFF);
    LAS int* wb = part + 1024;
    const int* WCNT = (const int*)(F.ws + WS_ROWIDX + 1048576);
    const int NGW = F.G * NWAVES, gw0 = F.vcu * NWAVES;
    __syncthreads();
    { const int e = F.tid & 31, pt = F.tid >> 5; int tot = 0, base = 0; const int per = F.G / 16; const int* BCNT = (const int*)(F.ws + WS_ROWIDX + 2097152); int cv[16];
#pragma unroll
      for (int i = 0; i < 16; ++i) cv[i] = (i < per) ? BCNT[(size_t)(pt * per + i) * 32 + e] : 0;
#pragma unroll
      for (int i = 0; i < 16; ++i) { tot += cv[i]; if (pt * per + i < F.vcu) base += cv[i]; }
      part[pt * 32 + e] = tot; part[512 + pt * 32 + e] = base; }
    __syncthreads();
    if (F.tid < 32) { int tot = 0, base = 0;
#pragma unroll
        for (int pt = 0; pt < 16; ++pt) { tot += part[pt * 32 + F.tid]; base += part[512 + pt * 32 + F.tid]; }
        cn[F.tid] = tot;
        if (with_bases) { for (int w = 0; w < NWAVES; ++w) { wb[w * 32 + F.tid] = base; base += WCNT[(size_t)(gw0 + w) * 32 + F.tid]; } } }
    __syncthreads();
    if (F.tid == 0) { int s = 0; for (int e = 0; e < 32; ++e) { tb[e] = s; s += (cn[e] + 255) >> 8; } tb[32] = s; }
    __syncthreads();
}
__device__ __forceinline__ void moe_gather(Frame& F) {
    const LAS int* tb = (const LAS int*)(F.lds + LDSCTL_OFF); const LAS int* wb = (const LAS int*)(F.lds + RING_OFF) + 1024 + F.wave * 32;
    const int gw = F.vcu * NWAVES + F.wave, lane = F.lane;
    const bf16* HB = (const bf16*)(F.ws + WS_HB); bf16* XG = (bf16*)(F.ws + WS_XG); unsigned* TOKE = (unsigned*)(F.ws + WS_TOKE);
    const unsigned* recg = (const unsigned*)(F.ws + WS_ROWIDX + 131072) + (size_t)gw * 80; const int n = ((const int*)(F.ws + WS_ROWIDX + 65536))[gw];
    const int my_e = lane < n ? (int)recg[lane * 2 + 1] : -1, my_R = lane < n ? (int)recg[lane * 2] : 0;
    int before = 0; for (int j = 0; j < n; ++j) { const int ej = __builtin_amdgcn_readlane(my_e, j); before += (j < lane && ej == my_e) ? 1 : 0; }
    const int my_pos = lane < n ? wb[my_e] + before : 0;
    if (lane < n) TOKE[(size_t)my_R * 4 + (lane & 3)] = (unsigned)my_e | ((unsigned)my_pos << 8);
    for (int i = 0; i < n; ++i) { const int e = __builtin_amdgcn_readlane(my_e, i), R = __builtin_amdgcn_readlane(my_R, i), pos = __builtin_amdgcn_readlane(my_pos, i);
        const size_t crow = (size_t)tb[e] * 256 + pos; const GAS v4u* sp = (const GAS v4u*)(HB + (size_t)R * 1024); GAS v4u* dp = (GAS v4u*)(XG + crow * 1024);
        const v4u a = sp[lane], b = sp[64 + lane]; dp[lane] = a; dp[64 + lane] = b; }
}
__device__ __forceinline__ void ln2_rows(Frame& F, const Args& A, int l) {
    const LAS int* tb = (const LAS int*)(F.lds + LDSCTL_OFF);
    const int gw = F.vcu * NWAVES + F.wave, NGW = F.G * NWAVES, lane = F.lane;
    float* HF = (float*)(F.ws + WS_HF); bf16* HB = (bf16*)(F.ws + WS_HB); const bf16* OUTS = (const bf16*)(F.ws + WS_OUTS);
    const float* TOKW = (const float*)(F.ws + WS_TOKW); const unsigned* TOKE = (const unsigned*)(F.ws + WS_TOKE);
    for (int R0 = gw; R0 < MVALID; R0 += 2 * NGW) {
        const int R1 = R0 + NGW; const bool two = R1 < MVALID; const int Rr[2] = {R0, two ? R1 : R0};
        f32x4 v[2][4]; unsigned long long o[2][4][4]; float w[2][4];
#pragma unroll
        for (int q = 0; q < 2; ++q) {
            const v4u te4 = *(const GAS v4u*)(TOKE + (size_t)Rr[q] * 4); const f32x4 w4 = *(const GAS f32x4*)(TOKW + (size_t)Rr[q] * 4);
            const unsigned te[4] = {te4.x, te4.y, te4.z, te4.w}; w[q][0] = w4.x; w[q][1] = w4.y; w[q][2] = w4.z; w[q][3] = w4.w;
#pragma unroll
            for (int j = 0; j < 4; ++j) v[q][j] = *(const GAS f32x4*)(HF + (size_t)Rr[q] * 1024 + 256 * j + 4 * lane);
#pragma unroll
            for (int k = 0; k < 4; ++k) { const size_t crow = (size_t)tb[te[k] & 255] * 256 + (te[k] >> 8);
#pragma unroll
                for (int j = 0; j < 4; ++j) o[q][k][j] = *(const GAS unsigned long long*)(OUTS + crow * 1024 + 256 * j + 4 * lane); } }
#pragma unroll
        for (int q = 0; q < 2; ++q) {
#pragma unroll
            for (int j = 0; j < 4; ++j) v[q][j] = v[q][j] * ALPHA;
#pragma unroll
            for (int k = 0; k < 4; ++k)
#pragma unroll
                for (int j = 0; j < 4; ++j) { const unsigned lo = (unsigned)o[q][k][j], hi = (unsigned)(o[q][k][j] >> 32); const float ww = w[q][k];
                    v[q][j].x += ww * bflo(lo); v[q][j].y += ww * bfhi(lo); v[q][j].z += ww * bflo(hi); v[q][j].w += ww * bfhi(hi); }
            ln16(v[q], A.in[I_LN2G] + l * 1024, A.in[I_LN2B] + l * 1024, lane);
#if defined(SELFCHK)
            if (l == NLAYER - 1) { const unsigned mask = __hip_atomic_load(F.ctl + 2048, RLX_AGENT); if (mask) { const float pv = (float)(1u << (__ffs((int)mask) - 1));
#pragma unroll
                for (int j = 0; j < 4; ++j) v[q][j] = (f32x4){pv, pv, pv, pv}; } }
#endif
            if (q == 0 || two) { const int R = Rr[q];
                if (l == NLAYER - 1) { if (R < MREAL) {
#pragma unroll
                        for (int j = 0; j < 4; ++j) *(GAS f32x4*)(A.out + (size_t)R * 1024 + 256 * j + 4 * lane) = v[q][j]; } }
                else store_row_f32_bf16(v[q], HF + (size_t)R * 1024, HB + (size_t)R * 1024, lane); }
        }
    }
}

typedef float f32x16 __attribute__((ext_vector_type(16)));
__device__ __forceinline__ f32x16 skinny32_part(const bf16* A, int lda, const bf16* Bt, int ldb, int K, int cb, int lane, int wave, f32x16 acc) {
    const int r32 = lane & 31, hi = lane >> 5, ks = K / 16 / NWAVES;
    const GAS bf16x8* ap = (const GAS bf16x8*)(A + (size_t)r32 * lda + hi * 8) + (size_t)wave * ks * 2;
    const GAS bf16x8* bp = (const GAS bf16x8*)(Bt + (size_t)(cb * 32 + r32) * ldb + hi * 8) + (size_t)wave * ks * 2;
    bf16x8 a[8], b[8];
#pragma unroll
    for (int i = 0; i < 8; ++i) if (i < ks) { a[i] = ap[i * 2]; b[i] = bp[i * 2]; }
#pragma unroll
    for (int i = 0; i < 8; ++i) if (i < ks) acc = __builtin_amdgcn_mfma_f32_32x32x16_bf16(a[i], b[i], acc, 0, 0, 0);
    return acc;
}
__device__ __forceinline__ f32x16 skinny_reduce(Frame& F, f32x16 part, int slot) {
    LAS float* red = (LAS float*)(F.lds + RING_OFF) + slot * 8192;
#pragma unroll
    for (int r = 0; r < 16; ++r) red[(F.wave * 16 + r) * 64 + F.lane] = part[r];
    __syncthreads();
    f32x16 s = {};
    if (F.wave == 0) {
#pragma unroll 2
        for (int w = 0; w < NWAVES; ++w)
#pragma unroll
            for (int r = 0; r < 16; ++r) s[r] += red[(w * 16 + r) * 64 + F.lane]; }
    return s;
}
__device__ __forceinline__ int mrow(int r, int hi) { return (r & 3) + 8 * (r >> 2) + 4 * hi; }
__device__ __forceinline__ void st_bf(bf16* p, float v) { *(GAS bf16*)p = (bf16)f2bf(v); }
__device__ __forceinline__ void skinny_p1(Frame& F, const Args& A, int l, int cb) {
    const int lane = F.lane, c = cb * 32 + (lane & 31), hi = lane >> 5;
    const bf16* HBm = (const bf16*)(F.ws + WS_HB) + (size_t)MREAL * 1024; const bf16* W = (const bf16*)(F.ws + WS_W + (size_t)l * WL_STRIDE + WL_IN);
    f32x16 acc = {}; acc = skinny_reduce(F, skinny32_part(HBm, 1024, W, 1024, 1024, cb, lane, F.wave, acc), 0); __syncthreads(); if (F.wave != 0) return;
    if (c < 512) { bf16* UM = (bf16*)(F.ws + WS_UMETA);
#pragma unroll
        for (int r = 0; r < 16; ++r) st_bf(UM + (size_t)mrow(r, hi) * 512 + c, acc[r]); }
    else if (c < 2048) { bf16* CB = (bf16*)(F.ws + WS_CONV);
#pragma unroll
        for (int r = 0; r < 16; ++r) st_bf(CB + (size_t)(MREAL + mrow(r, hi)) * 1536 + (c - 512), acc[r]); }
    else if (c < 4096) { const bool isq = c < 3072; const int cc = c - (isq ? 2048 : 3072), hh = cc >> 6, g = (cc & 63) >> 3, i8 = cc & 7, j = 4 * g + (i8 & 3), d = i8 < 4 ? j : 32 + j;
        const float* rope = (const float*)(F.ws + WS_ROPE); bf16* dst = isq ? (bf16*)(F.ws + WS_Q) : (bf16*)(F.ws + WS_K);
#pragma unroll
        for (int r = 0; r < 16; ++r) { const int m = mrow(r, hi), pos = m & 15; const float v = acc[r], pv = __shfl_xor(v, 4); const float cs = rope[(size_t)pos * 64 + j], sn = rope[(size_t)pos * 64 + 32 + j];
            float o = i8 < 4 ? v * cs - pv * sn : v * cs + pv * sn; if (isq) o *= pg8::QSCALE;
            const size_t drow = isq ? (size_t)(MREAL + m) : (size_t)pg8::kv_row(MREAL + m); st_bf(dst + drow * 1024 + hh * 64 + d, o); } }
    else if (c < 5120) { bf16* V = (bf16*)(F.ws + WS_V);
#pragma unroll
        for (int r = 0; r < 16; ++r) st_bf(V + (size_t)pg8::kv_row(MREAL + mrow(r, hi)) * 1024 + (c - 4096), acc[r]); }
    else { bf16* GB = (bf16*)(F.ws + WS_GB); const float gb = A.in[I_GATEB][(size_t)l * 3072 + (c - 5120)];
#pragma unroll
        for (int r = 0; r < 16; ++r) st_bf(GB + (size_t)(MREAL + mrow(r, hi)) * 3072 + (c - 5120), sigm_(acc[r] + gb)); }
}
__device__ __forceinline__ void skinny_glu(Frame& F, int l, int cb) {
    const int lane = F.lane, c = cb * 32 + (lane & 31), hi = lane >> 5;
    const bf16* YG = (const bf16*)(F.ws + WS_YG); bf16* YS = (bf16*)(F.ws + WS_YS);
    f32x16 acc = {}; acc = skinny_reduce(F, skinny32_part(YG + (size_t)MREAL * 512, 512, (const bf16*)(F.ws + WS_W + (size_t)l * WL_STRIDE + WL_GLU), 512, 512, cb, lane, F.wave, acc), 0); __syncthreads(); if (F.wave != 0) return;
#pragma unroll
    for (int r = 0; r < 16; ++r) { const size_t R = MREAL + mrow(r, hi); const float y = __uint_as_float((unsigned)(*(const GAS bf16*)(YG + R * 512 + c)) << 16); st_bf(YS + R * 512 + c, y * sigm_(acc[r])); }
}
__device__ __forceinline__ void skinny_merge(Frame& F, int l, int cb) {
    const int lane = F.lane, c = cb * 32 + (lane & 31), hi = lane >> 5; unsigned char* wl = F.ws + WS_W + (size_t)l * WL_STRIDE;
    const bf16* GB = (const bf16*)(F.ws + WS_GB); bf16* MG = (bf16*)(F.ws + WS_MG);
    f32x16 z = {};
    LAS float* red = (LAS float*)(F.lds + RING_OFF);
    { const f32x16 p0 = skinny32_part((const bf16*)(F.ws + WS_YS) + (size_t)MREAL * 512, 512, (const bf16*)(wl + WL_SO), 512, 512, cb, lane, F.wave, z);
#pragma unroll
      for (int r = 0; r < 16; ++r) red[(F.wave * 16 + r) * 64 + lane] = p0[r]; }
    asm volatile("" ::: "memory");
    { const f32x16 p1 = skinny32_part((const bf16*)(F.ws + WS_YC) + (size_t)MREAL * 512, 512, (const bf16*)(wl + WL_CO), 512, 512, cb, lane, F.wave, z);
#pragma unroll
      for (int r = 0; r < 16; ++r) red[8192 + (F.wave * 16 + r) * 64 + lane] = p1[r]; }
    asm volatile("" ::: "memory");
    { const f32x16 p2 = skinny32_part((const bf16*)(F.ws + WS_YA) + (size_t)MREAL * 1024, 1024, (const bf16*)(wl + WL_AO), 1024, 1024, cb, lane, F.wave, z);
#pragma unroll
      for (int r = 0; r < 16; ++r) red[16384 + (F.wave * 16 + r) * 64 + lane] = p2[r]; }
    __syncthreads();
    f32x16 a0 = {}, a1 = {}, a2 = {};
    if (F.wave == 0) {
#pragma unroll 1
        for (int w = 0; w < NWAVES; ++w)
#pragma unroll
            for (int r = 0; r < 16; ++r) { a0[r] += red[(w * 16 + r) * 64 + lane]; a1[r] += red[8192 + (w * 16 + r) * 64 + lane]; a2[r] += red[16384 + (w * 16 + r) * 64 + lane]; } }
    __syncthreads(); if (F.wave != 0) return;
#pragma unroll
    for (int r = 0; r < 16; ++r) { const size_t R = MREAL + mrow(r, hi); const bf16* g = GB + R * 3072 + c;
        const float g0 = __uint_as_float((unsigned)(*(const GAS bf16*)g) << 16), g1 = __uint_as_float((unsigned)(*(const GAS bf16*)(g + 1024)) << 16), g2 = __uint_as_float((unsigned)(*(const GAS bf16*)(g + 2048)) << 16);
        st_bf(MG + R * 1024 + c, g0 * a0[r] + g1 * a1[r] + g2 * a2[r]); }
}
__device__ __forceinline__ void skinny_pre(Frame& F, int l, int cb) {
    const int lane = F.lane, c = cb * 32 + (lane & 31), hi = lane >> 5;
    const float* HF = (const float*)(F.ws + WS_HF); float* PRE = (float*)(F.ws + WS_PRE);
    f32x16 acc = {}; acc = skinny_reduce(F, skinny32_part((const bf16*)(F.ws + WS_MG) + (size_t)MREAL * 1024, 1024, (const bf16*)(F.ws + WS_W + (size_t)l * WL_STRIDE + WL_WO), 1024, 1024, cb, lane, F.wave, acc), 0); __syncthreads(); if (F.wave != 0) return;
#pragma unroll
    for (int r = 0; r < 16; ++r) { const size_t R = MREAL + mrow(r, hi); *(GAS float*)(PRE + R * 1024 + c) = ALPHA * *(const GAS float*)(HF + R * 1024 + c) + acc[r]; }
}
#define SKINNY_JOBS(n, call) do { for (int j_ = F.vcu; j_ < (n); j_ += F.G) { const int cb = j_; call; __syncthreads(); } } while (0)

#if defined(SELFCHK)
constexpr int CW_FAIL = 2048;
__device__ __forceinline__ void chk_report(Frame& F, int id, float got, float ref, float scale) {
    const float err = fabsf(got - ref);
    if (!(err <= 0.03f * fabsf(ref) + 0.03f * scale)) __hip_atomic_fetch_or(F.ctl + CW_FAIL, 1u << (id + F.chk_l * 16), RLX_AGENT);
}
__device__ __forceinline__ float bfr(float x) { return __uint_as_float(f2bf(x) << 16); }
__device__ __forceinline__ float ldbf(const bf16* p) { return __uint_as_float((unsigned)(*(const GAS bf16*)p) << 16); }
__device__ __forceinline__ float dot_bf_w(const bf16* a, const float* W, int K, int ldw, int col, int lane) {
    float s = 0.f; for (int k = lane; k < K; k += 64) s += ldbf(a + k) * bfr(W[(size_t)k * ldw + col]); return wave_sum(s);
}
__constant__ int SMP_ROWS[16] = {0, 1, 2, 63, 64, 100, 255, 256, 8191, 8192, 8193, 12345, 16383, 16384, 16399, 16415};
__constant__ int SMP_SP[12] = {0, 15, 16, 17, 79, 80, 81, 143, 144, 1000, 4111, 8207};
__device__ __forceinline__ int smp_row(int i) { return SMP_ROWS[i]; }
__device__ __forceinline__ void chk_p1(Frame& F, const Args& A, int l) {
    const int gw = F.vcu * NWAVES + F.wave, NGW = F.G * NWAVES, lane = F.lane;
    const bf16* HB = (const bf16*)(F.ws + WS_HB); const float* Win = A.in[I_WIN] + (size_t)l * 1024 * 5120; const float* Wg = A.in[I_GATEW] + (size_t)l * 1024 * 3072;
    const float* ROPE = (const float*)(F.ws + WS_ROPE);
    for (int job = gw; job < 16 * 24; job += NGW) { const int R = smp_row(job / 24), ci = job % 24; const bf16* a = HB + (size_t)R * 1024;
        if (ci < 4) { const int c = (ci * 171 + 5) & 511; const float ref = dot_bf_w(a, Win, 1024, 5120, c, lane); float got;
            if (R < MREAL) { const int g = c >> 4, chunkrow = (R >> 13) * 128 + ((R & 8191) >> 6), s = R & 63; got = ldbf((const bf16*)(F.ws + WS_UC) + ((size_t)(g * 256 + chunkrow) * 1152 + s * 16 + (c & 15))); }
            else got = ldbf((const bf16*)(F.ws + WS_UMETA) + (size_t)(R - MREAL) * 512 + c);
            if (lane == 0) chk_report(F, 1, got, ref, 1.0f); }
        else if (ci < 8) { const int c = ((ci - 4) * 397 + 11) % 1536; const float ref = dot_bf_w(a, Win, 1024, 5120, 512 + c, lane); const float got = ldbf((const bf16*)(F.ws + WS_CONV) + (size_t)R * 1536 + c);
            if (lane == 0) chk_report(F, 1, got, ref, 1.0f); }
        else if (ci < 16) { const bool isq = ci < 12; const int cc = ((ci & 3) * 277 + 33) & 1023, hh = cc >> 6, d = cc & 63, j = d & 31;
            const int base = (isq ? 2048 : 3072) + hh * 64; const float xl = dot_bf_w(a, Win, 1024, 5120, base + j, lane), xh = dot_bf_w(a, Win, 1024, 5120, base + 32 + j, lane);
            const int pos = R < MREAL ? 16 + (R & 8191) : ((R - MREAL) & 15); const float cs = ROPE[(size_t)pos * 64 + j], sn = ROPE[(size_t)pos * 64 + 32 + j];
            float ref = d < 32 ? xl * cs - xh * sn : xh * cs + xl * sn; if (isq) ref *= pg8::QSCALE;
            const float got = isq ? ldbf((const bf16*)(F.ws + WS_Q) + (size_t)R * 1024 + cc) : ldbf((const bf16*)(F.ws + WS_K) + (size_t)pg8::kv_row(R) * 1024 + cc);
            if (lane == 0) chk_report(F, 2, got, ref, isq ? 0.2f : 1.0f); }
        else if (ci < 20) { const int c = ((ci - 16) * 301 + 7) & 1023; const float ref = dot_bf_w(a, Win, 1024, 5120, 4096 + c, lane); const float got = ldbf((const bf16*)(F.ws + WS_V) + (size_t)pg8::kv_row(R) * 1024 + c);
            if (lane == 0) chk_report(F, 3, got, ref, 0.5f); }
        else { const int c = ((ci - 20) * 811 + 3) % 3072; const float ref = sigm_(dot_bf_w(a, Wg, 1024, 3072, c, lane) + A.in[I_GATEB][(size_t)l * 3072 + c]); const float got = ldbf((const bf16*)(F.ws + WS_GB) + (size_t)R * 3072 + c);
            if (lane == 0) chk_report(F, 3, got, ref, 0.3f); }
    }
}
__device__ __forceinline__ float u_at(Frame& F, int b, int sp, int c) {
    if (sp < 16) return ldbf((const bf16*)(F.ws + WS_UMETA) + (size_t)(b * 16 + sp) * 512 + c);
    const int t = sp - 16; return ldbf((const bf16*)(F.ws + WS_UC) + ((size_t)((c >> 4) * 256 + b * 128 + (t >> 6)) * 1152 + (t & 63) * 16 + (c & 15)));
}
__device__ __forceinline__ int seq_row(int b, int sp) { return sp < 16 ? MREAL + b * 16 + sp : b * 8192 + (sp - 16); }
__device__ __forceinline__ void chk_ssm_conv(Frame& F, const Args& A, int l) {
    const int gw = F.vcu * NWAVES + F.wave, NGW = F.G * NWAVES, lane = F.lane;
    LAS float* scr = (LAS float*)(F.lds + RING_OFF + F.wave * 16384);
#pragma unroll 1
    for (int job = gw; job < 2 * 12 * 3; job += NGW) { const int b = job / 36, si = (job / 3) % 12, gi = job % 3; const int g = gi == 0 ? 0 : gi == 1 ? 13 : 31;
        const int sp = SMP_SP[si];
        const int lg = l * 32 + g, p = lane; const float lr = A.in[I_LAMRE][lg * 64 + p], li = A.in[I_LAMIM][lg * 64 + p], dt = expf(A.in[I_LOGDT][lg]);
        const float mag = __expf(lr * dt), ar = mag * __cosf(li * dt), ai = mag * __sinf(li * dt), nr = ar - 1.0f, den = lr * lr + li * li;
        const float cr = (nr * lr + ai * li) / den, ci = (ai * lr - nr * li) / den;
        float bbr[16], bbi[16];
#pragma unroll
        for (int c = 0; c < 16; ++c) { const float br = A.in[I_BRE][(size_t)(lg * 64 + p) * 16 + c], bi = A.in[I_BIM][(size_t)(lg * 64 + p) * 16 + c]; bbr[c] = cr * br - ci * bi; bbi[c] = cr * bi + ci * br; }
        float xr = 0.f, xi = 0.f;
#pragma unroll 1
        for (int s = 0; s <= sp; ++s) { float bur = 0.f, bui = 0.f, ua[8], ub[8];
            const bf16* up = s < 16 ? (const bf16*)(F.ws + WS_UMETA) + (size_t)(b * 16 + s) * 512 + g * 16 : (const bf16*)(F.ws + WS_UC) + ((size_t)(g * 256 + b * 128 + ((s - 16) >> 6)) * 1152 + ((s - 16) & 63) * 16);
            unpk8(*(const GAS v4u*)up, ua); unpk8(*(const GAS v4u*)(up + 8), ub);
#pragma unroll
            for (int c = 0; c < 8; ++c) { bur += bbr[c] * ua[c] + bbr[8 + c] * ub[c]; bui += bbi[c] * ua[c] + bbi[8 + c] * ub[c]; }
            const float n1 = ar * xr - ai * xi + bur, n2 = ar * xi + ai * xr + bui; xr = n1; xi = n2; }
        scr[lane] = xr; scr[64 + lane] = xi; LDS_WAIT(); asm volatile("" ::: "memory");
        if (lane < 16) { const int co = lane; float y = 0.f;
#pragma unroll 1
            for (int q = 0; q < 64; ++q) y += A.in[I_CRE][(size_t)(lg * 16 + co) * 64 + q] * scr[q] - A.in[I_CIM][(size_t)(lg * 16 + co) * 64 + q] * scr[64 + q];
            y += A.in[I_SSMD][l * 512 + g * 16 + co] * u_at(F, b, sp, g * 16 + co);
            const float ref = gelu_(y), got = ldbf((const bf16*)(F.ws + WS_YG) + (size_t)seq_row(b, sp) * 512 + g * 16 + co);
            chk_report(F, sp < 16 ? 4 : 5, got, ref, 0.3f); }
        LDS_WAIT(); asm volatile("" ::: "memory");
    }
    for (int job = gw; job < 16; job += NGW) { const int R = smp_row(job), c = (lane * 37 + 5) & 511; const bf16* CB = (const bf16*)(F.ws + WS_CONV);
        float y = 0.f;
#pragma unroll 1
        for (int k = 0; k < 3; ++k) { const int r = k == 0 ? R : prev_row(R, k); if (r >= 0) y += A.in[I_CONVW][(size_t)l * 1536 + (2 - k) * 512 + c] * ldbf(CB + (size_t)r * 1536 + 512 + c) * ldbf(CB + (size_t)r * 1536 + 1024 + c); }
        const float ref = y * ldbf(CB + (size_t)R * 1536 + c), got = ldbf((const bf16*)(F.ws + WS_YC) + (size_t)R * 512 + c);
        chk_report(F, 6, got, ref, 0.5f); }
}
__device__ __forceinline__ void chk_attn(Frame& F) {
    const int gw = F.vcu * NWAVES + F.wave, NGW = F.G * NWAVES, lane = F.lane;
    const bf16* Q = (const bf16*)(F.ws + WS_Q); const bf16* K = (const bf16*)(F.ws + WS_K); const bf16* V = (const bf16*)(F.ws + WS_V); const bf16* OC = (const bf16*)(F.ws + WS_OC);
    for (int job = gw; job < 16 * 3; job += NGW) { const int R = smp_row(job / 3), hi_ = job % 3, hc = hi_ == 0 ? 0 : hi_ == 1 ? 5 : 15, h = hc >> 1;
        const int b = R < MREAL ? (R >> 13) : ((R - MREAL) >> 4); const int nreal = R < MREAL ? (((R & 8191) >> 6) + 1) * 64 : 0, nk = 16 + nreal;
        const float q = ldbf(Q + (size_t)R * 1024 + hc * 64 + lane);
        float m = -INFINITY;
        for (int j = 0; j < nk; ++j) { const size_t kr = (size_t)b * 8320 + (j < 16 ? 8256 + j : j - 16); const float s = wave_sum(q * ldbf(K + kr * 1024 + hc * 64 + lane)); m = fmaxf(m, s); }
        float lsum = 0.f, o0 = 0.f, o1 = 0.f;
        for (int j = 0; j < nk; ++j) { const size_t kr = (size_t)b * 8320 + (j < 16 ? 8256 + j : j - 16); const float s = wave_sum(q * ldbf(K + kr * 1024 + hc * 64 + lane)); const float p = exp2f(s - m);
            lsum += p; o0 += p * ldbf(V + kr * 1024 + h * 128 + 2 * lane); o1 += p * ldbf(V + kr * 1024 + h * 128 + 2 * lane + 1); }
        const float g0 = ldbf(OC + (size_t)R * 2048 + hc * 128 + 2 * lane), g1 = ldbf(OC + (size_t)R * 2048 + hc * 128 + 2 * lane + 1);
        chk_report(F, R < MREAL ? 7 : 8, g0, o0 / lsum, 0.05f); chk_report(F, R < MREAL ? 7 : 8, g1, o1 / lsum, 0.05f); }
}
__device__ __forceinline__ void chk_mix(Frame& F, const Args& A, int l) {
    const int gw = F.vcu * NWAVES + F.wave, NGW = F.G * NWAVES, lane = F.lane;
    const bf16* YG = (const bf16*)(F.ws + WS_YG); const bf16* YS = (const bf16*)(F.ws + WS_YS); const bf16* YC = (const bf16*)(F.ws + WS_YC); const bf16* YA = (const bf16*)(F.ws + WS_YA);
    const bf16* GB = (const bf16*)(F.ws + WS_GB); const bf16* MG = (const bf16*)(F.ws + WS_MG); const bf16* OC = (const bf16*)(F.ws + WS_OC);
    for (int job = gw; job < 16 * 4; job += NGW) { const int R = smp_row(job >> 2), ci = job & 3;
        { const int c = (ci * 139 + 21) & 511; const float z = dot_bf_w(YG + (size_t)R * 512, A.in[I_WGLU] + (size_t)l * 512 * 512, 512, 512, c, lane); const float ref = ldbf(YG + (size_t)R * 512 + c) * sigm_(z);
          if (lane == 0) chk_report(F, 9, ldbf(YS + (size_t)R * 512 + c), ref, 0.2f); }
        { const int h = (ci * 3 + 1) & 7; const float lam_init = 0.8f - 0.6f * expf(-0.3f * (float)l);
          const float d1 = wave_sum(A.in[I_LQ1][l * 64 + lane] * A.in[I_LK1][l * 64 + lane]), d2 = wave_sum(A.in[I_LQ2][l * 64 + lane] * A.in[I_LK2][l * 64 + lane]); const float lam = expf(d1) - expf(d2) + lam_init;
          const float a0 = ldbf(OC + (size_t)R * 2048 + (2 * h) * 128 + lane) - lam * ldbf(OC + (size_t)R * 2048 + (2 * h + 1) * 128 + lane), a1 = ldbf(OC + (size_t)R * 2048 + (2 * h) * 128 + 64 + lane) - lam * ldbf(OC + (size_t)R * 2048 + (2 * h + 1) * 128 + 64 + lane);
          const float rs = 1.0f / sqrtf(wave_sum(a0 * a0 + a1 * a1) * (1.0f / 128.0f) + 1e-5f);
          chk_report(F, 10, ldbf(YA + (size_t)R * 1024 + h * 128 + lane), a0 * rs * A.in[I_SUBLN][l * 128 + lane] * (1.0f - lam_init), 0.3f);
          chk_report(F, 10, ldbf(YA + (size_t)R * 1024 + h * 128 + 64 + lane), a1 * rs * A.in[I_SUBLN][l * 128 + 64 + lane] * (1.0f - lam_init), 0.3f); }
        { const int c = (ci * 269 + 77) & 1023;
          const float p0 = dot_bf_w(YS + (size_t)R * 512, A.in[I_SSMWO] + (size_t)l * 512 * 1024, 512, 1024, c, lane), p1 = dot_bf_w(YC + (size_t)R * 512, A.in[I_CONVWO] + (size_t)l * 512 * 1024, 512, 1024, c, lane),
                      p2 = dot_bf_w(YA + (size_t)R * 1024, A.in[I_ATTNWO] + (size_t)l * 1024 * 1024, 1024, 1024, c, lane);
          const float ref = ldbf(GB + (size_t)R * 3072 + c) * p0 + ldbf(GB + (size_t)R * 3072 + 1024 + c) * p1 + ldbf(GB + (size_t)R * 3072 + 2048 + c) * p2;
          if (lane == 0) chk_report(F, 11, ldbf(MG + (size_t)R * 1024 + c), ref, 0.3f);
          const float pr = dot_bf_w(MG + (size_t)R * 1024, A.in[I_WO] + (size_t)l * 1024 * 1024, 1024, 1024, c, lane);
          if (lane == 0) chk_report(F, 12, ((const float*)(F.ws + WS_PRE))[(size_t)R * 1024 + c], ALPHA * ((const float*)(F.ws + WS_HF))[(size_t)R * 1024 + c] + pr, 0.5f); }
    }
}
__device__ __forceinline__ void chk_moe(Frame& F, const Args& A, int l) {
    const LAS int* tb = (const LAS int*)(F.lds + LDSCTL_OFF);
    const int gw = F.vcu * NWAVES + F.wave, NGW = F.G * NWAVES, lane = F.lane;
    const float* HF = (const float*)(F.ws + WS_HF); const bf16* HB = (const bf16*)(F.ws + WS_HB); const unsigned* TOKE = (const unsigned*)(F.ws + WS_TOKE); const float* TOKW = (const float*)(F.ws + WS_TOKW);
    LAS float* scr = (LAS float*)(F.lds + RING_OFF + F.wave * 16384);
    for (int job = gw; job < 16 * 4; job += NGW) { const int R = smp_row(job >> 2), k = job & 3;
        float lg_ = -INFINITY; if (lane < 32) { float s = 0.f; for (int q = 0; q < 1024; ++q) s += HF[(size_t)R * 1024 + q] * A.in[I_RW][(size_t)l * 32768 + q * 32 + lane]; lg_ = s + A.in[I_RB][l * 32 + lane]; }
        float val = lg_, tv[4]; int te[4];
#pragma unroll
        for (int kk = 0; kk < 4; ++kk) { const float m = wave_max(val); const int idx = wave_min_i(val == m ? lane : 99); tv[kk] = m; te[kk] = idx; if (lane == idx) val = -INFINITY; }
        const float den = 1.0f + expf(tv[1] - tv[0]) + expf(tv[2] - tv[0]) + expf(tv[3] - tv[0]);
        const unsigned tk = TOKE[(size_t)R * 4 + k]; const int e = tk & 255, pos = tk >> 8; const float w = TOKW[(size_t)R * 4 + k];
        const int ek = k == 0 ? te[0] : k == 1 ? te[1] : k == 2 ? te[2] : te[3]; const float wk = expf((k == 0 ? tv[0] : k == 1 ? tv[1] : k == 2 ? tv[2] : tv[3]) - tv[0]) / den;
        const float gap = tv[3] - wave_max(val);
        if (lane == 0 && gap > 1e-3f) { chk_report(F, 13, (float)e, (float)ek, 0.0f); chk_report(F, 13, w, wk, 0.01f); }
        if (((const int*)(F.ws + WS_ROWIDX))[(size_t)e * CAP + pos] != R && lane == 0) chk_report(F, 14, 1.0f, 0.0f, 0.0f);
        const float* wgu = A.in[I_WGU] + ((size_t)l * 32 + e) * 1024 * 2048; const float* bgu = A.in[I_BGU] + ((size_t)l * 32 + e) * 2048;
        for (int j = lane; j < 1024; j += 64) { float g = 0.f, u = 0.f; for (int q = 0; q < 1024; ++q) { const float x = ldbf(HB + (size_t)R * 1024 + q); g += x * bfr(wgu[(size_t)q * 2048 + j]); u += x * bfr(wgu[(size_t)q * 2048 + 1024 + j]); }
            g = fminf(g + bgu[j], 7.0f); u = fminf(fmaxf(u + bgu[1024 + j], -7.0f), 7.0f); scr[j] = bfr((u + 1.0f) * g * sigm_(1.702f * g)); }
        LDS_WAIT(); asm volatile("" ::: "memory");
        const float* wd = A.in[I_WDN] + ((size_t)l * 32 + e) * 1024 * 1024; const int c = (lane * 13 + k * 251) & 1023; float o = 0.f;
        for (int q = 0; q < 1024; ++q) o += scr[q] * bfr(wd[(size_t)q * 1024 + c]);
        o += A.in[I_BDN][((size_t)l * 32 + e) * 1024 + c];
        chk_report(F, 15, ldbf((const bf16*)(F.ws + WS_OUTS) + ((size_t)tb[e] * 256 + pos) * 1024 + c), o, 0.1f);
        LDS_WAIT(); asm volatile("" ::: "memory");
    }
}
#endif

#ifndef PHASE_MASK
#define PHASE_MASK 0x1fff
#endif
#define PH_ON(k) (((PHASE_MASK) >> (k)) & 1)
typedef const __attribute__((address_space(4))) Args* KArgs;
#define PHASE_ENV() KArgs kap_ = (KArgs)__builtin_amdgcn_kernarg_segment_ptr(); asm volatile("" : "+s"(kap_)); const Args& args = *(const Args*)kap_; unsigned char* ws = args.ws; F.ws = ws; F.ctl = (gu32*)(ws + WS_CTL); \
    { int t_ = threadIdx.x; asm volatile("" : "+v"(t_)); F.tid = t_; F.lane = t_ & 63; F.wave = __builtin_amdgcn_readfirstlane(t_ >> 6); } \
    int bid = (int)blockIdx.x; asm volatile("" : "+s"(bid)); F.G = gridDim.x; F.vcu = (F.G % 8 == 0) ? (bid % 8) * (F.G / 8) + bid / 8 : bid; \
    const int gw = F.vcu * NWAVES + F.wave, NGW = F.G * NWAVES; (void)gw; (void)NGW; \
    unsigned char* wl = ws + WS_W + (size_t)l * WL_STRIDE; bf16* HB = (bf16*)(ws + WS_HB); float* HF = (float*)(ws + WS_HF); (void)wl; (void)HB; (void)HF
__global__ void __launch_bounds__(NWAVES * 64, 2) mk_fwd(Args args_) {
    extern __shared__ __attribute__((aligned(16))) unsigned char lds[];
    Frame F;
    F.lds = (LAS unsigned char*)lds;
    F.MISC = (volatile LAS unsigned*)(F.lds + MISC_OFF);
    F.tid = threadIdx.x; F.lane = F.tid & 63; F.wave = __builtin_amdgcn_readfirstlane(F.tid >> 6);
    F.G = gridDim.x; { const int bx = blockIdx.x; F.vcu = (F.G % 8 == 0) ? (bx % 8) * (F.G / 8) + bx / 8 : bx; }
    F.ws = args_.ws; F.ctl = (gu32*)(args_.ws + WS_CTL);
    for (int u = F.tid; u < (LDS_BYTES - LDSCTL_OFF) / 4; u += NWAVES * 64) ((LAS unsigned*)(F.lds + LDSCTL_OFF))[u] = 0u;
    __syncthreads();
    XcdBarrier bar; bar.bar = (unsigned*)(F.ctl + CW_BAR); bar.x = 0; bar.st = nullptr;
    if (N_LAUNCHES == 1) bar = xcd_barrier_post((unsigned*)(F.ctl + CW_BAR), F.MISC + 8);
#define GRID_BAR() do { if (N_LAUNCHES != 1) { if (F.tid == 0) __hip_atomic_store(F.ctl + CW_TMO, 0xBADBA0u, RLX_AGENT); } else { xcd_barrier(bar); } } while (0)
    const int lo = args_.ph_lo, hi = args_.ph_hi;
#define IN(k) (lo <= (k) && (k) < hi)
#define BOTH(k) (IN(k) && IN((k) + 1))

    if (PH_ON(0) && IN(0)) { const int l = 0; PHASE_ENV(); p0_prologue(F, args); if (BOTH(0)) GRID_BAR(); }

    for (int l = 0; l < NLAYER; ++l) {
        const int pb = 1 + 12 * l;
        if (PH_ON(1) && IN(pb + 0)) { PHASE_ENV();
            pg8::Gemm g{HB, (const bf16*)(wl + WL_IN), 1024, 1024, 1024}; pg8::StaticOrder S; S.init(MREAL, NP1, F.G, bid);
            pg8::EpiP1 E{(bf16*)(ws + WS_UC), (bf16*)(ws + WS_UMETA), (bf16*)(ws + WS_CONV), (bf16*)(ws + WS_Q), (bf16*)(ws + WS_K), (bf16*)(ws + WS_V), (bf16*)(ws + WS_GB), (const float*)(ws + WS_ROPE), args.in[I_GATEB] + (size_t)l * 3072};
            pg8::gemm_phase<pg8::EpiP1, pg8::StaticOrder, PG8_ALIGN, PG8_SP2>(F.lds + RING_OFF, g, S, E);
            SKINNY_JOBS(256, skinny_p1(F, args, l, cb));
            if (BOTH(pb + 0)) GRID_BAR();
        }
        if (PH_ON(2) && IN(pb + 1)) { PHASE_ENV();
            pg8::Gemm g{(const bf16*)(ws + WS_UC), (const bf16*)(wl + WL_ST), 1152, 1024, 1024}; pg8::FirstN S{32, 1, F.G, bid};
            pg8::EpiSloc E{(float*)(ws + WS_SLOC)};
            pg8::gemm_phase<pg8::EpiSloc, pg8::FirstN, PG8_ALIGN, PG8_SP2>(F.lds + RING_OFF, g, S, E);
            for (int job = NGW - 1 - gw; job < 64; job += NGW) ssm_meta_job(F, args, l, job >> 5, job & 31);
            if (BOTH(pb + 1)) GRID_BAR();
        }
        if (PH_ON(3) && IN(pb + 2)) { PHASE_ENV(); ssm_carry(F, l); if (BOTH(pb + 2)) GRID_BAR(); }
        if (PH_ON(4) && IN(pb + 3)) { PHASE_ENV();
            { pg8::Gemm g{(const bf16*)(ws + WS_UC), (const bf16*)(wl + WL_TOE), 1152, 1152, 1152}; pg8::FirstN S{128, 4, F.G, bid};
              pg8::EpiY E{(bf16*)(ws + WS_YG)};
              pg8::gemm_phase<pg8::EpiY, pg8::FirstN, PG8_ALIGN, PG8_SP2>(F.lds + RING_OFF, g, S, E); }
            { const attn_body::AttnTensors AT{(const attn_body::bf16*)(ws + WS_Q), (const attn_body::bf16*)(ws + WS_K), (const attn_body::bf16*)(ws + WS_V), (attn_body::bf16*)(ws + WS_OC)};
              const attn_body::StaticOrder S((int)F.G, bid);
              attn_body::attn_phase<attn_body::StaticOrder>((char*)lds + RING_OFF, AT, S); }
            conv_rows(F, args, l);
            for (int job = gw; job < 256; job += NGW) attn_meta_job(F, job >> 3, job & 7);
            if (BOTH(pb + 3)) GRID_BAR();
        }
        if (PH_ON(5) && IN(pb + 4)) { PHASE_ENV();
            pg8::Gemm g{(const bf16*)(ws + WS_YG), (const bf16*)(wl + WL_GLU), 512, 512, 512}; pg8::StaticOrder S; S.init(MREAL, 512, F.G, bid);
            pg8::EpiGLU E{(const bf16*)(ws + WS_YG), (bf16*)(ws + WS_YS)};
            pg8::gemm_phase<pg8::EpiGLU, pg8::StaticOrder, PG8_ALIGN, PG8_SP2>(F.lds + RING_OFF, g, S, E);
            SKINNY_JOBS(16, skinny_glu(F, l, cb));
            attn_combine_rows(F, args, l);
            if (BOTH(pb + 4)) GRID_BAR();
        }
        if (PH_ON(6) && IN(pb + 5)) { PHASE_ENV();
            pg8::StaticOrder S; S.init(MREAL, 1024, F.G, bid);
            SKINNY_JOBS(32, skinny_merge(F, l, cb));
            { pg8::Gemm g{(const bf16*)(ws + WS_YS), (const bf16*)(wl + WL_SO), 512, 512, 512}; pg8::EpiMerge<0> E{(const bf16*)(ws + WS_GB), (bf16*)(ws + WS_MG)};
              pg8::gemm_phase<pg8::EpiMerge<0>, pg8::StaticOrder, PG8_ALIGN, PG8_SP2>(F.lds + RING_OFF, g, S, E); }
            { pg8::Gemm g{(const bf16*)(ws + WS_YC), (const bf16*)(wl + WL_CO), 512, 512, 512}; pg8::EpiMerge<1> E{(const bf16*)(ws + WS_GB), (bf16*)(ws + WS_MG)};
              pg8::gemm_phase<pg8::EpiMerge<1>, pg8::StaticOrder, PG8_ALIGN, PG8_SP2>(F.lds + RING_OFF, g, S, E); }
            { pg8::Gemm g{(const bf16*)(ws + WS_YA), (const bf16*)(wl + WL_AO), 1024, 1024, 1024}; pg8::EpiMerge<2> E{(const bf16*)(ws + WS_GB), (bf16*)(ws + WS_MG)};
              pg8::gemm_phase<pg8::EpiMerge<2>, pg8::StaticOrder, PG8_ALIGN, PG8_SP2>(F.lds + RING_OFF, g, S, E); }
            if (BOTH(pb + 5)) GRID_BAR();
        }
        if (PH_ON(7) && IN(pb + 6)) { PHASE_ENV();
            pg8::Gemm g{(const bf16*)(ws + WS_MG), (const bf16*)(wl + WL_WO), 1024, 1024, 1024}; pg8::StaticOrder S; S.init(MREAL, 1024, F.G, bid);
            pg8::EpiPre E{HF, (float*)(ws + WS_PRE), ALPHA};
            pg8::gemm_phase<pg8::EpiPre, pg8::StaticOrder, PG8_ALIGN, PG8_SP2>(F.lds + RING_OFF, g, S, E);
            SKINNY_JOBS(32, skinny_pre(F, l, cb));
            if (BOTH(pb + 6)) GRID_BAR();
        }
        if (PH_ON(8) && IN(pb + 7)) { PHASE_ENV();
            ln1_router(F, args, l); if (BOTH(pb + 7)) GRID_BAR(); }
        if (PH_ON(9) && IN(pb + 8)) { PHASE_ENV(); moe_tables(F, l, true); moe_gather(F); if (BOTH(pb + 8)) GRID_BAR(); }
        if (PH_ON(10) && IN(pb + 9)) { PHASE_ENV();
            moe_tables(F, l);
            pg8::Gemm g{(const bf16*)(ws + WS_XG), (const bf16*)(wl + WL_GU), 1024, 1024, 1024}; pg8::MoeOrder S{(const LAS int*)(F.lds + LDSCTL_OFF), 8, F.G, bid};
            pg8::EpiSwiGLU E{(bf16*)(ws + WS_HID), args.in[I_BGU] + (size_t)l * 32 * 2048};
            pg8::gemm_phase<pg8::EpiSwiGLU, pg8::MoeOrder, PG8_ALIGN, PG8_SP2>(F.lds + RING_OFF, g, S, E);
            if (BOTH(pb + 9)) GRID_BAR();
        }
        if (PH_ON(11) && IN(pb + 10)) { PHASE_ENV();
            moe_tables(F, l);
            pg8::Gemm g{(const bf16*)(ws + WS_HID), (const bf16*)(wl + WL_DN), 1024, 1024, 1024}; pg8::MoeOrder S{(const LAS int*)(F.lds + LDSCTL_OFF), 4, F.G, bid};
            pg8::EpiDown E{(bf16*)(ws + WS_OUTS), args.in[I_BDN] + (size_t)l * 32 * 1024};
            pg8::gemm_phase<pg8::EpiDown, pg8::MoeOrder, PG8_ALIGN, PG8_SP2>(F.lds + RING_OFF, g, S, E);
            if (BOTH(pb + 10)) GRID_BAR();
        }
        if (PH_ON(12) && IN(pb + 11)) { PHASE_ENV(); moe_tables(F, l);
            ln2_rows(F, args, l); if (BOTH(pb + 11)) GRID_BAR(); }
    }
#undef IN
#undef BOTH
}


#if defined(SELFCHK)
__global__ void __launch_bounds__(NWAVES * 64, 2) mk_chk(Args args_) {
    extern __shared__ __attribute__((aligned(16))) unsigned char lds[];
    Frame F;
    F.lds = (LAS unsigned char*)lds; F.MISC = (volatile LAS unsigned*)(F.lds + MISC_OFF);
    F.tid = threadIdx.x; F.lane = F.tid & 63; F.wave = __builtin_amdgcn_readfirstlane(F.tid >> 6);
    F.G = gridDim.x; { const int bx = blockIdx.x; F.vcu = (F.G % 8 == 0) ? (bx % 8) * (F.G / 8) + bx / 8 : bx; }
    F.ws = args_.ws; F.ctl = (gu32*)(args_.ws + WS_CTL);
    KArgs kap_ = (KArgs)__builtin_amdgcn_kernarg_segment_ptr(); const Args& args = *(const Args*)kap_; const int l = args_.li; F.chk_l = l;
    if (args_.pad == 1) { chk_p1(F, args, l); chk_ssm_conv(F, args, l); chk_attn(F); chk_mix(F, args, l); }
    if (args_.pad == 2) { moe_tables(F, l); chk_moe(F, args, l); }
}
#endif
extern "C" void kernel_launch(void* const* d_in, const int* in_sizes, int n_in, void* d_out, int out_size, void* d_ws, size_t ws_size, hipStream_t stream) {
    static int grid = 0;
    if (grid == 0) {
        if (n_in != N_IN || in_sizes[0] != MREAL * 1024 || out_size != MREAL * 1024 || ws_size < WS_END) { fprintf(stderr, "kernel_launch: unexpected shapes (n_in %d, in0 %d, out %d, ws %zu < %zu); nothing launched\n", n_in, n_in > 0 ? in_sizes[0] : -1, out_size, ws_size, (size_t)WS_END); grid = -1; return; }
        int dev = 0, cus = 0, per_cu = 0;
        if (hipGetDevice(&dev) != hipSuccess || hipDeviceGetAttribute(&cus, hipDeviceAttributeMultiprocessorCount, dev) != hipSuccess) { grid = -1; return; }
#if defined(SELFCHK)
        (void)hipFuncSetAttribute((const void*)mk_chk, hipFuncAttributeMaxDynamicSharedMemorySize, LDS_BYTES);
#endif
        if (hipFuncSetAttribute((const void*)mk_fwd, hipFuncAttributeMaxDynamicSharedMemorySize, LDS_BYTES) != hipSuccess) { fprintf(stderr, "kernel_launch: hipFuncSetAttribute failed\n"); grid = -1; return; }
        if (hipOccupancyMaxActiveBlocksPerMultiprocessor(&per_cu, (const void*)mk_fwd, NWAVES * 64, LDS_BYTES) != hipSuccess || per_cu < 1)
            fprintf(stderr, "kernel_launch: note: occupancy query reports %d workgroups per CU\n", per_cu);
        (void)hipGetLastError();
        grid = cus;
        if (grid != 256) fprintf(stderr, "kernel_launch: %d CUs; the unit orders assume 256\n", grid);
    }
    if (grid < 0) return;
    if (hipMemsetAsync((char*)d_ws + WS_CTL, 0, CTL_ZERO_BYTES, stream) != hipSuccess) return;
    Args a{};
    for (int i = 0; i < N_IN; ++i) a.in[i] = (const float*)d_in[i];
    a.out = (float*)d_out; a.ws = (unsigned char*)d_ws;
    for (int li = 0; li < N_LAUNCHES; ++li) {
        a.ph_lo = (N_LAUNCHES == 1) ? 0 : li; a.ph_hi = (N_LAUNCHES == 1) ? NPH : li + 1; a.li = li; a.pad = 0;
        hipLaunchKernelGGL(mk_fwd, dim3(grid), dim3(NWAVES * 64), LDS_BYTES, stream, a);
        if (hipPeekAtLastError() != hipSuccess) { fprintf(stderr, "kernel_launch: launch %d failed\n", li); break; }
#if defined(SELFCHK)
        if (N_LAUNCHES == NPH && (li == 7 || li == 11 || li == 19 || li == 23)) { Args c = a; c.ph_lo = 1000; c.ph_hi = 1000; c.pad = (li == 7 || li == 19) ? 1 : 2; c.li = li > 12 ? 1 : 0; hipLaunchKernelGGL(mk_chk, dim3(grid), dim3(NWAVES * 64), LDS_BYTES, stream, c); }
#endif
    }
}
```

```cpp
#include <hip/hip_runtime.h>
#include <cstdio>
#include <cstdint>
namespace pg8 {
#define PG8_LAS __attribute__((address_space(3)))
typedef unsigned short bf16_t;
typedef short bf16x8 __attribute__((ext_vector_type(8)));
typedef float f32x4 __attribute__((ext_vector_type(4)));
typedef unsigned u32x4 __attribute__((ext_vector_type(4)));
constexpr int BM = 256, BK = 64, HALF = 128, HTB = HALF * BK * 2  , STAGE_BYTES = 8 * HTB, NXCD = 8, WGM = 8;

__host__ __device__ __forceinline__ int lds_byte(int r, int c) { const int st = (r >> 4) * 2 + (c >> 5), rr = r & 15, cc = c & 31, ob = rr * 64 + cc * 2; return st * 1024 + (ob ^ (((ob >> 9) & 1) << 5)); }
__host__ __device__ __forceinline__ void stage_rc(int b, int& R, int& C) { const int st = b / 1024, sb = b % 1024, swz = sb ^ (((sb >> 9) & 1) << 5); R = (st >> 1) * 16 + swz / 64; C = (st & 1) * 32 + (swz % 64) / 2; }
__host__ __device__ __forceinline__ int perm32(int rho) { const int n = rho >> 4, i = rho & 15; return 8 * (i >> 2) + 4 * n + (i & 3); }

struct Unit { int pm, pn; };
struct Gemm { const bf16_t* A; const bf16_t* Bt; int lda, ldb, K; };

struct StaticOrder {
    int nM, nN, nwg, G, c;
    __host__ __device__ void init(int M, int N, int G_, int c_) { nM = M / BM; nN = N / BM; nwg = nM * nN; G = G_; c = c_; }
    __host__ __device__ bool next(int i, Unit& u) const {
        const long L = (long)i * G + c; if (L >= nwg) return false;
        int wgid = (int)L; { const int q = nwg / NXCD, r = nwg % NXCD, xcd = wgid % NXCD, off = wgid / NXCD; wgid = (xcd < r ? xcd * (q + 1) : r * (q + 1) + (xcd - r) * q) + off; }
        const int nig = WGM * nN, gid = wgid / nig, fm = gid * WGM, gsz = (nM - fm) < WGM ? (nM - fm) : WGM;
        u.pm = fm + ((wgid % nig) % gsz); u.pn = (wgid % nig) / gsz; return true;
    }
    __device__ __forceinline__ void a_ready(const Unit&) const {}
    __device__ __forceinline__ void done(const Unit&) const {}
};

typedef float cvt_f2_ __attribute__((ext_vector_type(2))); typedef __bf16 cvt_b2_ __attribute__((ext_vector_type(2)));
__device__ __forceinline__ unsigned cvt_pk_bf16(float lo, float hi) { const cvt_f2_ v = {lo, hi}; const cvt_b2_ b = __builtin_convertvector(v, cvt_b2_); return __builtin_bit_cast(unsigned, b); }
typedef float f32x2 __attribute__((ext_vector_type(2)));
typedef unsigned u32x2 __attribute__((ext_vector_type(2)));
__device__ __forceinline__ u32x4 pack8(f32x4 a, f32x4 b) { u32x4 w; w.x = cvt_pk_bf16(a[0], a[1]); w.y = cvt_pk_bf16(a[2], a[3]); w.z = cvt_pk_bf16(b[0], b[1]); w.w = cvt_pk_bf16(b[2], b[3]); return w; }
__device__ __forceinline__ u32x2 pack4(f32x4 a) { u32x2 w; w.x = cvt_pk_bf16(a[0], a[1]); w.y = cvt_pk_bf16(a[2], a[3]); return w; }
__device__ __forceinline__ float bf_lo(unsigned w) { return __uint_as_float(w << 16); }
__device__ __forceinline__ float bf_hi(unsigned w) { return __uint_as_float(w & 0xffff0000u); }
__device__ __forceinline__ void unpack8(u32x4 w, f32x4& a, f32x4& b) { a = (f32x4){bf_lo(w.x), bf_hi(w.x), bf_lo(w.y), bf_hi(w.y)}; b = (f32x4){bf_lo(w.z), bf_hi(w.z), bf_lo(w.w), bf_hi(w.w)}; }
__device__ __forceinline__ float sigm(float x) { return __builtin_amdgcn_rcpf(1.0f + __builtin_amdgcn_exp2f(-1.4426950408889634f * x)); }
__device__ __forceinline__ f32x4 sigm4(f32x4 v) { return (f32x4){sigm(v[0]), sigm(v[1]), sigm(v[2]), sigm(v[3])}; }
__device__ __forceinline__ float gelu_t(float x) { const float u = 0.7978845608028654f * (x + 0.044715f * x * x * x); return x * sigm(2.0f * u); }
__device__ __forceinline__ f32x4 gelu4(f32x4 v) { return (f32x4){gelu_t(v[0]), gelu_t(v[1]), gelu_t(v[2]), gelu_t(v[3])}; }

constexpr int MREAL = 16384, MVALID = 16416;
constexpr float QSCALE = 0.125f * 1.4426950408889634f;
__device__ __forceinline__ int kv_row(int R) { return R < MREAL ? (R >> 13) * 8320 + (R & 8191) : ((R - MREAL) >> 4) * 8320 + 8256 + ((R - MREAL) & 15); }

#define EPI_ROWS(R) _Pragma("unroll") for (int ai = 0; ai < 2; ++ai) _Pragma("unroll") for (int m = 0; m < 4; ++m) { const int R = rbase + ai * HALF + m * 16;
#define EPI_COLS _Pragma("unroll") for (int bj = 0; bj < 2; ++bj) {
#define EPI_END }

struct EpiP1 {
    static constexpr bool PERM = true, AFTER_DRAIN = false;
    bf16_t *UC, *UMETA, *CONVB, *Q, *K, *V, *GB; const float* rope; const float* gate_b;
    __device__ __forceinline__ void operator()(const f32x4 (&acc)[2][2][4][2], const Unit& u, int wr, int wc, int fr, int fq) const {
        const int pn = u.pn, rbase = u.pm * BM + wr * 64 + fr, cw = wc * 32 + 8 * fq;
        if (pn < 2) {
            EPI_ROWS(R)
                if (R < MREAL) { const int chunkrow = (R >> 13) * 128 + ((R & 8191) >> 6), s = R & 63;
                    EPI_COLS const int c = pn * 256 + bj * HALF + cw; *(u32x4*)(UC + ((size_t)((c >> 4) * 256 + chunkrow) * 1152 + s * 16 + (c & 15))) = pack8(acc[ai][bj][m][0], acc[ai][bj][m][1]); EPI_END }
                else if (R < MVALID) {
                    EPI_COLS const int c = pn * 256 + bj * HALF + cw; *(u32x4*)(UMETA + (size_t)(R - MREAL) * 512 + c) = pack8(acc[ai][bj][m][0], acc[ai][bj][m][1]); EPI_END }
            EPI_END
        } else if (pn < 8) {
            EPI_ROWS(R)
                if (R < MVALID) { EPI_COLS const int c = (pn - 2) * 256 + bj * HALF + cw; *(u32x4*)(CONVB + (size_t)R * 1536 + c) = pack8(acc[ai][bj][m][0], acc[ai][bj][m][1]); EPI_END }
            EPI_END
        } else if (pn < 16) {
            const bool isq = pn < 12; const int ct = (pn - (isq ? 8 : 12)) * 256; bf16_t* dstb = isq ? Q : K; const float sc = isq ? QSCALE : 1.0f;
            EPI_ROWS(R)
                if (R < MVALID) { const int pos = R < MREAL ? 16 + (R & 8191) : ((R - MREAL) & 15); const size_t drow = isq ? (size_t)R : (size_t)kv_row(R);
                    EPI_COLS const int c = ct + bj * HALF + cw, hh = c >> 6, gq = (c & 63) >> 3;
                        const f32x4 cs = *(const f32x4*)(rope + (size_t)pos * 64 + 4 * gq), sn = *(const f32x4*)(rope + (size_t)pos * 64 + 32 + 4 * gq);
                        const f32x4 x0 = acc[ai][bj][m][0], x1 = acc[ai][bj][m][1];
                        const f32x4 lo = (x0 * cs - x1 * sn) * sc, hi = (x1 * cs + x0 * sn) * sc;
                        bf16_t* d = dstb + drow * 1024 + hh * 64 + 4 * gq; *(u32x2*)d = pack4(lo); *(u32x2*)(d + 32) = pack4(hi); EPI_END }
            EPI_END
        } else if (pn < 20) {
            EPI_ROWS(R)
                if (R < MVALID) { const size_t drow = (size_t)kv_row(R);
                    EPI_COLS const int c = (pn - 16) * 256 + bj * HALF + cw; *(u32x4*)(V + drow * 1024 + c) = pack8(acc[ai][bj][m][0], acc[ai][bj][m][1]); EPI_END }
            EPI_END
        } else {
            f32x4 b0[2], b1[2];
#pragma unroll
            for (int bj = 0; bj < 2; ++bj) { const int c = (pn - 20) * 256 + bj * HALF + cw; b0[bj] = *(const f32x4*)(gate_b + c); b1[bj] = *(const f32x4*)(gate_b + c + 4); }
            EPI_ROWS(R)
                if (R < MVALID) { EPI_COLS const int c = (pn - 20) * 256 + bj * HALF + cw;
                    *(u32x4*)(GB + (size_t)R * 3072 + c) = pack8(sigm4(acc[ai][bj][m][0] + b0[bj]), sigm4(acc[ai][bj][m][1] + b1[bj])); EPI_END }
            EPI_END
        }
    }
};
struct EpiSloc {
    static constexpr bool PERM = false, AFTER_DRAIN = false;
    float* SL;
    __device__ __forceinline__ void operator()(const f32x4 (&acc)[2][2][4][2], const Unit& u, int wr, int wc, int fr, int fq) const {
        const int rbase = u.pm * BM + wr * 64 + fr, col0 = wc * 32 + 4 * fq;
        EPI_ROWS(R)
            float* rowp = SL + (size_t)R * 128 + col0;
#pragma unroll
            for (int n = 0; n < 2; ++n) *(f32x4*)(rowp + n * 16) = acc[ai][0][m][n];
        EPI_END
    }
};
struct EpiY {
    static constexpr bool PERM = true, AFTER_DRAIN = false;
    bf16_t* YG;
    __device__ __forceinline__ void operator()(const f32x4 (&acc)[2][2][4][2], const Unit& u, int wr, int wc, int fr, int fq) const {
        const int g = u.pm, nt = u.pn & 3, rbase = wr * 64 + fr, cw = wc * 32 + 8 * fq;
        EPI_ROWS(R)
            const int b = R >> 7, k = R & 127;
            EPI_COLS const int n = nt * 256 + bj * HALF + cw, t = n >> 4, co0 = n & 15; const size_t row = (size_t)b * 8192 + k * 64 + t;
                *(u32x4*)(YG + row * 512 + g * 16 + co0) = pack8(gelu4(acc[ai][bj][m][0]), gelu4(acc[ai][bj][m][1])); EPI_END
        EPI_END
    }
};
struct EpiGLU {
    static constexpr bool PERM = true, AFTER_DRAIN = false;
    const bf16_t* YG; bf16_t* YS;
    __device__ __forceinline__ void operator()(const f32x4 (&acc)[2][2][4][2], const Unit& u, int wr, int wc, int fr, int fq) const {
        const int rbase = u.pm * BM + wr * 64 + fr, cw = wc * 32 + 8 * fq;
        EPI_ROWS(R)
            EPI_COLS const int c = u.pn * 256 + bj * HALF + cw; f32x4 ya, yb; unpack8(*(const u32x4*)(YG + (size_t)R * 512 + c), ya, yb);
                *(u32x4*)(YS + (size_t)R * 512 + c) = pack8(ya * sigm4(acc[ai][bj][m][0]), yb * sigm4(acc[ai][bj][m][1])); EPI_END
        EPI_END
    }
};
template <int I> struct EpiMerge {
    static constexpr bool PERM = true, AFTER_DRAIN = false;
    const bf16_t* GB; bf16_t* MG;
    __device__ __forceinline__ void operator()(const f32x4 (&acc)[2][2][4][2], const Unit& u, int wr, int wc, int fr, int fq) const {
        const int rbase = u.pm * BM + wr * 64 + fr, cw = wc * 32 + 8 * fq;
        EPI_ROWS(R)
            EPI_COLS const int c = u.pn * 256 + bj * HALF + cw; f32x4 ga, gb; unpack8(*(const u32x4*)(GB + (size_t)R * 3072 + I * 1024 + c), ga, gb);
                f32x4 oa = ga * acc[ai][bj][m][0], ob = gb * acc[ai][bj][m][1];
                if (I > 0) { f32x4 pa, pb; unpack8(*(const u32x4*)(MG + (size_t)R * 1024 + c), pa, pb); oa += pa; ob += pb; }
                *(u32x4*)(MG + (size_t)R * 1024 + c) = pack8(oa, ob); EPI_END
        EPI_END
    }
};
struct EpiPre {
    static constexpr bool PERM = false, AFTER_DRAIN = false;
    const float* HF; float* PRE; float alpha;
    __device__ __forceinline__ void operator()(const f32x4 (&acc)[2][2][4][2], const Unit& u, int wr, int wc, int fr, int fq) const {
        const int rbase = u.pm * BM + wr * 64 + fr, col0 = u.pn * BM + wc * 32 + 4 * fq;
        EPI_ROWS(R)
            EPI_COLS
#pragma unroll
                for (int n = 0; n < 2; ++n) { const size_t off = (size_t)R * 1024 + col0 + bj * HALF + n * 16; *(f32x4*)(PRE + off) = *(const f32x4*)(HF + off) * alpha + acc[ai][bj][m][n]; }
            EPI_END
        EPI_END
    }
};
struct EpiSwiGLU {
    static constexpr bool PERM = true, AFTER_DRAIN = false;
    bf16_t* HID; const float* bgu;
    __device__ __forceinline__ void operator()(const f32x4 (&acc)[2][2][4][2], const Unit& u, int wr, int wc, int fr, int fq) const {
        const int e = u.pn >> 3, nt = u.pn & 7, rbase = u.pm * BM + wr * 64 + fr, hw = wc * 16 + 4 * fq;
        f32x4 bg[2], bu[2];
#pragma unroll
        for (int bj = 0; bj < 2; ++bj) { const int hcol = nt * 128 + bj * 64 + hw; bg[bj] = *(const f32x4*)(bgu + (size_t)e * 2048 + hcol); bu[bj] = *(const f32x4*)(bgu + (size_t)e * 2048 + 1024 + hcol); }
        EPI_ROWS(R)
            EPI_COLS const int hcol = nt * 128 + bj * 64 + hw; const f32x4 gt = acc[ai][bj][m][0] + bg[bj], up = acc[ai][bj][m][1] + bu[bj]; f32x4 h;
#pragma unroll
                for (int i = 0; i < 4; ++i) { const float gg = fminf(gt[i], 7.0f), uu = fminf(fmaxf(up[i], -7.0f), 7.0f); h[i] = (uu + 1.0f) * gg * sigm(1.702f * gg); }
                *(u32x2*)(HID + (size_t)R * 1024 + hcol) = pack4(h); EPI_END
        EPI_END
    }
};
struct EpiDown {
    static constexpr bool PERM = true, AFTER_DRAIN = false;
    bf16_t* OUTS; const float* bdn;
    __device__ __forceinline__ void operator()(const f32x4 (&acc)[2][2][4][2], const Unit& u, int wr, int wc, int fr, int fq) const {
        const int e = u.pn >> 2, nt = u.pn & 3, rbase = u.pm * BM + wr * 64 + fr, cw = wc * 32 + 8 * fq;
        f32x4 b0[2], b1[2];
#pragma unroll
        for (int bj = 0; bj < 2; ++bj) { const int c = nt * 256 + bj * HALF + cw; b0[bj] = *(const f32x4*)(bdn + (size_t)e * 1024 + c); b1[bj] = *(const f32x4*)(bdn + (size_t)e * 1024 + c + 4); }
        EPI_ROWS(R)
            EPI_COLS const int c = nt * 256 + bj * HALF + cw; *(u32x4*)(OUTS + (size_t)R * 1024 + c) = pack8(acc[ai][bj][m][0] + b0[bj], acc[ai][bj][m][1] + b1[bj]); EPI_END
        EPI_END
    }
};
struct FirstN {
    int n, div, G, c;
    __device__ __forceinline__ bool next(int i, Unit& u) const { const int L = i * G + c; if (L >= n) return false; u.pm = L / div; u.pn = L; return true; }
    __device__ __forceinline__ void a_ready(const Unit&) const {}
    __device__ __forceinline__ void done(const Unit&) const {}
};
struct MoeOrder {
    const PG8_LAS int* tb; int nN, G, c;
    __device__ __forceinline__ bool next(int i, Unit& u) const {
        const int L = i * G + c, mtg = L / nN; if (mtg >= tb[32]) return false;
        int e = 0; while (tb[e + 1] <= mtg) ++e;
        u.pm = mtg; u.pn = e * nN + (L - mtg * nN); return true; }
    __device__ __forceinline__ void a_ready(const Unit&) const {}
    __device__ __forceinline__ void done(const Unit&) const {}
};
template <class Epi, class Sched, bool ALIGN_EPI = false, bool SP2 = false>
__device__ __forceinline__ void gemm_phase(PG8_LAS unsigned char* lds, const Gemm g, const Sched& S, const Epi& E) {
    int tid_ = threadIdx.x; asm volatile("" : "+v"(tid_));
    const int tid = tid_, wid = __builtin_amdgcn_readfirstlane(tid >> 6), lane = tid & 63, wr = wid >> 2, wc = wid & 3, fr = lane & 15, fq = lane >> 4;
    const int K = g.K, nt = K / BK;
    unsigned voffA[2], voffB[2];
#pragma unroll
    for (int i = 0; i < 2; ++i) { int R, C; stage_rc(tid * 16 + i * 8192, R, C); const int Rb = Epi::PERM ? ((R & ~31) + perm32(R & 31)) : R;
        voffA[i] = (unsigned)(R * g.lda + C) * 2u; voffB[i] = (unsigned)(Rb * g.ldb + C) * 2u; }
    const size_t kstep = (size_t)(BK * 2);
    const size_t hstepA = (size_t)HALF * g.lda * 2, hstepB = (size_t)HALF * g.ldb * 2;
    const size_t tstepA = 2 * hstepA, tstepB = 2 * hstepB;
    const unsigned ldsw = (unsigned)wid * 1024u;
    const int aoff = lds_byte(wr * 64 + fr, fq * 8), boff = lds_byte(wc * 32 + fr, fq * 8);
#define PG8_SA(b, h) (((b) * 2 + (h)) * HTB)
#define PG8_SB(b, h) ((4 + (b) * 2 + (h)) * HTB)
#define PG8_STAGE(bufoff, gbase, voff) do { _Pragma("unroll") for (int _i = 0; _i < 2; ++_i) \
        __builtin_amdgcn_global_load_lds((const unsigned*)((const char*)(gbase) + (voff)[_i]), (PG8_LAS unsigned*)(lds + (bufoff) + ldsw + _i * 8192), 16, 0, 0); } while (0)
#define PG8_LDA(dst, b, h) do { _Pragma("unroll") for (int m = 0; m < 4; ++m) _Pragma("unroll") for (int k = 0; k < 2; ++k) dst[m][k] = *(const PG8_LAS bf16x8*)(lds + PG8_SA(b, h) + aoff + m * 2048 + k * 1024); } while (0)
#define PG8_LDB(dst, b, h) do { _Pragma("unroll") for (int n = 0; n < 2; ++n) _Pragma("unroll") for (int k = 0; k < 2; ++k) dst[n][k] = *(const PG8_LAS bf16x8*)(lds + PG8_SB(b, h) + boff + n * 2048 + k * 1024); } while (0)
#define PG8_MMA(ai, bj, At, Bt) do { __builtin_amdgcn_s_setprio(1); _Pragma("unroll") for (int m = 0; m < 4; ++m) _Pragma("unroll") for (int n = 0; n < 2; ++n) _Pragma("unroll") for (int k = 0; k < 2; ++k) \
        acc[ai][bj][m][n] = __builtin_amdgcn_mfma_f32_16x16x32_bf16(Bt[n][k], At[m][k], acc[ai][bj][m][n], 0, 0, 0); __builtin_amdgcn_s_setprio(0); } while (0)
#define PG8_WAIT_V(n) asm volatile("s_waitcnt vmcnt(" #n ")" ::: "memory")
#define PG8_WAIT_L(n) asm volatile("s_waitcnt lgkmcnt(" #n ")" ::: "memory")
#define PG8_BAR __builtin_amdgcn_s_barrier()
#define PG8_SCHED __builtin_amdgcn_sched_barrier(0)
    Unit cur, nxt; int ui = 0;
    if (!S.next(0, cur)) return;
    f32x4 acc[2][2][4][2];
#pragma unroll
    for (int a = 0; a < 2; ++a)
#pragma unroll
        for (int b = 0; b < 2; ++b)
#pragma unroll
            for (int m = 0; m < 4; ++m)
#pragma unroll
                for (int n = 0; n < 2; ++n) acc[a][b][m][n] = (f32x4){0.f, 0.f, 0.f, 0.f};
    bf16x8 At[4][2], B0[2][2], B1[2][2];
    const char* cA = (const char*)g.A + (size_t)cur.pm * tstepA; const char* cB = (const char*)g.Bt + (size_t)cur.pn * tstepB;
    S.a_ready(cur);
    if constexpr (SP2) {
        PG8_STAGE(PG8_SB(0, 0), cB, voffB); PG8_STAGE(PG8_SB(0, 1), cB + hstepB, voffB); PG8_STAGE(PG8_SA(0, 0), cA, voffA); PG8_STAGE(PG8_SA(0, 1), cA + hstepA, voffA);
        if (wr == 1) PG8_BAR;
        PG8_WAIT_V(2); PG8_BAR;
        PG8_STAGE(PG8_SB(1, 0), cB + kstep, voffB); PG8_STAGE(PG8_SA(1, 0), cA + kstep, voffA); PG8_STAGE(PG8_SB(1, 1), cB + hstepB + kstep, voffB);
        PG8_WAIT_V(6); PG8_BAR;
    } else {
        PG8_STAGE(PG8_SB(0, 0), cB, voffB); PG8_STAGE(PG8_SA(0, 0), cA, voffA); PG8_STAGE(PG8_SB(0, 1), cB + hstepB, voffB); PG8_STAGE(PG8_SA(0, 1), cA + hstepA, voffA);
        if (wr == 1) PG8_BAR;
        PG8_WAIT_V(4); PG8_BAR;
        PG8_STAGE(PG8_SB(1, 0), cB + kstep, voffB); PG8_STAGE(PG8_SA(1, 0), cA + kstep, voffA); PG8_STAGE(PG8_SB(1, 1), cB + hstepB + kstep, voffB);
        PG8_WAIT_V(6); PG8_BAR;
    }
    for (;;) {
        const bool has_next = S.next(ui + 1, nxt);
        const char* nA = has_next ? (const char*)g.A + (size_t)nxt.pm * tstepA : cA; const char* nB = has_next ? (const char*)g.Bt + (size_t)nxt.pn * tstepB : cB;
        for (int t = 0; t < nt; t += 2) {
            const bool last = (t == nt - 2);
            const char* a1 = cA + (size_t)(t + 1) * kstep;
            const char* a2 = last ? nA : cA + (size_t)(t + 2) * kstep; const char* b2 = last ? nB : cB + (size_t)(t + 2) * kstep;
            const char* a3 = a2 + kstep; const char* b3 = b2 + kstep;
            if (last && has_next) S.a_ready(nxt);
            if constexpr (SP2) {
            PG8_LDB(B0, 0, 0); PG8_LDB(B1, 0, 1); PG8_SCHED; PG8_LDA(At, 0, 0); PG8_STAGE(PG8_SA(1, 1), a1 + hstepA, voffA);
            PG8_WAIT_V(8); PG8_WAIT_L(0); PG8_BAR; PG8_MMA(0, 0, At, B0); PG8_MMA(0, 1, At, B1); PG8_BAR; PG8_SCHED;
            PG8_LDA(At, 0, 1); PG8_STAGE(PG8_SB(0, 0), b2, voffB); PG8_STAGE(PG8_SB(0, 1), b2 + hstepB, voffB); PG8_STAGE(PG8_SA(0, 0), a2, voffA);
            PG8_WAIT_V(8); PG8_WAIT_L(0); PG8_BAR; PG8_MMA(1, 0, At, B0); PG8_MMA(1, 1, At, B1); PG8_BAR; PG8_SCHED;
            PG8_LDB(B0, 1, 0); PG8_LDB(B1, 1, 1); PG8_SCHED; PG8_LDA(At, 1, 0); PG8_STAGE(PG8_SA(0, 1), a2 + hstepA, voffA);
            PG8_WAIT_V(8); PG8_WAIT_L(0); PG8_BAR; PG8_MMA(0, 0, At, B0); PG8_MMA(0, 1, At, B1); PG8_BAR; PG8_SCHED;
            PG8_LDA(At, 1, 1); PG8_STAGE(PG8_SB(1, 0), b3, voffB); PG8_STAGE(PG8_SB(1, 1), b3 + hstepB, voffB); PG8_STAGE(PG8_SA(1, 0), a3, voffA);
            PG8_WAIT_V(8); PG8_WAIT_L(0); PG8_BAR; PG8_MMA(1, 0, At, B0); PG8_MMA(1, 1, At, B1); PG8_BAR; PG8_SCHED;
            } else {
            PG8_LDB(B0, 0, 0); PG8_SCHED; PG8_LDA(At, 0, 0); PG8_STAGE(PG8_SA(1, 1), a1 + hstepA, voffA);
            PG8_WAIT_L(8); PG8_BAR; PG8_WAIT_L(0); PG8_MMA(0, 0, At, B0); PG8_BAR; PG8_SCHED;
            PG8_LDB(B1, 0, 1); PG8_STAGE(PG8_SB(0, 0), b2, voffB);
            PG8_BAR; PG8_WAIT_L(0); PG8_MMA(0, 1, At, B1); PG8_BAR;
            PG8_LDA(At, 0, 1); PG8_STAGE(PG8_SA(0, 0), a2, voffA);
            PG8_BAR; PG8_WAIT_L(0); PG8_MMA(1, 0, At, B0); PG8_BAR; PG8_SCHED;
            PG8_STAGE(PG8_SB(0, 1), b2 + hstepB, voffB);
            PG8_WAIT_V(6); PG8_BAR; PG8_MMA(1, 1, At, B1); PG8_BAR;
            PG8_LDB(B0, 1, 0); PG8_SCHED; PG8_LDA(At, 1, 0); PG8_STAGE(PG8_SA(0, 1), a2 + hstepA, voffA);
            PG8_WAIT_L(8); PG8_BAR; PG8_WAIT_L(0); PG8_MMA(0, 0, At, B0); PG8_BAR; PG8_SCHED;
            PG8_LDB(B1, 1, 1); PG8_STAGE(PG8_SB(1, 0), b3, voffB);
            PG8_BAR; PG8_WAIT_L(0); PG8_MMA(0, 1, At, B1); PG8_BAR;
            PG8_LDA(At, 1, 1); PG8_STAGE(PG8_SA(1, 0), a3, voffA);
            PG8_BAR; PG8_WAIT_L(0); PG8_MMA(1, 0, At, B0); PG8_BAR; PG8_SCHED;
            PG8_STAGE(PG8_SB(1, 1), b3 + hstepB, voffB);
            PG8_WAIT_V(6); PG8_BAR; PG8_MMA(1, 1, At, B1); PG8_BAR;
            }
        }
        if constexpr (ALIGN_EPI) { if (wr == 0) PG8_BAR; }
        if constexpr (!Epi::AFTER_DRAIN) { E(acc, cur, wr, wc, fr, fq); S.done(cur); }
        if (!has_next) break;
#pragma unroll
        for (int a = 0; a < 2; ++a)
#pragma unroll
            for (int b = 0; b < 2; ++b)
#pragma unroll
                for (int m = 0; m < 4; ++m)
#pragma unroll
                    for (int n = 0; n < 2; ++n) acc[a][b][m][n] = (f32x4){0.f, 0.f, 0.f, 0.f};
        cur = nxt; cA = nA; cB = nB; ++ui;
        if constexpr (ALIGN_EPI) { if (wr == 1) PG8_BAR; }
    }
    PG8_WAIT_V(0);
    if constexpr (!ALIGN_EPI) { if (wr == 0) PG8_BAR; }
    PG8_BAR;
    if constexpr (Epi::AFTER_DRAIN) { E.fused(acc, cur, wr, wc, fr, fq, lds, wid, lane); S.done(cur); }
#undef PG8_SA
#undef PG8_SB
#undef PG8_STAGE
#undef PG8_LDA
#undef PG8_LDB
#undef PG8_MMA
#undef PG8_WAIT_V
#undef PG8_WAIT_L
#undef PG8_BAR
#undef PG8_SCHED
}
}

#ifndef PG8_SP2
#define PG8_SP2 true
#endif
#ifndef PG8_ALIGN
#define PG8_ALIGN true
#endif
#include <hip/hip_bf16.h>
#include <cmath>
namespace attn_body {
using bf16=__hip_bfloat16;
using bf16x8=__attribute__((ext_vector_type(8)))short;
using s16x4=__attribute__((ext_vector_type(4)))short;
using f32x16=__attribute__((ext_vector_type(16)))float;
using u32x4=__attribute__((ext_vector_type(4)))unsigned;
constexpr int BATCH=2,NHEAD=16,SEQ=8192,D=64,DM=NHEAD*D;
constexpr int NW=8,QBLK=32,QB=QBLK*NW,KVBLK=64,NQB=SEQ/QB;
constexpr int ATTN_PITCH=DM, ATTN_UNIT_ROWS=QB, OPITCH=2048, KVROWS=8320, NHC=16;
__device__ __forceinline__ int crow(int r,int hi){return (r&3)+8*(r>>2)+4*hi;}
#define SBAR() __builtin_amdgcn_sched_barrier(0)
__device__ __forceinline__ void cmask(f32x16&p0,f32x16&p1,int jb,int qrel,int hi){
  const float NEG=-INFINITY;
  if(jb<4){ if(jb>(qrel>>6)){
    #pragma unroll
    for(int r=0;r<16;++r){p0[r]=NEG;p1[r]=NEG;} } }
  else if(jb==4){
    #pragma unroll
    for(int r=0;r<16;++r){p0[r]=NEG;p1[r]=NEG;} }
  else{
    #pragma unroll
    for(int r=0;r<16;++r){ if(r>=8)p0[r]=NEG; p1[r]=NEG; } }
}

constexpr int NSLOT=3, SLOTB=8192, VSLOTB=16384;
constexpr int LDS_K=0, LDS_V=NSLOT*SLOTB, LDS_WS=LDS_V+NSLOT*VSLOTB, LDS_OST=LDS_WS+NW*64*4, LDS_BYTES=LDS_OST+NW*4096;
constexpr float C2=0.125f*1.4426950408889634f;
__device__ __forceinline__ void glds16(const void*gsrc,unsigned lds_dst){unsigned keep;
  asm volatile("s_mov_b32 %0, m0\n\ts_mov_b32 m0, %2\n\ts_nop 0\n\tglobal_load_lds_dwordx4 %1, off\n\ts_mov_b32 m0, %0":"=&s"(keep):"v"(gsrc),"s"(lds_dst):"memory");}
__device__ __forceinline__ float max3f(float a,float b,float c){float r;asm("v_max3_f32 %0, %1, %2, %3":"=v"(r):"v"(a),"v"(b),"v"(c));return r;}
__device__ __forceinline__ float max2f(float a,float b){float r;asm("v_max_f32_e32 %0, %1, %2":"=v"(r):"v"(a),"v"(b));return r;}
__device__ __forceinline__ float fadd_s(float a,float b){float r;asm("v_add_f32_e32 %0, %1, %2":"=v"(r):"v"(a),"v"(b));return r;}
__device__ __forceinline__ float fsub_s(float a,float b){float r;asm("v_sub_f32_e32 %0, %1, %2":"=v"(r):"v"(a),"v"(b));return r;}
typedef float f32x2_t __attribute__((ext_vector_type(2))); typedef __bf16 bf16x2_t __attribute__((ext_vector_type(2)));
__device__ __forceinline__ unsigned cvtpk_s(float lo,float hi){f32x2_t v={lo,hi};bf16x2_t b=__builtin_convertvector(v,bf16x2_t);return __builtin_bit_cast(unsigned,b);}
#define WAIT_BAR(N) asm volatile("s_waitcnt vmcnt(" #N ") lgkmcnt(0)\n\ts_barrier":::"memory")

__device__ __forceinline__ void qkt(f32x16&p0,f32x16&p1,const char*Kslot,const bf16x8*qr,const f32x16&negm,int r32,int hi){
  const char*kb=Kslot+hi*1024+r32*16;
  #pragma unroll
  for(int d0=0;d0<4;++d0){
    const bf16x8 b0=*reinterpret_cast<const bf16x8*>(kb+d0*2048);
    const bf16x8 b1=*reinterpret_cast<const bf16x8*>(kb+d0*2048+512);
    if(d0==0){p0=__builtin_amdgcn_mfma_f32_32x32x16_bf16(b0,qr[0],negm,0,0,0);p1=__builtin_amdgcn_mfma_f32_32x32x16_bf16(b1,qr[0],negm,0,0,0);}
    else{p0=__builtin_amdgcn_mfma_f32_32x32x16_bf16(b0,qr[d0],p0,0,0,0);p1=__builtin_amdgcn_mfma_f32_32x32x16_bf16(b1,qr[d0],p1,0,0,0);}}
}
typedef __attribute__((address_space(3))) const char* lds_cptr;
typedef short v4i16_t __attribute__((ext_vector_type(4)));
__device__ __forceinline__ void kload8(bf16x8*kf,lds_cptr kp){
  kf[0]=*(const __attribute__((address_space(3))) bf16x8*)(kp);      kf[1]=*(const __attribute__((address_space(3))) bf16x8*)(kp+512);
  kf[2]=*(const __attribute__((address_space(3))) bf16x8*)(kp+2048); kf[3]=*(const __attribute__((address_space(3))) bf16x8*)(kp+2560);
  kf[4]=*(const __attribute__((address_space(3))) bf16x8*)(kp+4096); kf[5]=*(const __attribute__((address_space(3))) bf16x8*)(kp+4608);
  kf[6]=*(const __attribute__((address_space(3))) bf16x8*)(kp+6144); kf[7]=*(const __attribute__((address_space(3))) bf16x8*)(kp+6656);
}
__device__ __forceinline__ void kload2(bf16x8*kf,lds_cptr kp,int j){ kf[2*j]=*(const __attribute__((address_space(3))) bf16x8*)(kp+j*2048); kf[2*j+1]=*(const __attribute__((address_space(3))) bf16x8*)(kp+j*2048+512); }
__device__ __forceinline__ s16x4 vtr(lds_cptr p){ return __builtin_bit_cast(s16x4,__builtin_amdgcn_ds_read_tr16_b64_v4i16((__attribute__((address_space(3))) v4i16_t*)p)); }
__device__ __forceinline__ float rowmax(const f32x16&p0,const f32x16&p1){
  float a=max3f(p0[0],p0[1],p1[0]),b=max3f(p0[2],p0[3],p1[1]);a=max3f(a,p1[2],p1[3]);
  #pragma unroll
  for(int r=4;r<16;r+=4){a=max3f(a,p0[r],p0[r+1]);b=max3f(b,p0[r+2],p0[r+3]);a=max3f(a,p1[r],p1[r+1]);b=max3f(b,p1[r+2],p1[r+3]);}
  const float m=max2f(a,b);
  auto rr=__builtin_amdgcn_permlane32_swap(__float_as_uint(m),__float_as_uint(m),false,false);
  return max2f(__uint_as_float(rr[0]),__uint_as_float(rr[1]));
}
__device__ __forceinline__ void pv(f32x16*o,int vb,bf16x8 pa0,bf16x8 pa1,bf16x8 pa2,bf16x8 pa3){
  #pragma unroll
  for(int d0=0;d0<4;++d0){s16x4 lo[4],hi[4];
    #pragma unroll
    for(int ks=0;ks<4;++ks){
      asm volatile("ds_read_b64_tr_b16 %0,%1 offset:%c2":"=&v"(lo[ks]):"v"(vb),"i"(d0*4096+ks*1024):"memory");
      asm volatile("ds_read_b64_tr_b16 %0,%1 offset:%c2":"=&v"(hi[ks]):"v"(vb),"i"(d0*4096+ks*1024+512):"memory");}
    asm volatile("s_waitcnt lgkmcnt(0)":::"memory");SBAR();
    #define PK(k) (bf16x8){lo[k][0],lo[k][1],lo[k][2],lo[k][3],hi[k][0],hi[k][1],hi[k][2],hi[k][3]}
    o[d0]=__builtin_amdgcn_mfma_f32_32x32x16_bf16(pa0,PK(0),o[d0],0,0,0);
    o[d0]=__builtin_amdgcn_mfma_f32_32x32x16_bf16(pa1,PK(1),o[d0],0,0,0);
    o[d0]=__builtin_amdgcn_mfma_f32_32x32x16_bf16(pa2,PK(2),o[d0],0,0,0);
    o[d0]=__builtin_amdgcn_mfma_f32_32x32x16_bf16(pa3,PK(3),o[d0],0,0,0);
    #undef PK
  }
}

#ifndef ATTN_STORE16
#define ATTN_STORE16(p,v) (*(u32x4*)(p)=(v))
#endif
template<int THRL> __device__ __forceinline__ void attn_unit(int b,int hc,int qb,const bf16*Q,const bf16*__restrict__ K,const bf16*__restrict__ V,bf16*O,char*shm){
  int tid_=threadIdx.x; asm volatile("":"+v"(tid_));
  const int tid=tid_,lane=tid&63,r32=lane&31,hi=lane>>5; const int wid=__builtin_amdgcn_readfirstlane(tid>>6);
  const long rowbase=(long)b*SEQ, kvbase=(long)b*KVROWS; const int q0=qb*QB;
  const bf16*Qw=Q+(rowbase+q0+wid*QBLK)*DM+hc*D;
  const bf16*Kh=K+kvbase*DM+hc*D,*Vh=V+kvbase*DM+(hc>>1)*128;
  const unsigned lds0=(unsigned)(uintptr_t)shm;
  float*wsf=(float*)(shm+LDS_WS)+wid*64;
  const bf16*ksrc=Kh+(long)lane*DM+wid*8;
  const bf16*vsrc=Vh+(long)(16*(wid&3)+(lane>>2))*DM+(wid>>2)*32+(lane&3)*8;
  const unsigned kdst=lds0+LDS_K+wid*1024, vdst=lds0+LDS_V+wid*1024;
  #define TROW(t) (((t)<NT-2)?(long)(t)*KVBLK:(long)(8192+((t)-(NT-2))*KVBLK))
  #define DMA_K(t,slot) glds16(ksrc+TROW(t)*DM,(unsigned)__builtin_amdgcn_readfirstlane(kdst+(slot)))
  #define DMA_V(t,slot) do{ glds16(vsrc+TROW(t)*DM,(unsigned)__builtin_amdgcn_readfirstlane(vdst+2*(slot))); glds16(vsrc+64+TROW(t)*DM,(unsigned)__builtin_amdgcn_readfirstlane(vdst+8192+2*(slot))); }while(0)
  const int vb0=(int)(lds0+LDS_V)+((lane>>4)&1)*32+(lane&3)*8+(4*hi+((lane&15)>>2))*64;
  const char*Kbase=shm+LDS_K; bf16x8 kf[8];
  const lds_cptr shm3=(lds_cptr)shm; const lds_cptr kp0=shm3+LDS_K+hi*1024+r32*16; const lds_cptr vp0=shm3+LDS_V+((lane>>4)&1)*32+(lane&3)*8+(4*hi+((lane&15)>>2))*64;
  const int NT=(q0+QB)/KVBLK+2;
  DMA_K(0,0);DMA_V(0,0);DMA_K(1,SLOTB);
  bf16x8 qr[4];
  #pragma unroll
  for(int d0=0;d0<4;++d0)qr[d0]=*reinterpret_cast<const bf16x8*>(&Qw[(long)r32*DM+d0*16+hi*8]);
  float mhat=0.f,l_reg=0.f;f32x16 o[4];o[0]=f32x16{};o[1]=f32x16{};o[2]=f32x16{};o[3]=f32x16{};const f32x16 zc=f32x16{};
  const int qrel=wid*QBLK+r32;
  #define CMASK(P0,P1,t) do{int jb_=(t)-(NT-6); if(jb_>=0)cmask(P0,P1,jb_,qrel,hi);}while(0)
  bool resc=false;
  #define START(P0,P1) do{ const float rm=rowmax(P0,P1); resc=false; \
    { const float dl=rm; mhat=fadd_s(mhat,dl); \
      _Pragma("unroll") for(int r=0;r<16;++r){P0[r]=fsub_s(P0[r],dl);P1[r]=fsub_s(P1[r],dl);} } \
    _Pragma("unroll") for(int r=0;r<16;++r)P0[r]=__builtin_amdgcn_exp2f(P0[r]); }while(0)
  #define RESC() do{ if(resc){ asm volatile("s_waitcnt lgkmcnt(0)":::"memory"); \
      _Pragma("unroll") for(int d_=0;d_<4;++d_) _Pragma("unroll") for(int r=0;r<16;++r)o[d_][r]*=wsf[crow(r,hi)]; } }while(0)
  f32x16 pA0,pA1,pB0,pB1;
  int sl_prev=0,sl_cur=0,sl_next=SLOTB;
  #define ROT() do{sl_prev=sl_cur;sl_cur=sl_next;sl_next=(sl_next==(NSLOT-1)*SLOTB)?0:sl_next+SLOTB;}while(0)
  DMA_K(2,2*SLOTB);
  WAIT_BAR(4);
  qkt(pA0,pA1,Kbase,qr,zc,r32,hi);asm volatile("s_nop 15\n\ts_nop 7":"+v"(pA0),"+v"(pA1));CMASK(pA0,pA1,0);
  START(pA0,pA1);
  _Pragma("unroll") for(int r=0;r<16;++r)pA1[r]=__builtin_amdgcn_exp2f(pA1[r]);
  WAIT_BAR(0);
  DMA_K(3,0);DMA_V(1,SLOTB);
  ROT();
  kload8(kf,kp0+sl_cur);
  WAIT_BAR(3);
  s16x4 vlo[8],vhi[8]; u32x4 pw0,pw1,pw2,pw3;
  #define PKW(P,B) cvtpk_s(P[B],P[B+1])
  #define PAF(k) __builtin_bit_cast(bf16x8,pw##k)
  #define VFR(i) (bf16x8){vlo[i][0],vlo[i][1],vlo[i][2],vlo[i][3],vhi[i][0],vhi[i][1],vhi[i][2],vhi[i][3]}
  #define PIN(x) asm volatile("":"+v"(x))
  #define MX3(a,b,c) __builtin_fmaxf(__builtin_fmaxf((a),(b)),(c))
  #define GAPA(MF,A0,A1,A2,A3,W0,W1,PW) do{ MF; sacc+=A0; sacc+=A1; sacc+=A2; sacc+=A3; PIN(sacc); W0; W1; PIN(PW); SBAR(); }while(0)
  #define EX(v) __builtin_amdgcn_exp2f(v)
  #define GAPB(MF,X,B) do{ MF; X[B]=EX(X[B]); X[B+1]=EX(X[B+1]); X[B+2]=EX(X[B+2]); X[B+3]=EX(X[B+3]); PIN(X); SBAR(); }while(0)
  #define VRD(i) do{ vlo[i]=vtr(vp_+(((i)>>2)*4096+((i)&3)*1024)); vhi[i]=vtr(vp_+(((i)>>2)*4096+((i)&3)*1024+512)); }while(0)
  #define VRD2(i) do{ vlo[i]=vtr(vp_+((2+((i)>>2))*4096+((i)&3)*1024)); vhi[i]=vtr(vp_+((2+((i)>>2))*4096+((i)&3)*1024+512)); }while(0)
  #define GAPB2(MF,X,B) do{ MF; X[B]=EX(X[B]-mhat); X[B+1]=EX(X[B+1]-mhat); PIN(X); SBAR(); }while(0)
  #define KRD(G,j) do{ if(G){ kload2(kf,kp0+sl_next,j); SBAR(); } }while(0)
  #define STEP(C0,C1,P0,P1,t,GK,GV,GL) do{ SBAR(); \
    const lds_cptr vp_=vp0+2*sl_prev; \
    VRD(0); SBAR(); float sacc=(P0[0]+P0[1]); \
    GAPA(C0=__builtin_amdgcn_mfma_f32_32x32x16_bf16(kf[0],qr[0],zc,0,0,0), P0[2],P0[3],P0[4],P0[5],     pw0[0]=PKW(P0,0), pw0[1]=PKW(P0,2), pw0); \
    VRD(4); SBAR(); GAPA(C1=__builtin_amdgcn_mfma_f32_32x32x16_bf16(kf[1],qr[0],zc,0,0,0), P0[6],P0[7],P0[8],P0[9],     pw0[2]=PKW(P0,4), pw0[3]=PKW(P0,6), pw0); \
    VRD(1); SBAR(); GAPA(C0=__builtin_amdgcn_mfma_f32_32x32x16_bf16(kf[2],qr[1],C0,0,0,0),   P0[10],P0[11],P0[12],P0[13], pw1[0]=PKW(P0,8), pw1[1]=PKW(P0,10), pw1); \
    VRD(5); SBAR(); GAPA(C1=__builtin_amdgcn_mfma_f32_32x32x16_bf16(kf[3],qr[1],C1,0,0,0),   P0[14],P0[15],P1[0],P1[1],   pw1[2]=PKW(P0,12),pw1[3]=PKW(P0,14), pw1); \
    VRD(2); SBAR(); GAPA(C0=__builtin_amdgcn_mfma_f32_32x32x16_bf16(kf[4],qr[2],C0,0,0,0),   P1[2],P1[3],P1[4],P1[5],     pw2[0]=PKW(P1,0), pw2[1]=PKW(P1,2), pw2); \
    VRD(6); SBAR(); GAPA(C1=__builtin_amdgcn_mfma_f32_32x32x16_bf16(kf[5],qr[2],C1,0,0,0),   P1[6],P1[7],P1[8],P1[9],     pw2[2]=PKW(P1,4), pw2[3]=PKW(P1,6), pw2); \
    VRD(3); SBAR(); GAPA(C0=__builtin_amdgcn_mfma_f32_32x32x16_bf16(kf[6],qr[3],C0,0,0,0),   P1[10],P1[11],P1[12],P1[13], pw3[0]=PKW(P1,8), pw3[1]=PKW(P1,10), pw3); \
    VRD(7); SBAR(); GAPA(C1=__builtin_amdgcn_mfma_f32_32x32x16_bf16(kf[7],qr[3],C1,0,0,0),   P1[14],P1[15],0.f,0.f,       pw3[2]=PKW(P1,12),pw3[3]=PKW(P1,14), pw3); \
    l_reg+=sacc; \
    if(GK){DMA_K((t)+3,sl_cur);} if(GV){DMA_V((t)+1,sl_next);} \
    CMASK(C0,C1,t); \
    { float a=MX3(C0[0],C0[1],C1[0]),b=MX3(C0[2],C0[3],C1[1]); a=MX3(a,C1[2],C1[3]); \
      _Pragma("unroll") for(int r=4;r<16;r+=4){a=MX3(a,C0[r],C0[r+1]);b=MX3(b,C0[r+2],C0[r+3]);a=MX3(a,C1[r],C1[r+1]);b=MX3(b,C1[r+2],C1[r+3]);} \
      float rm=__builtin_fmaxf(a,b); { auto rr=__builtin_amdgcn_permlane32_swap(__float_as_uint(rm),__float_as_uint(rm),false,false); rm=__builtin_fmaxf(__uint_as_float(rr[0]),__uint_as_float(rr[1])); } \
      rm-=mhat; resc=false; \
      if(__builtin_expect(__any(rm>(float)THRL),0)){ const float dl=__builtin_fmaxf(rm,0.f); mhat+=dl; \
        const float f=__builtin_amdgcn_exp2f(-dl); l_reg*=f; if(hi==0)wsf[r32]=f; resc=true; } } \
    SBAR(); \
    GAPB2(o[0]=__builtin_amdgcn_mfma_f32_32x32x16_bf16(PAF(0),VFR(0),o[0],0,0,0), C0,0);  VRD2(0); SBAR(); \
    GAPB2(o[1]=__builtin_amdgcn_mfma_f32_32x32x16_bf16(PAF(0),VFR(4),o[1],0,0,0), C0,2);  VRD2(4); SBAR(); \
    KRD(GL,0); GAPB2(o[0]=__builtin_amdgcn_mfma_f32_32x32x16_bf16(PAF(1),VFR(1),o[0],0,0,0), C0,4);  VRD2(1); SBAR(); \
    KRD(GL,1); GAPB2(o[1]=__builtin_amdgcn_mfma_f32_32x32x16_bf16(PAF(1),VFR(5),o[1],0,0,0), C0,6);  VRD2(5); SBAR(); \
    KRD(GL,2); GAPB2(o[0]=__builtin_amdgcn_mfma_f32_32x32x16_bf16(PAF(2),VFR(2),o[0],0,0,0), C0,8);  VRD2(2); SBAR(); \
    KRD(GL,3); GAPB2(o[1]=__builtin_amdgcn_mfma_f32_32x32x16_bf16(PAF(2),VFR(6),o[1],0,0,0), C0,10); VRD2(6); SBAR(); \
    GAPB2(o[0]=__builtin_amdgcn_mfma_f32_32x32x16_bf16(PAF(3),VFR(3),o[0],0,0,0), C0,12); VRD2(3); SBAR(); \
    GAPB2(o[1]=__builtin_amdgcn_mfma_f32_32x32x16_bf16(PAF(3),VFR(7),o[1],0,0,0), C0,14); VRD2(7); SBAR(); \
    GAPB2(o[2]=__builtin_amdgcn_mfma_f32_32x32x16_bf16(PAF(0),VFR(0),o[2],0,0,0), C1,0); \
    GAPB2(o[3]=__builtin_amdgcn_mfma_f32_32x32x16_bf16(PAF(0),VFR(4),o[3],0,0,0), C1,2); \
    GAPB2(o[2]=__builtin_amdgcn_mfma_f32_32x32x16_bf16(PAF(1),VFR(1),o[2],0,0,0), C1,4); \
    GAPB2(o[3]=__builtin_amdgcn_mfma_f32_32x32x16_bf16(PAF(1),VFR(5),o[3],0,0,0), C1,6); \
    GAPB2(o[2]=__builtin_amdgcn_mfma_f32_32x32x16_bf16(PAF(2),VFR(2),o[2],0,0,0), C1,8); \
    GAPB2(o[3]=__builtin_amdgcn_mfma_f32_32x32x16_bf16(PAF(2),VFR(6),o[3],0,0,0), C1,10); \
    GAPB2(o[2]=__builtin_amdgcn_mfma_f32_32x32x16_bf16(PAF(3),VFR(3),o[2],0,0,0), C1,12); \
    GAPB2(o[3]=__builtin_amdgcn_mfma_f32_32x32x16_bf16(PAF(3),VFR(7),o[3],0,0,0), C1,14); \
    }while(0)
  int t=1;
  #undef CMASK
  #define CMASK(P0,P1,t) do{}while(0)
  for(;t+7<NT;t+=2){
    STEP(pB0,pB1,pA0,pA1,t,true,true,true);     WAIT_BAR(3); RESC(); ROT();
    STEP(pA0,pA1,pB0,pB1,t+1,true,true,true);   WAIT_BAR(3); RESC(); ROT();
  }
  #undef CMASK
  #define CMASK(P0,P1,t) do{int jb_=(t)-(NT-6); if(jb_>=0)cmask(P0,P1,jb_,qrel,hi);}while(0)
  #define ENDW(tt) do{ if((tt)+3<NT){WAIT_BAR(3);} else if((tt)+2<NT){WAIT_BAR(2);} else {WAIT_BAR(0);} }while(0)
  for(;t+1<NT;t+=2){
    STEP(pB0,pB1,pA0,pA1,t,(t+3<NT),(t+1<NT),(t+1<NT));       ENDW(t);   RESC(); ROT();
    STEP(pA0,pA1,pB0,pB1,t+1,(t+4<NT),(t+2<NT),(t+2<NT));     ENDW(t+1); RESC(); ROT();
  }
  STEP(pB0,pB1,pA0,pA1,NT-1,false,false,false); RESC();
  { float sacc=pB0[0]+pB0[1]; _Pragma("unroll") for(int r=2;r<16;++r)sacc+=pB0[r]; _Pragma("unroll") for(int r=0;r<16;++r)sacc+=pB1[r]; l_reg+=sacc;
    pw0=(u32x4){PKW(pB0,0),PKW(pB0,2),PKW(pB0,4),PKW(pB0,6)};pw1=(u32x4){PKW(pB0,8),PKW(pB0,10),PKW(pB0,12),PKW(pB0,14)};pw2=(u32x4){PKW(pB1,0),PKW(pB1,2),PKW(pB1,4),PKW(pB1,6)};pw3=(u32x4){PKW(pB1,8),PKW(pB1,10),PKW(pB1,12),PKW(pB1,14)};
    SBAR(); pv(o,vb0+2*sl_cur,PAF(0),PAF(1),PAF(2),PAF(3)); }
  #undef PKW
  #undef PAF
  #undef VFR
  #undef PIN
  #undef MX3
  #undef GAPA
  #undef GAPB
  #undef EX
  #undef VRD
  #undef VRD2
  #undef GAPB2
  #undef KRD
  #undef STEP
  #undef ENDW
  {auto rr=__builtin_amdgcn_permlane32_swap(__float_as_uint(l_reg),__float_as_uint(l_reg),false,false);l_reg=__uint_as_float(rr[0])+__uint_as_float(rr[1]);}
  if(hi==0)wsf[32+r32]=l_reg;asm volatile("s_waitcnt lgkmcnt(0)":::"memory");
  float rli[16];
  #pragma unroll
  for(int r=0;r<16;++r)rli[r]=__builtin_amdgcn_rcpf(wsf[32+crow(r,hi)]);
  bf16*Ow=O+(rowbase+q0+wid*QBLK)*OPITCH+hc*128;
  { bf16*stg=(bf16*)(shm+LDS_OST)+wid*2048;
    #pragma unroll
    for(int ps=0;ps<2;++ps){
      #pragma unroll
      for(int r=0;r<16;++r){const int orow=crow(r,hi);
        #pragma unroll
        for(int d0=0;d0<2;++d0)stg[orow*64+d0*32+r32]=__float2bfloat16(o[2*ps+d0][r]*rli[r]);}
      asm volatile("s_waitcnt lgkmcnt(0)":::"memory");
      #pragma unroll
      for(int i=0;i<4;++i){const int row=i*8+(lane>>3),ch=lane&7; const u32x4 v=*(const u32x4*)(stg+row*64+ch*8); ATTN_STORE16(Ow+(long)row*OPITCH+ps*64+ch*8,v);}
      asm volatile("s_waitcnt lgkmcnt(0)":::"memory"); } }
  asm volatile("s_waitcnt lgkmcnt(0)\n\ts_barrier":::"memory");
  #undef DMA_K
  #undef TROW
  #undef DMA_V
  #undef CMASK
  #undef START
  #undef RESC
  #undef ROT
}
constexpr int ATTN_LDS_BYTES=LDS_BYTES;
struct AttnTensors { const bf16* Q; const bf16* K; const bf16* V; bf16* O; };
struct AttnUnit { int bh; int qb; };
struct StaticOrder {
  int vcu;
  __device__ __forceinline__ explicit StaticOrder(int grid,int block):vcu((block%8)*(grid/8)+block/8){}
  __device__ __forceinline__ bool next(int i,AttnUnit&u)const{ if(i>=4)return false; const int s=vcu&7; u.bh=vcu>>3; u.qb=(i==0)?s:(i==1)?15-s:(i==2)?16+s:31-s; return true; }
  __device__ __forceinline__ void a_ready(const AttnUnit&)const{}
  __device__ __forceinline__ void done(const AttnUnit&)const{}
};
template<class Sched,int THRL=8> __device__ __forceinline__ void attn_phase(char*lds,const AttnTensors&T,const Sched&S){
  AttnUnit u;
  for(int i=0;S.next(i,u);++i){ S.a_ready(u); attn_unit<THRL>(u.bh/NHC,u.bh%NHC,u.qb,T.Q,T.K,T.V,T.O,lds); S.done(u); }
}
#undef SBAR
#undef WAIT_BAR
}
#define GAS __attribute__((address_space(1)))
#define LAS __attribute__((address_space(3)))
typedef unsigned short bf16;
typedef unsigned v4u __attribute__((ext_vector_type(4)));
typedef float f32x4 __attribute__((ext_vector_type(4)));
typedef short bf16x8 __attribute__((ext_vector_type(8)));
typedef GAS unsigned gu32;
typedef GAS unsigned long long gu64;
#define RLX_AGENT __ATOMIC_RELAXED, __HIP_MEMORY_SCOPE_AGENT
#define LDS_WAIT() asm volatile("s_waitcnt lgkmcnt(0)" ::: "memory")
#define VM_WAIT() asm volatile("s_waitcnt vmcnt(0)" ::: "memory")
__device__ __forceinline__ unsigned long long rt() { return __builtin_amdgcn_s_memrealtime(); }
__device__ __forceinline__ unsigned f2bf(float f) { unsigned u = __builtin_bit_cast(unsigned, f); return (u + 0x7fffu + ((u >> 16) & 1u)) >> 16; }
__device__ __forceinline__ unsigned pk2(float lo, float hi) { return f2bf(lo) | (f2bf(hi) << 16); }

#define XB_TMO      128
#define XB_XCNT(j)  (256  + 64 * (j))
#define XB_XSUB(j)  (1280 + 64 * (j))
#define XB_XGEN(j)  (2304 + 64 * (j))
#define XB_TOP      3328
#define XB_TOPGEN   3392
#define XCD_BAR_WORDS 3456
#define XB_SPIN_CAP (1u << 18)

__device__ __forceinline__ unsigned xb_ld(unsigned* p)              { return __hip_atomic_load(p, __ATOMIC_RELAXED, __HIP_MEMORY_SCOPE_AGENT); }
__device__ __forceinline__ unsigned xb_add(unsigned* p, unsigned v) { return __hip_atomic_fetch_add(p, v, __ATOMIC_RELAXED, __HIP_MEMORY_SCOPE_AGENT); }
__device__ __forceinline__ unsigned xb_xcc_id() { return (unsigned)__builtin_amdgcn_s_getreg((3 << 11) | 20) & 0xFu; }
#define XB_SPIN(cond, bar) do { unsigned _sp = 0; while (cond) { __builtin_amdgcn_s_sleep(1); \
    if ((++_sp & 255u) == 0u) { if (xb_ld(&(bar)[XB_TMO])) break; if (_sp > XB_SPIN_CAP) { atomicAdd(&(bar)[XB_TMO], 1u); break; } } } } while (0)

struct XcdBarrier {
    unsigned* bar; unsigned x;
    volatile LAS unsigned* st;
};

__device__ __forceinline__ XcdBarrier xcd_barrier_post(unsigned* bar, volatile LAS unsigned* st) {
    XcdBarrier b; b.bar = bar; b.x = xb_xcc_id(); b.st = st;
    if (threadIdx.x == 0) (void)xb_add(&bar[XB_XCNT(b.x)], 1u);
    return b;
}
__device__ __forceinline__ void xcd_barrier_complete(unsigned* bar, unsigned x, unsigned& nloc, unsigned& nx) {
    const unsigned G = gridDim.x * gridDim.y * gridDim.z;
    unsigned sum, cnt, mine, sp = 0u;
    for (;;) {
        sum = 0u; cnt = 0u; mine = 0u;
#pragma unroll
        for (unsigned j = 0; j < 16; ++j) { const unsigned c = xb_ld(&bar[XB_XCNT(j)]); sum += c; cnt += (c > 0u) ? 1u : 0u; mine = (j == x) ? c : mine; }
        if (sum == G) break;
        __builtin_amdgcn_s_sleep(1);
        if ((++sp & 255u) == 0u) { if (xb_ld(&bar[XB_TMO])) break; if (sp > XB_SPIN_CAP) { atomicAdd(&bar[XB_TMO], 1u); break; } }
    }
    nloc = mine > 0u ? mine : 1u; nx = cnt > 0u ? cnt : 1u;
}

__device__ __forceinline__ void xcd_barrier(const XcdBarrier& b) {
    asm volatile("s_waitcnt vmcnt(0)" ::: "memory");
    __syncthreads();
    if (threadIdx.x == 0) {
        unsigned* bar = b.bar;
        __builtin_amdgcn_s_waitcnt(0);
        unsigned nloc = b.st[0], nx = b.st[1];
        if (nloc == 0u) { xcd_barrier_complete(bar, b.x, nloc, nx); b.st[0] = nloc; b.st[1] = nx; }
        const unsigned old = xb_add(&bar[XB_XSUB(b.x)], 1u);
        const unsigned gen = old / nloc;
        if (old + 1u == (gen + 1u) * nloc) {
            __builtin_amdgcn_fence(__ATOMIC_RELEASE, "agent");
            asm volatile("s_waitcnt vmcnt(0)" ::: "memory");
            const unsigned og = xb_add(&bar[XB_TOP], 1u);
            const unsigned tg = og / nx;
            if (og + 1u == (tg + 1u) * nx) xb_add(&bar[XB_TOPGEN], 1u);
            else XB_SPIN(xb_ld(&bar[XB_TOPGEN]) == tg, bar);
            __builtin_amdgcn_fence(__ATOMIC_ACQUIRE, "agent");
            xb_add(&bar[XB_XGEN(b.x)], 1u);
            asm volatile("s_waitcnt vmcnt(0)" ::: "memory");
        } else {
            XB_SPIN(xb_ld(&bar[XB_XGEN(b.x)]) == gen, bar);
            __builtin_amdgcn_fence(__ATOMIC_ACQUIRE, "agent");
            asm volatile("s_waitcnt vmcnt(0)" ::: "memory");
        }
    }
    __syncthreads();
}

constexpr int NWAVES = 8;
#ifndef MK_N_LAUNCHES
#define MK_N_LAUNCHES 1
#endif
constexpr int NPH = 25;
constexpr int N_LAUNCHES = MK_N_LAUNCHES;
static_assert(N_LAUNCHES == 1 || N_LAUNCHES == NPH, "MK_N_LAUNCHES is 1 or 25");

constexpr int DM_ = 1024, NLAYER = 2, NMETA = 16, SEQ_ = 8192;
constexpr int MREAL = pg8::MREAL, MVALID = pg8::MVALID, MP = 16640;
constexpr int NP1 = 8192;
constexpr int MOE_ROWS = 74240;
constexpr int CAP = 16416;
constexpr float LN_EPS = 1e-5f, ALPHA = 1.4142135623730951f;

constexpr size_t MiB = 1u << 20;
constexpr size_t WS_CTL = 0, CTL_ZERO_BYTES = 1 * MiB;
constexpr size_t WL_IN = 0, WL_GLU = 16 * MiB, WL_SO = 17 * MiB, WL_CO = 18 * MiB, WL_AO = 19 * MiB, WL_WO = 21 * MiB, WL_GU = 23 * MiB, WL_DN = 151 * MiB, WL_ST = 215 * MiB, WL_TOE = 231 * MiB, WL_STRIDE = 304 * MiB;
constexpr size_t WS_W = 2 * MiB;
constexpr size_t WS_SSMC = WS_W + NLAYER * WL_STRIDE;
constexpr size_t WS_ROPE = WS_SSMC + 2 * MiB;
constexpr size_t WS_HF = WS_ROPE + 3 * MiB;
constexpr size_t WS_HB = WS_HF + 65 * MiB;
constexpr size_t WS_UC = WS_HB + 33 * MiB;
constexpr size_t WS_UMETA = WS_UC + 18 * MiB;
constexpr size_t WS_CONV = WS_UMETA + 1 * MiB;
constexpr size_t WS_Q = WS_CONV + 49 * MiB;
constexpr size_t WS_K = WS_Q + 33 * MiB;
constexpr size_t WS_V = WS_K + 33 * MiB;
constexpr size_t WS_GB = WS_V + 33 * MiB;
constexpr size_t WS_SLOC = WS_GB + 98 * MiB;
constexpr size_t WS_SM = WS_SLOC + 4 * MiB;
constexpr size_t WS_OC = WS_SM + 1 * MiB;
constexpr size_t WS_YG = WS_OC + 65 * MiB;
constexpr size_t WS_YS = WS_YG + 17 * MiB;
constexpr size_t WS_YC = WS_YS + 17 * MiB;
constexpr size_t WS_YA = WS_YC + 17 * MiB;
constexpr size_t WS_MG = WS_YA + 33 * MiB;
constexpr size_t WS_PRE = WS_MG + 33 * MiB;
constexpr size_t WS_XG = WS_PRE + 65 * MiB;
constexpr size_t WS_HID = WS_XG + 145 * MiB;
constexpr size_t WS_OUTS = WS_HID + 145 * MiB;
constexpr size_t WS_ROWIDX = WS_OUTS + 145 * MiB;
constexpr size_t WS_TOKE = WS_ROWIDX + 3 * MiB;
constexpr size_t WS_TOKW = WS_TOKE + 1 * MiB;
constexpr size_t WS_END = WS_TOKW + 1 * MiB;
static_assert((size_t)MOE_ROWS * 1024 * 2 <= 145 * MiB && (size_t)MP * 3072 * 2 <= 98 * MiB && (size_t)MP * 1536 * 2 <= 49 * MiB && (size_t)MP * 4096 <= 65 * MiB && (size_t)32 * 1024 * 1152 * 2 <= 73 * MiB, "d_ws map");
constexpr int CW_TMO = 0, CW_CODE = 1;
constexpr int CW_BAR = 4096;
constexpr int CW_CNT = 16384;
static_assert((CW_CNT + NLAYER * 32 * 64) * 4 <= (int)CTL_ZERO_BYTES, "CTL words inside the memset region");

constexpr int RING_OFF = 0, RING_BYTES = 131072;
constexpr int LDSCTL_OFF = RING_BYTES, MISC_OFF = LDSCTL_OFF + 320;
constexpr int REC_OFF = MISC_OFF + 192;
constexpr int LDS_BYTES = 147456;
static_assert(REC_OFF + 8 * 40 * 8 <= LDS_BYTES && (REC_OFF % 16) == 0, "LDS map");

enum InIdx { I_X = 0, I_META, I_LNIN_G, I_LNIN_B, I_WIN, I_LAMRE, I_LAMIM, I_LOGDT, I_BRE, I_BIM, I_CRE, I_CIM, I_SSMD, I_WGLU, I_SSMWO, I_CONVW, I_CONVWO,
             I_LQ1, I_LK1, I_LQ2, I_LK2, I_SUBLN, I_ATTNWO, I_GATEW, I_GATEB, I_WO, I_LN1G, I_LN1B, I_RW, I_RB, I_WGU, I_BGU, I_WDN, I_BDN, I_LN2G, I_LN2B, N_IN };
struct Args { const float* in[N_IN]; float* out; unsigned char* ws; int ph_lo, ph_hi, li, pad; };
struct Frame {
    LAS unsigned char* lds;
    volatile LAS unsigned* MISC;
    gu32* ctl;
    unsigned char* ws;
    int tid, lane, wave;
    int vcu, G;
    int chk_l;
};
__device__ __forceinline__ float wave_sum_slow(float v) {
#pragma unroll
    for (int o = 1; o < 64; o <<= 1) v += __shfl_xor(v, o);
    return v;
}
#define DPPF(x, ctrl) __builtin_bit_cast(float, __builtin_amdgcn_mov_dpp(__builtin_bit_cast(int, (x)), (ctrl), 0xf, 0xf, true))
__device__ __forceinline__ float wave_sum(float v) {
    v += DPPF(v, 0xB1); v += DPPF(v, 0x4E); v += DPPF(v, 0x141); v += DPPF(v, 0x140);
    const int iv = __builtin_bit_cast(int, v);
    const float r0 = __builtin_bit_cast(float, __builtin_amdgcn_readlane(iv, 0)), r1 = __builtin_bit_cast(float, __builtin_amdgcn_readlane(iv, 16)),
                r2 = __builtin_bit_cast(float, __builtin_amdgcn_readlane(iv, 32)), r3 = __builtin_bit_cast(float, __builtin_amdgcn_readlane(iv, 48));
    return (r0 + r1) + (r2 + r3);
}
__device__ __forceinline__ float wave_max(float v) {
#pragma unroll
    for (int o = 1; o < 64; o <<= 1) v = fmaxf(v, __shfl_xor(v, o));
    return v;
}
__device__ __forceinline__ int wave_min_i(int v) {
#pragma unroll
    for (int o = 1; o < 64; o <<= 1) { const int w = __shfl_xor(v, o); v = w < v ? w : v; }
    return v;
}
__device__ __forceinline__ float bflo(unsigned w) { return __uint_as_float(w << 16); }
__device__ __forceinline__ float bfhi(unsigned w) { return __uint_as_float(w & 0xffff0000u); }
__device__ __forceinline__ void unpk8(v4u w, float (&f)[8]) { f[0] = bflo(w.x); f[1] = bfhi(w.x); f[2] = bflo(w.y); f[3] = bfhi(w.y); f[4] = bflo(w.z); f[5] = bfhi(w.z); f[6] = bflo(w.w); f[7] = bfhi(w.w); }
__device__ __forceinline__ v4u pk8(const float (&f)[8]) { v4u o; o.x = pk2(f[0], f[1]); o.y = pk2(f[2], f[3]); o.z = pk2(f[4], f[5]); o.w = pk2(f[6], f[7]); return o; }
__device__ __forceinline__ float sigm_(float x) { return 1.0f / (1.0f + __expf(-x)); }
__device__ __forceinline__ float gelu_(float x) { const float u = 0.7978845608028654f * (x + 0.044715f * x * x * x); return x * sigm_(2.0f * u); }

__device__ __forceinline__ int rowmap(int n, int mode) {
    if (mode == 1) { if (n >= 2048 && n < 4096) { const int d = n & 63; return (n & ~63) + (d < 32 ? 8 * (d >> 2) + (d & 3) : 8 * ((d - 32) >> 2) + 4 + (d & 3)); } return n; }
    if (mode == 2) { return n < 1024 ? 8 * (n >> 2) + (n & 3) : 8 * ((n - 1024) >> 2) + 4 + (n & 3); }
    return n;
}
__device__ __forceinline__ void transpose_item(const float* W, int K, int N, bf16* WT, int mode, LAS float* scr, int item, int lane) {
    const int nblk = N / 32, kb = item / nblk, nb = item - kb * nblk, k0 = 64 * kb, n0 = 32 * nb;
    typedef float f2 __attribute__((ext_vector_type(2)));
    f2 v[16];
    const int lr = lane >> 4, lc = 2 * (lane & 15);
#pragma unroll
    for (int i = 0; i < 16; ++i) v[i] = *(const GAS f2*)(W + (size_t)(k0 + 4 * i + lr) * N + n0 + lc);
#pragma unroll
    for (int i = 0; i < 16; ++i) { scr[(4 * i + lr) * 33 + lc] = v[i].x; scr[(4 * i + lr) * 33 + lc + 1] = v[i].y; }
    LDS_WAIT(); asm volatile("" ::: "memory");
    const int c = lane & 7;
#pragma unroll
    for (int j = 0; j < 4; ++j) { const int n = (lane >> 3) + 8 * j; const LAS float* s = scr + (8 * c) * 33 + n;
        v4u o; o.x = pk2(s[0 * 33], s[1 * 33]); o.y = pk2(s[2 * 33], s[3 * 33]); o.z = pk2(s[4 * 33], s[5 * 33]); o.w = pk2(s[6 * 33], s[7 * 33]);
        *(GAS v4u*)(WT + (size_t)rowmap(n0 + n, mode) * K + k0 + 8 * c) = o; }
    LDS_WAIT(); asm volatile("" ::: "memory");
}
__device__ __forceinline__ void ln16(f32x4 (&v)[4], const float* g, const float* b, int lane) {
    float s = 0.f;
#pragma unroll
    for (int j = 0; j < 4; ++j) s += (v[j].x + v[j].y) + (v[j].z + v[j].w);
    const float mean = wave_sum(s) * (1.f / 1024.f); float s2 = 0.f;
#pragma unroll
    for (int j = 0; j < 4; ++j) { v[j] = v[j] - mean; s2 += (v[j].x * v[j].x + v[j].y * v[j].y) + (v[j].z * v[j].z + v[j].w * v[j].w); }
    const float rstd = 1.f / sqrtf(wave_sum(s2) * (1.f / 1024.f) + LN_EPS);
#pragma unroll
    for (int j = 0; j < 4; ++j) { const f32x4 gg = *(const GAS f32x4*)(g + 256 * j + 4 * lane), bb = *(const GAS f32x4*)(b + 256 * j + 4 * lane); v[j] = v[j] * rstd * gg + bb; }
}
__device__ __forceinline__ void store_row_f32_bf16(const f32x4 (&v)[4], float* hf, bf16* hb, int lane) {
#pragma unroll
    for (int j = 0; j < 4; ++j) { if (hf) *(GAS f32x4*)(hf + 256 * j + 4 * lane) = v[j];
        *(GAS unsigned long long*)(hb + 256 * j + 4 * lane) = (unsigned long long)pk2(v[j].x, v[j].y) | ((unsigned long long)pk2(v[j].z, v[j].w) << 32); }
}

__device__ __forceinline__ void ssm_build(Frame& F, const Args& A, int l, int g) {
    LAS float* L = (LAS float*)(F.lds + RING_OFF);
    LAS float* AP_re = L; LAS float* AP_im = L + 4160; LAS float* BB_re = L + 8320; LAS float* BB_im = L + 9344; LAS float* CC_re = L + 10368; LAS float* CC_im = L + 11392; LAS float* KM = L + 12416;
    const int lg = l * 32 + g; const int tid = F.tid;
    const float dt = __expf(A.in[I_LOGDT][lg]);
    for (int idx = tid; idx < 65 * 64; idx += 512) { const int j = idx >> 6, p = idx & 63; const float lr = A.in[I_LAMRE][lg * 64 + p], li = A.in[I_LAMIM][lg * 64 + p];
        const float mag = expf(lr * dt * (float)j), ang = li * dt * (float)j; AP_re[idx] = mag * cosf(ang); AP_im[idx] = mag * sinf(ang); }
    __syncthreads();
    for (int idx = tid; idx < 1024; idx += 512) {
        { const int p = idx >> 4, c = idx & 15; const float lr = A.in[I_LAMRE][lg * 64 + p], li = A.in[I_LAMIM][lg * 64 + p];
          const float ar = AP_re[64 + p], ai = AP_im[64 + p], nr = ar - 1.0f, den = lr * lr + li * li;
          const float cr = (nr * lr + ai * li) / den, ci = (ai * lr - nr * li) / den;
          const float br = A.in[I_BRE][(size_t)(lg * 64 + p) * 16 + c], bi = A.in[I_BIM][(size_t)(lg * 64 + p) * 16 + c];
          BB_re[idx] = cr * br - ci * bi; BB_im[idx] = cr * bi + ci * br; }
        { CC_re[idx] = A.in[I_CRE][(size_t)lg * 1024 + idx]; CC_im[idx] = A.in[I_CIM][(size_t)lg * 1024 + idx]; }
    }
    __syncthreads();
    for (int idx = tid; idx < 16384; idx += 512) { const int j = idx >> 8, co = (idx >> 4) & 15, ci = idx & 15; float s = 0.f;
        for (int p = 0; p < 64; ++p) { const float Ar = AP_re[j * 64 + p], Ai = AP_im[j * 64 + p], Br = BB_re[p * 16 + ci], Bi = BB_im[p * 16 + ci];
            const float er = Ar * Br - Ai * Bi, ei = Ar * Bi + Ai * Br; s += CC_re[co * 64 + p] * er - CC_im[co * 64 + p] * ei; }
        if (j == 0 && co == ci) s += A.in[I_SSMD][l * 512 + g * 16 + co];
        KM[idx] = s; }
    __syncthreads();
    bf16* TOE = (bf16*)(F.ws + WS_W + (size_t)l * WL_STRIDE + WL_TOE) + (size_t)g * 1024 * 1152;
    for (int q = tid; q < 1024 * 144; q += 512) { const int n = q / 144, kc = q - n * 144, t = n >> 4, co = n & 15; float f[8];
        if (kc < 128) { const int s = kc >> 1, ci0 = (kc & 1) * 8;
            if (s <= t) {
#pragma unroll
                for (int i = 0; i < 8; ++i) f[i] = KM[(t - s) * 256 + co * 16 + ci0 + i]; }
            else {
#pragma unroll
                for (int i = 0; i < 8; ++i) f[i] = 0.f; } }
        else { const int p0 = (kc - 128) * 8;
#pragma unroll
            for (int i = 0; i < 8; ++i) { const int p = (p0 + i) & 63; const float Cr = CC_re[co * 64 + p], Ci = CC_im[co * 64 + p], Ar = AP_re[(t + 1) * 64 + p], Ai = AP_im[(t + 1) * 64 + p];
                f[i] = p0 < 64 ? (Cr * Ar - Ci * Ai) : -(Cr * Ai + Ci * Ar); } }
        *(GAS v4u*)(TOE + (size_t)n * 1152 + kc * 8) = pk8(f); }
    bf16* WST = (bf16*)(F.ws + WS_W + (size_t)l * WL_STRIDE + WL_ST) + (size_t)g * 256 * 1024;
    for (int q = tid; q < 256 * 128; q += 512) { const int n = q >> 7, kc = q & 127, s = kc >> 1, ci0 = (kc & 1) * 8; float f[8];
        if (n < 128) { const int p = n & 63; const float Ar = AP_re[(63 - s) * 64 + p], Ai = AP_im[(63 - s) * 64 + p];
#pragma unroll
            for (int i = 0; i < 8; ++i) { const float Br = BB_re[p * 16 + ci0 + i], Bi = BB_im[p * 16 + ci0 + i]; f[i] = n < 64 ? (Ar * Br - Ai * Bi) : (Ar * Bi + Ai * Br); } }
        else {
#pragma unroll
            for (int i = 0; i < 8; ++i) f[i] = 0.f; }
        *(GAS v4u*)(WST + (size_t)n * 1024 + kc * 8) = pk8(f); }
    float* SC = (float*)(F.ws + WS_SSMC + (size_t)l * MiB);
    if (tid < 64) { const int p = tid; SC[(lg * 64 + p) * 2] = AP_re[64 + p]; SC[(lg * 64 + p) * 2 + 1] = AP_im[64 + p];
        SC[16384 + (lg * 64 + p) * 2] = AP_re[64 * 64 + p]; SC[16384 + (lg * 64 + p) * 2 + 1] = AP_im[64 * 64 + p]; }
    for (int idx = tid; idx < 1024; idx += 512) { const int p = idx >> 4, c = idx & 15; SC[32768 + (size_t)(lg * 64 + p) * 32 + c] = BB_re[idx]; SC[32768 + (size_t)(lg * 64 + p) * 32 + 16 + c] = BB_im[idx]; }
    __syncthreads();
}

__device__ __forceinline__ void p0_prologue(Frame& F, const Args& A) {
    for (int job = F.vcu; job < NLAYER * 32; job += F.G) ssm_build(F, A, job >> 5, job & 31);
    const int gw = F.vcu * NWAVES + F.wave, NGW = F.G * NWAVES, lane = F.lane;
    float* HF = (float*)(F.ws + WS_HF); bf16* HB = (bf16*)(F.ws + WS_HB);
    for (int R = gw; R < MVALID; R += NGW) { const float* src = R < MREAL ? A.in[I_X] + (size_t)R * 1024 : A.in[I_META] + (size_t)((R - MREAL) & 15) * 1024;
        f32x4 v[4];
#pragma unroll
        for (int j = 0; j < 4; ++j) v[j] = *(const GAS f32x4*)(src + 256 * j + 4 * lane);
        ln16(v, A.in[I_LNIN_G], A.in[I_LNIN_B], lane); store_row_f32_bf16(v, HF + (size_t)R * 1024, HB + (size_t)R * 1024, lane); }
    { float* ROPE = (float*)(F.ws + WS_ROPE); const int gt = F.vcu * 512 + F.tid, NGT = F.G * 512;
      for (int idx = gt; idx < 8208 * 32; idx += NGT) { const int pos = idx >> 5, j = idx & 31; const float inv = exp2f(-(float)j * (13.287712379549449f / 32.0f)); const float ang = (float)pos * inv;
          ROPE[(size_t)pos * 64 + j] = cosf(ang); ROPE[(size_t)pos * 64 + 32 + j] = sinf(ang); } }
    { bf16* KB = (bf16*)(F.ws + WS_K); bf16* VB = (bf16*)(F.ws + WS_V);
      for (int r = gw; r < 512; r += NGW) { bf16* base = (r & 256) ? VB : KB; const int b = (r >> 7) & 1, rr = r & 127; GAS v4u* d = (GAS v4u*)(base + (size_t)(b * 8320 + 8192 + rr) * 1024);
          d[lane] = (v4u){0u, 0u, 0u, 0u}; d[64 + lane] = (v4u){0u, 0u, 0u, 0u}; } }
    LAS float* scr = (LAS float*)(F.lds + RING_OFF + F.wave * 16384);
    constexpr int IT_IN = 16 * 160, IT_GATE = 16 * 96, IT_GLU = 8 * 16, IT_SO = 8 * 32, IT_CO = 8 * 32, IT_AO = 16 * 32, IT_WO = 16 * 32, IT_GU1 = 16 * 64, IT_DN1 = 16 * 32;
    constexpr int IT_L = IT_IN + IT_GATE + IT_GLU + IT_SO + IT_CO + IT_AO + IT_WO + 32 * IT_GU1 + 32 * IT_DN1;
    for (int it = gw; it < NLAYER * IT_L; it += NGW) {
        const int l = it / IT_L; int r = it - l * IT_L; unsigned char* wl = F.ws + WS_W + (size_t)l * WL_STRIDE;
        if (r < IT_IN) { transpose_item(A.in[I_WIN] + (size_t)l * 1024 * 5120, 1024, 5120, (bf16*)(wl + WL_IN), 1, scr, r, lane); continue; } r -= IT_IN;
        if (r < IT_GATE) { transpose_item(A.in[I_GATEW] + (size_t)l * 1024 * 3072, 1024, 3072, (bf16*)(wl + WL_IN) + (size_t)5120 * 1024, 0, scr, r, lane); continue; } r -= IT_GATE;
        if (r < IT_GLU) { transpose_item(A.in[I_WGLU] + (size_t)l * 512 * 512, 512, 512, (bf16*)(wl + WL_GLU), 0, scr, r, lane); continue; } r -= IT_GLU;
        if (r < IT_SO) { transpose_item(A.in[I_SSMWO] + (size_t)l * 512 * 1024, 512, 1024, (bf16*)(wl + WL_SO), 0, scr, r, lane); continue; } r -= IT_SO;
        if (r < IT_CO) { transpose_item(A.in[I_CONVWO] + (size_t)l * 512 * 1024, 512, 1024, (bf16*)(wl + WL_CO), 0, scr, r, lane); continue; } r -= IT_CO;
        if (r < IT_AO) { transpose_item(A.in[I_ATTNWO] + (size_t)l * 1024 * 1024, 1024, 1024, (bf16*)(wl + WL_AO), 0, scr, r, lane); continue; } r -= IT_AO;
        if (r < IT_WO) { transpose_item(A.in[I_WO] + (size_t)l * 1024 * 1024, 1024, 1024, (bf16*)(wl + WL_WO), 0, scr, r, lane); continue; } r -= IT_WO;
        if (r < 32 * IT_GU1) { const int e = r / IT_GU1; transpose_item(A.in[I_WGU] + ((size_t)l * 32 + e) * 1024 * 2048, 1024, 2048, (bf16*)(wl + WL_GU) + (size_t)e * 2048 * 1024, 2, scr, r - e * IT_GU1, lane); continue; } r -= 32 * IT_GU1;
        { const int e = r / IT_DN1; transpose_item(A.in[I_WDN] + ((size_t)l * 32 + e) * 1024 * 1024, 1024, 1024, (bf16*)(wl + WL_DN) + (size_t)e * 1024 * 1024, 0, scr, r - e * IT_DN1, lane); }
    }
}

__device__ __forceinline__ int prev_row(int R, int k) {
    if (R < MREAL) { const int t = R & 8191, b = R >> 13; return t >= k ? R - k : MREAL + b * 16 + 16 - (k - t); }
    const int i = (R - MREAL) & 15; return i >= k ? R - k : -1;
}
__device__ __forceinline__ void conv_rows(Frame& F, const Args& A, int l) {
    const int bidc = (int)blockIdx.x; if (bidc < 128) return;
    const int gw = (bidc - 128) * NWAVES + F.wave, NGW = (F.G - 128) * NWAVES, lane = F.lane, c0 = 8 * lane;
    const bf16* CB = (const bf16*)(F.ws + WS_CONV); bf16* YC = (bf16*)(F.ws + WS_YC);
    float w0[8], w1[8], w2[8];
#pragma unroll
    for (int i = 0; i < 8; ++i) { w0[i] = A.in[I_CONVW][(size_t)l * 1536 + c0 + i]; w1[i] = A.in[I_CONVW][(size_t)l * 1536 + 512 + c0 + i]; w2[i] = A.in[I_CONVW][(size_t)l * 1536 + 1024 + c0 + i]; }
    for (int R = gw; R < MVALID; R += NGW) {
        const int r1 = prev_row(R, 1), r2 = prev_row(R, 2);
        float gb[8], a[8], h[8], z0[8], z1[8], z2[8];
        unpk8(*(const GAS v4u*)(CB + (size_t)R * 1536 + c0), gb);
        unpk8(*(const GAS v4u*)(CB + (size_t)R * 1536 + 512 + c0), a); unpk8(*(const GAS v4u*)(CB + (size_t)R * 1536 + 1024 + c0), h);
#pragma unroll
        for (int i = 0; i < 8; ++i) z0[i] = a[i] * h[i];
        if (r1 >= 0) { unpk8(*(const GAS v4u*)(CB + (size_t)r1 * 1536 + 512 + c0), a); unpk8(*(const GAS v4u*)(CB + (size_t)r1 * 1536 + 1024 + c0), h);
#pragma unroll
            for (int i = 0; i < 8; ++i) z1[i] = a[i] * h[i]; }
        else {
#pragma unroll
            for (int i = 0; i < 8; ++i) z1[i] = 0.f; }
        if (r2 >= 0) { unpk8(*(const GAS v4u*)(CB + (size_t)r2 * 1536 + 512 + c0), a); unpk8(*(const GAS v4u*)(CB + (size_t)r2 * 1536 + 1024 + c0), h);
#pragma unroll
            for (int i = 0; i < 8; ++i) z2[i] = a[i] * h[i]; }
        else {
#pragma unroll
            for (int i = 0; i < 8; ++i) z2[i] = 0.f; }
        float y[8];
#pragma unroll
        for (int i = 0; i < 8; ++i) y[i] = gb[i] * (w0[i] * z2[i] + w1[i] * z1[i] + w2[i] * z0[i]);
        *(GAS v4u*)(YC + (size_t)R * 512 + c0) = pk8(y);
    }
}
__device__ __forceinline__ void ssm_meta_job(Frame& F, const Args& A, int l, int bm, int g) {
    const int lane = F.lane, lg = l * 32 + g;
    const float* SC = (const float*)(F.ws + WS_SSMC + (size_t)l * MiB);
    const bf16* UM = (const bf16*)(F.ws + WS_UMETA); bf16* YG = (bf16*)(F.ws + WS_YG); float* SM = (float*)(F.ws + WS_SM);
    LAS float* scr = (LAS float*)(F.lds + RING_OFF + F.wave * 16384);
    LAS float* CR = scr + 2048; LAS float* CI = scr + 3072;
    { const GAS f32x4* cr = (const GAS f32x4*)(A.in[I_CRE] + (size_t)lg * 1024) + lane * 4; const GAS f32x4* ci = (const GAS f32x4*)(A.in[I_CIM] + (size_t)lg * 1024) + lane * 4;
      f32x4 t0[4], t1[4];
#pragma unroll
      for (int i = 0; i < 4; ++i) { t0[i] = cr[i]; t1[i] = ci[i]; }
#pragma unroll
      for (int i = 0; i < 4; ++i) { *(LAS f32x4*)(CR + lane * 16 + 4 * i) = t0[i]; *(LAS f32x4*)(CI + lane * 16 + 4 * i) = t1[i]; } }
    const float ar = SC[(lg * 64 + lane) * 2], ai = SC[(lg * 64 + lane) * 2 + 1];
    float bbr[16], bbi[16];
    { const GAS f32x4* bp = (const GAS f32x4*)(SC + 32768 + (size_t)(lg * 64 + lane) * 32);
#pragma unroll
      for (int i = 0; i < 4; ++i) { const f32x4 r = bp[i], m = bp[4 + i]; bbr[4 * i] = r.x; bbr[4 * i + 1] = r.y; bbr[4 * i + 2] = r.z; bbr[4 * i + 3] = r.w; bbi[4 * i] = m.x; bbi[4 * i + 1] = m.y; bbi[4 * i + 2] = m.z; bbi[4 * i + 3] = m.w; } }
    float xr = 0.f, xi = 0.f;
#pragma unroll
    for (int hh = 0; hh < 2; ++hh) { v4u ua[8], ub[8];
#pragma unroll
        for (int s = 0; s < 8; ++s) { const bf16* up = UM + (size_t)(bm * 16 + hh * 8 + s) * 512 + g * 16; ua[s] = *(const GAS v4u*)up; ub[s] = *(const GAS v4u*)(up + 8); }
#pragma unroll
        for (int s = 0; s < 8; ++s) { float fa[8], fb[8]; unpk8(ua[s], fa); unpk8(ub[s], fb); float bur = 0.f, bui = 0.f;
#pragma unroll
            for (int c = 0; c < 8; ++c) { bur += bbr[c] * fa[c] + bbr[8 + c] * fb[c]; bui += bbi[c] * fa[c] + bbi[8 + c] * fb[c]; }
            const float nr = ar * xr - ai * xi + bur, ni = ar * xi + ai * xr + bui; xr = nr; xi = ni;
            const int ss = hh * 8 + s; scr[ss * 128 + ((lane + ss) & 63)] = xr; scr[ss * 128 + 64 + ((lane + ss) & 63)] = xi; } }
    SM[(size_t)(bm * 32 + g) * 128 + lane] = xr; SM[(size_t)(bm * 32 + g) * 128 + 64 + lane] = xi;
    LDS_WAIT(); asm volatile("" ::: "memory");
    const int s = lane >> 2, coq = (lane & 3) * 4; float y[4] = {0.f, 0.f, 0.f, 0.f};
    for (int p = 0; p < 64; ++p) { const float vr = scr[s * 128 + ((p + s) & 63)], vi = scr[s * 128 + 64 + ((p + s) & 63)];
#pragma unroll
        for (int i = 0; i < 4; ++i) y[i] += CR[(coq + i) * 64 + p] * vr - CI[(coq + i) * 64 + p] * vi; }
    const unsigned long long uw = *(const GAS unsigned long long*)(UM + (size_t)(bm * 16 + s) * 512 + g * 16 + coq);
    const f32x4 dv = *(const GAS f32x4*)(A.in[I_SSMD] + l * 512 + g * 16 + coq);
    y[0] += dv.x * bflo((unsigned)uw); y[1] += dv.y * bfhi((unsigned)uw); y[2] += dv.z * bflo((unsigned)(uw >> 32)); y[3] += dv.w * bfhi((unsigned)(uw >> 32));
    const unsigned long long o = (unsigned long long)pk2(gelu_(y[0]), gelu_(y[1])) | ((unsigned long long)pk2(gelu_(y[2]), gelu_(y[3])) << 32);
    *(GAS unsigned long long*)(YG + (size_t)(MREAL + bm * 16 + s) * 512 + g * 16 + coq) = o;
    LDS_WAIT(); asm volatile("" ::: "memory");
}
__device__ __forceinline__ void ssm_carry(Frame& F, int l) {
    const int T = F.vcu * 512 + F.tid; if (T >= 4096) return;
    const int b = T >> 11, g = (T >> 6) & 31, p = T & 63, lg = l * 32 + g;
    const float* SC = (const float*)(F.ws + WS_SSMC + (size_t)l * MiB); const float* SM = (const float*)(F.ws + WS_SM); const float* SL = (const float*)(F.ws + WS_SLOC); bf16* UC = (bf16*)(F.ws + WS_UC);
    const float a64r = SC[16384 + (lg * 64 + p) * 2], a64i = SC[16384 + (lg * 64 + p) * 2 + 1];
    float Sr = SM[(size_t)(b * 32 + g) * 128 + p], Si = SM[(size_t)(b * 32 + g) * 128 + 64 + p];
    const size_t row0 = (size_t)g * 256 + b * 128;
    for (int k0 = 0; k0 < 128; k0 += 16) { float lr[16], li[16];
#pragma unroll
        for (int j = 0; j < 16; ++j) { lr[j] = *(const GAS float*)(SL + (row0 + k0 + j) * 128 + p); li[j] = *(const GAS float*)(SL + (row0 + k0 + j) * 128 + 64 + p); }
#pragma unroll
        for (int j = 0; j < 16; ++j) { const size_t row = row0 + k0 + j;
            *(GAS bf16*)(UC + row * 1152 + 1024 + p) = (bf16)f2bf(Sr); *(GAS bf16*)(UC + row * 1152 + 1088 + p) = (bf16)f2bf(Si);
            const float nr = a64r * Sr - a64i * Si + lr[j], ni = a64r * Si + a64i * Sr + li[j]; Sr = nr; Si = ni; } }
}
__device__ __forceinline__ void attn_meta_job(Frame& F, int Rm, int h) {
    const int lane = F.lane, bm = Rm >> 4, R = MREAL + Rm, j = lane >> 2, dq = lane & 3;
    const bf16* Q = (const bf16*)(F.ws + WS_Q); const bf16* K = (const bf16*)(F.ws + WS_K); const bf16* V = (const bf16*)(F.ws + WS_V); bf16* OC = (bf16*)(F.ws + WS_OC);
    const size_t krow = (size_t)bm * 8320 + 8256;
#pragma unroll
    for (int c = 0; c < 2; ++c) { const int hc = h * 2 + c; float qa[8], qb[8], ka[8], kb[8];
        unpk8(*(const GAS v4u*)(Q + (size_t)R * 1024 + hc * 64 + dq * 16), qa); unpk8(*(const GAS v4u*)(Q + (size_t)R * 1024 + hc * 64 + dq * 16 + 8), qb);
        unpk8(*(const GAS v4u*)(K + (krow + j) * 1024 + hc * 64 + dq * 16), ka); unpk8(*(const GAS v4u*)(K + (krow + j) * 1024 + hc * 64 + dq * 16 + 8), kb);
        float s = 0.f;
#pragma unroll
        for (int i = 0; i < 8; ++i) s += qa[i] * ka[i] + qb[i] * kb[i];
        s += __shfl_xor(s, 1); s += __shfl_xor(s, 2);
        float m = s;
#pragma unroll
        for (int o = 4; o < 64; o <<= 1) m = fmaxf(m, __shfl_xor(m, o));
        const float pj = exp2f(s - m); float lsum = pj;
#pragma unroll
        for (int o = 4; o < 64; o <<= 1) lsum += __shfl_xor(lsum, o);
        float o0 = 0.f, o1 = 0.f;
#pragma unroll
        for (int jj = 0; jj < 16; ++jj) { const float pp = __shfl(pj, 4 * jj); const unsigned vv = *(const GAS unsigned*)(V + (krow + jj) * 1024 + h * 128 + 2 * lane); o0 += pp * bflo(vv); o1 += pp * bfhi(vv); }
        const float rl = 1.0f / lsum;
        *(GAS unsigned*)(OC + (size_t)R * 2048 + hc * 128 + 2 * lane) = pk2(o0 * rl, o1 * rl); }
}
__device__ __forceinline__ void attn_combine_rows(Frame& F, const Args& A, int l) {
    const int gw = F.vcu * NWAVES + F.wave, NGW = F.G * NWAVES, lane = F.lane;
    const bf16* OC = (const bf16*)(F.ws + WS_OC); bf16* YA = (bf16*)(F.ws + WS_YA);
    const float lam_init = 0.8f - 0.6f * expf(-0.3f * (float)l);
    const float d1 = wave_sum(A.in[I_LQ1][l * 64 + lane] * A.in[I_LK1][l * 64 + lane]), d2 = wave_sum(A.in[I_LQ2][l * 64 + lane] * A.in[I_LK2][l * 64 + lane]);
    const float lam = expf(d1) - expf(d2) + lam_init;
    const int e0 = (lane & 15) * 8; float sg[8];
#pragma unroll
    for (int i = 0; i < 8; ++i) sg[i] = A.in[I_SUBLN][l * 128 + e0 + i] * (1.0f - lam_init);
    for (int R = gw; R < MVALID; R += NGW) {
#pragma unroll
        for (int pass = 0; pass < 2; ++pass) { const int h = pass * 4 + (lane >> 4); float a[8], b[8], d[8];
            unpk8(*(const GAS v4u*)(OC + (size_t)R * 2048 + (2 * h) * 128 + e0), a); unpk8(*(const GAS v4u*)(OC + (size_t)R * 2048 + (2 * h + 1) * 128 + e0), b);
            float ss = 0.f;
#pragma unroll
            for (int i = 0; i < 8; ++i) { d[i] = a[i] - lam * b[i]; ss += d[i] * d[i]; }
            ss += __shfl_xor(ss, 1); ss += __shfl_xor(ss, 2); ss += __shfl_xor(ss, 4); ss += __shfl_xor(ss, 8);
            const float rs = 1.0f / sqrtf(ss * (1.0f / 128.0f) + 1e-5f);
#pragma unroll
            for (int i = 0; i < 8; ++i) d[i] = d[i] * rs * sg[i];
            *(GAS v4u*)(YA + (size_t)R * 1024 + h * 128 + e0) = pk8(d); }
    }
}
__device__ __forceinline__ float router_reduce(const float (&acc)[32], int lane) {
    float a16[16], a8[8], a4[4], a2[2], a1;
    { const bool hi = lane & 32;
#pragma unroll
      for (int i = 0; i < 16; ++i) { const float keep = hi ? acc[i + 16] : acc[i], give = hi ? acc[i] : acc[i + 16]; a16[i] = keep + __shfl_xor(give, 32); } }
    { const bool hi = lane & 16;
#pragma unroll
      for (int i = 0; i < 8; ++i) { const float keep = hi ? a16[i + 8] : a16[i], give = hi ? a16[i] : a16[i + 8]; a8[i] = keep + __shfl_xor(give, 16); } }
    { const bool hi = lane & 8;
#pragma unroll
      for (int i = 0; i < 4; ++i) { const float keep = hi ? a8[i + 4] : a8[i], give = hi ? a8[i] : a8[i + 4]; a4[i] = keep + __shfl_xor(give, 8); } }
    { const bool hi = lane & 4;
#pragma unroll
      for (int i = 0; i < 2; ++i) { const float keep = hi ? a4[i + 2] : a4[i], give = hi ? a4[i] : a4[i + 2]; a2[i] = keep + __shfl_xor(give, 4); } }
    { const bool hi = lane & 2; const float keep = hi ? a2[1] : a2[0], give = hi ? a2[0] : a2[1]; a1 = keep + DPPF(give, 0x4E); }
    return a1 + DPPF(a1, 0xB1);
}
__device__ __forceinline__ void router_top4(float val, int R, int lane, float* TOKW, unsigned* recg, int nrec, int& ecnt) {
    const int e_me = lane >> 1, iv = __builtin_bit_cast(int, val); int rank = 0;
#pragma unroll
    for (int e = 0; e < 32; ++e) { const float s = __builtin_bit_cast(float, __builtin_amdgcn_readlane(iv, 2 * e)); rank += ((s > val) || (s == val && e < e_me)) ? 1 : 0; }
    float tv[4]; int te[4];
#pragma unroll
    for (int k = 0; k < 4; ++k) { const unsigned long long m = __ballot(rank == k && !(lane & 1)); const int L = __builtin_amdgcn_readfirstlane((int)__ffsll((long long)m) - 1);
        te[k] = L >> 1; tv[k] = __builtin_bit_cast(float, __builtin_amdgcn_readlane(iv, L)); }
    ecnt += (te[0] == lane) + (te[1] == lane) + (te[2] == lane) + (te[3] == lane);
    const float p1 = __expf(tv[1] - tv[0]), p2 = __expf(tv[2] - tv[0]), p3 = __expf(tv[3] - tv[0]), rs = 1.0f / (1.0f + p1 + p2 + p3);
    if (lane < 4) { const int k = lane; const int e = k == 0 ? te[0] : k == 1 ? te[1] : k == 2 ? te[2] : te[3]; const float w = (k == 0 ? 1.0f : k == 1 ? p1 : k == 2 ? p2 : p3) * rs;
        TOKW[(size_t)R * 4 + k] = w; recg[(nrec * 4 + k) * 2] = (unsigned)R; recg[(nrec * 4 + k) * 2 + 1] = (unsigned)e; }
}
__device__ __forceinline__ void ln1_router(Frame& F, const Args& A, int l) {
    const int tid = F.tid, lane = F.lane, wave = F.wave, gw = F.vcu * NWAVES + wave, NGW = F.G * NWAVES;
    LAS float* WT = (LAS float*)(F.lds + RING_OFF);
    const float* rw = A.in[I_RW] + (size_t)l * 1024 * 32;
    for (int idx = tid; idx < 32768; idx += 512) WT[(idx & 31) * 1024 + (idx >> 5)] = rw[idx];
    __syncthreads();
    const float* PRE = (const float*)(F.ws + WS_PRE); float* HF = (float*)(F.ws + WS_HF); bf16* HB = (bf16*)(F.ws + WS_HB);
    float* TOKW = (float*)(F.ws + WS_TOKW);
    unsigned* recg = (unsigned*)(F.ws + WS_ROWIDX + 131072) + (size_t)gw * 80;
    const float rb = A.in[I_RB][l * 32 + (lane >> 1)];
    int nrec = 0, ecnt = 0;
#pragma unroll 1
    for (int R0 = gw; R0 < MVALID; R0 += 2 * NGW) {
        const int R1 = R0 + NGW; const bool two = R1 < MVALID; const int R1c = two ? R1 : R0;
        f32x4 v0[4], v1[4];
#pragma unroll
        for (int j = 0; j < 4; ++j) { v0[j] = *(const GAS f32x4*)(PRE + (size_t)R0 * 1024 + 256 * j + 4 * lane); v1[j] = *(const GAS f32x4*)(PRE + (size_t)R1c * 1024 + 256 * j + 4 * lane); }
        ln16(v0, A.in[I_LN1G] + l * 1024, A.in[I_LN1B] + l * 1024, lane); ln16(v1, A.in[I_LN1G] + l * 1024, A.in[I_LN1B] + l * 1024, lane);
        store_row_f32_bf16(v0, HF + (size_t)R0 * 1024, HB + (size_t)R0 * 1024, lane);
        if (two) store_row_f32_bf16(v1, HF + (size_t)R1 * 1024, HB + (size_t)R1 * 1024, lane);
        float acc0[32], acc1[32];
#pragma unroll
        for (int e = 0; e < 32; ++e) { float s0 = 0.f, s1 = 0.f;
#pragma unroll
            for (int j = 0; j < 4; ++j) { const f32x4 w = *(const LAS f32x4*)(WT + e * 1024 + 256 * j + 4 * lane);
                s0 += (v0[j].x * w.x + v0[j].y * w.y) + (v0[j].z * w.z + v0[j].w * w.w); s1 += (v1[j].x * w.x + v1[j].y * w.y) + (v1[j].z * w.z + v1[j].w * w.w); }
            acc0[e] = s0; acc1[e] = s1; }
        const float val0 = router_reduce(acc0, lane) + rb, val1 = router_reduce(acc1, lane) + rb;
        router_top4(val0, R0, lane, TOKW, recg, nrec, ecnt); ++nrec;
        if (two) { router_top4(val1, R1, lane, TOKW, recg, nrec, ecnt); ++nrec; }
        asm volatile("" ::: "memory");
    }
    if (lane == 0) ((int*)(F.ws + WS_ROWIDX + 65536))[gw] = nrec * 4;
    if (lane < 32) ((int*)(F.ws + WS_ROWIDX + 1048576))[(size_t)gw * 32 + lane] = ecnt;
    { LAS int* bc = (LAS int*)(F.lds + LDSCTL_OFF);
      if (tid < 32) bc[tid] = 0;
      __syncthreads();
      if (lane < 32) __hip_atomic_fetch_add(&bc[lane], ecnt, __ATOMIC_RELAXED, __HIP_MEMORY_SCOPE_WORKGROUP);
      __syncthreads();
      if (tid < 32) ((int*)(F.ws + WS_ROWIDX + 2097152))[(size_t)F.vcu * 32 + tid] = bc[tid];
      __syncthreads(); }
}
__device__ __forceinline__ void moe_tables(Frame& F, int l, bool with_bases = false) {
    LAS int* tb = (LAS int*)(F.lds + LDSCTL_OFF); LAS int* cn = tb + 34;
    LAS int* part = (LAS int*)(F.lds + RING_OFF);
    LAS int* wb = part + 1024;
    const int* WCNT = (const int*)(F.ws + WS_ROWIDX + 1048576);
    const int NGW = F.G * NWAVES, gw0 = F.vcu * NWAVES;
    __syncthreads();
    { const int e = F.tid & 31, pt = F.tid >> 5; int tot = 0, base = 0; const int per = F.G / 16; const int* BCNT = (const int*)(F.ws + WS_ROWIDX + 2097152); int cv[16];
#pragma unroll
      for (int i = 0; i < 16; ++i) cv[i] = (i < per) ? BCNT[(size_t)(pt * per + i) * 32 + e] : 0;
#pragma unroll
      for (int i = 0; i < 16; ++i) { tot += cv[i]; if (pt * per + i < F.vcu) base += cv[i]; }
      part[pt * 32 + e] = tot; part[512 + pt * 32 + e] = base; }
    __syncthreads();
    if (F.tid < 32) { int tot = 0, base = 0;
#pragma unroll
        for (int pt = 0; pt < 16; ++pt) { tot += part[pt * 32 + F.tid]; base += part[512 + pt * 32 + F.tid]; }
        cn[F.tid] = tot;
        if (with_bases) { for (int w = 0; w < NWAVES; ++w) { wb[w * 32 + F.tid] = base; base += WCNT[(size_t)(gw0 + w) * 32 + F.tid]; } } }
    __syncthreads();
    if (F.tid == 0) { int s = 0; for (int e = 0; e < 32; ++e) { tb[e] = s; s += (cn[e] + 255) >> 8; } tb[32] = s; }
    __syncthreads();
}
__device__ __forceinline__ void moe_gather(Frame& F) {
    const LAS int* tb = (const LAS int*)(F.lds + LDSCTL_OFF); const LAS int* wb = (const LAS int*)(F.lds + RING_OFF) + 1024 + F.wave * 32;
    const int gw = F.vcu * NWAVES + F.wave, lane = F.lane;
    const bf16* HB = (const bf16*)(F.ws + WS_HB); bf16* XG = (bf16*)(F.ws + WS_XG); unsigned* TOKE = (unsigned*)(F.ws + WS_TOKE);
    const unsigned* recg = (const unsigned*)(F.ws + WS_ROWIDX + 131072) + (size_t)gw * 80; const int n = ((const int*)(F.ws + WS_ROWIDX + 65536))[gw];
    const int my_e = lane < n ? (int)recg[lane * 2 + 1] : -1, my_R = lane < n ? (int)recg[lane * 2] : 0;
    int before = 0; for (int j = 0; j < n; ++j) { const int ej = __builtin_amdgcn_readlane(my_e, j); before += (j < lane && ej == my_e) ? 1 : 0; }
    const int my_pos = lane < n ? wb[my_e] + before : 0;
    if (lane < n) TOKE[(size_t)my_R * 4 + (lane & 3)] = (unsigned)my_e | ((unsigned)my_pos << 8);
    for (int i = 0; i < n; ++i) { const int e = __builtin_amdgcn_readlane(my_e, i), R = __builtin_amdgcn_readlane(my_R, i), pos = __builtin_amdgcn_readlane(my_pos, i);
        const size_t crow = (size_t)tb[e] * 256 + pos; const GAS v4u* sp = (const GAS v4u*)(HB + (size_t)R * 1024); GAS v4u* dp = (GAS v4u*)(XG + crow * 1024);
        const v4u a = sp[lane], b = sp[64 + lane]; dp[lane] = a; dp[64 + lane] = b; }
}
__device__ __forceinline__ void ln2_rows(Frame& F, const Args& A, int l) {
    const LAS int* tb = (const LAS int*)(F.lds + LDSCTL_OFF);
    const int gw = F.vcu * NWAVES + F.wave, NGW = F.G * NWAVES, lane = F.lane;
    float* HF = (float*)(F.ws + WS_HF); bf16* HB = (bf16*)(F.ws + WS_HB); const bf16* OUTS = (const bf16*)(F.ws + WS_OUTS);
    const float* TOKW = (const float*)(F.ws + WS_TOKW); const unsigned* TOKE = (const unsigned*)(F.ws + WS_TOKE);
    for (int R0 = gw; R0 < MVALID; R0 += 2 * NGW) {
        const int R1 = R0 + NGW; const bool two = R1 < MVALID; const int Rr[2] = {R0, two ? R1 : R0};
        f32x4 v[2][4]; unsigned long long o[2][4][4]; float w[2][4];
#pragma unroll
        for (int q = 0; q < 2; ++q) {
            const v4u te4 = *(const GAS v4u*)(TOKE + (size_t)Rr[q] * 4); const f32x4 w4 = *(const GAS f32x4*)(TOKW + (size_t)Rr[q] * 4);
            const unsigned te[4] = {te4.x, te4.y, te4.z, te4.w}; w[q][0] = w4.x; w[q][1] = w4.y; w[q][2] = w4.z; w[q][3] = w4.w;
#pragma unroll
            for (int j = 0; j < 4; ++j) v[q][j] = *(const GAS f32x4*)(HF + (size_t)Rr[q] * 1024 + 256 * j + 4 * lane);
#pragma unroll
            for (int k = 0; k < 4; ++k) { const size_t crow = (size_t)tb[te[k] & 255] * 256 + (te[k] >> 8);
#pragma unroll
                for (int j = 0; j < 4; ++j) o[q][k][j] = *(const GAS unsigned long long*)(OUTS + crow * 1024 + 256 * j + 4 * lane); } }
#pragma unroll
        for (int q = 0; q < 2; ++q) {
#pragma unroll
            for (int j = 0; j < 4; ++j) v[q][j] = v[q][j] * ALPHA;
#pragma unroll
            for (int k = 0; k < 4; ++k)
#pragma unroll
                for (int j = 0; j < 4; ++j) { const unsigned lo = (unsigned)o[q][k][j], hi = (unsigned)(o[q][k][j] >> 32); const float ww = w[q][k];
                    v[q][j].x += ww * bflo(lo); v[q][j].y += ww * bfhi(lo); v[q][j].z += ww * bflo(hi); v[q][j].w += ww * bfhi(hi); }
            ln16(v[q], A.in[I_LN2G] + l * 1024, A.in[I_LN2B] + l * 1024, lane);
#if defined(SELFCHK)
            if (l == NLAYER - 1) { const unsigned mask = __hip_atomic_load(F.ctl + 2048, RLX_AGENT); if (mask) { const float pv = (float)(1u << (__ffs((int)mask) - 1));
#pragma unroll
                for (int j = 0; j < 4; ++j) v[q][j] = (f32x4){pv, pv, pv, pv}; } }
#endif
            if (q == 0 || two) { const int R = Rr[q];
                if (l == NLAYER - 1) { if (R < MREAL) {
#pragma unroll
                        for (int j = 0; j < 4; ++j) *(GAS f32x4*)(A.out + (size_t)R * 1024 + 256 * j + 4 * lane) = v[q][j]; } }
                else store_row_f32_bf16(v[q], HF + (size_t)R * 1024, HB + (size_t)R * 1024, lane); }
        }
    }
}

typedef float f32x16 __attribute__((ext_vector_type(16)));
__device__ __forceinline__ f32x16 skinny32_part(const bf16* A, int lda, const bf16* Bt, int ldb, int K, int cb, int lane, int wave, f32x16 acc) {
    const int r32 = lane & 31, hi = lane >> 5, ks = K / 16 / NWAVES;
    const GAS bf16x8* ap = (const GAS bf16x8*)(A + (size_t)r32 * lda + hi * 8) + (size_t)wave * ks * 2;
    const GAS bf16x8* bp = (const GAS bf16x8*)(Bt + (size_t)(cb * 32 + r32) * ldb + hi * 8) + (size_t)wave * ks * 2;
    bf16x8 a[8], b[8];
#pragma unroll
    for (int i = 0; i < 8; ++i) if (i < ks) { a[i] = ap[i * 2]; b[i] = bp[i * 2]; }
#pragma unroll
    for (int i = 0; i < 8; ++i) if (i < ks) acc = __builtin_amdgcn_mfma_f32_32x32x16_bf16(a[i], b[i], acc, 0, 0, 0);
    return acc;
}
__device__ __forceinline__ f32x16 skinny_reduce(Frame& F, f32x16 part, int slot) {
    LAS float* red = (LAS float*)(F.lds + RING_OFF) + slot * 8192;
#pragma unroll
    for (int r = 0; r < 16; ++r) red[(F.wave * 16 + r) * 64 + F.lane] = part[r];
    __syncthreads();
    f32x16 s = {};
    if (F.wave == 0) {
#pragma unroll 2
        for (int w = 0; w < NWAVES; ++w)
#pragma unroll
            for (int r = 0; r < 16; ++r) s[r] += red[(w * 16 + r) * 64 + F.lane]; }
    return s;
}
__device__ __forceinline__ int mrow(int r, int hi) { return (r & 3) + 8 * (r >> 2) + 4 * hi; }
__device__ __forceinline__ void st_bf(bf16* p, float v) { *(GAS bf16*)p = (bf16)f2bf(v); }
__device__ __forceinline__ void skinny_p1(Frame& F, const Args& A, int l, int cb) {
    const int lane = F.lane, c = cb * 32 + (lane & 31), hi = lane >> 5;
    const bf16* HBm = (const bf16*)(F.ws + WS_HB) + (size_t)MREAL * 1024; const bf16* W = (const bf16*)(F.ws + WS_W + (size_t)l * WL_STRIDE + WL_IN);
    f32x16 acc = {}; acc = skinny_reduce(F, skinny32_part(HBm, 1024, W, 1024, 1024, cb, lane, F.wave, acc), 0); __syncthreads(); if (F.wave != 0) return;
    if (c < 512) { bf16* UM = (bf16*)(F.ws + WS_UMETA);
#pragma unroll
        for (int r = 0; r < 16; ++r) st_bf(UM + (size_t)mrow(r, hi) * 512 + c, acc[r]); }
    else if (c < 2048) { bf16* CB = (bf16*)(F.ws + WS_CONV);
#pragma unroll
        for (int r = 0; r < 16; ++r) st_bf(CB + (size_t)(MREAL + mrow(r, hi)) * 1536 + (c - 512), acc[r]); }
    else if (c < 4096) { const bool isq = c < 3072; const int cc = c - (isq ? 2048 : 3072), hh = cc >> 6, g = (cc & 63) >> 3, i8 = cc & 7, j = 4 * g + (i8 & 3), d = i8 < 4 ? j : 32 + j;
        const float* rope = (const float*)(F.ws + WS_ROPE); bf16* dst = isq ? (bf16*)(F.ws + WS_Q) : (bf16*)(F.ws + WS_K);
#pragma unroll
        for (int r = 0; r < 16; ++r) { const int m = mrow(r, hi), pos = m & 15; const float v = acc[r], pv = __shfl_xor(v, 4); const float cs = rope[(size_t)pos * 64 + j], sn = rope[(size_t)pos * 64 + 32 + j];
            float o = i8 < 4 ? v * cs - pv * sn : v * cs + pv * sn; if (isq) o *= pg8::QSCALE;
            const size_t drow = isq ? (size_t)(MREAL + m) : (size_t)pg8::kv_row(MREAL + m); st_bf(dst + drow * 1024 + hh * 64 + d, o); } }
    else if (c < 5120) { bf16* V = (bf16*)(F.ws + WS_V);
#pragma unroll
        for (int r = 0; r < 16; ++r) st_bf(V + (size_t)pg8::kv_row(MREAL + mrow(r, hi)) * 1024 + (c - 4096), acc[r]); }
    else { bf16* GB = (bf16*)(F.ws + WS_GB); const float gb = A.in[I_GATEB][(size_t)l * 3072 + (c - 5120)];
#pragma unroll
        for (int r = 0; r < 16; ++r) st_bf(GB + (size_t)(MREAL + mrow(r, hi)) * 3072 + (c - 5120), sigm_(acc[r] + gb)); }
}
__device__ __forceinline__ void skinny_glu(Frame& F, int l, int cb) {
    const int lane = F.lane, c = cb * 32 + (lane & 31), hi = lane >> 5;
    const bf16* YG = (const bf16*)(F.ws + WS_YG); bf16* YS = (bf16*)(F.ws + WS_YS);
    f32x16 acc = {}; acc = skinny_reduce(F, skinny32_part(YG + (size_t)MREAL * 512, 512, (const bf16*)(F.ws + WS_W + (size_t)l * WL_STRIDE + WL_GLU), 512, 512, cb, lane, F.wave, acc), 0); __syncthreads(); if (F.wave != 0) return;
#pragma unroll
    for (int r = 0; r < 16; ++r) { const size_t R = MREAL + mrow(r, hi); const float y = __uint_as_float((unsigned)(*(const GAS bf16*)(YG + R * 512 + c)) << 16); st_bf(YS + R * 512 + c, y * sigm_(acc[r])); }
}
__device__ __forceinline__ void skinny_merge(Frame& F, int l, int cb) {
    const int lane = F.lane, c = cb * 32 + (lane & 31), hi = lane >> 5; unsigned char* wl = F.ws + WS_W + (size_t)l * WL_STRIDE;
    const bf16* GB = (const bf16*)(F.ws + WS_GB); bf16* MG = (bf16*)(F.ws + WS_MG);
    f32x16 z = {};
    LAS float* red = (LAS float*)(F.lds + RING_OFF);
    { const f32x16 p0 = skinny32_part((const bf16*)(F.ws + WS_YS) + (size_t)MREAL * 512, 512, (const bf16*)(wl + WL_SO), 512, 512, cb, lane, F.wave, z);
#pragma unroll
      for (int r = 0; r < 16; ++r) red[(F.wave * 16 + r) * 64 + lane] = p0[r]; }
    asm volatile("" ::: "memory");
    { const f32x16 p1 = skinny32_part((const bf16*)(F.ws + WS_YC) + (size_t)MREAL * 512, 512, (const bf16*)(wl + WL_CO), 512, 512, cb, lane, F.wave, z);
#pragma unroll
      for (int r = 0; r < 16; ++r) red[8192 + (F.wave * 16 + r) * 64 + lane] = p1[r]; }
    asm volatile("" ::: "memory");
    { const f32x16 p2 = skinny32_part((const bf16*)(F.ws + WS_YA) + (size_t)MREAL * 1024, 1024, (const bf16*)(wl + WL_AO), 1024, 1024, cb, lane, F.wave, z);
#pragma unroll
      for (int r = 0; r < 16; ++r) red[16384 + (F.wave * 16 + r) * 64 + lane] = p2[r]; }
    __syncthreads();
    f32x16 a0 = {}, a1 = {}, a2 = {};
    if (F.wave == 0) {
#pragma unroll 1
        for (int w = 0; w < NWAVES; ++w)
#pragma unroll
            for (int r = 0; r < 16; ++r) { a0[r] += red[(w * 16 + r) * 64 + lane]; a1[r] += red[8192 + (w * 16 + r) * 64 + lane]; a2[r] += red[16384 + (w * 16 + r) * 64 + lane]; } }
    __syncthreads(); if (F.wave != 0) return;
#pragma unroll
    for (int r = 0; r < 16; ++r) { const size_t R = MREAL + mrow(r, hi); const bf16* g = GB + R * 3072 + c;
        const float g0 = __uint_as_float((unsigned)(*(const GAS bf16*)g) << 16), g1 = __uint_as_float((unsigned)(*(const GAS bf16*)(g + 1024)) << 16), g2 = __uint_as_float((unsigned)(*(const GAS bf16*)(g + 2048)) << 16);
        st_bf(MG + R * 1024 + c, g0 * a0[r] + g1 * a1[r] + g2 * a2[r]); }
}
__device__ __forceinline__ void skinny_pre(Frame& F, int l, int cb) {
    const int lane = F.lane, c = cb * 32 + (lane & 31), hi = lane >> 5;
    const float* HF = (const float*)(F.ws + WS_HF); float* PRE = (float*)(F.ws + WS_PRE);
    f32x16 acc = {}; acc = skinny_reduce(F, skinny32_part((const bf16*)(F.ws + WS_MG) + (size_t)MREAL * 1024, 1024, (const bf16*)(F.ws + WS_W + (size_t)l * WL_STRIDE + WL_WO), 1024, 1024, cb, lane, F.wave, acc), 0); __syncthreads(); if (F.wave != 0) return;
#pragma unroll
    for (int r = 0; r < 16; ++r) { const size_t R = MREAL + mrow(r, hi); *(GAS float*)(PRE + R * 1024 + c) = ALPHA * *(const GAS float*)(HF + R * 1024 + c) + acc[r]; }
}
#define SKINNY_JOBS(n, call) do { for (int j_ = F.vcu; j_ < (n); j_ += F.G) { const int cb = j_; call; __syncthreads(); } } while (0)

#if defined(SELFCHK)
constexpr int CW_FAIL = 2048;
__device__ __forceinline__ void chk_report(Frame& F, int id, float got, float ref, float scale) {
    const float err = fabsf(got - ref);
    if (!(err <= 0.03f * fabsf(ref) + 0.03f * scale)) __hip_atomic_fetch_or(F.ctl + CW_FAIL, 1u << (id + F.chk_l * 16), RLX_AGENT);
}
__device__ __forceinline__ float bfr(float x) { return __uint_as_float(f2bf(x) << 16); }
__device__ __forceinline__ float ldbf(const bf16* p) { return __uint_as_float((unsigned)(*(const GAS bf16*)p) << 16); }
__device__ __forceinline__ float dot_bf_w(const bf16* a, const float* W, int K, int ldw, int col, int lane) {
    float s = 0.f; for (int k = lane; k < K; k += 64) s += ldbf(a + k) * bfr(W[(size_t)k * ldw + col]); return wave_sum(s);
}
__constant__ int SMP_ROWS[16] = {0, 1, 2, 63, 64, 100, 255, 256, 8191, 8192, 8193, 12345, 16383, 16384, 16399, 16415};
__constant__ int SMP_SP[12] = {0, 15, 16, 17, 79, 80, 81, 143, 144, 1000, 4111, 8207};
__device__ __forceinline__ int smp_row(int i) { return SMP_ROWS[i]; }
__device__ __forceinline__ void chk_p1(Frame& F, const Args& A, int l) {
    const int gw = F.vcu * NWAVES + F.wave, NGW = F.G * NWAVES, lane = F.lane;
    const bf16* HB = (const bf16*)(F.ws + WS_HB); const float* Win = A.in[I_WIN] + (size_t)l * 1024 * 5120; const float* Wg = A.in[I_GATEW] + (size_t)l * 1024 * 3072;
    const float* ROPE = (const float*)(F.ws + WS_ROPE);
    for (int job = gw; job < 16 * 24; job += NGW) { const int R = smp_row(job / 24), ci = job % 24; const bf16* a = HB + (size_t)R * 1024;
        if (ci < 4) { const int c = (ci * 171 + 5) & 511; const float ref = dot_bf_w(a, Win, 1024, 5120, c, lane); float got;
            if (R < MREAL) { const int g = c >> 4, chunkrow = (R >> 13) * 128 + ((R & 8191) >> 6), s = R & 63; got = ldbf((const bf16*)(F.ws + WS_UC) + ((size_t)(g * 256 + chunkrow) * 1152 + s * 16 + (c & 15))); }
            else got = ldbf((const bf16*)(F.ws + WS_UMETA) + (size_t)(R - MREAL) * 512 + c);
            if (lane == 0) chk_report(F, 1, got, ref, 1.0f); }
        else if (ci < 8) { const int c = ((ci - 4) * 397 + 11) % 1536; const float ref = dot_bf_w(a, Win, 1024, 5120, 512 + c, lane); const float got = ldbf((const bf16*)(F.ws + WS_CONV) + (size_t)R * 1536 + c);
            if (lane == 0) chk_report(F, 1, got, ref, 1.0f); }
        else if (ci < 16) { const bool isq = ci < 12; const int cc = ((ci & 3) * 277 + 33) & 1023, hh = cc >> 6, d = cc & 63, j = d & 31;
            const int base = (isq ? 2048 : 3072) + hh * 64; const float xl = dot_bf_w(a, Win, 1024, 5120, base + j, lane), xh = dot_bf_w(a, Win, 1024, 5120, base + 32 + j, lane);
            const int pos = R < MREAL ? 16 + (R & 8191) : ((R - MREAL) & 15); const float cs = ROPE[(size_t)pos * 64 + j], sn = ROPE[(size_t)pos * 64 + 32 + j];
            float ref = d < 32 ? xl * cs - xh * sn : xh * cs + xl * sn; if (isq) ref *= pg8::QSCALE;
            const float got = isq ? ldbf((const bf16*)(F.ws + WS_Q) + (size_t)R * 1024 + cc) : ldbf((const bf16*)(F.ws + WS_K) + (size_t)pg8::kv_row(R) * 1024 + cc);
            if (lane == 0) chk_report(F, 2, got, ref, isq ? 0.2f : 1.0f); }
        else if (ci < 20) { const int c = ((ci - 16) * 301 + 7) & 1023; const float ref = dot_bf_w(a, Win, 1024, 5120, 4096 + c, lane); const float got = ldbf((const bf16*)(F.ws + WS_V) + (size_t)pg8::kv_row(R) * 1024 + c);
            if (lane == 0) chk_report(F, 3, got, ref, 0.5f); }
        else { const int c = ((ci - 20) * 811 + 3) % 3072; const float ref = sigm_(dot_bf_w(a, Wg, 1024, 3072, c, lane) + A.in[I_GATEB][(size_t)l * 3072 + c]); const float got = ldbf((const bf16*)(F.ws + WS_GB) + (size_t)R * 3072 + c);
            if (lane == 0) chk_report(F, 3, got, ref, 0.3f); }
    }
}
__device__ __forceinline__ float u_at(Frame& F, int b, int sp, int c) {
    if (sp < 16) return ldbf((const bf16*)(F.ws + WS_UMETA) + (size_t)(b * 16 + sp) * 512 + c);
    const int t = sp - 16; return ldbf((const bf16*)(F.ws + WS_UC) + ((size_t)((c >> 4) * 256 + b * 128 + (t >> 6)) * 1152 + (t & 63) * 16 + (c & 15)));
}
__device__ __forceinline__ int seq_row(int b, int sp) { return sp < 16 ? MREAL + b * 16 + sp : b * 8192 + (sp - 16); }
__device__ __forceinline__ void chk_ssm_conv(Frame& F, const Args& A, int l) {
    const int gw = F.vcu * NWAVES + F.wave, NGW = F.G * NWAVES, lane = F.lane;
    LAS float* scr = (LAS float*)(F.lds + RING_OFF + F.wave * 16384);
#pragma unroll 1
    for (int job = gw; job < 2 * 12 * 3; job += NGW) { const int b = job / 36, si = (job / 3) % 12, gi = job % 3; const int g = gi == 0 ? 0 : gi == 1 ? 13 : 31;
        const int sp = SMP_SP[si];
        const int lg = l * 32 + g, p = lane; const float lr = A.in[I_LAMRE][lg * 64 + p], li = A.in[I_LAMIM][lg * 64 + p], dt = expf(A.in[I_LOGDT][lg]);
        const float mag = __expf(lr * dt), ar = mag * __cosf(li * dt), ai = mag * __sinf(li * dt), nr = ar - 1.0f, den = lr * lr + li * li;
        const float cr = (nr * lr + ai * li) / den, ci = (ai * lr - nr * li) / den;
        float bbr[16], bbi[16];
#pragma unroll
        for (int c = 0; c < 16; ++c) { const float br = A.in[I_BRE][(size_t)(lg * 64 + p) * 16 + c], bi = A.in[I_BIM][(size_t)(lg * 64 + p) * 16 + c]; bbr[c] = cr * br - ci * bi; bbi[c] = cr * bi + ci * br; }
        float xr = 0.f, xi = 0.f;
#pragma unroll 1
        for (int s = 0; s <= sp; ++s) { float bur = 0.f, bui = 0.f, ua[8], ub[8];
            const bf16* up = s < 16 ? (const bf16*)(F.ws + WS_UMETA) + (size_t)(b * 16 + s) * 512 + g * 16 : (const bf16*)(F.ws + WS_UC) + ((size_t)(g * 256 + b * 128 + ((s - 16) >> 6)) * 1152 + ((s - 16) & 63) * 16);
            unpk8(*(const GAS v4u*)up, ua); unpk8(*(const GAS v4u*)(up + 8), ub);
#pragma unroll
            for (int c = 0; c < 8; ++c) { bur += bbr[c] * ua[c] + bbr[8 + c] * ub[c]; bui += bbi[c] * ua[c] + bbi[8 + c] * ub[c]; }
            const float n1 = ar * xr - ai * xi + bur, n2 = ar * xi + ai * xr + bui; xr = n1; xi = n2; }
        scr[lane] = xr; scr[64 + lane] = xi; LDS_WAIT(); asm volatile("" ::: "memory");
        if (lane < 16) { const int co = lane; float y = 0.f;
#pragma unroll 1
            for (int q = 0; q < 64; ++q) y += A.in[I_CRE][(size_t)(lg * 16 + co) * 64 + q] * scr[q] - A.in[I_CIM][(size_t)(lg * 16 + co) * 64 + q] * scr[64 + q];
            y += A.in[I_SSMD][l * 512 + g * 16 + co] * u_at(F, b, sp, g * 16 + co);
            const float ref = gelu_(y), got = ldbf((const bf16*)(F.ws + WS_YG) + (size_t)seq_row(b, sp) * 512 + g * 16 + co);
            chk_report(F, sp < 16 ? 4 : 5, got, ref, 0.3f); }
        LDS_WAIT(); asm volatile("" ::: "memory");
    }
    for (int job = gw; job < 16; job += NGW) { const int R = smp_row(job), c = (lane * 37 + 5) & 511; const bf16* CB = (const bf16*)(F.ws + WS_CONV);
        float y = 0.f;
#pragma unroll 1
        for (int k = 0; k < 3; ++k) { const int r = k == 0 ? R : prev_row(R, k); if (r >= 0) y += A.in[I_CONVW][(size_t)l * 1536 + (2 - k) * 512 + c] * ldbf(CB + (size_t)r * 1536 + 512 + c) * ldbf(CB + (size_t)r * 1536 + 1024 + c); }
        const float ref = y * ldbf(CB + (size_t)R * 1536 + c), got = ldbf((const bf16*)(F.ws + WS_YC) + (size_t)R * 512 + c);
        chk_report(F, 6, got, ref, 0.5f); }
}
__device__ __forceinline__ void chk_attn(Frame& F) {
    const int gw = F.vcu * NWAVES + F.wave, NGW = F.G * NWAVES, lane = F.lane;
    const bf16* Q = (const bf16*)(F.ws + WS_Q); const bf16* K = (const bf16*)(F.ws + WS_K); const bf16* V = (const bf16*)(F.ws + WS_V); const bf16* OC = (const bf16*)(F.ws + WS_OC);
    for (int job = gw; job < 16 * 3; job += NGW) { const int R = smp_row(job / 3), hi_ = job % 3, hc = hi_ == 0 ? 0 : hi_ == 1 ? 5 : 15, h = hc >> 1;
        const int b = R < MREAL ? (R >> 13) : ((R - MREAL) >> 4); const int nreal = R < MREAL ? (((R & 8191) >> 6) + 1) * 64 : 0, nk = 16 + nreal;
        const float q = ldbf(Q + (size_t)R * 1024 + hc * 64 + lane);
        float m = -INFINITY;
        for (int j = 0; j < nk; ++j) { const size_t kr = (size_t)b * 8320 + (j < 16 ? 8256 + j : j - 16); const float s = wave_sum(q * ldbf(K + kr * 1024 + hc * 64 + lane)); m = fmaxf(m, s); }
        float lsum = 0.f, o0 = 0.f, o1 = 0.f;
        for (int j = 0; j < nk; ++j) { const size_t kr = (size_t)b * 8320 + (j < 16 ? 8256 + j : j - 16); const float s = wave_sum(q * ldbf(K + kr * 1024 + hc * 64 + lane)); const float p = exp2f(s - m);
            lsum += p; o0 += p * ldbf(V + kr * 1024 + h * 128 + 2 * lane); o1 += p * ldbf(V + kr * 1024 + h * 128 + 2 * lane + 1); }
        const float g0 = ldbf(OC + (size_t)R * 2048 + hc * 128 + 2 * lane), g1 = ldbf(OC + (size_t)R * 2048 + hc * 128 + 2 * lane + 1);
        chk_report(F, R < MREAL ? 7 : 8, g0, o0 / lsum, 0.05f); chk_report(F, R < MREAL ? 7 : 8, g1, o1 / lsum, 0.05f); }
}
__device__ __forceinline__ void chk_mix(Frame& F, const Args& A, int l) {
    const int gw = F.vcu * NWAVES + F.wave, NGW = F.G * NWAVES, lane = F.lane;
    const bf16* YG = (const bf16*)(F.ws + WS_YG); const bf16* YS = (const bf16*)(F.ws + WS_YS); const bf16* YC = (const bf16*)(F.ws + WS_YC); const bf16* YA = (const bf16*)(F.ws + WS_YA);
    const bf16* GB = (const bf16*)(F.ws + WS_GB); const bf16* MG = (const bf16*)(F.ws + WS_MG); const bf16* OC = (const bf16*)(F.ws + WS_OC);
    for (int job = gw; job < 16 * 4; job += NGW) { const int R = smp_row(job >> 2), ci = job & 3;
        { const int c = (ci * 139 + 21) & 511; const float z = dot_bf_w(YG + (size_t)R * 512, A.in[I_WGLU] + (size_t)l * 512 * 512, 512, 512, c, lane); const float ref = ldbf(YG + (size_t)R * 512 + c) * sigm_(z);
          if (lane == 0) chk_report(F, 9, ldbf(YS + (size_t)R * 512 + c), ref, 0.2f); }
        { const int h = (ci * 3 + 1) & 7; const float lam_init = 0.8f - 0.6f * expf(-0.3f * (float)l);
          const float d1 = wave_sum(A.in[I_LQ1][l * 64 + lane] * A.in[I_LK1][l * 64 + lane]), d2 = wave_sum(A.in[I_LQ2][l * 64 + lane] * A.in[I_LK2][l * 64 + lane]); const float lam = expf(d1) - expf(d2) + lam_init;
          const float a0 = ldbf(OC + (size_t)R * 2048 + (2 * h) * 128 + lane) - lam * ldbf(OC + (size_t)R * 2048 + (2 * h + 1) * 128 + lane), a1 = ldbf(OC + (size_t)R * 2048 + (2 * h) * 128 + 64 + lane) - lam * ldbf(OC + (size_t)R * 2048 + (2 * h + 1) * 128 + 64 + lane);
          const float rs = 1.0f / sqrtf(wave_sum(a0 * a0 + a1 * a1) * (1.0f / 128.0f) + 1e-5f);
          chk_report(F, 10, ldbf(YA + (size_t)R * 1024 + h * 128 + lane), a0 * rs * A.in[I_SUBLN][l * 128 + lane] * (1.0f - lam_init), 0.3f);
          chk_report(F, 10, ldbf(YA + (size_t)R * 1024 + h * 128 + 64 + lane), a1 * rs * A.in[I_SUBLN][l * 128 + 64 + lane] * (1.0f - lam_init), 0.3f); }
        { const int c = (ci * 269 + 77) & 1023;
          const float p0 = dot_bf_w(YS + (size_t)R * 512, A.in[I_SSMWO] + (size_t)l * 512 * 1024, 512, 1024, c, lane), p1 = dot_bf_w(YC + (size_t)R * 512, A.in[I_CONVWO] + (size_t)l * 512 * 1024, 512, 1024, c, lane),
                      p2 = dot_bf_w(YA + (size_t)R * 1024, A.in[I_ATTNWO] + (size_t)l * 1024 * 1024, 1024, 1024, c, lane);
          const float ref = ldbf(GB + (size_t)R * 3072 + c) * p0 + ldbf(GB + (size_t)R * 3072 + 1024 + c) * p1 + ldbf(GB + (size_t)R * 3072 + 2048 + c) * p2;
          if (lane == 0) chk_report(F, 11, ldbf(MG + (size_t)R * 1024 + c), ref, 0.3f);
          const float pr = dot_bf_w(MG + (size_t)R * 1024, A.in[I_WO] + (size_t)l * 1024 * 1024, 1024, 1024, c, lane);
          if (lane == 0) chk_report(F, 12, ((const float*)(F.ws + WS_PRE))[(size_t)R * 1024 + c], ALPHA * ((const float*)(F.ws + WS_HF))[(size_t)R * 1024 + c] + pr, 0.5f); }
    }
}
__device__ __forceinline__ void chk_moe(Frame& F, const Args& A, int l) {
    const LAS int* tb = (const LAS int*)(F.lds + LDSCTL_OFF);
    const int gw = F.vcu * NWAVES + F.wave, NGW = F.G * NWAVES, lane = F.lane;
    const float* HF = (const float*)(F.ws + WS_HF); const bf16* HB = (const bf16*)(F.ws + WS_HB); const unsigned* TOKE = (const unsigned*)(F.ws + WS_TOKE); const float* TOKW = (const float*)(F.ws + WS_TOKW);
    LAS float* scr = (LAS float*)(F.lds + RING_OFF + F.wave * 16384);
    for (int job = gw; job < 16 * 4; job += NGW) { const int R = smp_row(job >> 2), k = job & 3;
        float lg_ = -INFINITY; if (lane < 32) { float s = 0.f; for (int q = 0; q < 1024; ++q) s += HF[(size_t)R * 1024 + q] * A.in[I_RW][(size_t)l * 32768 + q * 32 + lane]; lg_ = s + A.in[I_RB][l * 32 + lane]; }
        float val = lg_, tv[4]; int te[4];
#pragma unroll
        for (int kk = 0; kk < 4; ++kk) { const float m = wave_max(val); const int idx = wave_min_i(val == m ? lane : 99); tv[kk] = m; te[kk] = idx; if (lane == idx) val = -INFINITY; }
        const float den = 1.0f + expf(tv[1] - tv[0]) + expf(tv[2] - tv[0]) + expf(tv[3] - tv[0]);
        const unsigned tk = TOKE[(size_t)R * 4 + k]; const int e = tk & 255, pos = tk >> 8; const float w = TOKW[(size_t)R * 4 + k];
        const int ek = k == 0 ? te[0] : k == 1 ? te[1] : k == 2 ? te[2] : te[3]; const float wk = expf((k == 0 ? tv[0] : k == 1 ? tv[1] : k == 2 ? tv[2] : tv[3]) - tv[0]) / den;
        const float gap = tv[3] - wave_max(val);
        if (lane == 0 && gap > 1e-3f) { chk_report(F, 13, (float)e, (float)ek, 0.0f); chk_report(F, 13, w, wk, 0.01f); }
        if (((const int*)(F.ws + WS_ROWIDX))[(size_t)e * CAP + pos] != R && lane == 0) chk_report(F, 14, 1.0f, 0.0f, 0.0f);
        const float* wgu = A.in[I_WGU] + ((size_t)l * 32 + e) * 1024 * 2048; const float* bgu = A.in[I_BGU] + ((size_t)l * 32 + e) * 2048;
        for (int j = lane; j < 1024; j += 64) { float g = 0.f, u = 0.f; for (int q = 0; q < 1024; ++q) { const float x = ldbf(HB + (size_t)R * 1024 + q); g += x * bfr(wgu[(size_t)q * 2048 + j]); u += x * bfr(wgu[(size_t)q * 2048 + 1024 + j]); }
            g = fminf(g + bgu[j], 7.0f); u = fminf(fmaxf(u + bgu[1024 + j], -7.0f), 7.0f); scr[j] = bfr((u + 1.0f) * g * sigm_(1.702f * g)); }
        LDS_WAIT(); asm volatile("" ::: "memory");
        const float* wd = A.in[I_WDN] + ((size_t)l * 32 + e) * 1024 * 1024; const int c = (lane * 13 + k * 251) & 1023; float o = 0.f;
        for (int q = 0; q < 1024; ++q) o += scr[q] * bfr(wd[(size_t)q * 1024 + c]);
        o += A.in[I_BDN][((size_t)l * 32 + e) * 1024 + c];
        chk_report(F, 15, ldbf((const bf16*)(F.ws + WS_OUTS) + ((size_t)tb[e] * 256 + pos) * 1024 + c), o, 0.1f);
        LDS_WAIT(); asm volatile("" ::: "memory");
    }
}
#endif

#ifndef PHASE_MASK
#define PHASE_MASK 0x1fff
#endif
#define PH_ON(k) (((PHASE_MASK) >> (k)) & 1)
typedef const __attribute__((address_space(4))) Args* KArgs;
#define PHASE_ENV() KArgs kap_ = (KArgs)__builtin_amdgcn_kernarg_segment_ptr(); asm volatile("" : "+s"(kap_)); const Args& args = *(const Args*)kap_; unsigned char* ws = args.ws; F.ws = ws; F.ctl = (gu32*)(ws + WS_CTL); \
    { int t_ = threadIdx.x; asm volatile("" : "+v"(t_)); F.tid = t_; F.lane = t_ & 63; F.wave = __builtin_amdgcn_readfirstlane(t_ >> 6); } \
    int bid = (int)blockIdx.x; asm volatile("" : "+s"(bid)); F.G = gridDim.x; F.vcu = (F.G % 8 == 0) ? (bid % 8) * (F.G / 8) + bid / 8 : bid; \
    const int gw = F.vcu * NWAVES + F.wave, NGW = F.G * NWAVES; (void)gw; (void)NGW; \
    unsigned char* wl = ws + WS_W + (size_t)l * WL_STRIDE; bf16* HB = (bf16*)(ws + WS_HB); float* HF = (float*)(ws + WS_HF); (void)wl; (void)HB; (void)HF
__global__ void __launch_bounds__(NWAVES * 64, 2) mk_fwd(Args args_) {
    extern __shared__ __attribute__((aligned(16))) unsigned char lds[];
    Frame F;
    F.lds = (LAS unsigned char*)lds;
    F.MISC = (volatile LAS unsigned*)(F.lds + MISC_OFF);
    F.tid = threadIdx.x; F.lane = F.tid & 63; F.wave = __builtin_amdgcn_readfirstlane(F.tid >> 6);
    F.G = gridDim.x; { const int bx = blockIdx.x; F.vcu = (F.G % 8 == 0) ? (bx % 8) * (F.G / 8) + bx / 8 : bx; }
    F.ws = args_.ws; F.ctl = (gu32*)(args_.ws + WS_CTL);
    for (int u = F.tid; u < (LDS_BYTES - LDSCTL_OFF) / 4; u += NWAVES * 64) ((LAS unsigned*)(F.lds + LDSCTL_OFF))[u] = 0u;
    __syncthreads();
    XcdBarrier bar; bar.bar = (unsigned*)(F.ctl + CW_BAR); bar.x = 0; bar.st = nullptr;
    if (N_LAUNCHES == 1) bar = xcd_barrier_post((unsigned*)(F.ctl + CW_BAR), F.MISC + 8);
#define GRID_BAR() do { if (N_LAUNCHES != 1) { if (F.tid == 0) __hip_atomic_store(F.ctl + CW_TMO, 0xBADBA0u, RLX_AGENT); } else { xcd_barrier(bar); } } while (0)
    const int lo = args_.ph_lo, hi = args_.ph_hi;
#define IN(k) (lo <= (k) && (k) < hi)
#define BOTH(k) (IN(k) && IN((k) + 1))

    if (PH_ON(0) && IN(0)) { const int l = 0; PHASE_ENV(); p0_prologue(F, args); if (BOTH(0)) GRID_BAR(); }

    for (int l = 0; l < NLAYER; ++l) {
        const int pb = 1 + 12 * l;
        if (PH_ON(1) && IN(pb + 0)) { PHASE_ENV();
            pg8::Gemm g{HB, (const bf16*)(wl + WL_IN), 1024, 1024, 1024}; pg8::StaticOrder S; S.init(MREAL, NP1, F.G, bid);
            pg8::EpiP1 E{(bf16*)(ws + WS_UC), (bf16*)(ws + WS_UMETA), (bf16*)(ws + WS_CONV), (bf16*)(ws + WS_Q), (bf16*)(ws + WS_K), (bf16*)(ws + WS_V), (bf16*)(ws + WS_GB), (const float*)(ws + WS_ROPE), args.in[I_GATEB] + (size_t)l * 3072};
            pg8::gemm_phase<pg8::EpiP1, pg8::StaticOrder, PG8_ALIGN, PG8_SP2>(F.lds + RING_OFF, g, S, E);
            SKINNY_JOBS(256, skinny_p1(F, args, l, cb));
            if (BOTH(pb + 0)) GRID_BAR();
        }
        if (PH_ON(2) && IN(pb + 1)) { PHASE_ENV();
            pg8::Gemm g{(const bf16*)(ws + WS_UC), (const bf16*)(wl + WL_ST), 1152, 1024, 1024}; pg8::FirstN S{32, 1, F.G, bid};
            pg8::EpiSloc E{(float*)(ws + WS_SLOC)};
            pg8::gemm_phase<pg8::EpiSloc, pg8::FirstN, PG8_ALIGN, PG8_SP2>(F.lds + RING_OFF, g, S, E);
            for (int job = NGW - 1 - gw; job < 64; job += NGW) ssm_meta_job(F, args, l, job >> 5, job & 31);
            if (BOTH(pb + 1)) GRID_BAR();
        }
        if (PH_ON(3) && IN(pb + 2)) { PHASE_ENV(); ssm_carry(F, l); if (BOTH(pb + 2)) GRID_BAR(); }
        if (PH_ON(4) && IN(pb + 3)) { PHASE_ENV();
            { pg8::Gemm g{(const bf16*)(ws + WS_UC), (const bf16*)(wl + WL_TOE), 1152, 1152, 1152}; pg8::FirstN S{128, 4, F.G, bid};
              pg8::EpiY E{(bf16*)(ws + WS_YG)};
              pg8::gemm_phase<pg8::EpiY, pg8::FirstN, PG8_ALIGN, PG8_SP2>(F.lds + RING_OFF, g, S, E); }
            { const attn_body::AttnTensors AT{(const attn_body::bf16*)(ws + WS_Q), (const attn_body::bf16*)(ws + WS_K), (const attn_body::bf16*)(ws + WS_V), (attn_body::bf16*)(ws + WS_OC)};
              const attn_body::StaticOrder S((int)F.G, bid);
              attn_body::attn_phase<attn_body::StaticOrder>((char*)lds + RING_OFF, AT, S); }
            conv_rows(F, args, l);
            for (int job = gw; job < 256; job += NGW) attn_meta_job(F, job >> 3, job & 7);
            if (BOTH(pb + 3)) GRID_BAR();
        }
        if (PH_ON(5) && IN(pb + 4)) { PHASE_ENV();
            pg8::Gemm g{(const bf16*)(ws + WS_YG), (const bf16*)(wl + WL_GLU), 512, 512, 512}; pg8::StaticOrder S; S.init(MREAL, 512, F.G, bid);
            pg8::EpiGLU E{(const bf16*)(ws + WS_YG), (bf16*)(ws + WS_YS)};
            pg8::gemm_phase<pg8::EpiGLU, pg8::StaticOrder, PG8_ALIGN, PG8_SP2>(F.lds + RING_OFF, g, S, E);
            SKINNY_JOBS(16, skinny_glu(F, l, cb));
            attn_combine_rows(F, args, l);
            if (BOTH(pb + 4)) GRID_BAR();
        }
        if (PH_ON(6) && IN(pb + 5)) { PHASE_ENV();
            pg8::StaticOrder S; S.init(MREAL, 1024, F.G, bid);
            SKINNY_JOBS(32, skinny_merge(F, l, cb));
            { pg8::Gemm g{(const bf16*)(ws + WS_YS), (const bf16*)(wl + WL_SO), 512, 512, 512}; pg8::EpiMerge<0> E{(const bf16*)(ws + WS_GB), (bf16*)(ws + WS_MG)};
              pg8::gemm_phase<pg8::EpiMerge<0>, pg8::StaticOrder, PG8_ALIGN, PG8_SP2>(F.lds + RING_OFF, g, S, E); }
            { pg8::Gemm g{(const bf16*)(ws + WS_YC), (const bf16*)(wl + WL_CO), 512, 512, 512}; pg8::EpiMerge<1> E{(const bf16*)(ws + WS_GB), (bf16*)(ws + WS_MG)};
              pg8::gemm_phase<pg8::EpiMerge<1>, pg8::StaticOrder, PG8_ALIGN, PG8_SP2>(F.lds + RING_OFF, g, S, E); }
            { pg8::Gemm g{(const bf16*)(ws + WS_YA), (const bf16*)(wl + WL_AO), 1024, 1024, 1024}; pg8::EpiMerge<2> E{(const bf16*)(ws + WS_GB), (bf16*)(ws + WS_MG)};
              pg8::gemm_phase<pg8::EpiMerge<2>, pg8::StaticOrder, PG8_ALIGN, PG8_SP2>(F.lds + RING_OFF, g, S, E); }
            if (BOTH(pb + 5)) GRID_BAR();
        }
        if (PH_ON(7) && IN(pb + 6)) { PHASE_ENV();
            pg8::Gemm g{(const bf16*)(ws + WS_MG), (const bf16*)(wl + WL_WO), 1024, 1024, 1024}; pg8::StaticOrder S; S.init(MREAL, 1024, F.G, bid);
            pg8::EpiPre E{HF, (float*)(ws + WS_PRE), ALPHA};
            pg8::gemm_phase<pg8::EpiPre, pg8::StaticOrder, PG8_ALIGN, PG8_SP2>(F.lds + RING_OFF, g, S, E);
            SKINNY_JOBS(32, skinny_pre(F, l, cb));
            if (BOTH(pb + 6)) GRID_BAR();
        }
        if (PH_ON(8) && IN(pb + 7)) { PHASE_ENV();
            ln1_router(F, args, l); if (BOTH(pb + 7)) GRID_BAR(); }
        if (PH_ON(9) && IN(pb + 8)) { PHASE_ENV(); moe_tables(F, l, true); moe_gather(F); if (BOTH(pb + 8)) GRID_BAR(); }
        if (PH_ON(10) && IN(pb + 9)) { PHASE_ENV();
            moe_tables(F, l);
            pg8::Gemm g{(const bf16*)(ws + WS_XG), (const bf16*)(wl + WL_GU), 1024, 1024, 1024}; pg8::MoeOrder S{(const LAS int*)(F.lds + LDSCTL_OFF), 8, F.G, bid};
            pg8::EpiSwiGLU E{(bf16*)(ws + WS_HID), args.in[I_BGU] + (size_t)l * 32 * 2048};
            pg8::gemm_phase<pg8::EpiSwiGLU, pg8::MoeOrder, PG8_ALIGN, PG8_SP2>(F.lds + RING_OFF, g, S, E);
            if (BOTH(pb + 9)) GRID_BAR();
        }
        if (PH_ON(11) && IN(pb + 10)) { PHASE_ENV();
            moe_tables(F, l);
            pg8::Gemm g{(const bf16*)(ws + WS_HID), (const bf16*)(wl + WL_DN), 1024, 1024, 1024}; pg8::MoeOrder S{(const LAS int*)(F.lds + LDSCTL_OFF), 4, F.G, bid};
            pg8::EpiDown E{(bf16*)(ws + WS_OUTS), args.in[I_BDN] + (size_t)l * 32 * 1024};
            pg8::gemm_phase<pg8::EpiDown, pg8::MoeOrder, PG8_ALIGN, PG8_SP2>(F.lds + RING_OFF, g, S, E);
            if (BOTH(pb + 10)) GRID_BAR();
        }
        if (PH_ON(12) && IN(pb + 11)) { PHASE_ENV(); moe_tables(F, l);
            ln2_rows(F, args, l); if (BOTH(pb + 11)) GRID_BAR(); }
    }
#undef IN
#undef BOTH
}


#if defined(SELFCHK)
__global__ void __launch_bounds__(NWAVES * 64, 2) mk_chk(Args args_) {
    extern __shared__ __attribute__((aligned(16))) unsigned char lds[];
    Frame F;
    F.lds = (LAS unsigned char*)lds; F.MISC = (volatile LAS unsigned*)(F.lds + MISC_OFF);
    F.tid = threadIdx.x; F.lane = F.tid & 63; F.wave = __builtin_amdgcn_readfirstlane(F.tid >> 6);
    F.G = gridDim.x; { const int bx = blockIdx.x; F.vcu = (F.G % 8 == 0) ? (bx % 8) * (F.G / 8) + bx / 8 : bx; }
    F.ws = args_.ws; F.ctl = (gu32*)(args_.ws + WS_CTL);
    KArgs kap_ = (KArgs)__builtin_amdgcn_kernarg_segment_ptr(); const Args& args = *(const Args*)kap_; const int l = args_.li; F.chk_l = l;
    if (args_.pad == 1) { chk_p1(F, args, l); chk_ssm_conv(F, args, l); chk_attn(F); chk_mix(F, args, l); }
    if (args_.pad == 2) { moe_tables(F, l); chk_moe(F, args, l); }
}
#endif
extern "C" void kernel_launch(void* const* d_in, const int* in_sizes, int n_in, void* d_out, int out_size, void* d_ws, size_t ws_size, hipStream_t stream) {
    static int grid = 0;
    if (grid == 0) {
        if (n_in != N_IN || in_sizes[0] != MREAL * 1024 || out_size != MREAL * 1024 || ws_size < WS_END) { fprintf(stderr, "kernel_launch: unexpected shapes (n_in %d, in0 %d, out %d, ws %zu < %zu); nothing launched\n", n_in, n_in > 0 ? in_sizes[0] : -1, out_size, ws_size, (size_t)WS_END); grid = -1; return; }
        int dev = 0, cus = 0, per_cu = 0;
        if (hipGetDevice(&dev) != hipSuccess || hipDeviceGetAttribute(&cus, hipDeviceAttributeMultiprocessorCount, dev) != hipSuccess) { grid = -1; return; }
#if defined(SELFCHK)
        (void)hipFuncSetAttribute((const void*)mk_chk, hipFuncAttributeMaxDynamicSharedMemorySize, LDS_BYTES);
#endif
        if (hipFuncSetAttribute((const void*)mk_fwd, hipFuncAttributeMaxDynamicSharedMemorySize, LDS_BYTES) != hipSuccess) { fprintf(stderr, "kernel_launch: hipFuncSetAttribute failed\n"); grid = -1; return; }
        if (hipOccupancyMaxActiveBlocksPerMultiprocessor(&per_cu, (const void*)mk_fwd, NWAVES * 64, LDS_BYTES) != hipSuccess || per_cu < 1)
            fprintf(stderr, "kernel_launch: note: occupancy query reports %d workgroups per CU\n", per_cu);
        (void)hipGetLastError();
        grid = cus;
        if (grid != 256) fprintf(stderr, "kernel_launch: %d CUs; the unit orders assume 256\n", grid);
    }
    if (grid < 0) return;
    if (hipMemsetAsync((char*)d_ws + WS_CTL, 0, CTL_ZERO_BYTES, stream) != hipSuccess) return;
    Args a{};
    for (int i = 0; i < N_IN; ++i) a.in[i] = (const float*)d_in[i];
    a.out = (float*)d_out; a.ws = (unsigned char*)d_ws;
    for (int li = 0; li < N_LAUNCHES; ++li) {
        a.ph_lo = (N_LAUNCHES == 1) ? 0 : li; a.ph_hi = (N_LAUNCHES == 1) ? NPH : li + 1; a.li = li; a.pad = 0;
        hipLaunchKernelGGL(mk_fwd, dim3(grid), dim3(NWAVES * 64), LDS_BYTES, stream, a);
        if (hipPeekAtLastError() != hipSuccess) { fprintf(stderr, "kernel_launch: launch %d failed\n", li); break; }
#if defined(SELFCHK)
        if (N_LAUNCHES == NPH && (li == 7 || li == 11 || li == 19 || li == 23)) { Args c = a; c.ph_lo = 1000; c.ph_hi = 1000; c.pad = (li == 7 || li == 19) ? 1 : 2; c.li = li > 12 ? 1 : 0; hipLaunchKernelGGL(mk_chk, dim3(grid), dim3(NWAVES * 64), LDS_BYTES, stream, c); }
#endif
    }
}
```

```cpp
#include <hip/hip_runtime.h>
#include <cstdio>
#include <cstdint>
namespace pg8 {
#define PG8_LAS __attribute__((address_space(3)))
typedef unsigned short bf16_t;
typedef short bf16x8 __attribute__((ext_vector_type(8)));
typedef float f32x4 __attribute__((ext_vector_type(4)));
typedef unsigned u32x4 __attribute__((ext_vector_type(4)));
constexpr int BM = 256, BK = 64, HALF = 128, HTB = HALF * BK * 2  , STAGE_BYTES = 8 * HTB, NXCD = 8, WGM = 8;

__host__ __device__ __forceinline__ int lds_byte(int r, int c) { const int st = (r >> 4) * 2 + (c >> 5), rr = r & 15, cc = c & 31, ob = rr * 64 + cc * 2; return st * 1024 + (ob ^ (((ob >> 9) & 1) << 5)); }
__host__ __device__ __forceinline__ void stage_rc(int b, int& R, int& C) { const int st = b / 1024, sb = b % 1024, swz = sb ^ (((sb >> 9) & 1) << 5); R = (st >> 1) * 16 + swz / 64; C = (st & 1) * 32 + (swz % 64) / 2; }
__host__ __device__ __forceinline__ int perm32(int rho) { const int n = rho >> 4, i = rho & 15; return 8 * (i >> 2) + 4 * n + (i & 3); }

struct Unit { int pm, pn; };
struct Gemm { const bf16_t* A; const bf16_t* Bt; int lda, ldb, K; };

struct StaticOrder {
    int nM, nN, nwg, G, c;
    __host__ __device__ void init(int M, int N, int G_, int c_) { nM = M / BM; nN = N / BM; nwg = nM * nN; G = G_; c = c_; }
    __host__ __device__ bool next(int i, Unit& u) const {
        const long L = (long)i * G + c; if (L >= nwg) return false;
        int wgid = (int)L; { const int q = nwg / NXCD, r = nwg % NXCD, xcd = wgid % NXCD, off = wgid / NXCD; wgid = (xcd < r ? xcd * (q + 1) : r * (q + 1) + (xcd - r) * q) + off; }
        const int nig = WGM * nN, gid = wgid / nig, fm = gid * WGM, gsz = (nM - fm) < WGM ? (nM - fm) : WGM;
        u.pm = fm + ((wgid % nig) % gsz); u.pn = (wgid % nig) / gsz; return true;
    }
    __device__ __forceinline__ void a_ready(const Unit&) const {}
    __device__ __forceinline__ void done(const Unit&) const {}
};

typedef float cvt_f2_ __attribute__((ext_vector_type(2))); typedef __bf16 cvt_b2_ __attribute__((ext_vector_type(2)));
__device__ __forceinline__ unsigned cvt_pk_bf16(float lo, float hi) { const cvt_f2_ v = {lo, hi}; const cvt_b2_ b = __builtin_convertvector(v, cvt_b2_); return __builtin_bit_cast(unsigned, b); }
typedef float f32x2 __attribute__((ext_vector_type(2)));
typedef unsigned u32x2 __attribute__((ext_vector_type(2)));
__device__ __forceinline__ u32x4 pack8(f32x4 a, f32x4 b) { u32x4 w; w.x = cvt_pk_bf16(a[0], a[1]); w.y = cvt_pk_bf16(a[2], a[3]); w.z = cvt_pk_bf16(b[0], b[1]); w.w = cvt_pk_bf16(b[2], b[3]); return w; }
__device__ __forceinline__ u32x2 pack4(f32x4 a) { u32x2 w; w.x = cvt_pk_bf16(a[0], a[1]); w.y = cvt_pk_bf16(a[2], a[3]); return w; }
__device__ __forceinline__ float bf_lo(unsigned w) { return __uint_as_float(w << 16); }
__device__ __forceinline__ float bf_hi(unsigned w) { return __uint_as_float(w & 0xffff0000u); }
__device__ __forceinline__ void unpack8(u32x4 w, f32x4& a, f32x4& b) { a = (f32x4){bf_lo(w.x), bf_hi(w.x), bf_lo(w.y), bf_hi(w.y)}; b = (f32x4){bf_lo(w.z), bf_hi(w.z), bf_lo(w.w), bf_hi(w.w)}; }
__device__ __forceinline__ float sigm(float x) { return __builtin_amdgcn_rcpf(1.0f + __builtin_amdgcn_exp2f(-1.4426950408889634f * x)); }
__device__ __forceinline__ f32x4 sigm4(f32x4 v) { return (f32x4){sigm(v[0]), sigm(v[1]), sigm(v[2]), sigm(v[3])}; }
__device__ __forceinline__ float gelu_t(float x) { const float u = 0.7978845608028654f * (x + 0.044715f * x * x * x); return x * sigm(2.0f * u); }
__device__ __forceinline__ f32x4 gelu4(f32x4 v) { return (f32x4){gelu_t(v[0]), gelu_t(v[1]), gelu_t(v[2]), gelu_t(v[3])}; }

constexpr int MREAL = 16384, MVALID = 16416;
constexpr float QSCALE = 0.125f * 1.4426950408889634f;
__device__ __forceinline__ int kv_row(int R) { return R < MREAL ? (R >> 13) * 8320 + (R & 8191) : ((R - MREAL) >> 4) * 8320 + 8256 + ((R - MREAL) & 15); }

#define EPI_ROWS(R) _Pragma("unroll") for (int ai = 0; ai < 2; ++ai) _Pragma("unroll") for (int m = 0; m < 4; ++m) { const int R = rbase + ai * HALF + m * 16;
#define EPI_COLS _Pragma("unroll") for (int bj = 0; bj < 2; ++bj) {
#define EPI_END }

struct EpiP1 {
    static constexpr bool PERM = true, AFTER_DRAIN = false;
    bf16_t *UC, *UMETA, *CONVB, *Q, *K, *V, *GB; const float* rope; const float* gate_b;
    __device__ __forceinline__ void operator()(const f32x4 (&acc)[2][2][4][2], const Unit& u, int wr, int wc, int fr, int fq) const {
        const int pn = u.pn, rbase = u.pm * BM + wr * 64 + fr, cw = wc * 32 + 8 * fq;
        if (pn < 2) {
            EPI_ROWS(R)
                if (R < MREAL) { const int chunkrow = (R >> 13) * 128 + ((R & 8191) >> 6), s = R & 63;
                    EPI_COLS const int c = pn * 256 + bj * HALF + cw; *(u32x4*)(UC + ((size_t)((c >> 4) * 256 + chunkrow) * 1152 + s * 16 + (c & 15))) = pack8(acc[ai][bj][m][0], acc[ai][bj][m][1]); EPI_END }
                else if (R < MVALID) {
                    EPI_COLS const int c = pn * 256 + bj * HALF + cw; *(u32x4*)(UMETA + (size_t)(R - MREAL) * 512 + c) = pack8(acc[ai][bj][m][0], acc[ai][bj][m][1]); EPI_END }
            EPI_END
        } else if (pn < 8) {
            EPI_ROWS(R)
                if (R < MVALID) { EPI_COLS const int c = (pn - 2) * 256 + bj * HALF + cw; *(u32x4*)(CONVB + (size_t)R * 1536 + c) = pack8(acc[ai][bj][m][0], acc[ai][bj][m][1]); EPI_END }
            EPI_END
        } else if (pn < 16) {
            const bool isq = pn < 12; const int ct = (pn - (isq ? 8 : 12)) * 256; bf16_t* dstb = isq ? Q : K; const float sc = isq ? QSCALE : 1.0f;
            EPI_ROWS(R)
                if (R < MVALID) { const int pos = R < MREAL ? 16 + (R & 8191) : ((R - MREAL) & 15); const size_t drow = isq ? (size_t)R : (size_t)kv_row(R);
                    EPI_COLS const int c = ct + bj * HALF + cw, hh = c >> 6, gq = (c & 63) >> 3;
                        const f32x4 cs = *(const f32x4*)(rope + (size_t)pos * 64 + 4 * gq), sn = *(const f32x4*)(rope + (size_t)pos * 64 + 32 + 4 * gq);
                        const f32x4 x0 = acc[ai][bj][m][0], x1 = acc[ai][bj][m][1];
                        const f32x4 lo = (x0 * cs - x1 * sn) * sc, hi = (x1 * cs + x0 * sn) * sc;
                        bf16_t* d = dstb + drow * 1024 + hh * 64 + 4 * gq; *(u32x2*)d = pack4(lo); *(u32x2*)(d + 32) = pack4(hi); EPI_END }
            EPI_END
        } else if (pn < 20) {
            EPI_ROWS(R)
                if (R < MVALID) { const size_t drow = (size_t)kv_row(R);
                    EPI_COLS const int c = (pn - 16) * 256 + bj * HALF + cw; *(u32x4*)(V + drow * 1024 + c) = pack8(acc[ai][bj][m][0], acc[ai][bj][m][1]); EPI_END }
            EPI_END
        } else {
            f32x4 b0[2], b1[2];
#pragma unroll
            for (int bj = 0; bj < 2; ++bj) { const int c = (pn - 20) * 256 + bj * HALF + cw; b0[bj] = *(const f32x4*)(gate_b + c); b1[bj] = *(const f32x4*)(gate_b + c + 4); }
            EPI_ROWS(R)
                if (R < MVALID) { EPI_COLS const int c = (pn - 20) * 256 + bj * HALF + cw;
                    *(u32x4*)(GB + (size_t)R * 3072 + c) = pack8(sigm4(acc[ai][bj][m][0] + b0[bj]), sigm4(acc[ai][bj][m][1] + b1[bj])); EPI_END }
            EPI_END
        }
    }
};
struct EpiSloc {
    static constexpr bool PERM = false, AFTER_DRAIN = false;
    float* SL;
    __device__ __forceinline__ void operator()(const f32x4 (&acc)[2][2][4][2], const Unit& u, int wr, int wc, int fr, int fq) const {
        const int rbase = u.pm * BM + wr * 64 + fr, col0 = wc * 32 + 4 * fq;
        EPI_ROWS(R)
            float* rowp = SL + (size_t)R * 128 + col0;
#pragma unroll
            for (int n = 0; n < 2; ++n) *(f32x4*)(rowp + n * 16) = acc[ai][0][m][n];
        EPI_END
    }
};
struct EpiY {
    static constexpr bool PERM = true, AFTER_DRAIN = false;
    bf16_t* YG;
    __device__ __forceinline__ void operator()(const f32x4 (&acc)[2][2][4][2], const Unit& u, int wr, int wc, int fr, int fq) const {
        const int g = u.pm, nt = u.pn & 3, rbase = wr * 64 + fr, cw = wc * 32 + 8 * fq;
        EPI_ROWS(R)
            const int b = R >> 7, k = R & 127;
            EPI_COLS const int n = nt * 256 + bj * HALF + cw, t = n >> 4, co0 = n & 15; const size_t row = (size_t)b * 8192 + k * 64 + t;
                *(u32x4*)(YG + row * 512 + g * 16 + co0) = pack8(gelu4(acc[ai][bj][m][0]), gelu4(acc[ai][bj][m][1])); EPI_END
        EPI_END
    }
};
struct EpiGLU {
    static constexpr bool PERM = true, AFTER_DRAIN = false;
    const bf16_t* YG; bf16_t* YS;
    __device__ __forceinline__ void operator()(const f32x4 (&acc)[2][2][4][2], const Unit& u, int wr, int wc, int fr, int fq) const {
        const int rbase = u.pm * BM + wr * 64 + fr, cw = wc * 32 + 8 * fq;
        EPI_ROWS(R)
            EPI_COLS const int c = u.pn * 256 + bj * HALF + cw; f32x4 ya, yb; unpack8(*(const u32x4*)(YG + (size_t)R * 512 + c), ya, yb);
                *(u32x4*)(YS + (size_t)R * 512 + c) = pack8(ya * sigm4(acc[ai][bj][m][0]), yb * sigm4(acc[ai][bj][m][1])); EPI_END
        EPI_END
    }
};
template <int I> struct EpiMerge {
    static constexpr bool PERM = true, AFTER_DRAIN = false;
    const bf16_t* GB; bf16_t* MG;
    __device__ __forceinline__ void operator()(const f32x4 (&acc)[2][2][4][2], const Unit& u, int wr, int wc, int fr, int fq) const {
        const int rbase = u.pm * BM + wr * 64 + fr, cw = wc * 32 + 8 * fq;
        EPI_ROWS(R)
            EPI_COLS const int c = u.pn * 256 + bj * HALF + cw; f32x4 ga, gb; unpack8(*(const u32x4*)(GB + (size_t)R * 3072 + I * 1024 + c), ga, gb);
                f32x4 oa = ga * acc[ai][bj][m][0], ob = gb * acc[ai][bj][m][1];
                if (I > 0) { f32x4 pa, pb; unpack8(*(const u32x4*)(MG + (size_t)R * 1024 + c), pa, pb); oa += pa; ob += pb; }
                *(u32x4*)(MG + (size_t)R * 1024 + c) = pack8(oa, ob); EPI_END
        EPI_END
    }
};
struct EpiPre {
    static constexpr bool PERM = false, AFTER_DRAIN = false;
    const bf16_t* HBr; float* PRE; float alpha;
    __device__ __forceinline__ void operator()(const f32x4 (&acc)[2][2][4][2], const Unit& u, int wr, int wc, int fr, int fq) const {
        const int rbase = u.pm * BM + wr * 64 + fr, col0 = u.pn * BM + wc * 32 + 4 * fq;
        EPI_ROWS(R)
            EPI_COLS
#pragma unroll
                for (int n = 0; n < 2; ++n) { const size_t off = (size_t)R * 1024 + col0 + bj * HALF + n * 16; const u32x2 hw = *(const u32x2*)(HBr + off);
                    const f32x4 hv = (f32x4){bf_lo(hw.x), bf_hi(hw.x), bf_lo(hw.y), bf_hi(hw.y)}; *(f32x4*)(PRE + off) = hv * alpha + acc[ai][bj][m][n]; }
            EPI_END
        EPI_END
    }
};
struct EpiSwiGLU {
    static constexpr bool PERM = true, AFTER_DRAIN = false;
    bf16_t* HID; const float* bgu;
    __device__ __forceinline__ void operator()(const f32x4 (&acc)[2][2][4][2], const Unit& u, int wr, int wc, int fr, int fq) const {
        const int e = u.pn >> 3, nt = u.pn & 7, rbase = u.pm * BM + wr * 64 + fr, hw = wc * 16 + 4 * fq;
        f32x4 bg[2], bu[2];
#pragma unroll
        for (int bj = 0; bj < 2; ++bj) { const int hcol = nt * 128 + bj * 64 + hw; bg[bj] = *(const f32x4*)(bgu + (size_t)e * 2048 + hcol); bu[bj] = *(const f32x4*)(bgu + (size_t)e * 2048 + 1024 + hcol); }
        EPI_ROWS(R)
            EPI_COLS const int hcol = nt * 128 + bj * 64 + hw; const f32x4 gt = acc[ai][bj][m][0] + bg[bj], up = acc[ai][bj][m][1] + bu[bj]; f32x4 h;
#pragma unroll
                for (int i = 0; i < 4; ++i) { const float gg = fminf(gt[i], 7.0f), uu = fminf(fmaxf(up[i], -7.0f), 7.0f); h[i] = (uu + 1.0f) * gg * sigm(1.702f * gg); }
                *(u32x2*)(HID + (size_t)R * 1024 + hcol) = pack4(h); EPI_END
        EPI_END
    }
};
struct EpiDown {
    static constexpr bool PERM = true, AFTER_DRAIN = false;
    bf16_t* OUTS; const float* bdn;
    __device__ __forceinline__ void operator()(const f32x4 (&acc)[2][2][4][2], const Unit& u, int wr, int wc, int fr, int fq) const {
        const int e = u.pn >> 2, nt = u.pn & 3, rbase = u.pm * BM + wr * 64 + fr, cw = wc * 32 + 8 * fq;
        f32x4 b0[2], b1[2];
#pragma unroll
        for (int bj = 0; bj < 2; ++bj) { const int c = nt * 256 + bj * HALF + cw; b0[bj] = *(const f32x4*)(bdn + (size_t)e * 1024 + c); b1[bj] = *(const f32x4*)(bdn + (size_t)e * 1024 + c + 4); }
        EPI_ROWS(R)
            EPI_COLS const int c = nt * 256 + bj * HALF + cw; *(u32x4*)(OUTS + (size_t)R * 1024 + c) = pack8(acc[ai][bj][m][0] + b0[bj], acc[ai][bj][m][1] + b1[bj]); EPI_END
        EPI_END
    }
};
struct FirstN {
    int n, div, G, c;
    __device__ __forceinline__ bool next(int i, Unit& u) const { const int L = i * G + c; if (L >= n) return false; u.pm = L / div; u.pn = L; return true; }
    __device__ __forceinline__ void a_ready(const Unit&) const {}
    __device__ __forceinline__ void done(const Unit&) const {}
};
struct MoeOrder {
    const PG8_LAS int* tb; int nN, G, c;
    __device__ __forceinline__ bool next(int i, Unit& u) const {
        const int L = i * G + c, mtg = L / nN; if (mtg >= tb[32]) return false;
        int e = 0; while (tb[e + 1] <= mtg) ++e;
        u.pm = mtg; u.pn = e * nN + (L - mtg * nN); return true; }
    __device__ __forceinline__ void a_ready(const Unit&) const {}
    __device__ __forceinline__ void done(const Unit&) const {}
};
template <class Epi, class Sched, bool ALIGN_EPI = false, bool SP2 = false>
__device__ __forceinline__ void gemm_phase(PG8_LAS unsigned char* lds, const Gemm g, const Sched& S, const Epi& E) {
    int tid_ = threadIdx.x; asm volatile("" : "+v"(tid_));
    const int tid = tid_, wid = __builtin_amdgcn_readfirstlane(tid >> 6), lane = tid & 63, wr = wid >> 2, wc = wid & 3, fr = lane & 15, fq = lane >> 4;
    const int K = g.K, nt = K / BK;
    unsigned voffA[2], voffB[2];
#pragma unroll
    for (int i = 0; i < 2; ++i) { int R, C; stage_rc(tid * 16 + i * 8192, R, C); const int Rb = Epi::PERM ? ((R & ~31) + perm32(R & 31)) : R;
        voffA[i] = (unsigned)(R * g.lda + C) * 2u; voffB[i] = (unsigned)(Rb * g.ldb + C) * 2u; }
    const size_t kstep = (size_t)(BK * 2);
    const size_t hstepA = (size_t)HALF * g.lda * 2, hstepB = (size_t)HALF * g.ldb * 2;
    const size_t tstepA = 2 * hstepA, tstepB = 2 * hstepB;
    const unsigned ldsw = (unsigned)wid * 1024u;
    const int aoff = lds_byte(wr * 64 + fr, fq * 8), boff = lds_byte(wc * 32 + fr, fq * 8);
#define PG8_SA(b, h) (((b) * 2 + (h)) * HTB)
#define PG8_SB(b, h) ((4 + (b) * 2 + (h)) * HTB)
#define PG8_STAGE(bufoff, gbase, voff) do { _Pragma("unroll") for (int _i = 0; _i < 2; ++_i) \
        __builtin_amdgcn_global_load_lds((const unsigned*)((const char*)(gbase) + (voff)[_i]), (PG8_LAS unsigned*)(lds + (bufoff) + ldsw + _i * 8192), 16, 0, 0); } while (0)
#define PG8_LDA(dst, b, h) do { _Pragma("unroll") for (int m = 0; m < 4; ++m) _Pragma("unroll") for (int k = 0; k < 2; ++k) dst[m][k] = *(const PG8_LAS bf16x8*)(lds + PG8_SA(b, h) + aoff + m * 2048 + k * 1024); } while (0)
#define PG8_LDB(dst, b, h) do { _Pragma("unroll") for (int n = 0; n < 2; ++n) _Pragma("unroll") for (int k = 0; k < 2; ++k) dst[n][k] = *(const PG8_LAS bf16x8*)(lds + PG8_SB(b, h) + boff + n * 2048 + k * 1024); } while (0)
#define PG8_MMA(ai, bj, At, Bt) do { __builtin_amdgcn_s_setprio(1); _Pragma("unroll") for (int m = 0; m < 4; ++m) _Pragma("unroll") for (int n = 0; n < 2; ++n) _Pragma("unroll") for (int k = 0; k < 2; ++k) \
        acc[ai][bj][m][n] = __builtin_amdgcn_mfma_f32_16x16x32_bf16(Bt[n][k], At[m][k], acc[ai][bj][m][n], 0, 0, 0); __builtin_amdgcn_s_setprio(0); } while (0)
#define PG8_WAIT_V(n) asm volatile("s_waitcnt vmcnt(" #n ")" ::: "memory")
#define PG8_WAIT_L(n) asm volatile("s_waitcnt lgkmcnt(" #n ")" ::: "memory")
#define PG8_BAR __builtin_amdgcn_s_barrier()
#define PG8_SCHED __builtin_amdgcn_sched_barrier(0)
    Unit cur, nxt; int ui = 0;
    if (!S.next(0, cur)) return;
    f32x4 acc[2][2][4][2];
#pragma unroll
    for (int a = 0; a < 2; ++a)
#pragma unroll
        for (int b = 0; b < 2; ++b)
#pragma unroll
            for (int m = 0; m < 4; ++m)
#pragma unroll
                for (int n = 0; n < 2; ++n) acc[a][b][m][n] = (f32x4){0.f, 0.f, 0.f, 0.f};
    bf16x8 At[4][2], B0[2][2], B1[2][2];
    const char* cA = (const char*)g.A + (size_t)cur.pm * tstepA; const char* cB = (const char*)g.Bt + (size_t)cur.pn * tstepB;
    S.a_ready(cur);
    if constexpr (SP2) {
        PG8_STAGE(PG8_SB(0, 0), cB, voffB); PG8_STAGE(PG8_SB(0, 1), cB + hstepB, voffB); PG8_STAGE(PG8_SA(0, 0), cA, voffA); PG8_STAGE(PG8_SA(0, 1), cA + hstepA, voffA);
        if (wr == 1) PG8_BAR;
        PG8_WAIT_V(2); PG8_BAR;
        PG8_STAGE(PG8_SB(1, 0), cB + kstep, voffB); PG8_STAGE(PG8_SA(1, 0), cA + kstep, voffA); PG8_STAGE(PG8_SB(1, 1), cB + hstepB + kstep, voffB);
        PG8_WAIT_V(6); PG8_BAR;
    } else {
        PG8_STAGE(PG8_SB(0, 0), cB, voffB); PG8_STAGE(PG8_SA(0, 0), cA, voffA); PG8_STAGE(PG8_SB(0, 1), cB + hstepB, voffB); PG8_STAGE(PG8_SA(0, 1), cA + hstepA, voffA);
        if (wr == 1) PG8_BAR;
        PG8_WAIT_V(4); PG8_BAR;
        PG8_STAGE(PG8_SB(1, 0), cB + kstep, voffB); PG8_STAGE(PG8_SA(1, 0), cA + kstep, voffA); PG8_STAGE(PG8_SB(1, 1), cB + hstepB + kstep, voffB);
        PG8_WAIT_V(6); PG8_BAR;
    }
    for (;;) {
        const bool has_next = S.next(ui + 1, nxt);
        const char* nA = has_next ? (const char*)g.A + (size_t)nxt.pm * tstepA : cA; const char* nB = has_next ? (const char*)g.Bt + (size_t)nxt.pn * tstepB : cB;
        for (int t = 0; t < nt; t += 2) {
            const bool last = (t == nt - 2);
            const char* a1 = cA + (size_t)(t + 1) * kstep;
            const char* a2 = last ? nA : cA + (size_t)(t + 2) * kstep; const char* b2 = last ? nB : cB + (size_t)(t + 2) * kstep;
            const char* a3 = a2 + kstep; const char* b3 = b2 + kstep;
            if (last && has_next) S.a_ready(nxt);
            if constexpr (SP2) {
            PG8_LDB(B0, 0, 0); PG8_LDB(B1, 0, 1); PG8_SCHED; PG8_LDA(At, 0, 0); PG8_STAGE(PG8_SA(1, 1), a1 + hstepA, voffA);
            PG8_WAIT_V(8); PG8_WAIT_L(0); PG8_BAR; PG8_MMA(0, 0, At, B0); PG8_MMA(0, 1, At, B1); PG8_BAR; PG8_SCHED;
            PG8_LDA(At, 0, 1); PG8_STAGE(PG8_SB(0, 0), b2, voffB); PG8_STAGE(PG8_SB(0, 1), b2 + hstepB, voffB); PG8_STAGE(PG8_SA(0, 0), a2, voffA);
            PG8_WAIT_V(8); PG8_WAIT_L(0); PG8_BAR; PG8_MMA(1, 0, At, B0); PG8_MMA(1, 1, At, B1); PG8_BAR; PG8_SCHED;
            PG8_LDB(B0, 1, 0); PG8_LDB(B1, 1, 1); PG8_SCHED; PG8_LDA(At, 1, 0); PG8_STAGE(PG8_SA(0, 1), a2 + hstepA, voffA);
            PG8_WAIT_V(8); PG8_WAIT_L(0); PG8_BAR; PG8_MMA(0, 0, At, B0); PG8_MMA(0, 1, At, B1); PG8_BAR; PG8_SCHED;
            PG8_LDA(At, 1, 1); PG8_STAGE(PG8_SB(1, 0), b3, voffB); PG8_STAGE(PG8_SB(1, 1), b3 + hstepB, voffB); PG8_STAGE(PG8_SA(1, 0), a3, voffA);
            PG8_WAIT_V(8); PG8_WAIT_L(0); PG8_BAR; PG8_MMA(1, 0, At, B0); PG8_MMA(1, 1, At, B1); PG8_BAR; PG8_SCHED;
            } else {
            PG8_LDB(B0, 0, 0); PG8_SCHED; PG8_LDA(At, 0, 0); PG8_STAGE(PG8_SA(1, 1), a1 + hstepA, voffA);
            PG8_WAIT_L(8); PG8_BAR; PG8_WAIT_L(0); PG8_MMA(0, 0, At, B0); PG8_BAR; PG8_SCHED;
            PG8_LDB(B1, 0, 1); PG8_STAGE(PG8_SB(0, 0), b2, voffB);
            PG8_BAR; PG8_WAIT_L(0); PG8_MMA(0, 1, At, B1); PG8_BAR;
            PG8_LDA(At, 0, 1); PG8_STAGE(PG8_SA(0, 0), a2, voffA);
            PG8_BAR; PG8_WAIT_L(0); PG8_MMA(1, 0, At, B0); PG8_BAR; PG8_SCHED;
            PG8_STAGE(PG8_SB(0, 1), b2 + hstepB, voffB);
            PG8_WAIT_V(6); PG8_BAR; PG8_MMA(1, 1, At, B1); PG8_BAR;
            PG8_LDB(B0, 1, 0); PG8_SCHED; PG8_LDA(At, 1, 0); PG8_STAGE(PG8_SA(0, 1), a2 + hstepA, voffA);
            PG8_WAIT_L(8); PG8_BAR; PG8_WAIT_L(0); PG8_MMA(0, 0, At, B0); PG8_BAR; PG8_SCHED;
            PG8_LDB(B1, 1, 1); PG8_STAGE(PG8_SB(1, 0), b3, voffB);
            PG8_BAR; PG8_WAIT_L(0); PG8_MMA(0, 1, At, B1); PG8_BAR;
            PG8_LDA(At, 1, 1); PG8_STAGE(PG8_SA(1, 0), a3, voffA);
            PG8_BAR; PG8_WAIT_L(0); PG8_MMA(1, 0, At, B0); PG8_BAR; PG8_SCHED;
            PG8_STAGE(PG8_SB(1, 1), b3 + hstepB, voffB);
            PG8_WAIT_V(6); PG8_BAR; PG8_MMA(1, 1, At, B1); PG8_BAR;
            }
        }
        if constexpr (ALIGN_EPI) { if (wr == 0) PG8_BAR; }
        if constexpr (!Epi::AFTER_DRAIN) { E(acc, cur, wr, wc, fr, fq); S.done(cur); }
        if (!has_next) break;
#pragma unroll
        for (int a = 0; a < 2; ++a)
#pragma unroll
            for (int b = 0; b < 2; ++b)
#pragma unroll
                for (int m = 0; m < 4; ++m)
#pragma unroll
                    for (int n = 0; n < 2; ++n) acc[a][b][m][n] = (f32x4){0.f, 0.f, 0.f, 0.f};
        cur = nxt; cA = nA; cB = nB; ++ui;
        if constexpr (ALIGN_EPI) { if (wr == 1) PG8_BAR; }
    }
    PG8_WAIT_V(0);
    if constexpr (!ALIGN_EPI) { if (wr == 0) PG8_BAR; }
    PG8_BAR;
    if constexpr (Epi::AFTER_DRAIN) { E.fused(acc, cur, wr, wc, fr, fq, lds, wid, lane); S.done(cur); }
#undef PG8_SA
#undef PG8_SB
#undef PG8_STAGE
#undef PG8_LDA
#undef PG8_LDB
#undef PG8_MMA
#undef PG8_WAIT_V
#undef PG8_WAIT_L
#undef PG8_BAR
#undef PG8_SCHED
}
}

#ifndef PG8_SP2
#define PG8_SP2 true
#endif
#ifndef PG8_ALIGN
#define PG8_ALIGN true
#endif
#include <hip/hip_bf16.h>
#include <cmath>
namespace attn_body {
using bf16=__hip_bfloat16;
using bf16x8=__attribute__((ext_vector_type(8)))short;
using s16x4=__attribute__((ext_vector_type(4)))short;
using f32x16=__attribute__((ext_vector_type(16)))float;
using u32x4=__attribute__((ext_vector_type(4)))unsigned;
constexpr int BATCH=2,NHEAD=16,SEQ=8192,D=64,DM=NHEAD*D;
constexpr int NW=8,QBLK=32,QB=QBLK*NW,KVBLK=64,NQB=SEQ/QB;
constexpr int ATTN_PITCH=DM, ATTN_UNIT_ROWS=QB, OPITCH=2048, KVROWS=8320, NHC=16;
__device__ __forceinline__ int crow(int r,int hi){return (r&3)+8*(r>>2)+4*hi;}
#define SBAR() __builtin_amdgcn_sched_barrier(0)
__device__ __forceinline__ void cmask(f32x16&p0,f32x16&p1,int jb,int qrel,int hi){
  const float NEG=-INFINITY;
  if(jb<4){ if(jb>(qrel>>6)){
    #pragma unroll
    for(int r=0;r<16;++r){p0[r]=NEG;p1[r]=NEG;} } }
  else if(jb==4){
    #pragma unroll
    for(int r=0;r<16;++r){p0[r]=NEG;p1[r]=NEG;} }
  else{
    #pragma unroll
    for(int r=0;r<16;++r){ if(r>=8)p0[r]=NEG; p1[r]=NEG; } }
}

constexpr int NSLOT=3, SLOTB=8192, VSLOTB=16384;
constexpr int LDS_K=0, LDS_V=NSLOT*SLOTB, LDS_WS=LDS_V+NSLOT*VSLOTB, LDS_OST=LDS_WS+NW*64*4, LDS_BYTES=LDS_OST+NW*4096;
constexpr float C2=0.125f*1.4426950408889634f;
__device__ __forceinline__ void glds16(const void*gsrc,unsigned lds_dst){unsigned keep;
  asm volatile("s_mov_b32 %0, m0\n\ts_mov_b32 m0, %2\n\ts_nop 0\n\tglobal_load_lds_dwordx4 %1, off\n\ts_mov_b32 m0, %0":"=&s"(keep):"v"(gsrc),"s"(lds_dst):"memory");}
__device__ __forceinline__ float max3f(float a,float b,float c){float r;asm("v_max3_f32 %0, %1, %2, %3":"=v"(r):"v"(a),"v"(b),"v"(c));return r;}
__device__ __forceinline__ float max2f(float a,float b){float r;asm("v_max_f32_e32 %0, %1, %2":"=v"(r):"v"(a),"v"(b));return r;}
__device__ __forceinline__ float fadd_s(float a,float b){float r;asm("v_add_f32_e32 %0, %1, %2":"=v"(r):"v"(a),"v"(b));return r;}
__device__ __forceinline__ float fsub_s(float a,float b){float r;asm("v_sub_f32_e32 %0, %1, %2":"=v"(r):"v"(a),"v"(b));return r;}
typedef float f32x2_t __attribute__((ext_vector_type(2))); typedef __bf16 bf16x2_t __attribute__((ext_vector_type(2)));
__device__ __forceinline__ unsigned cvtpk_s(float lo,float hi){f32x2_t v={lo,hi};bf16x2_t b=__builtin_convertvector(v,bf16x2_t);return __builtin_bit_cast(unsigned,b);}
#define WAIT_BAR(N) asm volatile("s_waitcnt vmcnt(" #N ") lgkmcnt(0)\n\ts_barrier":::"memory")

__device__ __forceinline__ void qkt(f32x16&p0,f32x16&p1,const char*Kslot,const bf16x8*qr,const f32x16&negm,int r32,int hi){
  const char*kb=Kslot+hi*1024+r32*16;
  #pragma unroll
  for(int d0=0;d0<4;++d0){
    const bf16x8 b0=*reinterpret_cast<const bf16x8*>(kb+d0*2048);
    const bf16x8 b1=*reinterpret_cast<const bf16x8*>(kb+d0*2048+512);
    if(d0==0){p0=__builtin_amdgcn_mfma_f32_32x32x16_bf16(b0,qr[0],negm,0,0,0);p1=__builtin_amdgcn_mfma_f32_32x32x16_bf16(b1,qr[0],negm,0,0,0);}
    else{p0=__builtin_amdgcn_mfma_f32_32x32x16_bf16(b0,qr[d0],p0,0,0,0);p1=__builtin_amdgcn_mfma_f32_32x32x16_bf16(b1,qr[d0],p1,0,0,0);}}
}
typedef __attribute__((address_space(3))) const char* lds_cptr;
typedef short v4i16_t __attribute__((ext_vector_type(4)));
__device__ __forceinline__ void kload8(bf16x8*kf,lds_cptr kp){
  kf[0]=*(const __attribute__((address_space(3))) bf16x8*)(kp);      kf[1]=*(const __attribute__((address_space(3))) bf16x8*)(kp+512);
  kf[2]=*(const __attribute__((address_space(3))) bf16x8*)(kp+2048); kf[3]=*(const __attribute__((address_space(3))) bf16x8*)(kp+2560);
  kf[4]=*(const __attribute__((address_space(3))) bf16x8*)(kp+4096); kf[5]=*(const __attribute__((address_space(3))) bf16x8*)(kp+4608);
  kf[6]=*(const __attribute__((address_space(3))) bf16x8*)(kp+6144); kf[7]=*(const __attribute__((address_space(3))) bf16x8*)(kp+6656);
}
__device__ __forceinline__ void kload2(bf16x8*kf,lds_cptr kp,int j){ kf[2*j]=*(const __attribute__((address_space(3))) bf16x8*)(kp+j*2048); kf[2*j+1]=*(const __attribute__((address_space(3))) bf16x8*)(kp+j*2048+512); }
__device__ __forceinline__ s16x4 vtr(lds_cptr p){ return __builtin_bit_cast(s16x4,__builtin_amdgcn_ds_read_tr16_b64_v4i16((__attribute__((address_space(3))) v4i16_t*)p)); }
__device__ __forceinline__ float rowmax(const f32x16&p0,const f32x16&p1){
  float a=max3f(p0[0],p0[1],p1[0]),b=max3f(p0[2],p0[3],p1[1]);a=max3f(a,p1[2],p1[3]);
  #pragma unroll
  for(int r=4;r<16;r+=4){a=max3f(a,p0[r],p0[r+1]);b=max3f(b,p0[r+2],p0[r+3]);a=max3f(a,p1[r],p1[r+1]);b=max3f(b,p1[r+2],p1[r+3]);}
  const float m=max2f(a,b);
  auto rr=__builtin_amdgcn_permlane32_swap(__float_as_uint(m),__float_as_uint(m),false,false);
  return max2f(__uint_as_float(rr[0]),__uint_as_float(rr[1]));
}
__device__ __forceinline__ void pv(f32x16*o,int vb,bf16x8 pa0,bf16x8 pa1,bf16x8 pa2,bf16x8 pa3){
  #pragma unroll
  for(int d0=0;d0<4;++d0){s16x4 lo[4],hi[4];
    #pragma unroll
    for(int ks=0;ks<4;++ks){
      asm volatile("ds_read_b64_tr_b16 %0,%1 offset:%c2":"=&v"(lo[ks]):"v"(vb),"i"(d0*4096+ks*1024):"memory");
      asm volatile("ds_read_b64_tr_b16 %0,%1 offset:%c2":"=&v"(hi[ks]):"v"(vb),"i"(d0*4096+ks*1024+512):"memory");}
    asm volatile("s_waitcnt lgkmcnt(0)":::"memory");SBAR();
    #define PK(k) (bf16x8){lo[k][0],lo[k][1],lo[k][2],lo[k][3],hi[k][0],hi[k][1],hi[k][2],hi[k][3]}
    o[d0]=__builtin_amdgcn_mfma_f32_32x32x16_bf16(pa0,PK(0),o[d0],0,0,0);
    o[d0]=__builtin_amdgcn_mfma_f32_32x32x16_bf16(pa1,PK(1),o[d0],0,0,0);
    o[d0]=__builtin_amdgcn_mfma_f32_32x32x16_bf16(pa2,PK(2),o[d0],0,0,0);
    o[d0]=__builtin_amdgcn_mfma_f32_32x32x16_bf16(pa3,PK(3),o[d0],0,0,0);
    #undef PK
  }
}

#ifndef ATTN_STORE16
#define ATTN_STORE16(p,v) (*(u32x4*)(p)=(v))
#endif
template<int THRL> __device__ __forceinline__ void attn_unit(int b,int hc,int qb,const bf16*Q,const bf16*__restrict__ K,const bf16*__restrict__ V,bf16*O,char*shm){
  int tid_=threadIdx.x; asm volatile("":"+v"(tid_));
  const int tid=tid_,lane=tid&63,r32=lane&31,hi=lane>>5; const int wid=__builtin_amdgcn_readfirstlane(tid>>6);
  const long rowbase=(long)b*SEQ, kvbase=(long)b*KVROWS; const int q0=qb*QB;
  const bf16*Qw=Q+(rowbase+q0+wid*QBLK)*DM+hc*D;
  const bf16*Kh=K+kvbase*DM+hc*D,*Vh=V+kvbase*DM+(hc>>1)*128;
  const unsigned lds0=(unsigned)(uintptr_t)shm;
  float*wsf=(float*)(shm+LDS_WS)+wid*64;
  const bf16*ksrc=Kh+(long)lane*DM+wid*8;
  const bf16*vsrc=Vh+(long)(16*(wid&3)+(lane>>2))*DM+(wid>>2)*32+(lane&3)*8;
  const unsigned kdst=lds0+LDS_K+wid*1024, vdst=lds0+LDS_V+wid*1024;
  #define TROW(t) (((t)<NT-2)?(long)(t)*KVBLK:(long)(8192+((t)-(NT-2))*KVBLK))
  #define DMA_K(t,slot) glds16(ksrc+TROW(t)*DM,(unsigned)__builtin_amdgcn_readfirstlane(kdst+(slot)))
  #define DMA_V(t,slot) do{ glds16(vsrc+TROW(t)*DM,(unsigned)__builtin_amdgcn_readfirstlane(vdst+2*(slot))); glds16(vsrc+64+TROW(t)*DM,(unsigned)__builtin_amdgcn_readfirstlane(vdst+8192+2*(slot))); }while(0)
  const int vb0=(int)(lds0+LDS_V)+((lane>>4)&1)*32+(lane&3)*8+(4*hi+((lane&15)>>2))*64;
  const char*Kbase=shm+LDS_K; bf16x8 kf[8];
  const lds_cptr shm3=(lds_cptr)shm; const lds_cptr kp0=shm3+LDS_K+hi*1024+r32*16; const lds_cptr vp0=shm3+LDS_V+((lane>>4)&1)*32+(lane&3)*8+(4*hi+((lane&15)>>2))*64;
  const int NT=(q0+QB)/KVBLK+2;
  DMA_K(0,0);DMA_V(0,0);DMA_K(1,SLOTB);
  bf16x8 qr[4];
  #pragma unroll
  for(int d0=0;d0<4;++d0)qr[d0]=*reinterpret_cast<const bf16x8*>(&Qw[(long)r32*DM+d0*16+hi*8]);
  float mhat=0.f,l_reg=0.f;f32x16 o[4];o[0]=f32x16{};o[1]=f32x16{};o[2]=f32x16{};o[3]=f32x16{};const f32x16 zc=f32x16{};
  const int qrel=wid*QBLK+r32;
  #define CMASK(P0,P1,t) do{int jb_=(t)-(NT-6); if(jb_>=0)cmask(P0,P1,jb_,qrel,hi);}while(0)
  bool resc=false;
  #define START(P0,P1) do{ const float rm=rowmax(P0,P1); resc=false; \
    { const float dl=rm; mhat=fadd_s(mhat,dl); \
      _Pragma("unroll") for(int r=0;r<16;++r){P0[r]=fsub_s(P0[r],dl);P1[r]=fsub_s(P1[r],dl);} } \
    _Pragma("unroll") for(int r=0;r<16;++r)P0[r]=__builtin_amdgcn_exp2f(P0[r]); }while(0)
  #define RESC() do{ if(resc){ asm volatile("s_waitcnt lgkmcnt(0)":::"memory"); \
      _Pragma("unroll") for(int d_=0;d_<4;++d_) _Pragma("unroll") for(int r=0;r<16;++r)o[d_][r]*=wsf[crow(r,hi)]; } }while(0)
  f32x16 pA0,pA1,pB0,pB1;
  int sl_prev=0,sl_cur=0,sl_next=SLOTB;
  #define ROT() do{sl_prev=sl_cur;sl_cur=sl_next;sl_next=(sl_next==(NSLOT-1)*SLOTB)?0:sl_next+SLOTB;}while(0)
  DMA_K(2,2*SLOTB);
  WAIT_BAR(4);
  qkt(pA0,pA1,Kbase,qr,zc,r32,hi);asm volatile("s_nop 15\n\ts_nop 7":"+v"(pA0),"+v"(pA1));CMASK(pA0,pA1,0);
  START(pA0,pA1);
  _Pragma("unroll") for(int r=0;r<16;++r)pA1[r]=__builtin_amdgcn_exp2f(pA1[r]);
  WAIT_BAR(0);
  DMA_K(3,0);DMA_V(1,SLOTB);
  ROT();
  kload8(kf,kp0+sl_cur);
  WAIT_BAR(3);
  s16x4 vlo[8],vhi[8]; u32x4 pw0,pw1,pw2,pw3;
  #define PKW(P,B) cvtpk_s(P[B],P[B+1])
  #define PAF(k) __builtin_bit_cast(bf16x8,pw##k)
  #define VFR(i) (bf16x8){vlo[i][0],vlo[i][1],vlo[i][2],vlo[i][3],vhi[i][0],vhi[i][1],vhi[i][2],vhi[i][3]}
  #define PIN(x) asm volatile("":"+v"(x))
  #define MX3(a,b,c) __builtin_fmaxf(__builtin_fmaxf((a),(b)),(c))
  #define GAPA(MF,A0,A1,A2,A3,W0,W1,PW) do{ MF; sacc+=A0; sacc+=A1; sacc+=A2; sacc+=A3; PIN(sacc); W0; W1; PIN(PW); SBAR(); }while(0)
  #define EX(v) __builtin_amdgcn_exp2f(v)
  #define GAPB(MF,X,B) do{ MF; X[B]=EX(X[B]); X[B+1]=EX(X[B+1]); X[B+2]=EX(X[B+2]); X[B+3]=EX(X[B+3]); PIN(X); SBAR(); }while(0)
  #define VRD(i) do{ vlo[i]=vtr(vp_+(((i)>>2)*4096+((i)&3)*1024)); vhi[i]=vtr(vp_+(((i)>>2)*4096+((i)&3)*1024+512)); }while(0)
  #define VRD2(i) do{ vlo[i]=vtr(vp_+((2+((i)>>2))*4096+((i)&3)*1024)); vhi[i]=vtr(vp_+((2+((i)>>2))*4096+((i)&3)*1024+512)); }while(0)
  #define GAPB2(MF,X,B) do{ MF; X[B]=EX(X[B]-mhat); X[B+1]=EX(X[B+1]-mhat); PIN(X); SBAR(); }while(0)
  #define KRD(G,j) do{ if(G){ kload2(kf,kp0+sl_next,j); SBAR(); } }while(0)
  #define STEP(C0,C1,P0,P1,t,GK,GV,GL) do{ SBAR(); \
    const lds_cptr vp_=vp0+2*sl_prev; \
    VRD(0); SBAR(); float sacc=(P0[0]+P0[1]); \
    GAPA(C0=__builtin_amdgcn_mfma_f32_32x32x16_bf16(kf[0],qr[0],zc,0,0,0), P0[2],P0[3],P0[4],P0[5],     pw0[0]=PKW(P0,0), pw0[1]=PKW(P0,2), pw0); \
    VRD(4); SBAR(); GAPA(C1=__builtin_amdgcn_mfma_f32_32x32x16_bf16(kf[1],qr[0],zc,0,0,0), P0[6],P0[7],P0[8],P0[9],     pw0[2]=PKW(P0,4), pw0[3]=PKW(P0,6), pw0); \
    VRD(1); SBAR(); GAPA(C0=__builtin_amdgcn_mfma_f32_32x32x16_bf16(kf[2],qr[1],C0,0,0,0),   P0[10],P0[11],P0[12],P0[13], pw1[0]=PKW(P0,8), pw1[1]=PKW(P0,10), pw1); \
    VRD(5); SBAR(); GAPA(C1=__builtin_amdgcn_mfma_f32_32x32x16_bf16(kf[3],qr[1],C1,0,0,0),   P0[14],P0[15],P1[0],P1[1],   pw1[2]=PKW(P0,12),pw1[3]=PKW(P0,14), pw1); \
    VRD(2); SBAR(); GAPA(C0=__builtin_amdgcn_mfma_f32_32x32x16_bf16(kf[4],qr[2],C0,0,0,0),   P1[2],P1[3],P1[4],P1[5],     pw2[0]=PKW(P1,0), pw2[1]=PKW(P1,2), pw2); \
    VRD(6); SBAR(); GAPA(C1=__builtin_amdgcn_mfma_f32_32x32x16_bf16(kf[5],qr[2],C1,0,0,0),   P1[6],P1[7],P1[8],P1[9],     pw2[2]=PKW(P1,4), pw2[3]=PKW(P1,6), pw2); \
    VRD(3); SBAR(); GAPA(C0=__builtin_amdgcn_mfma_f32_32x32x16_bf16(kf[6],qr[3],C0,0,0,0),   P1[10],P1[11],P1[12],P1[13], pw3[0]=PKW(P1,8), pw3[1]=PKW(P1,10), pw3); \
    VRD(7); SBAR(); GAPA(C1=__builtin_amdgcn_mfma_f32_32x32x16_bf16(kf[7],qr[3],C1,0,0,0),   P1[14],P1[15],0.f,0.f,       pw3[2]=PKW(P1,12),pw3[3]=PKW(P1,14), pw3); \
    l_reg+=sacc; \
    if(GK){DMA_K((t)+3,sl_cur);} if(GV){DMA_V((t)+1,sl_next);} \
    CMASK(C0,C1,t); \
    { float a=MX3(C0[0],C0[1],C1[0]),b=MX3(C0[2],C0[3],C1[1]); a=MX3(a,C1[2],C1[3]); \
      _Pragma("unroll") for(int r=4;r<16;r+=4){a=MX3(a,C0[r],C0[r+1]);b=MX3(b,C0[r+2],C0[r+3]);a=MX3(a,C1[r],C1[r+1]);b=MX3(b,C1[r+2],C1[r+3]);} \
      float rm=__builtin_fmaxf(a,b); { auto rr=__builtin_amdgcn_permlane32_swap(__float_as_uint(rm),__float_as_uint(rm),false,false); rm=__builtin_fmaxf(__uint_as_float(rr[0]),__uint_as_float(rr[1])); } \
      rm-=mhat; resc=false; \
      if(__builtin_expect(__any(rm>(float)THRL),0)){ const float dl=__builtin_fmaxf(rm,0.f); mhat+=dl; \
        const float f=__builtin_amdgcn_exp2f(-dl); l_reg*=f; if(hi==0)wsf[r32]=f; resc=true; } } \
    SBAR(); \
    GAPB2(o[0]=__builtin_amdgcn_mfma_f32_32x32x16_bf16(PAF(0),VFR(0),o[0],0,0,0), C0,0);  VRD2(0); SBAR(); \
    GAPB2(o[1]=__builtin_amdgcn_mfma_f32_32x32x16_bf16(PAF(0),VFR(4),o[1],0,0,0), C0,2);  VRD2(4); SBAR(); \
    KRD(GL,0); GAPB2(o[0]=__builtin_amdgcn_mfma_f32_32x32x16_bf16(PAF(1),VFR(1),o[0],0,0,0), C0,4);  VRD2(1); SBAR(); \
    KRD(GL,1); GAPB2(o[1]=__builtin_amdgcn_mfma_f32_32x32x16_bf16(PAF(1),VFR(5),o[1],0,0,0), C0,6);  VRD2(5); SBAR(); \
    KRD(GL,2); GAPB2(o[0]=__builtin_amdgcn_mfma_f32_32x32x16_bf16(PAF(2),VFR(2),o[0],0,0,0), C0,8);  VRD2(2); SBAR(); \
    KRD(GL,3); GAPB2(o[1]=__builtin_amdgcn_mfma_f32_32x32x16_bf16(PAF(2),VFR(6),o[1],0,0,0), C0,10); VRD2(6); SBAR(); \
    GAPB2(o[0]=__builtin_amdgcn_mfma_f32_32x32x16_bf16(PAF(3),VFR(3),o[0],0,0,0), C0,12); VRD2(3); SBAR(); \
    GAPB2(o[1]=__builtin_amdgcn_mfma_f32_32x32x16_bf16(PAF(3),VFR(7),o[1],0,0,0), C0,14); VRD2(7); SBAR(); \
    GAPB2(o[2]=__builtin_amdgcn_mfma_f32_32x32x16_bf16(PAF(0),VFR(0),o[2],0,0,0), C1,0); \
    GAPB2(o[3]=__builtin_amdgcn_mfma_f32_32x32x16_bf16(PAF(0),VFR(4),o[3],0,0,0), C1,2); \
    GAPB2(o[2]=__builtin_amdgcn_mfma_f32_32x32x16_bf16(PAF(1),VFR(1),o[2],0,0,0), C1,4); \
    GAPB2(o[3]=__builtin_amdgcn_mfma_f32_32x32x16_bf16(PAF(1),VFR(5),o[3],0,0,0), C1,6); \
    GAPB2(o[2]=__builtin_amdgcn_mfma_f32_32x32x16_bf16(PAF(2),VFR(2),o[2],0,0,0), C1,8); \
    GAPB2(o[3]=__builtin_amdgcn_mfma_f32_32x32x16_bf16(PAF(2),VFR(6),o[3],0,0,0), C1,10); \
    GAPB2(o[2]=__builtin_amdgcn_mfma_f32_32x32x16_bf16(PAF(3),VFR(3),o[2],0,0,0), C1,12); \
    GAPB2(o[3]=__builtin_amdgcn_mfma_f32_32x32x16_bf16(PAF(3),VFR(7),o[3],0,0,0), C1,14); \
    }while(0)
  int t=1;
  #undef CMASK
  #define CMASK(P0,P1,t) do{}while(0)
  for(;t+7<NT;t+=2){
    STEP(pB0,pB1,pA0,pA1,t,true,true,true);     WAIT_BAR(3); RESC(); ROT();
    STEP(pA0,pA1,pB0,pB1,t+1,true,true,true);   WAIT_BAR(3); RESC(); ROT();
  }
  #undef CMASK
  #define CMASK(P0,P1,t) do{int jb_=(t)-(NT-6); if(jb_>=0)cmask(P0,P1,jb_,qrel,hi);}while(0)
  #define ENDW(tt) do{ if((tt)+3<NT){WAIT_BAR(3);} else if((tt)+2<NT){WAIT_BAR(2);} else {WAIT_BAR(0);} }while(0)
  for(;t+1<NT;t+=2){
    STEP(pB0,pB1,pA0,pA1,t,(t+3<NT),(t+1<NT),(t+1<NT));       ENDW(t);   RESC(); ROT();
    STEP(pA0,pA1,pB0,pB1,t+1,(t+4<NT),(t+2<NT),(t+2<NT));     ENDW(t+1); RESC(); ROT();
  }
  STEP(pB0,pB1,pA0,pA1,NT-1,false,false,false); RESC();
  { float sacc=pB0[0]+pB0[1]; _Pragma("unroll") for(int r=2;r<16;++r)sacc+=pB0[r]; _Pragma("unroll") for(int r=0;r<16;++r)sacc+=pB1[r]; l_reg+=sacc;
    pw0=(u32x4){PKW(pB0,0),PKW(pB0,2),PKW(pB0,4),PKW(pB0,6)};pw1=(u32x4){PKW(pB0,8),PKW(pB0,10),PKW(pB0,12),PKW(pB0,14)};pw2=(u32x4){PKW(pB1,0),PKW(pB1,2),PKW(pB1,4),PKW(pB1,6)};pw3=(u32x4){PKW(pB1,8),PKW(pB1,10),PKW(pB1,12),PKW(pB1,14)};
    SBAR(); pv(o,vb0+2*sl_cur,PAF(0),PAF(1),PAF(2),PAF(3)); }
  #undef PKW
  #undef PAF
  #undef VFR
  #undef PIN
  #undef MX3
  #undef GAPA
  #undef GAPB
  #undef EX
  #undef VRD
  #undef VRD2
  #undef GAPB2
  #undef KRD
  #undef STEP
  #undef ENDW
  {auto rr=__builtin_amdgcn_permlane32_swap(__float_as_uint(l_reg),__float_as_uint(l_reg),false,false);l_reg=__uint_as_float(rr[0])+__uint_as_float(rr[1]);}
  if(hi==0)wsf[32+r32]=l_reg;asm volatile("s_waitcnt lgkmcnt(0)":::"memory");
  float rli[16];
  #pragma unroll
  for(int r=0;r<16;++r)rli[r]=__builtin_amdgcn_rcpf(wsf[32+crow(r,hi)]);
  bf16*Ow=O+(rowbase+q0+wid*QBLK)*OPITCH+hc*128;
  { bf16*stg=(bf16*)(shm+LDS_OST)+wid*2048;
    #pragma unroll
    for(int ps=0;ps<2;++ps){
      #pragma unroll
      for(int r=0;r<16;++r){const int orow=crow(r,hi);
        #pragma unroll
        for(int d0=0;d0<2;++d0)stg[orow*64+d0*32+r32]=__float2bfloat16(o[2*ps+d0][r]*rli[r]);}
      asm volatile("s_waitcnt lgkmcnt(0)":::"memory");
      #pragma unroll
      for(int i=0;i<4;++i){const int row=i*8+(lane>>3),ch=lane&7; const u32x4 v=*(const u32x4*)(stg+row*64+ch*8); ATTN_STORE16(Ow+(long)row*OPITCH+ps*64+ch*8,v);}
      asm volatile("s_waitcnt lgkmcnt(0)":::"memory"); } }
  asm volatile("s_waitcnt lgkmcnt(0)\n\ts_barrier":::"memory");
  #undef DMA_K
  #undef TROW
  #undef DMA_V
  #undef CMASK
  #undef START
  #undef RESC
  #undef ROT
}
constexpr int ATTN_LDS_BYTES=LDS_BYTES;
struct AttnTensors { const bf16* Q; const bf16* K; const bf16* V; bf16* O; };
struct AttnUnit { int bh; int qb; };
struct StaticOrder {
  int vcu;
  __device__ __forceinline__ explicit StaticOrder(int grid,int block):vcu((block%8)*(grid/8)+block/8){}
  __device__ __forceinline__ bool next(int i,AttnUnit&u)const{ if(i>=4)return false; const int s=vcu&7; u.bh=vcu>>3; u.qb=(i==0)?s:(i==1)?15-s:(i==2)?16+s:31-s; return true; }
  __device__ __forceinline__ void a_ready(const AttnUnit&)const{}
  __device__ __forceinline__ void done(const AttnUnit&)const{}
};
template<class Sched,int THRL=8> __device__ __forceinline__ void attn_phase(char*lds,const AttnTensors&T,const Sched&S){
  AttnUnit u;
  for(int i=0;S.next(i,u);++i){ S.a_ready(u); attn_unit<THRL>(u.bh/NHC,u.bh%NHC,u.qb,T.Q,T.K,T.V,T.O,lds); S.done(u); }
}
#undef SBAR
#undef WAIT_BAR
}
#define GAS __attribute__((address_space(1)))
#define LAS __attribute__((address_space(3)))
typedef unsigned short bf16;
typedef unsigned v4u __attribute__((ext_vector_type(4)));
typedef float f32x4 __attribute__((ext_vector_type(4)));
typedef short bf16x8 __attribute__((ext_vector_type(8)));
typedef GAS unsigned gu32;
typedef GAS unsigned long long gu64;
#define RLX_AGENT __ATOMIC_RELAXED, __HIP_MEMORY_SCOPE_AGENT
#define LDS_WAIT() asm volatile("s_waitcnt lgkmcnt(0)" ::: "memory")
#define VM_WAIT() asm volatile("s_waitcnt vmcnt(0)" ::: "memory")
__device__ __forceinline__ unsigned long long rt() { return __builtin_amdgcn_s_memrealtime(); }
__device__ __forceinline__ unsigned f2bf(float f) { unsigned u = __builtin_bit_cast(unsigned, f); return (u + 0x7fffu + ((u >> 16) & 1u)) >> 16; }
__device__ __forceinline__ unsigned pk2(float lo, float hi) { return f2bf(lo) | (f2bf(hi) << 16); }

#define XB_TMO      128
#define XB_XCNT(j)  (256  + 64 * (j))
#define XB_XSUB(j)  (1280 + 64 * (j))
#define XB_XGEN(j)  (2304 + 64 * (j))
#define XB_TOP      3328
#define XB_TOPGEN   3392
#define XCD_BAR_WORDS 3456
#define XB_SPIN_CAP (1u << 18)

__device__ __forceinline__ unsigned xb_ld(unsigned* p)              { return __hip_atomic_load(p, __ATOMIC_RELAXED, __HIP_MEMORY_SCOPE_AGENT); }
__device__ __forceinline__ unsigned xb_add(unsigned* p, unsigned v) { return __hip_atomic_fetch_add(p, v, __ATOMIC_RELAXED, __HIP_MEMORY_SCOPE_AGENT); }
__device__ __forceinline__ unsigned xb_xcc_id() { return (unsigned)__builtin_amdgcn_s_getreg((3 << 11) | 20) & 0xFu; }
#define XB_SPIN(cond, bar) do { unsigned _sp = 0; while (cond) { __builtin_amdgcn_s_sleep(1); \
    if ((++_sp & 255u) == 0u) { if (xb_ld(&(bar)[XB_TMO])) break; if (_sp > XB_SPIN_CAP) { atomicAdd(&(bar)[XB_TMO], 1u); break; } } } } while (0)

struct XcdBarrier {
    unsigned* bar; unsigned x;
    volatile LAS unsigned* st;
};

__device__ __forceinline__ XcdBarrier xcd_barrier_post(unsigned* bar, volatile LAS unsigned* st) {
    XcdBarrier b; b.bar = bar; b.x = xb_xcc_id(); b.st = st;
    if (threadIdx.x == 0) (void)xb_add(&bar[XB_XCNT(b.x)], 1u);
    return b;
}
__device__ __forceinline__ void xcd_barrier_complete(unsigned* bar, unsigned x, unsigned& nloc, unsigned& nx) {
    const unsigned G = gridDim.x * gridDim.y * gridDim.z;
    unsigned sum, cnt, mine, sp = 0u;
    for (;;) {
        sum = 0u; cnt = 0u; mine = 0u;
#pragma unroll
        for (unsigned j = 0; j < 16; ++j) { const unsigned c = xb_ld(&bar[XB_XCNT(j)]); sum += c; cnt += (c > 0u) ? 1u : 0u; mine = (j == x) ? c : mine; }
        if (sum == G) break;
        __builtin_amdgcn_s_sleep(1);
        if ((++sp & 255u) == 0u) { if (xb_ld(&bar[XB_TMO])) break; if (sp > XB_SPIN_CAP) { atomicAdd(&bar[XB_TMO], 1u); break; } }
    }
    nloc = mine > 0u ? mine : 1u; nx = cnt > 0u ? cnt : 1u;
}

__device__ __forceinline__ void xcd_barrier(const XcdBarrier& b) {
    asm volatile("s_waitcnt vmcnt(0)" ::: "memory");
    __syncthreads();
    if (threadIdx.x == 0) {
        unsigned* bar = b.bar;
        __builtin_amdgcn_s_waitcnt(0);
        unsigned nloc = b.st[0], nx = b.st[1];
        if (nloc == 0u) { xcd_barrier_complete(bar, b.x, nloc, nx); b.st[0] = nloc; b.st[1] = nx; }
        const unsigned old = xb_add(&bar[XB_XSUB(b.x)], 1u);
        const unsigned gen = old / nloc;
        if (old + 1u == (gen + 1u) * nloc) {
            __builtin_amdgcn_fence(__ATOMIC_RELEASE, "agent");
            asm volatile("s_waitcnt vmcnt(0)" ::: "memory");
            const unsigned og = xb_add(&bar[XB_TOP], 1u);
            const unsigned tg = og / nx;
            if (og + 1u == (tg + 1u) * nx) xb_add(&bar[XB_TOPGEN], 1u);
            else XB_SPIN(xb_ld(&bar[XB_TOPGEN]) == tg, bar);
            __builtin_amdgcn_fence(__ATOMIC_ACQUIRE, "agent");
            xb_add(&bar[XB_XGEN(b.x)], 1u);
            asm volatile("s_waitcnt vmcnt(0)" ::: "memory");
        } else {
            XB_SPIN(xb_ld(&bar[XB_XGEN(b.x)]) == gen, bar);
            __builtin_amdgcn_fence(__ATOMIC_ACQUIRE, "agent");
            asm volatile("s_waitcnt vmcnt(0)" ::: "memory");
        }
    }
    __syncthreads();
}

constexpr int NWAVES = 8;
#ifndef MK_N_LAUNCHES
#define MK_N_LAUNCHES 1
#endif
constexpr int NPH = 25;
constexpr int N_LAUNCHES = MK_N_LAUNCHES;
static_assert(N_LAUNCHES == 1 || N_LAUNCHES == NPH, "MK_N_LAUNCHES is 1 or 25");

constexpr int DM_ = 1024, NLAYER = 2, NMETA = 16, SEQ_ = 8192;
constexpr int MREAL = pg8::MREAL, MVALID = pg8::MVALID, MP = 16640;
constexpr int NP1 = 8192;
constexpr int MOE_ROWS = 74240;
constexpr int CAP = 16416;
constexpr float LN_EPS = 1e-5f, ALPHA = 1.4142135623730951f;

constexpr size_t MiB = 1u << 20;
constexpr size_t WS_CTL = 0, CTL_ZERO_BYTES = 1 * MiB;
constexpr size_t WL_IN = 0, WL_GLU = 16 * MiB, WL_SO = 17 * MiB, WL_CO = 18 * MiB, WL_AO = 19 * MiB, WL_WO = 21 * MiB, WL_GU = 23 * MiB, WL_DN = 151 * MiB, WL_ST = 215 * MiB, WL_TOE = 231 * MiB, WL_STRIDE = 304 * MiB;
constexpr size_t WS_W = 2 * MiB;
constexpr size_t WS_SSMC = WS_W + NLAYER * WL_STRIDE;
constexpr size_t WS_ROPE = WS_SSMC + 2 * MiB;
constexpr size_t WS_HF = WS_ROPE + 3 * MiB;
constexpr size_t WS_HB = WS_HF + 65 * MiB;
constexpr size_t WS_UC = WS_HB + 33 * MiB;
constexpr size_t WS_UMETA = WS_UC + 18 * MiB;
constexpr size_t WS_CONV = WS_UMETA + 1 * MiB;
constexpr size_t WS_Q = WS_CONV + 49 * MiB;
constexpr size_t WS_K = WS_Q + 33 * MiB;
constexpr size_t WS_V = WS_K + 33 * MiB;
constexpr size_t WS_GB = WS_V + 33 * MiB;
constexpr size_t WS_SLOC = WS_GB + 98 * MiB;
constexpr size_t WS_SM = WS_SLOC + 4 * MiB;
constexpr size_t WS_OC = WS_SM + 1 * MiB;
constexpr size_t WS_YG = WS_OC + 65 * MiB;
constexpr size_t WS_YS = WS_YG + 17 * MiB;
constexpr size_t WS_YC = WS_YS + 17 * MiB;
constexpr size_t WS_YA = WS_YC + 17 * MiB;
constexpr size_t WS_MG = WS_YA + 33 * MiB;
constexpr size_t WS_PRE = WS_MG + 33 * MiB;
constexpr size_t WS_XG = WS_PRE + 65 * MiB;
constexpr size_t WS_HID = WS_XG + 145 * MiB;
constexpr size_t WS_OUTS = WS_HID + 145 * MiB;
constexpr size_t WS_ROWIDX = WS_OUTS + 145 * MiB;
constexpr size_t WS_TOKE = WS_ROWIDX + 3 * MiB;
constexpr size_t WS_TOKW = WS_TOKE + 1 * MiB;
constexpr size_t WS_END = WS_TOKW + 1 * MiB;
static_assert((size_t)MOE_ROWS * 1024 * 2 <= 145 * MiB && (size_t)MP * 3072 * 2 <= 98 * MiB && (size_t)MP * 1536 * 2 <= 49 * MiB && (size_t)MP * 4096 <= 65 * MiB && (size_t)32 * 1024 * 1152 * 2 <= 73 * MiB, "d_ws map");
constexpr int CW_TMO = 0, CW_CODE = 1;
constexpr int CW_BAR = 4096;
constexpr int CW_CNT = 16384;
static_assert((CW_CNT + NLAYER * 32 * 64) * 4 <= (int)CTL_ZERO_BYTES, "CTL words inside the memset region");

constexpr int RING_OFF = 0, RING_BYTES = 131072;
constexpr int LDSCTL_OFF = RING_BYTES, MISC_OFF = LDSCTL_OFF + 320;
constexpr int REC_OFF = MISC_OFF + 192;
constexpr int LDS_BYTES = 147456;
static_assert(REC_OFF + 8 * 40 * 8 <= LDS_BYTES && (REC_OFF % 16) == 0, "LDS map");

enum InIdx { I_X = 0, I_META, I_LNIN_G, I_LNIN_B, I_WIN, I_LAMRE, I_LAMIM, I_LOGDT, I_BRE, I_BIM, I_CRE, I_CIM, I_SSMD, I_WGLU, I_SSMWO, I_CONVW, I_CONVWO,
             I_LQ1, I_LK1, I_LQ2, I_LK2, I_SUBLN, I_ATTNWO, I_GATEW, I_GATEB, I_WO, I_LN1G, I_LN1B, I_RW, I_RB, I_WGU, I_BGU, I_WDN, I_BDN, I_LN2G, I_LN2B, N_IN };
struct Args { const float* in[N_IN]; float* out; unsigned char* ws; int ph_lo, ph_hi, li, pad; };
struct Frame {
    LAS unsigned char* lds;
    volatile LAS unsigned* MISC;
    gu32* ctl;
    unsigned char* ws;
    int tid, lane, wave;
    int vcu, G;
    int chk_l;
};
__device__ __forceinline__ float wave_sum_slow(float v) {
#pragma unroll
    for (int o = 1; o < 64; o <<= 1) v += __shfl_xor(v, o);
    return v;
}
#define DPPF(x, ctrl) __builtin_bit_cast(float, __builtin_amdgcn_mov_dpp(__builtin_bit_cast(int, (x)), (ctrl), 0xf, 0xf, true))
__device__ __forceinline__ float wave_sum(float v) {
    v += DPPF(v, 0xB1); v += DPPF(v, 0x4E); v += DPPF(v, 0x141); v += DPPF(v, 0x140);
    const int iv = __builtin_bit_cast(int, v);
    const float r0 = __builtin_bit_cast(float, __builtin_amdgcn_readlane(iv, 0)), r1 = __builtin_bit_cast(float, __builtin_amdgcn_readlane(iv, 16)),
                r2 = __builtin_bit_cast(float, __builtin_amdgcn_readlane(iv, 32)), r3 = __builtin_bit_cast(float, __builtin_amdgcn_readlane(iv, 48));
    return (r0 + r1) + (r2 + r3);
}
__device__ __forceinline__ float wave_max(float v) {
#pragma unroll
    for (int o = 1; o < 64; o <<= 1) v = fmaxf(v, __shfl_xor(v, o));
    return v;
}
__device__ __forceinline__ int wave_min_i(int v) {
#pragma unroll
    for (int o = 1; o < 64; o <<= 1) { const int w = __shfl_xor(v, o); v = w < v ? w : v; }
    return v;
}
__device__ __forceinline__ float bflo(unsigned w) { return __uint_as_float(w << 16); }
__device__ __forceinline__ float bfhi(unsigned w) { return __uint_as_float(w & 0xffff0000u); }
__device__ __forceinline__ void unpk8(v4u w, float (&f)[8]) { f[0] = bflo(w.x); f[1] = bfhi(w.x); f[2] = bflo(w.y); f[3] = bfhi(w.y); f[4] = bflo(w.z); f[5] = bfhi(w.z); f[6] = bflo(w.w); f[7] = bfhi(w.w); }
__device__ __forceinline__ v4u pk8(const float (&f)[8]) { v4u o; o.x = pk2(f[0], f[1]); o.y = pk2(f[2], f[3]); o.z = pk2(f[4], f[5]); o.w = pk2(f[6], f[7]); return o; }
__device__ __forceinline__ float sigm_(float x) { return 1.0f / (1.0f + __expf(-x)); }
__device__ __forceinline__ float gelu_(float x) { const float u = 0.7978845608028654f * (x + 0.044715f * x * x * x); return x * sigm_(2.0f * u); }

__device__ __forceinline__ int rowmap(int n, int mode) {
    if (mode == 1) { if (n >= 2048 && n < 4096) { const int d = n & 63; return (n & ~63) + (d < 32 ? 8 * (d >> 2) + (d & 3) : 8 * ((d - 32) >> 2) + 4 + (d & 3)); } return n; }
    if (mode == 2) { return n < 1024 ? 8 * (n >> 2) + (n & 3) : 8 * ((n - 1024) >> 2) + 4 + (n & 3); }
    return n;
}
__device__ __forceinline__ void transpose_item(const float* W, int K, int N, bf16* WT, int mode, LAS float* scr, int item, int lane) {
    const int nblk = N / 32, kb = item / nblk, nb = item - kb * nblk, k0 = 64 * kb, n0 = 32 * nb;
    typedef float f2 __attribute__((ext_vector_type(2)));
    f2 v[16];
    const int lr = lane >> 4, lc = 2 * (lane & 15);
#pragma unroll
    for (int i = 0; i < 16; ++i) v[i] = *(const GAS f2*)(W + (size_t)(k0 + 4 * i + lr) * N + n0 + lc);
#pragma unroll
    for (int i = 0; i < 16; ++i) { scr[(4 * i + lr) * 33 + lc] = v[i].x; scr[(4 * i + lr) * 33 + lc + 1] = v[i].y; }
    LDS_WAIT(); asm volatile("" ::: "memory");
    const int c = lane & 7;
#pragma unroll
    for (int j = 0; j < 4; ++j) { const int n = (lane >> 3) + 8 * j; const LAS float* s = scr + (8 * c) * 33 + n;
        v4u o; o.x = pk2(s[0 * 33], s[1 * 33]); o.y = pk2(s[2 * 33], s[3 * 33]); o.z = pk2(s[4 * 33], s[5 * 33]); o.w = pk2(s[6 * 33], s[7 * 33]);
        *(GAS v4u*)(WT + (size_t)rowmap(n0 + n, mode) * K + k0 + 8 * c) = o; }
    LDS_WAIT(); asm volatile("" ::: "memory");
}
__device__ __forceinline__ void ln16(f32x4 (&v)[4], const float* g, const float* b, int lane) {
    float s = 0.f;
#pragma unroll
    for (int j = 0; j < 4; ++j) s += (v[j].x + v[j].y) + (v[j].z + v[j].w);
    const float mean = wave_sum(s) * (1.f / 1024.f); float s2 = 0.f;
#pragma unroll
    for (int j = 0; j < 4; ++j) { v[j] = v[j] - mean; s2 += (v[j].x * v[j].x + v[j].y * v[j].y) + (v[j].z * v[j].z + v[j].w * v[j].w); }
    const float rstd = 1.f / sqrtf(wave_sum(s2) * (1.f / 1024.f) + LN_EPS);
#pragma unroll
    for (int j = 0; j < 4; ++j) { const f32x4 gg = *(const GAS f32x4*)(g + 256 * j + 4 * lane), bb = *(const GAS f32x4*)(b + 256 * j + 4 * lane); v[j] = v[j] * rstd * gg + bb; }
}
__device__ __forceinline__ void store_row_f32_bf16(const f32x4 (&v)[4], float* hf, bf16* hb, int lane) {
#pragma unroll
    for (int j = 0; j < 4; ++j) { if (hf) *(GAS f32x4*)(hf + 256 * j + 4 * lane) = v[j];
        *(GAS unsigned long long*)(hb + 256 * j + 4 * lane) = (unsigned long long)pk2(v[j].x, v[j].y) | ((unsigned long long)pk2(v[j].z, v[j].w) << 32); }
}

__device__ __forceinline__ void ssm_build(Frame& F, const Args& A, int l, int g) {
    LAS float* L = (LAS float*)(F.lds + RING_OFF);
    LAS float* AP_re = L; LAS float* AP_im = L + 4160; LAS float* BB_re = L + 8320; LAS float* BB_im = L + 9344; LAS float* CC_re = L + 10368; LAS float* CC_im = L + 11392; LAS float* KM = L + 12416;
    const int lg = l * 32 + g; const int tid = F.tid;
    const float dt = __expf(A.in[I_LOGDT][lg]);
    for (int idx = tid; idx < 65 * 64; idx += 512) { const int j = idx >> 6, p = idx & 63; const float lr = A.in[I_LAMRE][lg * 64 + p], li = A.in[I_LAMIM][lg * 64 + p];
        const float mag = expf(lr * dt * (float)j), ang = li * dt * (float)j; AP_re[idx] = mag * cosf(ang); AP_im[idx] = mag * sinf(ang); }
    __syncthreads();
    for (int idx = tid; idx < 1024; idx += 512) {
        { const int p = idx >> 4, c = idx & 15; const float lr = A.in[I_LAMRE][lg * 64 + p], li = A.in[I_LAMIM][lg * 64 + p];
          const float ar = AP_re[64 + p], ai = AP_im[64 + p], nr = ar - 1.0f, den = lr * lr + li * li;
          const float cr = (nr * lr + ai * li) / den, ci = (ai * lr - nr * li) / den;
          const float br = A.in[I_BRE][(size_t)(lg * 64 + p) * 16 + c], bi = A.in[I_BIM][(size_t)(lg * 64 + p) * 16 + c];
          BB_re[idx] = cr * br - ci * bi; BB_im[idx] = cr * bi + ci * br; }
        { CC_re[idx] = A.in[I_CRE][(size_t)lg * 1024 + idx]; CC_im[idx] = A.in[I_CIM][(size_t)lg * 1024 + idx]; }
    }
    __syncthreads();
    for (int idx = tid; idx < 16384; idx += 512) { const int j = idx >> 8, co = (idx >> 4) & 15, ci = idx & 15; float s = 0.f;
        for (int p = 0; p < 64; ++p) { const float Ar = AP_re[j * 64 + p], Ai = AP_im[j * 64 + p], Br = BB_re[p * 16 + ci], Bi = BB_im[p * 16 + ci];
            const float er = Ar * Br - Ai * Bi, ei = Ar * Bi + Ai * Br; s += CC_re[co * 64 + p] * er - CC_im[co * 64 + p] * ei; }
        if (j == 0 && co == ci) s += A.in[I_SSMD][l * 512 + g * 16 + co];
        KM[idx] = s; }
    __syncthreads();
    bf16* TOE = (bf16*)(F.ws + WS_W + (size_t)l * WL_STRIDE + WL_TOE) + (size_t)g * 1024 * 1152;
    for (int q = tid; q < 1024 * 144; q += 512) { const int n = q / 144, kc = q - n * 144, t = n >> 4, co = n & 15; float f[8];
        if (kc < 128) { const int s = kc >> 1, ci0 = (kc & 1) * 8;
            if (s <= t) {
#pragma unroll
                for (int i = 0; i < 8; ++i) f[i] = KM[(t - s) * 256 + co * 16 + ci0 + i]; }
            else {
#pragma unroll
                for (int i = 0; i < 8; ++i) f[i] = 0.f; } }
        else { const int p0 = (kc - 128) * 8;
#pragma unroll
            for (int i = 0; i < 8; ++i) { const int p = (p0 + i) & 63; const float Cr = CC_re[co * 64 + p], Ci = CC_im[co * 64 + p], Ar = AP_re[(t + 1) * 64 + p], Ai = AP_im[(t + 1) * 64 + p];
                f[i] = p0 < 64 ? (Cr * Ar - Ci * Ai) : -(Cr * Ai + Ci * Ar); } }
        *(GAS v4u*)(TOE + (size_t)n * 1152 + kc * 8) = pk8(f); }
    bf16* WST = (bf16*)(F.ws + WS_W + (size_t)l * WL_STRIDE + WL_ST) + (size_t)g * 256 * 1024;
    for (int q = tid; q < 256 * 128; q += 512) { const int n = q >> 7, kc = q & 127, s = kc >> 1, ci0 = (kc & 1) * 8; float f[8];
        if (n < 128) { const int p = n & 63; const float Ar = AP_re[(63 - s) * 64 + p], Ai = AP_im[(63 - s) * 64 + p];
#pragma unroll
            for (int i = 0; i < 8; ++i) { const float Br = BB_re[p * 16 + ci0 + i], Bi = BB_im[p * 16 + ci0 + i]; f[i] = n < 64 ? (Ar * Br - Ai * Bi) : (Ar * Bi + Ai * Br); } }
        else {
#pragma unroll
            for (int i = 0; i < 8; ++i) f[i] = 0.f; }
        *(GAS v4u*)(WST + (size_t)n * 1024 + kc * 8) = pk8(f); }
    float* SC = (float*)(F.ws + WS_SSMC + (size_t)l * MiB);
    if (tid < 64) { const int p = tid; SC[(lg * 64 + p) * 2] = AP_re[64 + p]; SC[(lg * 64 + p) * 2 + 1] = AP_im[64 + p];
        SC[16384 + (lg * 64 + p) * 2] = AP_re[64 * 64 + p]; SC[16384 + (lg * 64 + p) * 2 + 1] = AP_im[64 * 64 + p]; }
    for (int idx = tid; idx < 1024; idx += 512) { const int p = idx >> 4, c = idx & 15; SC[32768 + (size_t)(lg * 64 + p) * 32 + c] = BB_re[idx]; SC[32768 + (size_t)(lg * 64 + p) * 32 + 16 + c] = BB_im[idx]; }
    __syncthreads();
}

__device__ __forceinline__ void p0_prologue(Frame& F, const Args& A) {
    for (int job = F.vcu; job < NLAYER * 32; job += F.G) ssm_build(F, A, job >> 5, job & 31);
    const int gw = F.vcu * NWAVES + F.wave, NGW = F.G * NWAVES, lane = F.lane;
    float* HF = (float*)(F.ws + WS_HF); bf16* HB = (bf16*)(F.ws + WS_HB);
    for (int R = gw; R < MVALID; R += NGW) { const float* src = R < MREAL ? A.in[I_X] + (size_t)R * 1024 : A.in[I_META] + (size_t)((R - MREAL) & 15) * 1024;
        f32x4 v[4];
#pragma unroll
        for (int j = 0; j < 4; ++j) v[j] = *(const GAS f32x4*)(src + 256 * j + 4 * lane);
        ln16(v, A.in[I_LNIN_G], A.in[I_LNIN_B], lane); store_row_f32_bf16(v, nullptr, HB + (size_t)R * 1024, lane); }
    { float* ROPE = (float*)(F.ws + WS_ROPE); const int gt = F.vcu * 512 + F.tid, NGT = F.G * 512;
      for (int idx = gt; idx < 8208 * 32; idx += NGT) { const int pos = idx >> 5, j = idx & 31; const float inv = exp2f(-(float)j * (13.287712379549449f / 32.0f)); const float ang = (float)pos * inv;
          ROPE[(size_t)pos * 64 + j] = cosf(ang); ROPE[(size_t)pos * 64 + 32 + j] = sinf(ang); } }
    { bf16* KB = (bf16*)(F.ws + WS_K); bf16* VB = (bf16*)(F.ws + WS_V);
      for (int r = gw; r < 512; r += NGW) { bf16* base = (r & 256) ? VB : KB; const int b = (r >> 7) & 1, rr = r & 127; GAS v4u* d = (GAS v4u*)(base + (size_t)(b * 8320 + 8192 + rr) * 1024);
          d[lane] = (v4u){0u, 0u, 0u, 0u}; d[64 + lane] = (v4u){0u, 0u, 0u, 0u}; } }
    LAS float* scr = (LAS float*)(F.lds + RING_OFF + F.wave * 16384);
    constexpr int IT_IN = 16 * 160, IT_GATE = 16 * 96, IT_GLU = 8 * 16, IT_SO = 8 * 32, IT_CO = 8 * 32, IT_AO = 16 * 32, IT_WO = 16 * 32, IT_GU1 = 16 * 64, IT_DN1 = 16 * 32;
    constexpr int IT_L = IT_IN + IT_GATE + IT_GLU + IT_SO + IT_CO + IT_AO + IT_WO + 32 * IT_GU1 + 32 * IT_DN1;
    constexpr int TK = 8, NTK = (NLAYER * IT_L + TK - 1) / TK;
    for (;;) {
        int tk = 0; if (lane == 0) tk = (int)__hip_atomic_fetch_add(F.ctl + 3072, 1u, RLX_AGENT); tk = __builtin_amdgcn_readfirstlane(tk);
        if (tk >= NTK) break;
      for (int it = tk * TK; it < (tk + 1) * TK && it < NLAYER * IT_L; ++it) {
        const int l = it / IT_L; int r = it - l * IT_L; unsigned char* wl = F.ws + WS_W + (size_t)l * WL_STRIDE;
        if (r < IT_IN) { transpose_item(A.in[I_WIN] + (size_t)l * 1024 * 5120, 1024, 5120, (bf16*)(wl + WL_IN), 1, scr, r, lane); continue; } r -= IT_IN;
        if (r < IT_GATE) { transpose_item(A.in[I_GATEW] + (size_t)l * 1024 * 3072, 1024, 3072, (bf16*)(wl + WL_IN) + (size_t)5120 * 1024, 0, scr, r, lane); continue; } r -= IT_GATE;
        if (r < IT_GLU) { transpose_item(A.in[I_WGLU] + (size_t)l * 512 * 512, 512, 512, (bf16*)(wl + WL_GLU), 0, scr, r, lane); continue; } r -= IT_GLU;
        if (r < IT_SO) { transpose_item(A.in[I_SSMWO] + (size_t)l * 512 * 1024, 512, 1024, (bf16*)(wl + WL_SO), 0, scr, r, lane); continue; } r -= IT_SO;
        if (r < IT_CO) { transpose_item(A.in[I_CONVWO] + (size_t)l * 512 * 1024, 512, 1024, (bf16*)(wl + WL_CO), 0, scr, r, lane); continue; } r -= IT_CO;
        if (r < IT_AO) { transpose_item(A.in[I_ATTNWO] + (size_t)l * 1024 * 1024, 1024, 1024, (bf16*)(wl + WL_AO), 0, scr, r, lane); continue; } r -= IT_AO;
        if (r < IT_WO) { transpose_item(A.in[I_WO] + (size_t)l * 1024 * 1024, 1024, 1024, (bf16*)(wl + WL_WO), 0, scr, r, lane); continue; } r -= IT_WO;
        if (r < 32 * IT_GU1) { const int e = r / IT_GU1; transpose_item(A.in[I_WGU] + ((size_t)l * 32 + e) * 1024 * 2048, 1024, 2048, (bf16*)(wl + WL_GU) + (size_t)e * 2048 * 1024, 2, scr, r - e * IT_GU1, lane); continue; } r -= 32 * IT_GU1;
        { const int e = r / IT_DN1; transpose_item(A.in[I_WDN] + ((size_t)l * 32 + e) * 1024 * 1024, 1024, 1024, (bf16*)(wl + WL_DN) + (size_t)e * 1024 * 1024, 0, scr, r - e * IT_DN1, lane); }
    } }
}

__device__ __forceinline__ int prev_row(int R, int k) {
    if (R < MREAL) { const int t = R & 8191, b = R >> 13; return t >= k ? R - k : MREAL + b * 16 + 16 - (k - t); }
    const int i = (R - MREAL) & 15; return i >= k ? R - k : -1;
}
__device__ __forceinline__ void conv_rows(Frame& F, const Args& A, int l) {
    const int bidc = (int)blockIdx.x; if (bidc < 128) return;
    const int gw = (bidc - 128) * NWAVES + F.wave, NGW = (F.G - 128) * NWAVES, lane = F.lane, c0 = 8 * lane;
    const bf16* CB = (const bf16*)(F.ws + WS_CONV); bf16* YC = (bf16*)(F.ws + WS_YC);
    float w0[8], w1[8], w2[8];
#pragma unroll
    for (int i = 0; i < 8; ++i) { w0[i] = A.in[I_CONVW][(size_t)l * 1536 + c0 + i]; w1[i] = A.in[I_CONVW][(size_t)l * 1536 + 512 + c0 + i]; w2[i] = A.in[I_CONVW][(size_t)l * 1536 + 1024 + c0 + i]; }
    for (int R = gw; R < MVALID; R += NGW) {
        const int r1 = prev_row(R, 1), r2 = prev_row(R, 2);
        float gb[8], a[8], h[8], z0[8], z1[8], z2[8];
        unpk8(*(const GAS v4u*)(CB + (size_t)R * 1536 + c0), gb);
        unpk8(*(const GAS v4u*)(CB + (size_t)R * 1536 + 512 + c0), a); unpk8(*(const GAS v4u*)(CB + (size_t)R * 1536 + 1024 + c0), h);
#pragma unroll
        for (int i = 0; i < 8; ++i) z0[i] = a[i] * h[i];
        if (r1 >= 0) { unpk8(*(const GAS v4u*)(CB + (size_t)r1 * 1536 + 512 + c0), a); unpk8(*(const GAS v4u*)(CB + (size_t)r1 * 1536 + 1024 + c0), h);
#pragma unroll
            for (int i = 0; i < 8; ++i) z1[i] = a[i] * h[i]; }
        else {
#pragma unroll
            for (int i = 0; i < 8; ++i) z1[i] = 0.f; }
        if (r2 >= 0) { unpk8(*(const GAS v4u*)(CB + (size_t)r2 * 1536 + 512 + c0), a); unpk8(*(const GAS v4u*)(CB + (size_t)r2 * 1536 + 1024 + c0), h);
#pragma unroll
            for (int i = 0; i < 8; ++i) z2[i] = a[i] * h[i]; }
        else {
#pragma unroll
            for (int i = 0; i < 8; ++i) z2[i] = 0.f; }
        float y[8];
#pragma unroll
        for (int i = 0; i < 8; ++i) y[i] = gb[i] * (w0[i] * z2[i] + w1[i] * z1[i] + w2[i] * z0[i]);
        *(GAS v4u*)(YC + (size_t)R * 512 + c0) = pk8(y);
    }
}
__device__ __forceinline__ void ssm_meta_job(Frame& F, const Args& A, int l, int bm, int g, LAS float* scr, LAS float* smo) {
    const int lane = F.lane, lg = l * 32 + g;
    const float* SC = (const float*)(F.ws + WS_SSMC + (size_t)l * MiB);
    const bf16* UM = (const bf16*)(F.ws + WS_UMETA); bf16* YG = (bf16*)(F.ws + WS_YG);
    LAS float* CR = scr + 2048; LAS float* CI = scr + 3072;
    { const GAS f32x4* cr = (const GAS f32x4*)(A.in[I_CRE] + (size_t)lg * 1024) + lane * 4; const GAS f32x4* ci = (const GAS f32x4*)(A.in[I_CIM] + (size_t)lg * 1024) + lane * 4;
      f32x4 t0[4], t1[4];
#pragma unroll
      for (int i = 0; i < 4; ++i) { t0[i] = cr[i]; t1[i] = ci[i]; }
#pragma unroll
      for (int i = 0; i < 4; ++i) { *(LAS f32x4*)(CR + lane * 16 + 4 * i) = t0[i]; *(LAS f32x4*)(CI + lane * 16 + 4 * i) = t1[i]; } }
    const float ar = SC[(lg * 64 + lane) * 2], ai = SC[(lg * 64 + lane) * 2 + 1];
    float bbr[16], bbi[16];
    { const GAS f32x4* bp = (const GAS f32x4*)(SC + 32768 + (size_t)(lg * 64 + lane) * 32);
#pragma unroll
      for (int i = 0; i < 4; ++i) { const f32x4 r = bp[i], m = bp[4 + i]; bbr[4 * i] = r.x; bbr[4 * i + 1] = r.y; bbr[4 * i + 2] = r.z; bbr[4 * i + 3] = r.w; bbi[4 * i] = m.x; bbi[4 * i + 1] = m.y; bbi[4 * i + 2] = m.z; bbi[4 * i + 3] = m.w; } }
    float xr = 0.f, xi = 0.f;
#pragma unroll
    for (int hh = 0; hh < 2; ++hh) { v4u ua[8], ub[8];
#pragma unroll
        for (int s = 0; s < 8; ++s) { const bf16* up = UM + (size_t)(bm * 16 + hh * 8 + s) * 512 + g * 16; ua[s] = *(const GAS v4u*)up; ub[s] = *(const GAS v4u*)(up + 8); }
#pragma unroll
        for (int s = 0; s < 8; ++s) { float fa[8], fb[8]; unpk8(ua[s], fa); unpk8(ub[s], fb); float bur = 0.f, bui = 0.f;
#pragma unroll
            for (int c = 0; c < 8; ++c) { bur += bbr[c] * fa[c] + bbr[8 + c] * fb[c]; bui += bbi[c] * fa[c] + bbi[8 + c] * fb[c]; }
            const float nr = ar * xr - ai * xi + bur, ni = ar * xi + ai * xr + bui; xr = nr; xi = ni;
            const int ss = hh * 8 + s; scr[ss * 128 + ((lane + ss) & 63)] = xr; scr[ss * 128 + 64 + ((lane + ss) & 63)] = xi; } }
    smo[lane] = xr; smo[64 + lane] = xi;
    LDS_WAIT(); asm volatile("" ::: "memory");
    const int s = lane >> 2, coq = (lane & 3) * 4; float y[4] = {0.f, 0.f, 0.f, 0.f};
    for (int p = 0; p < 64; ++p) { const float vr = scr[s * 128 + ((p + s) & 63)], vi = scr[s * 128 + 64 + ((p + s) & 63)];
#pragma unroll
        for (int i = 0; i < 4; ++i) y[i] += CR[(coq + i) * 64 + p] * vr - CI[(coq + i) * 64 + p] * vi; }
    const unsigned long long uw = *(const GAS unsigned long long*)(UM + (size_t)(bm * 16 + s) * 512 + g * 16 + coq);
    const f32x4 dv = *(const GAS f32x4*)(A.in[I_SSMD] + l * 512 + g * 16 + coq);
    y[0] += dv.x * bflo((unsigned)uw); y[1] += dv.y * bfhi((unsigned)uw); y[2] += dv.z * bflo((unsigned)(uw >> 32)); y[3] += dv.w * bfhi((unsigned)(uw >> 32));
    const unsigned long long o = (unsigned long long)pk2(gelu_(y[0]), gelu_(y[1])) | ((unsigned long long)pk2(gelu_(y[2]), gelu_(y[3])) << 32);
    *(GAS unsigned long long*)(YG + (size_t)(MREAL + bm * 16 + s) * 512 + g * 16 + coq) = o;
    LDS_WAIT(); asm volatile("" ::: "memory");
}
__device__ __forceinline__ void ssm_pre_job(Frame& F, const Args& A, int l, int b, int g) {
    typedef float f32x16_ __attribute__((ext_vector_type(16)));
    const int lane = F.lane, wave = F.wave, lg = l * 32 + g;
    LAS float* scr = (LAS float*)(F.lds + RING_OFF);
    LAS float* smo = scr + 4096;
    LAS float* SLl = scr + 8192;
    if (wave == 0) ssm_meta_job(F, A, l, b, g, scr, smo);
    const bf16* UC = (const bf16*)(F.ws + WS_UC) + ((size_t)g * 256 + b * 128) * 1152; const bf16* WST = (const bf16*)(F.ws + WS_W + (size_t)l * WL_STRIDE + WL_ST) + (size_t)g * 256 * 1024;
    const int r32 = lane & 31, hi = lane >> 5;
#pragma unroll 1
    for (int blk = wave; blk < 16; blk += NWAVES) { const int rb = blk >> 2, cb = blk & 3;
        const GAS bf16x8* ap = (const GAS bf16x8*)(UC + (size_t)(rb * 32 + r32) * 1152 + hi * 8); const GAS bf16x8* bp = (const GAS bf16x8*)(WST + (size_t)(cb * 32 + r32) * 1024 + hi * 8);
        f32x16_ acc = {};
#pragma unroll 1
        for (int k0 = 0; k0 < 64; k0 += 16) { bf16x8 a[16], bb[16];
#pragma unroll
            for (int i = 0; i < 16; ++i) { a[i] = ap[(k0 + i) * 2]; bb[i] = bp[(k0 + i) * 2]; }
#pragma unroll
            for (int i = 0; i < 16; ++i) acc = __builtin_amdgcn_mfma_f32_32x32x16_bf16(a[i], bb[i], acc, 0, 0, 0); }
#pragma unroll
        for (int r = 0; r < 16; ++r) SLl[(rb * 32 + (r & 3) + 8 * (r >> 2) + 4 * hi) * 128 + cb * 32 + r32] = acc[r]; }
    __syncthreads();
    if (F.tid < 64) { const int p = F.tid; const float* SC = (const float*)(F.ws + WS_SSMC + (size_t)l * MiB); bf16* UCw = (bf16*)(F.ws + WS_UC) + ((size_t)g * 256 + b * 128) * 1152;
        const float a64r = SC[16384 + (lg * 64 + p) * 2], a64i = SC[16384 + (lg * 64 + p) * 2 + 1];
        float Sr = smo[p], Si = smo[64 + p];
#pragma unroll 8
        for (int k = 0; k < 128; ++k) { *(GAS bf16*)(UCw + (size_t)k * 1152 + 1024 + p) = (bf16)f2bf(Sr); *(GAS bf16*)(UCw + (size_t)k * 1152 + 1088 + p) = (bf16)f2bf(Si);
            const float lr = SLl[k * 128 + p], li = SLl[k * 128 + 64 + p]; const float nr = a64r * Sr - a64i * Si + lr, ni = a64r * Si + a64i * Sr + li; Sr = nr; Si = ni; } }
    __syncthreads();
}
__device__ __forceinline__ void attn_meta_job(Frame& F, int Rm, int h) {
    const int lane = F.lane, bm = Rm >> 4, R = MREAL + Rm, j = lane >> 2, dq = lane & 3;
    const bf16* Q = (const bf16*)(F.ws + WS_Q); const bf16* K = (const bf16*)(F.ws + WS_K); const bf16* V = (const bf16*)(F.ws + WS_V); bf16* OC = (bf16*)(F.ws + WS_OC);
    const size_t krow = (size_t)bm * 8320 + 8256;
#pragma unroll
    for (int c = 0; c < 2; ++c) { const int hc = h * 2 + c; float qa[8], qb[8], ka[8], kb[8];
        unpk8(*(const GAS v4u*)(Q + (size_t)R * 1024 + hc * 64 + dq * 16), qa); unpk8(*(const GAS v4u*)(Q + (size_t)R * 1024 + hc * 64 + dq * 16 + 8), qb);
        unpk8(*(const GAS v4u*)(K + (krow + j) * 1024 + hc * 64 + dq * 16), ka); unpk8(*(const GAS v4u*)(K + (krow + j) * 1024 + hc * 64 + dq * 16 + 8), kb);
        float s = 0.f;
#pragma unroll
        for (int i = 0; i < 8; ++i) s += qa[i] * ka[i] + qb[i] * kb[i];
        s += __shfl_xor(s, 1); s += __shfl_xor(s, 2);
        float m = s;
#pragma unroll
        for (int o = 4; o < 64; o <<= 1) m = fmaxf(m, __shfl_xor(m, o));
        const float pj = exp2f(s - m); float lsum = pj;
#pragma unroll
        for (int o = 4; o < 64; o <<= 1) lsum += __shfl_xor(lsum, o);
        float o0 = 0.f, o1 = 0.f;
#pragma unroll
        for (int jj = 0; jj < 16; ++jj) { const float pp = __shfl(pj, 4 * jj); const unsigned vv = *(const GAS unsigned*)(V + (krow + jj) * 1024 + h * 128 + 2 * lane); o0 += pp * bflo(vv); o1 += pp * bfhi(vv); }
        const float rl = 1.0f / lsum;
        *(GAS unsigned*)(OC + (size_t)R * 2048 + hc * 128 + 2 * lane) = pk2(o0 * rl, o1 * rl); }
}
__device__ __forceinline__ void attn_combine_rows(Frame& F, const Args& A, int l) {
    const int gw = F.vcu * NWAVES + F.wave, NGW = F.G * NWAVES, lane = F.lane;
    const bf16* OC = (const bf16*)(F.ws + WS_OC); bf16* YA = (bf16*)(F.ws + WS_YA);
    const float lam_init = 0.8f - 0.6f * expf(-0.3f * (float)l);
    const float d1 = wave_sum(A.in[I_LQ1][l * 64 + lane] * A.in[I_LK1][l * 64 + lane]), d2 = wave_sum(A.in[I_LQ2][l * 64 + lane] * A.in[I_LK2][l * 64 + lane]);
    const float lam = expf(d1) - expf(d2) + lam_init;
    const int e0 = (lane & 15) * 8; float sg[8];
#pragma unroll
    for (int i = 0; i < 8; ++i) sg[i] = A.in[I_SUBLN][l * 128 + e0 + i] * (1.0f - lam_init);
    for (int R = gw; R < MVALID; R += NGW) {
#pragma unroll
        for (int pass = 0; pass < 2; ++pass) { const int h = pass * 4 + (lane >> 4); float a[8], b[8], d[8];
            unpk8(*(const GAS v4u*)(OC + (size_t)R * 2048 + (2 * h) * 128 + e0), a); unpk8(*(const GAS v4u*)(OC + (size_t)R * 2048 + (2 * h + 1) * 128 + e0), b);
            float ss = 0.f;
#pragma unroll
            for (int i = 0; i < 8; ++i) { d[i] = a[i] - lam * b[i]; ss += d[i] * d[i]; }
            ss += __shfl_xor(ss, 1); ss += __shfl_xor(ss, 2); ss += __shfl_xor(ss, 4); ss += __shfl_xor(ss, 8);
            const float rs = 1.0f / sqrtf(ss * (1.0f / 128.0f) + 1e-5f);
#pragma unroll
            for (int i = 0; i < 8; ++i) d[i] = d[i] * rs * sg[i];
            *(GAS v4u*)(YA + (size_t)R * 1024 + h * 128 + e0) = pk8(d); }
    }
}
__device__ __forceinline__ float router_reduce(const float (&acc)[32], int lane) {
    float a16[16], a8[8], a4[4], a2[2], a1;
    { const bool hi = lane & 32;
#pragma unroll
      for (int i = 0; i < 16; ++i) { const float keep = hi ? acc[i + 16] : acc[i], give = hi ? acc[i] : acc[i + 16]; a16[i] = keep + __shfl_xor(give, 32); } }
    { const bool hi = lane & 16;
#pragma unroll
      for (int i = 0; i < 8; ++i) { const float keep = hi ? a16[i + 8] : a16[i], give = hi ? a16[i] : a16[i + 8]; a8[i] = keep + __shfl_xor(give, 16); } }
    { const bool hi = lane & 8;
#pragma unroll
      for (int i = 0; i < 4; ++i) { const float keep = hi ? a8[i + 4] : a8[i], give = hi ? a8[i] : a8[i + 4]; a4[i] = keep + __shfl_xor(give, 8); } }
    { const bool hi = lane & 4;
#pragma unroll
      for (int i = 0; i < 2; ++i) { const float keep = hi ? a4[i + 2] : a4[i], give = hi ? a4[i] : a4[i + 2]; a2[i] = keep + __shfl_xor(give, 4); } }
    { const bool hi = lane & 2; const float keep = hi ? a2[1] : a2[0], give = hi ? a2[0] : a2[1]; a1 = keep + DPPF(give, 0x4E); }
    return a1 + DPPF(a1, 0xB1);
}
__device__ __forceinline__ void router_top4(float val, int R, int lane, float* TOKW, unsigned* recg, int nrec, int& ecnt) {
    const int e_me = lane >> 1, iv = __builtin_bit_cast(int, val); int rank = 0;
#pragma unroll
    for (int e = 0; e < 32; ++e) { const float s = __builtin_bit_cast(float, __builtin_amdgcn_readlane(iv, 2 * e)); rank += ((s > val) || (s == val && e < e_me)) ? 1 : 0; }
    float tv[4]; int te[4];
#pragma unroll
    for (int k = 0; k < 4; ++k) { const unsigned long long m = __ballot(rank == k && !(lane & 1)); const int L = __builtin_amdgcn_readfirstlane((int)__ffsll((long long)m) - 1);
        te[k] = L >> 1; tv[k] = __builtin_bit_cast(float, __builtin_amdgcn_readlane(iv, L)); }
    ecnt += (te[0] == lane) + (te[1] == lane) + (te[2] == lane) + (te[3] == lane);
    const float p1 = __expf(tv[1] - tv[0]), p2 = __expf(tv[2] - tv[0]), p3 = __expf(tv[3] - tv[0]), rs = 1.0f / (1.0f + p1 + p2 + p3);
    if (lane < 4) { const int k = lane; const int e = k == 0 ? te[0] : k == 1 ? te[1] : k == 2 ? te[2] : te[3]; const float w = (k == 0 ? 1.0f : k == 1 ? p1 : k == 2 ? p2 : p3) * rs;
        TOKW[(size_t)R * 4 + k] = w; recg[(nrec * 4 + k) * 2] = (unsigned)R; recg[(nrec * 4 + k) * 2 + 1] = (unsigned)e; }
}
__device__ __forceinline__ void ln1_router(Frame& F, const Args& A, int l) {
    const int tid = F.tid, lane = F.lane, wave = F.wave, gw = F.vcu * NWAVES + wave, NGW = F.G * NWAVES;
    LAS float* WT = (LAS float*)(F.lds + RING_OFF);
    const float* rw = A.in[I_RW] + (size_t)l * 1024 * 32;
    for (int idx = tid; idx < 32768; idx += 512) WT[(idx & 31) * 1024 + (idx >> 5)] = rw[idx];
    __syncthreads();
    const float* PRE = (const float*)(F.ws + WS_PRE); float* HF = (float*)(F.ws + WS_HF); bf16* HB = (bf16*)(F.ws + WS_HB);
    float* TOKW = (float*)(F.ws + WS_TOKW);
    unsigned* recg = (unsigned*)(F.ws + WS_ROWIDX + 131072) + (size_t)gw * 80;
    const float rb = A.in[I_RB][l * 32 + (lane >> 1)];
    int nrec = 0, ecnt = 0;
#pragma unroll 1
    for (int R0 = gw; R0 < MVALID; R0 += 2 * NGW) {
        const int R1 = R0 + NGW; const bool two = R1 < MVALID; const int R1c = two ? R1 : R0;
        f32x4 v0[4], v1[4];
#pragma unroll
        for (int j = 0; j < 4; ++j) { v0[j] = *(const GAS f32x4*)(PRE + (size_t)R0 * 1024 + 256 * j + 4 * lane); v1[j] = *(const GAS f32x4*)(PRE + (size_t)R1c * 1024 + 256 * j + 4 * lane); }
        ln16(v0, A.in[I_LN1G] + l * 1024, A.in[I_LN1B] + l * 1024, lane); ln16(v1, A.in[I_LN1G] + l * 1024, A.in[I_LN1B] + l * 1024, lane);
        store_row_f32_bf16(v0, nullptr, HB + (size_t)R0 * 1024, lane);
        if (two) store_row_f32_bf16(v1, nullptr, HB + (size_t)R1 * 1024, lane);
        float acc0[32], acc1[32];
#pragma unroll
        for (int e = 0; e < 32; ++e) { float s0 = 0.f, s1 = 0.f;
#pragma unroll
            for (int j = 0; j < 4; ++j) { const f32x4 w = *(const LAS f32x4*)(WT + e * 1024 + 256 * j + 4 * lane);
                s0 += (v0[j].x * w.x + v0[j].y * w.y) + (v0[j].z * w.z + v0[j].w * w.w); s1 += (v1[j].x * w.x + v1[j].y * w.y) + (v1[j].z * w.z + v1[j].w * w.w); }
            acc0[e] = s0; acc1[e] = s1; }
        const float val0 = router_reduce(acc0, lane) + rb, val1 = router_reduce(acc1, lane) + rb;
        router_top4(val0, R0, lane, TOKW, recg, nrec, ecnt); ++nrec;
        if (two) { router_top4(val1, R1, lane, TOKW, recg, nrec, ecnt); ++nrec; }
        asm volatile("" ::: "memory");
    }
    if (lane == 0) ((int*)(F.ws + WS_ROWIDX + 65536))[gw] = nrec * 4;
    if (lane < 32) ((int*)(F.ws + WS_ROWIDX + 1048576))[(size_t)gw * 32 + lane] = ecnt;
    { LAS int* bc = (LAS int*)(F.lds + LDSCTL_OFF);
      if (tid < 32) bc[tid] = 0;
      __syncthreads();
      if (lane < 32) __hip_atomic_fetch_add(&bc[lane], ecnt, __ATOMIC_RELAXED, __HIP_MEMORY_SCOPE_WORKGROUP);
      __syncthreads();
      if (tid < 32) ((int*)(F.ws + WS_ROWIDX + 2097152))[(size_t)F.vcu * 32 + tid] = bc[tid];
      __syncthreads(); }
}
__device__ __forceinline__ void moe_tables(Frame& F, int l, bool with_bases = false) {
    LAS int* tb = (LAS int*)(F.lds + LDSCTL_OFF); LAS int* cn = tb + 34;
    LAS int* part = (LAS int*)(F.lds + RING_OFF);
    LAS int* wb = part + 1024;
    const int* WCNT = (const int*)(F.ws + WS_ROWIDX + 1048576);
    const int NGW = F.G * NWAVES, gw0 = F.vcu * NWAVES;
    __syncthreads();
    { const int e = F.tid & 31, pt = F.tid >> 5; int tot = 0, base = 0; const int per = F.G / 16; const int* BCNT = (const int*)(F.ws + WS_ROWIDX + 2097152); int cv[16];
#pragma unroll
      for (int i = 0; i < 16; ++i) cv[i] = (i < per) ? BCNT[(size_t)(pt * per + i) * 32 + e] : 0;
#pragma unroll
      for (int i = 0; i < 16; ++i) { tot += cv[i]; if (pt * per + i < F.vcu) base += cv[i]; }
      part[pt * 32 + e] = tot; part[512 + pt * 32 + e] = base; }
    __syncthreads();
    if (F.tid < 32) { int tot = 0, base = 0;
#pragma unroll
        for (int pt = 0; pt < 16; ++pt) { tot += part[pt * 32 + F.tid]; base += part[512 + pt * 32 + F.tid]; }
        cn[F.tid] = tot;
        if (with_bases) { for (int w = 0; w < NWAVES; ++w) { wb[w * 32 + F.tid] = base; base += WCNT[(size_t)(gw0 + w) * 32 + F.tid]; } } }
    __syncthreads();
    if (F.tid == 0) { int s = 0; for (int e = 0; e < 32; ++e) { tb[e] = s; s += (cn[e] + 255) >> 8; } tb[32] = s; }
    __syncthreads();
}
__device__ __forceinline__ void moe_gather(Frame& F) {
    const LAS int* tb = (const LAS int*)(F.lds + LDSCTL_OFF); const LAS int* wb = (const LAS int*)(F.lds + RING_OFF) + 1024 + F.wave * 32;
    const int gw = F.vcu * NWAVES + F.wave, lane = F.lane;
    const bf16* HB = (const bf16*)(F.ws + WS_HB); bf16* XG = (bf16*)(F.ws + WS_XG); unsigned* TOKE = (unsigned*)(F.ws + WS_TOKE);
    const unsigned* recg = (const unsigned*)(F.ws + WS_ROWIDX + 131072) + (size_t)gw * 80; const int n = ((const int*)(F.ws + WS_ROWIDX + 65536))[gw];
    const int my_e = lane < n ? (int)recg[lane * 2 + 1] : -1, my_R = lane < n ? (int)recg[lane * 2] : 0;
    int before = 0; for (int j = 0; j < n; ++j) { const int ej = __builtin_amdgcn_readlane(my_e, j); before += (j < lane && ej == my_e) ? 1 : 0; }
    const int my_pos = lane < n ? wb[my_e] + before : 0;
    if (lane < n) TOKE[(size_t)my_R * 4 + (lane & 3)] = (unsigned)my_e | ((unsigned)my_pos << 8);
    for (int i = 0; i < n; ++i) { const int e = __builtin_amdgcn_readlane(my_e, i), R = __builtin_amdgcn_readlane(my_R, i), pos = __builtin_amdgcn_readlane(my_pos, i);
        const size_t crow = (size_t)tb[e] * 256 + pos; const GAS v4u* sp = (const GAS v4u*)(HB + (size_t)R * 1024); GAS v4u* dp = (GAS v4u*)(XG + crow * 1024);
        const v4u a = sp[lane], b = sp[64 + lane]; dp[lane] = a; dp[64 + lane] = b; }
}
__device__ __forceinline__ void ln2_rows(Frame& F, const Args& A, int l) {
    const LAS int* tb = (const LAS int*)(F.lds + LDSCTL_OFF);
    const int gw = F.vcu * NWAVES + F.wave, NGW = F.G * NWAVES, lane = F.lane;
    float* HF = (float*)(F.ws + WS_HF); bf16* HB = (bf16*)(F.ws + WS_HB); const bf16* OUTS = (const bf16*)(F.ws + WS_OUTS);
    const float* TOKW = (const float*)(F.ws + WS_TOKW); const unsigned* TOKE = (const unsigned*)(F.ws + WS_TOKE);
    for (int R0 = gw; R0 < MVALID; R0 += 2 * NGW) {
        const int R1 = R0 + NGW; const bool two = R1 < MVALID; const int Rr[2] = {R0, two ? R1 : R0};
        f32x4 v[2][4]; unsigned long long o[2][4][4]; float w[2][4];
#pragma unroll
        for (int q = 0; q < 2; ++q) {
            const v4u te4 = *(const GAS v4u*)(TOKE + (size_t)Rr[q] * 4); const f32x4 w4 = *(const GAS f32x4*)(TOKW + (size_t)Rr[q] * 4);
            const unsigned te[4] = {te4.x, te4.y, te4.z, te4.w}; w[q][0] = w4.x; w[q][1] = w4.y; w[q][2] = w4.z; w[q][3] = w4.w;
#pragma unroll
            for (int j = 0; j < 4; ++j) { const unsigned long long hw = *(const GAS unsigned long long*)(HB + (size_t)Rr[q] * 1024 + 256 * j + 4 * lane); v[q][j] = (f32x4){bflo((unsigned)hw), bfhi((unsigned)hw), bflo((unsigned)(hw >> 32)), bfhi((unsigned)(hw >> 32))}; }
#pragma unroll
            for (int k = 0; k < 4; ++k) { const size_t crow = (size_t)tb[te[k] & 255] * 256 + (te[k] >> 8);
#pragma unroll
                for (int j = 0; j < 4; ++j) o[q][k][j] = *(const GAS unsigned long long*)(OUTS + crow * 1024 + 256 * j + 4 * lane); } }
#pragma unroll
        for (int q = 0; q < 2; ++q) {
#pragma unroll
            for (int j = 0; j < 4; ++j) v[q][j] = v[q][j] * ALPHA;
#pragma unroll
            for (int k = 0; k < 4; ++k)
#pragma unroll
                for (int j = 0; j < 4; ++j) { const unsigned lo = (unsigned)o[q][k][j], hi = (unsigned)(o[q][k][j] >> 32); const float ww = w[q][k];
                    v[q][j].x += ww * bflo(lo); v[q][j].y += ww * bfhi(lo); v[q][j].z += ww * bflo(hi); v[q][j].w += ww * bfhi(hi); }
            ln16(v[q], A.in[I_LN2G] + l * 1024, A.in[I_LN2B] + l * 1024, lane);
#if defined(SELFCHK)
            if (l == NLAYER - 1) { const unsigned mask = __hip_atomic_load(F.ctl + 2048, RLX_AGENT); if (mask) { const float pv = (float)(1u << (__ffs((int)mask) - 1));
#pragma unroll
                for (int j = 0; j < 4; ++j) v[q][j] = (f32x4){pv, pv, pv, pv}; } }
#endif
            if (q == 0 || two) { const int R = Rr[q];
                if (l == NLAYER - 1) { if (R < MREAL) {
#pragma unroll
                        for (int j = 0; j < 4; ++j) *(GAS f32x4*)(A.out + (size_t)R * 1024 + 256 * j + 4 * lane) = v[q][j]; } }
                else store_row_f32_bf16(v[q], nullptr, HB + (size_t)R * 1024, lane); }
        }
    }
}

typedef float f32x16 __attribute__((ext_vector_type(16)));
__device__ __forceinline__ f32x16 skinny32_part(const bf16* A, int lda, const bf16* Bt, int ldb, int K, int cb, int lane, int wave, f32x16 acc) {
    const int r32 = lane & 31, hi = lane >> 5, ks = K / 16 / NWAVES;
    const GAS bf16x8* ap = (const GAS bf16x8*)(A + (size_t)r32 * lda + hi * 8) + (size_t)wave * ks * 2;
    const GAS bf16x8* bp = (const GAS bf16x8*)(Bt + (size_t)(cb * 32 + r32) * ldb + hi * 8) + (size_t)wave * ks * 2;
    bf16x8 a[8], b[8];
#pragma unroll
    for (int i = 0; i < 8; ++i) if (i < ks) { a[i] = ap[i * 2]; b[i] = bp[i * 2]; }
#pragma unroll
    for (int i = 0; i < 8; ++i) if (i < ks) acc = __builtin_amdgcn_mfma_f32_32x32x16_bf16(a[i], b[i], acc, 0, 0, 0);
    return acc;
}
__device__ __forceinline__ f32x16 skinny_reduce(Frame& F, f32x16 part, int slot) {
    LAS float* red = (LAS float*)(F.lds + RING_OFF) + slot * 8192;
#pragma unroll
    for (int r = 0; r < 16; ++r) red[(F.wave * 16 + r) * 64 + F.lane] = part[r];
    __syncthreads();
    f32x16 s = {};
    if (F.wave == 0) {
#pragma unroll 2
        for (int w = 0; w < NWAVES; ++w)
#pragma unroll
            for (int r = 0; r < 16; ++r) s[r] += red[(w * 16 + r) * 64 + F.lane]; }
    return s;
}
__device__ __forceinline__ int mrow(int r, int hi) { return (r & 3) + 8 * (r >> 2) + 4 * hi; }
__device__ __forceinline__ void st_bf(bf16* p, float v) { *(GAS bf16*)p = (bf16)f2bf(v); }
__device__ __forceinline__ void skinny_p1(Frame& F, const Args& A, int l, int cb) {
    const int lane = F.lane, c = cb * 32 + (lane & 31), hi = lane >> 5;
    const bf16* HBm = (const bf16*)(F.ws + WS_HB) + (size_t)MREAL * 1024; const bf16* W = (const bf16*)(F.ws + WS_W + (size_t)l * WL_STRIDE + WL_IN);
    f32x16 acc = {}; acc = skinny_reduce(F, skinny32_part(HBm, 1024, W, 1024, 1024, cb, lane, F.wave, acc), 0); __syncthreads(); if (F.wave != 0) return;
    if (c < 512) { bf16* UM = (bf16*)(F.ws + WS_UMETA);
#pragma unroll
        for (int r = 0; r < 16; ++r) st_bf(UM + (size_t)mrow(r, hi) * 512 + c, acc[r]); }
    else if (c < 2048) { bf16* CB = (bf16*)(F.ws + WS_CONV);
#pragma unroll
        for (int r = 0; r < 16; ++r) st_bf(CB + (size_t)(MREAL + mrow(r, hi)) * 1536 + (c - 512), acc[r]); }
    else if (c < 4096) { const bool isq = c < 3072; const int cc = c - (isq ? 2048 : 3072), hh = cc >> 6, g = (cc & 63) >> 3, i8 = cc & 7, j = 4 * g + (i8 & 3), d = i8 < 4 ? j : 32 + j;
        const float* rope = (const float*)(F.ws + WS_ROPE); bf16* dst = isq ? (bf16*)(F.ws + WS_Q) : (bf16*)(F.ws + WS_K);
#pragma unroll
        for (int r = 0; r < 16; ++r) { const int m = mrow(r, hi), pos = m & 15; const float v = acc[r], pv = __shfl_xor(v, 4); const float cs = rope[(size_t)pos * 64 + j], sn = rope[(size_t)pos * 64 + 32 + j];
            float o = i8 < 4 ? v * cs - pv * sn : v * cs + pv * sn; if (isq) o *= pg8::QSCALE;
            const size_t drow = isq ? (size_t)(MREAL + m) : (size_t)pg8::kv_row(MREAL + m); st_bf(dst + drow * 1024 + hh * 64 + d, o); } }
    else if (c < 5120) { bf16* V = (bf16*)(F.ws + WS_V);
#pragma unroll
        for (int r = 0; r < 16; ++r) st_bf(V + (size_t)pg8::kv_row(MREAL + mrow(r, hi)) * 1024 + (c - 4096), acc[r]); }
    else { bf16* GB = (bf16*)(F.ws + WS_GB); const float gb = A.in[I_GATEB][(size_t)l * 3072 + (c - 5120)];
#pragma unroll
        for (int r = 0; r < 16; ++r) st_bf(GB + (size_t)(MREAL + mrow(r, hi)) * 3072 + (c - 5120), sigm_(acc[r] + gb)); }
}
__device__ __forceinline__ void skinny_glu(Frame& F, int l, int cb) {
    const int lane = F.lane, c = cb * 32 + (lane & 31), hi = lane >> 5;
    const bf16* YG = (const bf16*)(F.ws + WS_YG); bf16* YS = (bf16*)(F.ws + WS_YS);
    f32x16 acc = {}; acc = skinny_reduce(F, skinny32_part(YG + (size_t)MREAL * 512, 512, (const bf16*)(F.ws + WS_W + (size_t)l * WL_STRIDE + WL_GLU), 512, 512, cb, lane, F.wave, acc), 0); __syncthreads(); if (F.wave != 0) return;
#pragma unroll
    for (int r = 0; r < 16; ++r) { const size_t R = MREAL + mrow(r, hi); const float y = __uint_as_float((unsigned)(*(const GAS bf16*)(YG + R * 512 + c)) << 16); st_bf(YS + R * 512 + c, y * sigm_(acc[r])); }
}
__device__ __forceinline__ void skinny_merge(Frame& F, int l, int cb) {
    const int lane = F.lane, c = cb * 32 + (lane & 31), hi = lane >> 5; unsigned char* wl = F.ws + WS_W + (size_t)l * WL_STRIDE;
    const bf16* GB = (const bf16*)(F.ws + WS_GB); bf16* MG = (bf16*)(F.ws + WS_MG);
    f32x16 z = {};
    LAS float* red = (LAS float*)(F.lds + RING_OFF);
    { const f32x16 p0 = skinny32_part((const bf16*)(F.ws + WS_YS) + (size_t)MREAL * 512, 512, (const bf16*)(wl + WL_SO), 512, 512, cb, lane, F.wave, z);
#pragma unroll
      for (int r = 0; r < 16; ++r) red[(F.wave * 16 + r) * 64 + lane] = p0[r]; }
    asm volatile("" ::: "memory");
    { const f32x16 p1 = skinny32_part((const bf16*)(F.ws + WS_YC) + (size_t)MREAL * 512, 512, (const bf16*)(wl + WL_CO), 512, 512, cb, lane, F.wave, z);
#pragma unroll
      for (int r = 0; r < 16; ++r) red[8192 + (F.wave * 16 + r) * 64 + lane] = p1[r]; }
    asm volatile("" ::: "memory");
    { const f32x16 p2 = skinny32_part((const bf16*)(F.ws + WS_YA) + (size_t)MREAL * 1024, 1024, (const bf16*)(wl + WL_AO), 1024, 1024, cb, lane, F.wave, z);
#pragma unroll
      for (int r = 0; r < 16; ++r) red[16384 + (F.wave * 16 + r) * 64 + lane] = p2[r]; }
    __syncthreads();
    f32x16 a0 = {}, a1 = {}, a2 = {};
    if (F.wave == 0) {
#pragma unroll 1
        for (int w = 0; w < NWAVES; ++w)
#pragma unroll
            for (int r = 0; r < 16; ++r) { a0[r] += red[(w * 16 + r) * 64 + lane]; a1[r] += red[8192 + (w * 16 + r) * 64 + lane]; a2[r] += red[16384 + (w * 16 + r) * 64 + lane]; } }
    __syncthreads(); if (F.wave != 0) return;
#pragma unroll
    for (int r = 0; r < 16; ++r) { const size_t R = MREAL + mrow(r, hi); const bf16* g = GB + R * 3072 + c;
        const float g0 = __uint_as_float((unsigned)(*(const GAS bf16*)g) << 16), g1 = __uint_as_float((unsigned)(*(const GAS bf16*)(g + 1024)) << 16), g2 = __uint_as_float((unsigned)(*(const GAS bf16*)(g + 2048)) << 16);
        st_bf(MG + R * 1024 + c, g0 * a0[r] + g1 * a1[r] + g2 * a2[r]); }
}
__device__ __forceinline__ void skinny_pre(Frame& F, int l, int cb) {
    const int lane = F.lane, c = cb * 32 + (lane & 31), hi = lane >> 5;
    const bf16* HBm = (const bf16*)(F.ws + WS_HB); float* PRE = (float*)(F.ws + WS_PRE);
    f32x16 acc = {}; acc = skinny_reduce(F, skinny32_part((const bf16*)(F.ws + WS_MG) + (size_t)MREAL * 1024, 1024, (const bf16*)(F.ws + WS_W + (size_t)l * WL_STRIDE + WL_WO), 1024, 1024, cb, lane, F.wave, acc), 0); __syncthreads(); if (F.wave != 0) return;
#pragma unroll
    for (int r = 0; r < 16; ++r) { const size_t R = MREAL + mrow(r, hi); *(GAS float*)(PRE + R * 1024 + c) = ALPHA * __uint_as_float((unsigned)(*(const GAS bf16*)(HBm + R * 1024 + c)) << 16) + acc[r]; }
}
#define SKINNY_JOBS(n, call) do { for (int j_ = F.vcu; j_ < (n); j_ += F.G) { const int cb = j_; call; __syncthreads(); } } while (0)

#if defined(SELFCHK)
constexpr int CW_FAIL = 2048;
__device__ __forceinline__ void chk_report(Frame& F, int id, float got, float ref, float scale) {
    const float err = fabsf(got - ref);
    if (!(err <= 0.03f * fabsf(ref) + 0.03f * scale)) __hip_atomic_fetch_or(F.ctl + CW_FAIL, 1u << (id + F.chk_l * 16), RLX_AGENT);
}
__device__ __forceinline__ float bfr(float x) { return __uint_as_float(f2bf(x) << 16); }
__device__ __forceinline__ float ldbf(const bf16* p) { return __uint_as_float((unsigned)(*(const GAS bf16*)p) << 16); }
__device__ __forceinline__ float dot_bf_w(const bf16* a, const float* W, int K, int ldw, int col, int lane) {
    float s = 0.f; for (int k = lane; k < K; k += 64) s += ldbf(a + k) * bfr(W[(size_t)k * ldw + col]); return wave_sum(s);
}
__constant__ int SMP_ROWS[16] = {0, 1, 2, 63, 64, 100, 255, 256, 8191, 8192, 8193, 12345, 16383, 16384, 16399, 16415};
__constant__ int SMP_SP[12] = {0, 15, 16, 17, 79, 80, 81, 143, 144, 1000, 4111, 8207};
__device__ __forceinline__ int smp_row(int i) { return SMP_ROWS[i]; }
__device__ __forceinline__ void chk_p1(Frame& F, const Args& A, int l) {
    const int gw = F.vcu * NWAVES + F.wave, NGW = F.G * NWAVES, lane = F.lane;
    const bf16* HB = (const bf16*)(F.ws + WS_HB); const float* Win = A.in[I_WIN] + (size_t)l * 1024 * 5120; const float* Wg = A.in[I_GATEW] + (size_t)l * 1024 * 3072;
    const float* ROPE = (const float*)(F.ws + WS_ROPE);
    for (int job = gw; job < 16 * 24; job += NGW) { const int R = smp_row(job / 24), ci = job % 24; const bf16* a = HB + (size_t)R * 1024;
        if (ci < 4) { const int c = (ci * 171 + 5) & 511; const float ref = dot_bf_w(a, Win, 1024, 5120, c, lane); float got;
            if (R < MREAL) { const int g = c >> 4, chunkrow = (R >> 13) * 128 + ((R & 8191) >> 6), s = R & 63; got = ldbf((const bf16*)(F.ws + WS_UC) + ((size_t)(g * 256 + chunkrow) * 1152 + s * 16 + (c & 15))); }
            else got = ldbf((const bf16*)(F.ws + WS_UMETA) + (size_t)(R - MREAL) * 512 + c);
            if (lane == 0) chk_report(F, 1, got, ref, 1.0f); }
        else if (ci < 8) { const int c = ((ci - 4) * 397 + 11) % 1536; const float ref = dot_bf_w(a, Win, 1024, 5120, 512 + c, lane); const float got = ldbf((const bf16*)(F.ws + WS_CONV) + (size_t)R * 1536 + c);
            if (lane == 0) chk_report(F, 1, got, ref, 1.0f); }
        else if (ci < 16) { const bool isq = ci < 12; const int cc = ((ci & 3) * 277 + 33) & 1023, hh = cc >> 6, d = cc & 63, j = d & 31;
            const int base = (isq ? 2048 : 3072) + hh * 64; const float xl = dot_bf_w(a, Win, 1024, 5120, base + j, lane), xh = dot_bf_w(a, Win, 1024, 5120, base + 32 + j, lane);
            const int pos = R < MREAL ? 16 + (R & 8191) : ((R - MREAL) & 15); const float cs = ROPE[(size_t)pos * 64 + j], sn = ROPE[(size_t)pos * 64 + 32 + j];
            float ref = d < 32 ? xl * cs - xh * sn : xh * cs + xl * sn; if (isq) ref *= pg8::QSCALE;
            const float got = isq ? ldbf((const bf16*)(F.ws + WS_Q) + (size_t)R * 1024 + cc) : ldbf((const bf16*)(F.ws + WS_K) + (size_t)pg8::kv_row(R) * 1024 + cc);
            if (lane == 0) chk_report(F, 2, got, ref, isq ? 0.2f : 1.0f); }
        else if (ci < 20) { const int c = ((ci - 16) * 301 + 7) & 1023; const float ref = dot_bf_w(a, Win, 1024, 5120, 4096 + c, lane); const float got = ldbf((const bf16*)(F.ws + WS_V) + (size_t)pg8::kv_row(R) * 1024 + c);
            if (lane == 0) chk_report(F, 3, got, ref, 0.5f); }
        else { const int c = ((ci - 20) * 811 + 3) % 3072; const float ref = sigm_(dot_bf_w(a, Wg, 1024, 3072, c, lane) + A.in[I_GATEB][(size_t)l * 3072 + c]); const float got = ldbf((const bf16*)(F.ws + WS_GB) + (size_t)R * 3072 + c);
            if (lane == 0) chk_report(F, 3, got, ref, 0.3f); }
    }
}
__device__ __forceinline__ float u_at(Frame& F, int b, int sp, int c) {
    if (sp < 16) return ldbf((const bf16*)(F.ws + WS_UMETA) + (size_t)(b * 16 + sp) * 512 + c);
    const int t = sp - 16; return ldbf((const bf16*)(F.ws + WS_UC) + ((size_t)((c >> 4) * 256 + b * 128 + (t >> 6)) * 1152 + (t & 63) * 16 + (c & 15)));
}
__device__ __forceinline__ int seq_row(int b, int sp) { return sp < 16 ? MREAL + b * 16 + sp : b * 8192 + (sp - 16); }
__device__ __forceinline__ void chk_ssm_conv(Frame& F, const Args& A, int l) {
    const int gw = F.vcu * NWAVES + F.wave, NGW = F.G * NWAVES, lane = F.lane;
    LAS float* scr = (LAS float*)(F.lds + RING_OFF + F.wave * 16384);
#pragma unroll 1
    for (int job = gw; job < 2 * 12 * 3; job += NGW) { const int b = job / 36, si = (job / 3) % 12, gi = job % 3; const int g = gi == 0 ? 0 : gi == 1 ? 13 : 31;
        const int sp = SMP_SP[si];
        const int lg = l * 32 + g, p = lane; const float lr = A.in[I_LAMRE][lg * 64 + p], li = A.in[I_LAMIM][lg * 64 + p], dt = expf(A.in[I_LOGDT][lg]);
        const float mag = __expf(lr * dt), ar = mag * __cosf(li * dt), ai = mag * __sinf(li * dt), nr = ar - 1.0f, den = lr * lr + li * li;
        const float cr = (nr * lr + ai * li) / den, ci = (ai * lr - nr * li) / den;
        float bbr[16], bbi[16];
#pragma unroll
        for (int c = 0; c < 16; ++c) { const float br = A.in[I_BRE][(size_t)(lg * 64 + p) * 16 + c], bi = A.in[I_BIM][(size_t)(lg * 64 + p) * 16 + c]; bbr[c] = cr * br - ci * bi; bbi[c] = cr * bi + ci * br; }
        float xr = 0.f, xi = 0.f;
#pragma unroll 1
        for (int s = 0; s <= sp; ++s) { float bur = 0.f, bui = 0.f, ua[8], ub[8];
            const bf16* up = s < 16 ? (const bf16*)(F.ws + WS_UMETA) + (size_t)(b * 16 + s) * 512 + g * 16 : (const bf16*)(F.ws + WS_UC) + ((size_t)(g * 256 + b * 128 + ((s - 16) >> 6)) * 1152 + ((s - 16) & 63) * 16);
            unpk8(*(const GAS v4u*)up, ua); unpk8(*(const GAS v4u*)(up + 8), ub);
#pragma unroll
            for (int c = 0; c < 8; ++c) { bur += bbr[c] * ua[c] + bbr[8 + c] * ub[c]; bui += bbi[c] * ua[c] + bbi[8 + c] * ub[c]; }
            const float n1 = ar * xr - ai * xi + bur, n2 = ar * xi + ai * xr + bui; xr = n1; xi = n2; }
        scr[lane] = xr; scr[64 + lane] = xi; LDS_WAIT(); asm volatile("" ::: "memory");
        if (lane < 16) { const int co = lane; float y = 0.f;
#pragma unroll 1
            for (int q = 0; q < 64; ++q) y += A.in[I_CRE][(size_t)(lg * 16 + co) * 64 + q] * scr[q] - A.in[I_CIM][(size_t)(lg * 16 + co) * 64 + q] * scr[64 + q];
            y += A.in[I_SSMD][l * 512 + g * 16 + co] * u_at(F, b, sp, g * 16 + co);
            const float ref = gelu_(y), got = ldbf((const bf16*)(F.ws + WS_YG) + (size_t)seq_row(b, sp) * 512 + g * 16 + co);
            chk_report(F, sp < 16 ? 4 : 5, got, ref, 0.3f); }
        LDS_WAIT(); asm volatile("" ::: "memory");
    }
    for (int job = gw; job < 16; job += NGW) { const int R = smp_row(job), c = (lane * 37 + 5) & 511; const bf16* CB = (const bf16*)(F.ws + WS_CONV);
        float y = 0.f;
#pragma unroll 1
        for (int k = 0; k < 3; ++k) { const int r = k == 0 ? R : prev_row(R, k); if (r >= 0) y += A.in[I_CONVW][(size_t)l * 1536 + (2 - k) * 512 + c] * ldbf(CB + (size_t)r * 1536 + 512 + c) * ldbf(CB + (size_t)r * 1536 + 1024 + c); }
        const float ref = y * ldbf(CB + (size_t)R * 1536 + c), got = ldbf((const bf16*)(F.ws + WS_YC) + (size_t)R * 512 + c);
        chk_report(F, 6, got, ref, 0.5f); }
}
__device__ __forceinline__ void chk_attn(Frame& F) {
    const int gw = F.vcu * NWAVES + F.wave, NGW = F.G * NWAVES, lane = F.lane;
    const bf16* Q = (const bf16*)(F.ws + WS_Q); const bf16* K = (const bf16*)(F.ws + WS_K); const bf16* V = (const bf16*)(F.ws + WS_V); const bf16* OC = (const bf16*)(F.ws + WS_OC);
    for (int job = gw; job < 16 * 3; job += NGW) { const int R = smp_row(job / 3), hi_ = job % 3, hc = hi_ == 0 ? 0 : hi_ == 1 ? 5 : 15, h = hc >> 1;
        const int b = R < MREAL ? (R >> 13) : ((R - MREAL) >> 4); const int nreal = R < MREAL ? (((R & 8191) >> 6) + 1) * 64 : 0, nk = 16 + nreal;
        const float q = ldbf(Q + (size_t)R * 1024 + hc * 64 + lane);
        float m = -INFINITY;
        for (int j = 0; j < nk; ++j) { const size_t kr = (size_t)b * 8320 + (j < 16 ? 8256 + j : j - 16); const float s = wave_sum(q * ldbf(K + kr * 1024 + hc * 64 + lane)); m = fmaxf(m, s); }
        float lsum = 0.f, o0 = 0.f, o1 = 0.f;
        for (int j = 0; j < nk; ++j) { const size_t kr = (size_t)b * 8320 + (j < 16 ? 8256 + j : j - 16); const float s = wave_sum(q * ldbf(K + kr * 1024 + hc * 64 + lane)); const float p = exp2f(s - m);
            lsum += p; o0 += p * ldbf(V + kr * 1024 + h * 128 + 2 * lane); o1 += p * ldbf(V + kr * 1024 + h * 128 + 2 * lane + 1); }
        const float g0 = ldbf(OC + (size_t)R * 2048 + hc * 128 + 2 * lane), g1 = ldbf(OC + (size_t)R * 2048 + hc * 128 + 2 * lane + 1);
        chk_report(F, R < MREAL ? 7 : 8, g0, o0 / lsum, 0.05f); chk_report(F, R < MREAL ? 7 : 8, g1, o1 / lsum, 0.05f); }
}
__device__ __forceinline__ void chk_mix(Frame& F, const Args& A, int l) {
    const int gw = F.vcu * NWAVES + F.wave, NGW = F.G * NWAVES, lane = F.lane;
    const bf16* YG = (const bf16*)(F.ws + WS_YG); const bf16* YS = (const bf16*)(F.ws + WS_YS); const bf16* YC = (const bf16*)(F.ws + WS_YC); const bf16* YA = (const bf16*)(F.ws + WS_YA);
    const bf16* GB = (const bf16*)(F.ws + WS_GB); const bf16* MG = (const bf16*)(F.ws + WS_MG); const bf16* OC = (const bf16*)(F.ws + WS_OC);
    for (int job = gw; job < 16 * 4; job += NGW) { const int R = smp_row(job >> 2), ci = job & 3;
        { const int c = (ci * 139 + 21) & 511; const float z = dot_bf_w(YG + (size_t)R * 512, A.in[I_WGLU] + (size_t)l * 512 * 512, 512, 512, c, lane); const float ref = ldbf(YG + (size_t)R * 512 + c) * sigm_(z);
          if (lane == 0) chk_report(F, 9, ldbf(YS + (size_t)R * 512 + c), ref, 0.2f); }
        { const int h = (ci * 3 + 1) & 7; const float lam_init = 0.8f - 0.6f * expf(-0.3f * (float)l);
          const float d1 = wave_sum(A.in[I_LQ1][l * 64 + lane] * A.in[I_LK1][l * 64 + lane]), d2 = wave_sum(A.in[I_LQ2][l * 64 + lane] * A.in[I_LK2][l * 64 + lane]); const float lam = expf(d1) - expf(d2) + lam_init;
          const float a0 = ldbf(OC + (size_t)R * 2048 + (2 * h) * 128 + lane) - lam * ldbf(OC + (size_t)R * 2048 + (2 * h + 1) * 128 + lane), a1 = ldbf(OC + (size_t)R * 2048 + (2 * h) * 128 + 64 + lane) - lam * ldbf(OC + (size_t)R * 2048 + (2 * h + 1) * 128 + 64 + lane);
          const float rs = 1.0f / sqrtf(wave_sum(a0 * a0 + a1 * a1) * (1.0f / 128.0f) + 1e-5f);
          chk_report(F, 10, ldbf(YA + (size_t)R * 1024 + h * 128 + lane), a0 * rs * A.in[I_SUBLN][l * 128 + lane] * (1.0f - lam_init), 0.3f);
          chk_report(F, 10, ldbf(YA + (size_t)R * 1024 + h * 128 + 64 + lane), a1 * rs * A.in[I_SUBLN][l * 128 + 64 + lane] * (1.0f - lam_init), 0.3f); }
        { const int c = (ci * 269 + 77) & 1023;
          const float p0 = dot_bf_w(YS + (size_t)R * 512, A.in[I_SSMWO] + (size_t)l * 512 * 1024, 512, 1024, c, lane), p1 = dot_bf_w(YC + (size_t)R * 512, A.in[I_CONVWO] + (size_t)l * 512 * 1024, 512, 1024, c, lane),
                      p2 = dot_bf_w(YA + (size_t)R * 1024, A.in[I_ATTNWO] + (size_t)l * 1024 * 1024, 1024, 1024, c, lane);
          const float ref = ldbf(GB + (size_t)R * 3072 + c) * p0 + ldbf(GB + (size_t)R * 3072 + 1024 + c) * p1 + ldbf(GB + (size_t)R * 3072 + 2048 + c) * p2;
          if (lane == 0) chk_report(F, 11, ldbf(MG + (size_t)R * 1024 + c), ref, 0.3f);
          const float pr = dot_bf_w(MG + (size_t)R * 1024, A.in[I_WO] + (size_t)l * 1024 * 1024, 1024, 1024, c, lane);
          if (lane == 0) chk_report(F, 12, ((const float*)(F.ws + WS_PRE))[(size_t)R * 1024 + c], ALPHA * ((const float*)(F.ws + WS_HF))[(size_t)R * 1024 + c] + pr, 0.5f); }
    }
}
__device__ __forceinline__ void chk_moe(Frame& F, const Args& A, int l) {
    const LAS int* tb = (const LAS int*)(F.lds + LDSCTL_OFF);
    const int gw = F.vcu * NWAVES + F.wave, NGW = F.G * NWAVES, lane = F.lane;
    const float* HF = (const float*)(F.ws + WS_HF); const bf16* HB = (const bf16*)(F.ws + WS_HB); const unsigned* TOKE = (const unsigned*)(F.ws + WS_TOKE); const float* TOKW = (const float*)(F.ws + WS_TOKW);
    LAS float* scr = (LAS float*)(F.lds + RING_OFF + F.wave * 16384);
    for (int job = gw; job < 16 * 4; job += NGW) { const int R = smp_row(job >> 2), k = job & 3;
        float lg_ = -INFINITY; if (lane < 32) { float s = 0.f; for (int q = 0; q < 1024; ++q) s += HF[(size_t)R * 1024 + q] * A.in[I_RW][(size_t)l * 32768 + q * 32 + lane]; lg_ = s + A.in[I_RB][l * 32 + lane]; }
        float val = lg_, tv[4]; int te[4];
#pragma unroll
        for (int kk = 0; kk < 4; ++kk) { const float m = wave_max(val); const int idx = wave_min_i(val == m ? lane : 99); tv[kk] = m; te[kk] = idx; if (lane == idx) val = -INFINITY; }
        const float den = 1.0f + expf(tv[1] - tv[0]) + expf(tv[2] - tv[0]) + expf(tv[3] - tv[0]);
        const unsigned tk = TOKE[(size_t)R * 4 + k]; const int e = tk & 255, pos = tk >> 8; const float w = TOKW[(size_t)R * 4 + k];
        const int ek = k == 0 ? te[0] : k == 1 ? te[1] : k == 2 ? te[2] : te[3]; const float wk = expf((k == 0 ? tv[0] : k == 1 ? tv[1] : k == 2 ? tv[2] : tv[3]) - tv[0]) / den;
        const float gap = tv[3] - wave_max(val);
        if (lane == 0 && gap > 1e-3f) { chk_report(F, 13, (float)e, (float)ek, 0.0f); chk_report(F, 13, w, wk, 0.01f); }
        if (((const int*)(F.ws + WS_ROWIDX))[(size_t)e * CAP + pos] != R && lane == 0) chk_report(F, 14, 1.0f, 0.0f, 0.0f);
        const float* wgu = A.in[I_WGU] + ((size_t)l * 32 + e) * 1024 * 2048; const float* bgu = A.in[I_BGU] + ((size_t)l * 32 + e) * 2048;
        for (int j = lane; j < 1024; j += 64) { float g = 0.f, u = 0.f; for (int q = 0; q < 1024; ++q) { const float x = ldbf(HB + (size_t)R * 1024 + q); g += x * bfr(wgu[(size_t)q * 2048 + j]); u += x * bfr(wgu[(size_t)q * 2048 + 1024 + j]); }
            g = fminf(g + bgu[j], 7.0f); u = fminf(fmaxf(u + bgu[1024 + j], -7.0f), 7.0f); scr[j] = bfr((u + 1.0f) * g * sigm_(1.702f * g)); }
        LDS_WAIT(); asm volatile("" ::: "memory");
        const float* wd = A.in[I_WDN] + ((size_t)l * 32 + e) * 1024 * 1024; const int c = (lane * 13 + k * 251) & 1023; float o = 0.f;
        for (int q = 0; q < 1024; ++q) o += scr[q] * bfr(wd[(size_t)q * 1024 + c]);
        o += A.in[I_BDN][((size_t)l * 32 + e) * 1024 + c];
        chk_report(F, 15, ldbf((const bf16*)(F.ws + WS_OUTS) + ((size_t)tb[e] * 256 + pos) * 1024 + c), o, 0.1f);
        LDS_WAIT(); asm volatile("" ::: "memory");
    }
}
#endif

#ifndef PHASE_MASK
#define PHASE_MASK 0x1fff
#endif
#define PH_ON(k) (((PHASE_MASK) >> (k)) & 1)
typedef const __attribute__((address_space(4))) Args* KArgs;
#define PHASE_ENV() KArgs kap_ = (KArgs)__builtin_amdgcn_kernarg_segment_ptr(); asm volatile("" : "+s"(kap_)); const Args& args = *(const Args*)kap_; unsigned char* ws = args.ws; F.ws = ws; F.ctl = (gu32*)(ws + WS_CTL); \
    { int t_ = threadIdx.x; asm volatile("" : "+v"(t_)); F.tid = t_; F.lane = t_ & 63; F.wave = __builtin_amdgcn_readfirstlane(t_ >> 6); } \
    int bid = (int)blockIdx.x; asm volatile("" : "+s"(bid)); F.G = gridDim.x; F.vcu = (F.G % 8 == 0) ? (bid % 8) * (F.G / 8) + bid / 8 : bid; \
    const int gw = F.vcu * NWAVES + F.wave, NGW = F.G * NWAVES; (void)gw; (void)NGW; \
    unsigned char* wl = ws + WS_W + (size_t)l * WL_STRIDE; bf16* HB = (bf16*)(ws + WS_HB); float* HF = (float*)(ws + WS_HF); (void)wl; (void)HB; (void)HF
__global__ void __launch_bounds__(NWAVES * 64, 2) mk_fwd(Args args_) {
    extern __shared__ __attribute__((aligned(16))) unsigned char lds[];
    Frame F;
    F.lds = (LAS unsigned char*)lds;
    F.MISC = (volatile LAS unsigned*)(F.lds + MISC_OFF);
    F.tid = threadIdx.x; F.lane = F.tid & 63; F.wave = __builtin_amdgcn_readfirstlane(F.tid >> 6);
    F.G = gridDim.x; { const int bx = blockIdx.x; F.vcu = (F.G % 8 == 0) ? (bx % 8) * (F.G / 8) + bx / 8 : bx; }
    F.ws = args_.ws; F.ctl = (gu32*)(args_.ws + WS_CTL);
    for (int u = F.tid; u < (LDS_BYTES - LDSCTL_OFF) / 4; u += NWAVES * 64) ((LAS unsigned*)(F.lds + LDSCTL_OFF))[u] = 0u;
    __syncthreads();
    XcdBarrier bar; bar.bar = (unsigned*)(F.ctl + CW_BAR); bar.x = 0; bar.st = nullptr;
    if (N_LAUNCHES == 1) bar = xcd_barrier_post((unsigned*)(F.ctl + CW_BAR), F.MISC + 8);
#define GRID_BAR() do { if (N_LAUNCHES != 1) { if (F.tid == 0) __hip_atomic_store(F.ctl + CW_TMO, 0xBADBA0u, RLX_AGENT); } else { xcd_barrier(bar); } } while (0)
    const int lo = args_.ph_lo, hi = args_.ph_hi;
#define IN(k) (lo <= (k) && (k) < hi)
#define BOTH(k) (IN(k) && IN((k) + 1))

    if (PH_ON(0) && IN(0)) { const int l = 0; PHASE_ENV(); p0_prologue(F, args); if (BOTH(0)) GRID_BAR(); }

    for (int l = 0; l < NLAYER; ++l) {
        const int pb = 1 + 12 * l;
        if (PH_ON(1) && IN(pb + 0)) { PHASE_ENV();
            pg8::Gemm g{HB, (const bf16*)(wl + WL_IN), 1024, 1024, 1024}; pg8::StaticOrder S; S.init(MREAL, NP1, F.G, bid);
            pg8::EpiP1 E{(bf16*)(ws + WS_UC), (bf16*)(ws + WS_UMETA), (bf16*)(ws + WS_CONV), (bf16*)(ws + WS_Q), (bf16*)(ws + WS_K), (bf16*)(ws + WS_V), (bf16*)(ws + WS_GB), (const float*)(ws + WS_ROPE), args.in[I_GATEB] + (size_t)l * 3072};
            pg8::gemm_phase<pg8::EpiP1, pg8::StaticOrder, PG8_ALIGN, PG8_SP2>(F.lds + RING_OFF, g, S, E);
            SKINNY_JOBS(256, skinny_p1(F, args, l, cb));
            if (BOTH(pb + 0)) GRID_BAR();
        }
        if (PH_ON(2) && IN(pb + 1)) { PHASE_ENV();
            for (int job = F.vcu; job < 64; job += F.G) ssm_pre_job(F, args, l, job >> 5, job & 31);
            if (BOTH(pb + 1)) GRID_BAR();
        }
        if (PH_ON(3) && IN(pb + 2)) { }
        if (PH_ON(4) && IN(pb + 3)) { PHASE_ENV();
            { pg8::Gemm g{(const bf16*)(ws + WS_UC), (const bf16*)(wl + WL_TOE), 1152, 1152, 1152}; pg8::FirstN S{128, 4, F.G, bid};
              pg8::EpiY E{(bf16*)(ws + WS_YG)};
              pg8::gemm_phase<pg8::EpiY, pg8::FirstN, PG8_ALIGN, PG8_SP2>(F.lds + RING_OFF, g, S, E); }
            { const attn_body::AttnTensors AT{(const attn_body::bf16*)(ws + WS_Q), (const attn_body::bf16*)(ws + WS_K), (const attn_body::bf16*)(ws + WS_V), (attn_body::bf16*)(ws + WS_OC)};
              const attn_body::StaticOrder S((int)F.G, bid);
              attn_body::attn_phase<attn_body::StaticOrder>((char*)lds + RING_OFF, AT, S); }
            conv_rows(F, args, l);
            for (int job = gw; job < 256; job += NGW) attn_meta_job(F, job >> 3, job & 7);
            if (BOTH(pb + 3)) GRID_BAR();
        }
        if (PH_ON(5) && IN(pb + 4)) { PHASE_ENV();
            pg8::Gemm g{(const bf16*)(ws + WS_YG), (const bf16*)(wl + WL_GLU), 512, 512, 512}; pg8::StaticOrder S; S.init(MREAL, 512, F.G, bid);
            pg8::EpiGLU E{(const bf16*)(ws + WS_YG), (bf16*)(ws + WS_YS)};
            pg8::gemm_phase<pg8::EpiGLU, pg8::StaticOrder, PG8_ALIGN, PG8_SP2>(F.lds + RING_OFF, g, S, E);
            SKINNY_JOBS(16, skinny_glu(F, l, cb));
            attn_combine_rows(F, args, l);
            if (BOTH(pb + 4)) GRID_BAR();
        }
        if (PH_ON(6) && IN(pb + 5)) { PHASE_ENV();
            pg8::StaticOrder S; S.init(MREAL, 1024, F.G, bid);
            SKINNY_JOBS(32, skinny_merge(F, l, cb));
            { pg8::Gemm g{(const bf16*)(ws + WS_YS), (const bf16*)(wl + WL_SO), 512, 512, 512}; pg8::EpiMerge<0> E{(const bf16*)(ws + WS_GB), (bf16*)(ws + WS_MG)};
              pg8::gemm_phase<pg8::EpiMerge<0>, pg8::StaticOrder, PG8_ALIGN, PG8_SP2>(F.lds + RING_OFF, g, S, E); }
            { pg8::Gemm g{(const bf16*)(ws + WS_YC), (const bf16*)(wl + WL_CO), 512, 512, 512}; pg8::EpiMerge<1> E{(const bf16*)(ws + WS_GB), (bf16*)(ws + WS_MG)};
              pg8::gemm_phase<pg8::EpiMerge<1>, pg8::StaticOrder, PG8_ALIGN, PG8_SP2>(F.lds + RING_OFF, g, S, E); }
            { pg8::Gemm g{(const bf16*)(ws + WS_YA), (const bf16*)(wl + WL_AO), 1024, 1024, 1024}; pg8::EpiMerge<2> E{(const bf16*)(ws + WS_GB), (bf16*)(ws + WS_MG)};
              pg8::gemm_phase<pg8::EpiMerge<2>, pg8::StaticOrder, PG8_ALIGN, PG8_SP2>(F.lds + RING_OFF, g, S, E); }
            if (BOTH(pb + 5)) GRID_BAR();
        }
        if (PH_ON(7) && IN(pb + 6)) { PHASE_ENV();
            pg8::Gemm g{(const bf16*)(ws + WS_MG), (const bf16*)(wl + WL_WO), 1024, 1024, 1024}; pg8::StaticOrder S; S.init(MREAL, 1024, F.G, bid);
            pg8::EpiPre E{HB, (float*)(ws + WS_PRE), ALPHA};
            pg8::gemm_phase<pg8::EpiPre, pg8::StaticOrder, PG8_ALIGN, PG8_SP2>(F.lds + RING_OFF, g, S, E);
            SKINNY_JOBS(32, skinny_pre(F, l, cb));
            if (BOTH(pb + 6)) GRID_BAR();
        }
        if (PH_ON(8) && IN(pb + 7)) { PHASE_ENV();
            ln1_router(F, args, l); if (BOTH(pb + 7)) GRID_BAR(); }
        if (PH_ON(9) && IN(pb + 8)) { PHASE_ENV(); moe_tables(F, l, true); moe_gather(F); if (BOTH(pb + 8)) GRID_BAR(); }
        if (PH_ON(10) && IN(pb + 9)) { PHASE_ENV();
            moe_tables(F, l);
            pg8::Gemm g{(const bf16*)(ws + WS_XG), (const bf16*)(wl + WL_GU), 1024, 1024, 1024}; pg8::MoeOrder S{(const LAS int*)(F.lds + LDSCTL_OFF), 8, F.G, bid};
            pg8::EpiSwiGLU E{(bf16*)(ws + WS_HID), args.in[I_BGU] + (size_t)l * 32 * 2048};
            pg8::gemm_phase<pg8::EpiSwiGLU, pg8::MoeOrder, PG8_ALIGN, PG8_SP2>(F.lds + RING_OFF, g, S, E);
            if (BOTH(pb + 9)) GRID_BAR();
        }
        if (PH_ON(11) && IN(pb + 10)) { PHASE_ENV();
            moe_tables(F, l);
            pg8::Gemm g{(const bf16*)(ws + WS_HID), (const bf16*)(wl + WL_DN), 1024, 1024, 1024}; pg8::MoeOrder S{(const LAS int*)(F.lds + LDSCTL_OFF), 4, F.G, bid};
            pg8::EpiDown E{(bf16*)(ws + WS_OUTS), args.in[I_BDN] + (size_t)l * 32 * 1024};
            pg8::gemm_phase<pg8::EpiDown, pg8::MoeOrder, PG8_ALIGN, PG8_SP2>(F.lds + RING_OFF, g, S, E);
            if (BOTH(pb + 10)) GRID_BAR();
        }
        if (PH_ON(12) && IN(pb + 11)) { PHASE_ENV(); moe_tables(F, l);
            ln2_rows(F, args, l); if (BOTH(pb + 11)) GRID_BAR(); }
    }
#undef IN
#undef BOTH
}


#if defined(SELFCHK)
__global__ void __launch_bounds__(NWAVES * 64, 2) mk_chk(Args args_) {
    extern __shared__ __attribute__((aligned(16))) unsigned char lds[];
    Frame F;
    F.lds = (LAS unsigned char*)lds; F.MISC = (volatile LAS unsigned*)(F.lds + MISC_OFF);
    F.tid = threadIdx.x; F.lane = F.tid & 63; F.wave = __builtin_amdgcn_readfirstlane(F.tid >> 6);
    F.G = gridDim.x; { const int bx = blockIdx.x; F.vcu = (F.G % 8 == 0) ? (bx % 8) * (F.G / 8) + bx / 8 : bx; }
    F.ws = args_.ws; F.ctl = (gu32*)(args_.ws + WS_CTL);
    KArgs kap_ = (KArgs)__builtin_amdgcn_kernarg_segment_ptr(); const Args& args = *(const Args*)kap_; const int l = args_.li; F.chk_l = l;
    if (args_.pad == 1) { chk_p1(F, args, l); chk_ssm_conv(F, args, l); chk_attn(F); chk_mix(F, args, l); }
    if (args_.pad == 2) { moe_tables(F, l); chk_moe(F, args, l); }
}
#endif
extern "C" void kernel_launch(void* const* d_in, const int* in_sizes, int n_in, void* d_out, int out_size, void* d_ws, size_t ws_size, hipStream_t stream) {
    static int grid = 0;
    if (grid == 0) {
        if (n_in != N_IN || in_sizes[0] != MREAL * 1024 || out_size != MREAL * 1024 || ws_size < WS_END) { fprintf(stderr, "kernel_launch: unexpected shapes (n_in %d, in0 %d, out %d, ws %zu < %zu); nothing launched\n", n_in, n_in > 0 ? in_sizes[0] : -1, out_size, ws_size, (size_t)WS_END); grid = -1; return; }
        int dev = 0, cus = 0, per_cu = 0;
        if (hipGetDevice(&dev) != hipSuccess || hipDeviceGetAttribute(&cus, hipDeviceAttributeMultiprocessorCount, dev) != hipSuccess) { grid = -1; return; }
#if defined(SELFCHK)
        (void)hipFuncSetAttribute((const void*)mk_chk, hipFuncAttributeMaxDynamicSharedMemorySize, LDS_BYTES);
#endif
        if (hipFuncSetAttribute((const void*)mk_fwd, hipFuncAttributeMaxDynamicSharedMemorySize, LDS_BYTES) != hipSuccess) { fprintf(stderr, "kernel_launch: hipFuncSetAttribute failed\n"); grid = -1; return; }
        if (hipOccupancyMaxActiveBlocksPerMultiprocessor(&per_cu, (const void*)mk_fwd, NWAVES * 64, LDS_BYTES) != hipSuccess || per_cu < 1)
            fprintf(stderr, "kernel_launch: note: occupancy query reports %d workgroups per CU\n", per_cu);
        (void)hipGetLastError();
        grid = cus;
        if (grid != 256) fprintf(stderr, "kernel_launch: %d CUs; the unit orders assume 256\n", grid);
    }
    if (grid < 0) return;
    if (hipMemsetAsync((char*)d_ws + WS_CTL, 0, CTL_ZERO_BYTES, stream) != hipSuccess) return;
    Args a{};
    for (int i = 0; i < N_IN; ++i) a.in[i] = (const float*)d_in[i];
    a.out = (float*)d_out; a.ws = (unsigned char*)d_ws;
    for (int li = 0; li < N_LAUNCHES; ++li) {
        a.ph_lo = (N_LAUNCHES == 1) ? 0 : li; a.ph_hi = (N_LAUNCHES == 1) ? NPH : li + 1; a.li = li; a.pad = 0;
        hipLaunchKernelGGL(mk_fwd, dim3(grid), dim3(NWAVES * 64), LDS_BYTES, stream, a);
        if (hipPeekAtLastError() != hipSuccess) { fprintf(stderr, "kernel_launch: launch %d failed\n", li); break; }
#if defined(SELFCHK)
        if (N_LAUNCHES == NPH && (li == 7 || li == 11 || li == 19 || li == 23)) { Args c = a; c.ph_lo = 1000; c.ph_hi = 1000; c.pad = (li == 7 || li == 19) ? 1 : 2; c.li = li > 12 ? 1 : 0; hipLaunchKernelGGL(mk_chk, dim3(grid), dim3(NWAVES * 64), LDS_BYTES, stream, c); }
#endif
    }
}
```
